# Optimizing an MI355X kernel written in HIP

```python
import jax, jax.numpy as jnp
from jax import lax
import numpy as np

D_MODEL = 1024
BATCH = 8
SEQ = 2048
DEPTH = 1
DEC_BATCH = 128
DEC_SEQ = 8
PAST_LEN = 16384
PAGE_SIZE = 128

MIX_WIDTH = D_MODEL
R_WIDTH = MIX_WIDTH // 2
G_WIDTH = MIX_WIDTH - R_WIDTH
N_R = 64
H_R = R_WIDTH // N_R
H_C = 8
N_C = G_WIDTH // H_C
CHUNK = 128
W_RANK = 64
A_RANK = 64
G_RANK = 128
R_COLS = 3 * R_WIDTH + W_RANK + A_RANK + G_RANK
P_COLS = R_COLS + 2 * G_WIDTH
R_SPLITS = (R_WIDTH, 2 * R_WIDTH, 3 * R_WIDTH, 3 * R_WIDTH + W_RANK, 3 * R_WIDTH + W_RANK + A_RANK)
D_FF = ((8 * D_MODEL // 3 + 127) // 128) * 128
N_MOD = 9
RMS_EPS = 1e-6
LN_EPS = 1e-5
GN_EPS = 64e-5

kernel_name = 'rwkv7_gmlp_hymba_macaron_adaln_step'


def _rms(x):
    xf = x.astype(jnp.float32)
    return (xf * lax.rsqrt(jnp.mean(xf * xf, -1, keepdims=True) + RMS_EPS)).astype(x.dtype)


def _swiglu(h, w_gu, w_dn):
    g, u = jnp.split(h @ w_gu, 2, axis=-1)
    return (jax.nn.silu(g) * u) @ w_dn


def _wkv_scan(r, w, k, v, aa, bb, s0):
    def step(s, inp):
        r_t, w_t, k_t, v_t, a_t, b_t = inp
        sa = jnp.einsum('bhvk,bhk->bhv', s, a_t)
        s = s * w_t[:, :, None, :] + sa[..., None] * b_t[:, :, None, :] + v_t[..., None] * k_t[:, :, None, :]
        return s, jnp.einsum('bhvk,bhk->bhv', s, r_t)
    xs = tuple(jnp.moveaxis(t, 1, 0) for t in (r, w, k, v, aa, bb))
    s, ys = lax.scan(step, s0, xs)
    return jnp.moveaxis(ys, 0, 1), s


def _chunk_mix(vn, w_s, b_s):
    B, T = vn.shape[0], vn.shape[1]
    n_chunks = -(-T // CHUNK)
    pad = n_chunks * CHUNK - T
    vp = jnp.pad(vn, ((0, 0), (0, pad), (0, 0), (0, 0))).reshape(B, n_chunks, CHUNK, H_C, N_C)
    ws = jnp.where(jnp.tril(jnp.ones((CHUNK, CHUNK), bool)), w_s, jnp.zeros_like(w_s))
    mixed = jnp.einsum('hij,bcjhd->bcihd', ws, vp) + b_s.T[None, None, :, :, None]
    return mixed.reshape(B, n_chunks * CHUNK, H_C, N_C)[:, :T]


def _layer(x, c, shift0, wkv0, w_ada, b_ada, ffn1_gu, ffn1_dn, w_in, mu_shift, w0, w_lora_up, a0,
           a_lora_up, g_lora_up, k_k, k_a, r_k, gn_w, gn_b, ln_v_g, ln_v_b, w_s, b_s, w_out,
           ffn2_gu, ffn2_dn):
    B, T, _ = x.shape
    dt = x.dtype
    mod = jax.nn.silu(c) @ w_ada + b_ada
    sh1, sc1, g1, sh2, sc2, g2, sh3, sc3, g3 = [m[:, None, :] for m in jnp.split(mod, N_MOD, axis=-1)]

    h = x + 0.5 * g1 * _swiglu(_rms(x) * (1 + sc1) + sh1, ffn1_gu, ffn1_dn)

    n = _rms(h) * (1 + sc2) + sh2
    p = n @ w_in
    p_r = p[..., :R_COLS]
    p_u = p[..., R_COLS:R_COLS + G_WIDTH]
    p_v = p[..., R_COLS + G_WIDTH:]

    prev = jnp.concatenate([shift0[:, None, :].astype(dt), p_r[:, :-1]], axis=1)
    xm = p_r + (prev - p_r) * mu_shift
    r, k, v, wd, ad, gd = jnp.split(xm, R_SPLITS, axis=-1)
    w_log = -jax.nn.softplus(-(w0 + jnp.tanh(wd) @ w_lora_up)) - 0.5
    decay = jnp.exp(-jnp.exp(w_log.astype(jnp.float32)))
    a = jax.nn.sigmoid(a0 + ad @ a_lora_up)
    g = jax.nn.sigmoid(gd) @ g_lora_up
    heads = lambda t: t.reshape(B, T, H_R, N_R)
    kk = heads(k * k_k).astype(jnp.float32)
    kk = kk / jnp.maximum(jnp.sqrt(jnp.sum(kk * kk, -1, keepdims=True)), 1e-12)
    k = k * (1 + (a - 1) * k_a)
    r_h, k_h, v_h, a_h = heads(r), heads(k), heads(v), heads(a)
    f32 = lambda t: t.astype(jnp.float32)
    y, s_new = _wkv_scan(f32(r_h), heads(decay), f32(k_h), f32(v_h), -kk, kk * f32(a_h),
                         wkv0.astype(jnp.float32))
    mu = jnp.mean(y, -1, keepdims=True)
    var = jnp.mean(jnp.square(y - mu), -1, keepdims=True)
    y = ((y - mu) * lax.rsqrt(var + GN_EPS)).reshape(B, T, R_WIDTH).astype(dt) * gn_w + gn_b
    y = y + (jnp.sum(r_h * k_h * r_k, -1, keepdims=True) * v_h).reshape(B, T, R_WIDTH)
    y_r = y * g

    pv = p_v.astype(jnp.float32)
    pm = jnp.mean(pv, -1, keepdims=True)
    pvar = jnp.mean(jnp.square(pv - pm), -1, keepdims=True)
    vn = ((pv - pm) * lax.rsqrt(pvar + LN_EPS)).astype(dt) * ln_v_g + ln_v_b
    mixed = _chunk_mix(vn.reshape(B, T, H_C, N_C), w_s, b_s).reshape(B, T, G_WIDTH)
    y_c = p_u * mixed

    h = h + g2 * (jnp.concatenate([y_r, y_c], axis=-1) @ w_out)

    h = h + 0.5 * g3 * _swiglu(_rms(h) * (1 + sc3) + sh3, ffn2_gu, ffn2_dn)
    return h, p_r[:, -1], s_new.astype(wkv0.dtype), vn


def setup_inputs(seed: int = 0) -> dict:
    key = jax.random.key(seed)
    ks = iter(jax.random.split(key, 40))
    nrm = lambda shape, s: jax.random.normal(next(ks), shape, jnp.float32) * s
    L, D = DEPTH, D_MODEL
    return {
        'x_prompt': nrm((BATCH, SEQ, D), 1.0),
        'x_sample': nrm((DEC_BATCH, DEC_SEQ, D), 1.0),
        'state_shift': nrm((L, DEC_BATCH, R_COLS), 1.0),
        'state_wkv': nrm((L, DEC_BATCH, H_R, N_R, N_R), 0.5),
        'c_prompt': nrm((BATCH, D), 1.0),
        'c_sample': nrm((DEC_BATCH, D), 1.0),
        'w_ada': nrm((L, D, N_MOD * D), D ** -0.5),
        'b_ada': nrm((L, N_MOD * D), 0.01),
        'ffn1_gu': nrm((L, D, 2 * D_FF), D ** -0.5),
        'ffn1_dn': nrm((L, D_FF, D), D_FF ** -0.5),
        'w_in': nrm((L, D, P_COLS), D ** -0.5),
        'mu_shift': jax.random.uniform(next(ks), (L, R_COLS), jnp.float32),
        'w0': jax.random.uniform(next(ks), (L, R_WIDTH), jnp.float32, minval=-6.0, maxval=1.0),
        'w_lora_up': nrm((L, W_RANK, R_WIDTH), 0.1),
        'a0': nrm((L, R_WIDTH), 0.1),
        'a_lora_up': nrm((L, A_RANK, R_WIDTH), 0.1),
        'g_lora_up': nrm((L, G_RANK, R_WIDTH), G_RANK ** -0.5),
        'k_k': 0.85 + nrm((L, R_WIDTH), 0.02),
        'k_a': 1.0 + nrm((L, R_WIDTH), 0.02),
        'r_k': nrm((L, H_R, N_R), 0.1),
        'gn_w': 1.0 + nrm((L, R_WIDTH), 0.02),
        'gn_b': nrm((L, R_WIDTH), 0.01),
        'ln_v_g': 1.0 + nrm((L, G_WIDTH), 0.02),
        'ln_v_b': nrm((L, G_WIDTH), 0.01),
        'w_s': nrm((L, H_C, CHUNK, CHUNK), CHUNK ** -0.5),
        'b_s': 1.0 + nrm((L, H_C, CHUNK), 0.02),
        'w_out': nrm((L, MIX_WIDTH, D), MIX_WIDTH ** -0.5),
        'ffn2_gu': nrm((L, D, 2 * D_FF), D ** -0.5),
        'ffn2_dn': nrm((L, D_FF, D), D_FF ** -0.5),
        'final_g': 1.0 + nrm((D,), 0.02),
    }


def reference(x_prompt, x_sample, state_shift, state_wkv, c_prompt, c_sample, w_ada, b_ada, ffn1_gu,
              ffn1_dn, w_in, mu_shift, w0, w_lora_up, a0, a_lora_up, g_lora_up, k_k, k_a, r_k, gn_w,
              gn_b, ln_v_g, ln_v_b, w_s, b_s, w_out, ffn2_gu, ffn2_dn, final_g):
    xp, xs = x_prompt, x_sample
    shp, wkp, shs, wks, cvs = [], [], [], [], []
    for l in range(DEPTH):
        lw = (w_ada[l], b_ada[l], ffn1_gu[l], ffn1_dn[l], w_in[l], mu_shift[l], w0[l], w_lora_up[l],
              a0[l], a_lora_up[l], g_lora_up[l], k_k[l], k_a[l], r_k[l], gn_w[l], gn_b[l], ln_v_g[l],
              ln_v_b[l], w_s[l], b_s[l], w_out[l], ffn2_gu[l], ffn2_dn[l])
        zero_shift = jnp.zeros((xp.shape[0], R_COLS), xp.dtype)
        zero_wkv = jnp.zeros((xp.shape[0], H_R, N_R, N_R), state_wkv.dtype)
        xp, sh_p, wk_p, _ = _layer(xp, c_prompt, zero_shift, zero_wkv, *lw)
        xs, sh_s, wk_s, v_s = _layer(xs, c_sample, state_shift[l], state_wkv[l], *lw)
        shp.append(sh_p); wkp.append(wk_p); shs.append(sh_s); wks.append(wk_s); cvs.append(v_s)
    y_prompt = _rms(xp) * final_g
    y_sample = _rms(xs) * final_g
    return (y_prompt, y_sample, jnp.stack(shp), jnp.stack(wkp), jnp.stack(shs), jnp.stack(wks), jnp.stack(cvs))
```

```cpp
#include <hip/hip_runtime.h>
#include <cstdio>
#include <cstdint>
#define MK_N_LAUNCHES 15
namespace pg8 {
#define PG8_LAS __attribute__((address_space(3)))
typedef unsigned short bf16_t;
typedef short bf16x8 __attribute__((ext_vector_type(8)));
typedef float f32x4 __attribute__((ext_vector_type(4)));
typedef unsigned u32x4 __attribute__((ext_vector_type(4)));
constexpr int BM = 256, BK = 64, HALF = 128, HTB = HALF * BK * 2  , STAGE_BYTES = 8 * HTB, NXCD = 8, WGM = 8;

__host__ __device__ __forceinline__ int lds_byte(int r, int c) { const int st = (r >> 4) * 2 + (c >> 5), rr = r & 15, cc = c & 31, ob = rr * 64 + cc * 2; return st * 1024 + (ob ^ (((ob >> 9) & 1) << 5)); }
__host__ __device__ __forceinline__ void stage_rc(int b, int& R, int& C) { const int st = b / 1024, sb = b % 1024, swz = sb ^ (((sb >> 9) & 1) << 5); R = (st >> 1) * 16 + swz / 64; C = (st & 1) * 32 + (swz % 64) / 2; }
__host__ __device__ __forceinline__ int perm32(int rho) { const int n = rho >> 4, i = rho & 15; return 8 * (i >> 2) + 4 * n + (i & 3); }

struct Unit { int pm, pn; };
struct Gemm { const bf16_t* A; const bf16_t* Bt; int M, N, K; };

struct StaticOrder {
    int nM, nN, nwg, G, c;
    __host__ __device__ void init(int M, int N, int G_, int c_) { nM = M / BM; nN = N / BM; nwg = nM * nN; G = G_; c = c_; }
    __host__ __device__ bool next(int i, Unit& u) const {
        const long L = (long)i * G + c; if (L >= nwg) return false;
        int wgid = (int)L; { const int q = nwg / NXCD, r = nwg % NXCD, xcd = wgid % NXCD, off = wgid / NXCD; wgid = (xcd < r ? xcd * (q + 1) : r * (q + 1) + (xcd - r) * q) + off; }
        const int nig = WGM * nN, gid = wgid / nig, fm = gid * WGM, gsz = (nM - fm) < WGM ? (nM - fm) : WGM;
        u.pm = fm + ((wgid % nig) % gsz); u.pn = (wgid % nig) / gsz; return true;
    }
    __device__ __forceinline__ void a_ready(const Unit&) const {}
    __device__ __forceinline__ void done(const Unit&) const {}
};

__device__ __forceinline__ unsigned cvt_pk_bf16(float lo, float hi) { unsigned r; asm volatile("v_cvt_pk_bf16_f32 %0, %1, %2" : "=v"(r) : "v"(lo), "v"(hi)); return r; }
typedef float f32x2 __attribute__((ext_vector_type(2)));
constexpr int ROWS_P = 16384, ROWS_ALL = 17408, DM = 1024, MODW = 9216, FFW = 2816, RCOLS = 1792;
__device__ __forceinline__ int seq_of_row(int r) { return r < ROWS_P ? (r >> 11) : 8 + ((r - ROWS_P) >> 3); }
__device__ __forceinline__ bool row_is_first(int r) { return r < ROWS_P ? ((r & 2047) == 0) : (((r - ROWS_P) & 7) == 0); }
__device__ __forceinline__ bool row_is_last(int r) { return r < ROWS_P ? ((r & 2047) == 2047) : (((r - ROWS_P) & 7) == 7); }
__device__ __forceinline__ float silu_f(float x) { return x * __builtin_amdgcn_rcpf(1.0f + __builtin_amdgcn_exp2f(-1.4426950408889634f * x)); }

struct EpiSwiglu {
    static constexpr bool PERM = true, AFTER_DRAIN = false;
    bf16_t* O;
    __device__ __forceinline__ void operator()(const f32x4 (&acc)[2][2][4][2], const Unit& u, int wr, int wc, int fr, int fq) const {
        const int row0 = u.pm * BM + wr * 64 + fr, col0 = u.pn * HALF + wc * 32 + 8 * fq;
#pragma unroll
        for (int ai = 0; ai < 2; ++ai)
#pragma unroll
            for (int m = 0; m < 4; ++m) {
                bf16_t* rowp = O + (size_t)(row0 + ai * HALF + m * 16) * FFW + col0;
                const f32x4 g0 = acc[ai][0][m][0], g1 = acc[ai][0][m][1], u0 = acc[ai][1][m][0], u1 = acc[ai][1][m][1];
                u32x4 w;
                w.x = cvt_pk_bf16(silu_f(g0[0]) * u0[0], silu_f(g0[1]) * u0[1]); w.y = cvt_pk_bf16(silu_f(g0[2]) * u0[2], silu_f(g0[3]) * u0[3]);
                w.z = cvt_pk_bf16(silu_f(g1[0]) * u1[0], silu_f(g1[1]) * u1[1]); w.w = cvt_pk_bf16(silu_f(g1[2]) * u1[2], silu_f(g1[3]) * u1[3]);
                *(u32x4*)rowp = w;
            }
    }
};
struct EpiResid {
    static constexpr bool PERM = false, AFTER_DRAIN = false;
    const float* resP; const float* resS; float* out; const float* gate; float coef;
    __device__ __forceinline__ void operator()(const f32x4 (&acc)[2][2][4][2], const Unit& u, int wr, int wc, int fr, int fq) const {
        const int col0 = u.pn * BM + wc * 32 + 4 * fq;
#pragma unroll
        for (int ai = 0; ai < 2; ++ai)
#pragma unroll
            for (int m = 0; m < 4; ++m) {
                const int row = u.pm * BM + ai * HALF + wr * 64 + m * 16 + fr; const int s = seq_of_row(row);
                const float* rrow = (row < ROWS_P ? resP + (size_t)row * DM : resS + (size_t)(row - ROWS_P) * DM) + col0;
                float* orow = out + (size_t)row * DM + col0; const float* grow = gate + (size_t)s * MODW + col0;
#pragma unroll
                for (int bj = 0; bj < 2; ++bj)
#pragma unroll
                    for (int n = 0; n < 2; ++n) { const int off = bj * HALF + n * 16; const f32x4 r = *(const f32x4*)(rrow + off), g = *(const f32x4*)(grow + off);
                        *(f32x4*)(orow + off) = r + (g * coef) * acc[ai][bj][m][n]; }
            }
    }
};
struct EpiP {
    static constexpr bool PERM = true, AFTER_DRAIN = false;
    bf16_t* P; float* shp; float* shs;
    __device__ __forceinline__ void operator()(const f32x4 (&acc)[2][2][4][2], const Unit& u, int wr, int wc, int fr, int fq) const {
        const int row0 = u.pm * BM + wr * 64 + fr, col0 = u.pn * BM + wc * 32 + 8 * fq;
#pragma unroll
        for (int ai = 0; ai < 2; ++ai)
#pragma unroll
            for (int m = 0; m < 4; ++m) {
                const int row = row0 + ai * HALF + m * 16; const bool last = row_is_last(row);
                bf16_t* rowp = P + (size_t)row * FFW + col0;
#pragma unroll
                for (int bj = 0; bj < 2; ++bj) { const f32x4 v0 = acc[ai][bj][m][0], v1 = acc[ai][bj][m][1]; const int col = col0 + bj * HALF;
                    u32x4 w; w.x = cvt_pk_bf16(v0[0], v0[1]); w.y = cvt_pk_bf16(v0[2], v0[3]); w.z = cvt_pk_bf16(v1[0], v1[1]); w.w = cvt_pk_bf16(v1[2], v1[3]);
                    *(u32x4*)(rowp + bj * HALF) = w;
                    if (last && col < RCOLS) { float* o = (row < ROWS_P ? shp + (size_t)(row >> 11) * RCOLS : shs + (size_t)((row - ROWS_P) >> 3) * RCOLS) + col;
                        *(f32x4*)o = v0; *(f32x4*)(o + 4) = v1; } }
            }
    }
};
template <class Epi, class Sched, bool ALIGN_EPI = false, bool SP2 = false>
__device__ __forceinline__ void gemm_phase(PG8_LAS unsigned char* lds, const Gemm g, const Sched& S, const Epi& E) {
    const int tid = threadIdx.x, wid = __builtin_amdgcn_readfirstlane(tid >> 6), lane = tid & 63, wr = wid >> 2, wc = wid & 3, fr = lane & 15, fq = lane >> 4;
    const int K = g.K, nt = K / BK;
    unsigned voffA[2], voffB[2];
#pragma unroll
    for (int i = 0; i < 2; ++i) { int R, C; stage_rc(tid * 16 + i * 8192, R, C); const int Rb = Epi::PERM ? ((R & ~31) + perm32(R & 31)) : R;
        voffA[i] = (unsigned)(R * K + C) * 2u; voffB[i] = (unsigned)(Rb * K + C) * 2u; }
    const size_t kstep = (size_t)(BK * 2);
    const size_t hstep = (size_t)HALF * K * 2;
    const size_t tstep = 2 * hstep;
    const unsigned ldsw = (unsigned)wid * 1024u;
    const int aoff = lds_byte(wr * 64 + fr, fq * 8), boff = lds_byte(wc * 32 + fr, fq * 8);
#define PG8_SA(b, h) (((b) * 2 + (h)) * HTB)
#define PG8_SB(b, h) ((4 + (b) * 2 + (h)) * HTB)
#define PG8_STAGE(bufoff, gbase, voff) do { _Pragma("unroll") for (int _i = 0; _i < 2; ++_i) \
        __builtin_amdgcn_global_load_lds((const unsigned*)((const char*)(gbase) + (voff)[_i]), (PG8_LAS unsigned*)(lds + (bufoff) + ldsw + _i * 8192), 16, 0, 0); } while (0)
#define PG8_LDA(dst, b, h) do { _Pragma("unroll") for (int m = 0; m < 4; ++m) _Pragma("unroll") for (int k = 0; k < 2; ++k) dst[m][k] = *(const PG8_LAS bf16x8*)(lds + PG8_SA(b, h) + aoff + m * 2048 + k * 1024); } while (0)
#define PG8_LDB(dst, b, h) do { _Pragma("unroll") for (int n = 0; n < 2; ++n) _Pragma("unroll") for (int k = 0; k < 2; ++k) dst[n][k] = *(const PG8_LAS bf16x8*)(lds + PG8_SB(b, h) + boff + n * 2048 + k * 1024); } while (0)
#define PG8_MMA(ai, bj, At, Bt) do { __builtin_amdgcn_s_setprio(1); _Pragma("unroll") for (int m = 0; m < 4; ++m) _Pragma("unroll") for (int n = 0; n < 2; ++n) _Pragma("unroll") for (int k = 0; k < 2; ++k) \
        acc[ai][bj][m][n] = __builtin_amdgcn_mfma_f32_16x16x32_bf16(Bt[n][k], At[m][k], acc[ai][bj][m][n], 0, 0, 0); __builtin_amdgcn_s_setprio(0); } while (0)
#define PG8_WAIT_V(n) asm volatile("s_waitcnt vmcnt(" #n ")" ::: "memory")
#define PG8_WAIT_L(n) asm volatile("s_waitcnt lgkmcnt(" #n ")" ::: "memory")
#define PG8_BAR __builtin_amdgcn_s_barrier()
#define PG8_SCHED __builtin_amdgcn_sched_barrier(0)
    Unit cur, nxt; int ui = 0;
    if (!S.next(0, cur)) return;
    f32x4 acc[2][2][4][2];
#pragma unroll
    for (int a = 0; a < 2; ++a)
#pragma unroll
        for (int b = 0; b < 2; ++b)
#pragma unroll
            for (int m = 0; m < 4; ++m)
#pragma unroll
                for (int n = 0; n < 2; ++n) acc[a][b][m][n] = (f32x4){0.f, 0.f, 0.f, 0.f};
    bf16x8 At[4][2], B0[2][2], B1[2][2];
    const char* cA = (const char*)g.A + (size_t)cur.pm * tstep; const char* cB = (const char*)g.Bt + (size_t)cur.pn * tstep;
    S.a_ready(cur);
    if constexpr (SP2) {
        PG8_STAGE(PG8_SB(0, 0), cB, voffB); PG8_STAGE(PG8_SB(0, 1), cB + hstep, voffB); PG8_STAGE(PG8_SA(0, 0), cA, voffA); PG8_STAGE(PG8_SA(0, 1), cA + hstep, voffA);
        if (wr == 1) PG8_BAR;
        PG8_WAIT_V(2); PG8_BAR;
        PG8_STAGE(PG8_SB(1, 0), cB + kstep, voffB); PG8_STAGE(PG8_SA(1, 0), cA + kstep, voffA); PG8_STAGE(PG8_SB(1, 1), cB + hstep + kstep, voffB);
        PG8_WAIT_V(6); PG8_BAR;
    } else {
        PG8_STAGE(PG8_SB(0, 0), cB, voffB); PG8_STAGE(PG8_SA(0, 0), cA, voffA); PG8_STAGE(PG8_SB(0, 1), cB + hstep, voffB); PG8_STAGE(PG8_SA(0, 1), cA + hstep, voffA);
        if (wr == 1) PG8_BAR;
        PG8_WAIT_V(4); PG8_BAR;
        PG8_STAGE(PG8_SB(1, 0), cB + kstep, voffB); PG8_STAGE(PG8_SA(1, 0), cA + kstep, voffA); PG8_STAGE(PG8_SB(1, 1), cB + hstep + kstep, voffB);
        PG8_WAIT_V(6); PG8_BAR;
    }
    for (;;) {
        const bool has_next = S.next(ui + 1, nxt);
        const char* nA = has_next ? (const char*)g.A + (size_t)nxt.pm * tstep : cA; const char* nB = has_next ? (const char*)g.Bt + (size_t)nxt.pn * tstep : cB;
        for (int t = 0; t < nt; t += 2) {
            const bool last = (t == nt - 2);
            const char* a1 = cA + (size_t)(t + 1) * kstep;
            const char* a2 = last ? nA : cA + (size_t)(t + 2) * kstep; const char* b2 = last ? nB : cB + (size_t)(t + 2) * kstep;
            const char* a3 = a2 + kstep; const char* b3 = b2 + kstep;
            if (last && has_next) S.a_ready(nxt);
            if constexpr (SP2) {
            PG8_LDB(B0, 0, 0); PG8_LDB(B1, 0, 1); PG8_SCHED; PG8_LDA(At, 0, 0); PG8_STAGE(PG8_SA(1, 1), a1 + hstep, voffA);
            PG8_WAIT_V(8); PG8_WAIT_L(0); PG8_BAR; PG8_MMA(0, 0, At, B0); PG8_MMA(0, 1, At, B1); PG8_BAR; PG8_SCHED;
            PG8_LDA(At, 0, 1); PG8_STAGE(PG8_SB(0, 0), b2, voffB); PG8_STAGE(PG8_SB(0, 1), b2 + hstep, voffB); PG8_STAGE(PG8_SA(0, 0), a2, voffA);
            PG8_WAIT_V(8); PG8_WAIT_L(0); PG8_BAR; PG8_MMA(1, 0, At, B0); PG8_MMA(1, 1, At, B1); PG8_BAR; PG8_SCHED;
            PG8_LDB(B0, 1, 0); PG8_LDB(B1, 1, 1); PG8_SCHED; PG8_LDA(At, 1, 0); PG8_STAGE(PG8_SA(0, 1), a2 + hstep, voffA);
            PG8_WAIT_V(8); PG8_WAIT_L(0); PG8_BAR; PG8_MMA(0, 0, At, B0); PG8_MMA(0, 1, At, B1); PG8_BAR; PG8_SCHED;
            PG8_LDA(At, 1, 1); PG8_STAGE(PG8_SB(1, 0), b3, voffB); PG8_STAGE(PG8_SB(1, 1), b3 + hstep, voffB); PG8_STAGE(PG8_SA(1, 0), a3, voffA);
            PG8_WAIT_V(8); PG8_WAIT_L(0); PG8_BAR; PG8_MMA(1, 0, At, B0); PG8_MMA(1, 1, At, B1); PG8_BAR; PG8_SCHED;
            } else {
            PG8_LDB(B0, 0, 0); PG8_SCHED; PG8_LDA(At, 0, 0); PG8_STAGE(PG8_SA(1, 1), a1 + hstep, voffA);
            PG8_WAIT_L(8); PG8_BAR; PG8_WAIT_L(0); PG8_MMA(0, 0, At, B0); PG8_BAR; PG8_SCHED;
            PG8_LDB(B1, 0, 1); PG8_STAGE(PG8_SB(0, 0), b2, voffB);
            PG8_BAR; PG8_WAIT_L(0); PG8_MMA(0, 1, At, B1); PG8_BAR;
            PG8_LDA(At, 0, 1); PG8_STAGE(PG8_SA(0, 0), a2, voffA);
            PG8_BAR; PG8_WAIT_L(0); PG8_MMA(1, 0, At, B0); PG8_BAR; PG8_SCHED;
            PG8_STAGE(PG8_SB(0, 1), b2 + hstep, voffB);
            PG8_WAIT_V(6); PG8_BAR; PG8_MMA(1, 1, At, B1); PG8_BAR;
            PG8_LDB(B0, 1, 0); PG8_SCHED; PG8_LDA(At, 1, 0); PG8_STAGE(PG8_SA(0, 1), a2 + hstep, voffA);
            PG8_WAIT_L(8); PG8_BAR; PG8_WAIT_L(0); PG8_MMA(0, 0, At, B0); PG8_BAR; PG8_SCHED;
            PG8_LDB(B1, 1, 1); PG8_STAGE(PG8_SB(1, 0), b3, voffB);
            PG8_BAR; PG8_WAIT_L(0); PG8_MMA(0, 1, At, B1); PG8_BAR;
            PG8_LDA(At, 1, 1); PG8_STAGE(PG8_SA(1, 0), a3, voffA);
            PG8_BAR; PG8_WAIT_L(0); PG8_MMA(1, 0, At, B0); PG8_BAR; PG8_SCHED;
            PG8_STAGE(PG8_SB(1, 1), b3 + hstep, voffB);
            PG8_WAIT_V(6); PG8_BAR; PG8_MMA(1, 1, At, B1); PG8_BAR;
            }
        }
        if constexpr (ALIGN_EPI) { if (wr == 0) PG8_BAR; }
        if constexpr (!Epi::AFTER_DRAIN) { E(acc, cur, wr, wc, fr, fq); S.done(cur); }
        if (!has_next) break;
#pragma unroll
        for (int a = 0; a < 2; ++a)
#pragma unroll
            for (int b = 0; b < 2; ++b)
#pragma unroll
                for (int m = 0; m < 4; ++m)
#pragma unroll
                    for (int n = 0; n < 2; ++n) acc[a][b][m][n] = (f32x4){0.f, 0.f, 0.f, 0.f};
        cur = nxt; cA = nA; cB = nB; ++ui;
        if constexpr (ALIGN_EPI) { if (wr == 1) PG8_BAR; }
    }
    PG8_WAIT_V(0);
    if constexpr (!ALIGN_EPI) { if (wr == 0) PG8_BAR; }
    PG8_BAR;
    if constexpr (Epi::AFTER_DRAIN) { E.fused(acc, cur, wr, wc, fr, fq, lds, wid, lane); S.done(cur); }
#undef PG8_SA
#undef PG8_SB
#undef PG8_STAGE
#undef PG8_LDA
#undef PG8_LDB
#undef PG8_MMA
#undef PG8_WAIT_V
#undef PG8_WAIT_L
#undef PG8_BAR
#undef PG8_SCHED
}
}
#ifndef PG8_SP2
#define PG8_SP2 true
#endif
#ifndef PG8_ALIGN
#define PG8_ALIGN true
#endif
#ifndef MK_N_LAUNCHES
#define MK_N_LAUNCHES 1
#endif
constexpr int NWAVES = 8;
constexpr int N_PHASES = 15;
constexpr int D = 1024, MP = 16384, MS = 1024, M = MP + MS, NSEQ = 136, FF = 2816, RC = 1792, PC = 2816, RW = 512, MODW = 9216;
constexpr float RMS_EPS = 1e-6f, LN_EPS = 1e-5f, GN_EPS = 64e-5f;
constexpr size_t O_Y = 0, O_SHP = 17825792, O_WKVP = 17840128, O_SHS = 18102272, O_WKVS = 18331648, O_CVS = 22525952, O_END = 23050240;
constexpr size_t MiB = 1u << 20;
constexpr size_t WS_CTL = 0, CTL_ZERO_BYTES = 1 * MiB;
constexpr size_t WS_GU1 = 1 * MiB, WS_DN1 = 12 * MiB, WS_WIN = 18 * MiB, WS_WOUT = 24 * MiB, WS_GU2 = 26 * MiB, WS_DN2 = 37 * MiB;
constexpr size_t WS_SMALL = 43 * MiB;
constexpr size_t WS_WLT = WS_SMALL, WS_ALT = WS_SMALL + 65536, WS_GLT = WS_SMALL + 131072, WS_WSB = WS_SMALL + 262144, WS_SILUC = WS_SMALL + 524288;
constexpr size_t WS_MOD = 44 * MiB;
constexpr size_t WS_BON = 49 * MiB;
constexpr size_t WS_XN = 50 * MiB;
constexpr size_t WS_ACT = 84 * MiB;
constexpr size_t WS_SC = 178 * MiB, SC_STRIDE = 17 * MiB;
constexpr size_t WS_G = 280 * MiB;
constexpr size_t WS_Y = 297 * MiB;
constexpr size_t WS_END = 331 * MiB;
static_assert(WS_DN1 - WS_GU1 >= (size_t)5632 * 1024 * 2 && WS_WIN - WS_DN1 >= (size_t)1024 * 2816 * 2 && WS_WOUT - WS_WIN >= (size_t)2816 * 1024 * 2 && WS_GU2 - WS_WOUT >= (size_t)1024 * 1024 * 2, "ws map a");
static_assert(WS_DN2 - WS_GU2 >= (size_t)5632 * 1024 * 2 && WS_SMALL - WS_DN2 >= (size_t)1024 * 2816 * 2 && WS_BON - WS_MOD >= (size_t)136 * 9216 * 4 && WS_XN - WS_BON >= (size_t)M * 8 * 4, "ws map b");
static_assert(WS_ACT - WS_XN >= (size_t)M * 1024 * 2 && WS_SC - WS_ACT >= (size_t)M * 2816 * 2 && SC_STRIDE >= (size_t)M * 512 * 2 && WS_G - WS_SC >= 6 * SC_STRIDE && WS_Y - WS_G >= (size_t)M * 512 * 2 && WS_END - WS_Y >= (size_t)M * 512 * 4, "ws map c");
constexpr int CW_TMO = 0, CW_CODE = 1, CW_BAR = 4096;
constexpr int RING_OFF = 0, RING_BYTES = 131072;
constexpr int LDSCTL_OFF = RING_BYTES, MISC_OFF = LDSCTL_OFF + 320;
constexpr int LDS_BYTES = 147456;
struct Args { const float* in[30]; float* out; unsigned char* ws; int ph_lo, ph_hi; };
#define GAS __attribute__((address_space(1)))
#define LAS __attribute__((address_space(3)))
typedef unsigned short bf16;
typedef unsigned v4u __attribute__((ext_vector_type(4)));
typedef float f32x4 __attribute__((ext_vector_type(4)));
typedef short bf16x8 __attribute__((ext_vector_type(8)));
typedef GAS unsigned gu32;
typedef GAS unsigned long long gu64;
#define RLX_AGENT __ATOMIC_RELAXED, __HIP_MEMORY_SCOPE_AGENT
#define LDS_WAIT() asm volatile("s_waitcnt lgkmcnt(0)" ::: "memory")
#define VM_WAIT() asm volatile("s_waitcnt vmcnt(0)" ::: "memory")
__device__ __forceinline__ unsigned long long rt() { return __builtin_amdgcn_s_memrealtime(); }
__device__ __forceinline__ unsigned f2bf(float f) { unsigned u = __builtin_bit_cast(unsigned, f); return (u + 0x7fffu + ((u >> 16) & 1u)) >> 16; }
__device__ __forceinline__ unsigned pk2(float lo, float hi) { return f2bf(lo) | (f2bf(hi) << 16); }
#define XB_TMO      128
#define XB_XCNT(j)  (256  + 64 * (j))
#define XB_XSUB(j)  (1280 + 64 * (j))
#define XB_XGEN(j)  (2304 + 64 * (j))
#define XB_TOP      3328
#define XB_TOPGEN   3392
#define XCD_BAR_WORDS 3456
#define XB_SPIN_CAP (1u << 18)

__device__ __forceinline__ unsigned xb_ld(unsigned* p)              { return __hip_atomic_load(p, __ATOMIC_RELAXED, __HIP_MEMORY_SCOPE_AGENT); }
__device__ __forceinline__ unsigned xb_add(unsigned* p, unsigned v) { return __hip_atomic_fetch_add(p, v, __ATOMIC_RELAXED, __HIP_MEMORY_SCOPE_AGENT); }
__device__ __forceinline__ unsigned xb_xcc_id() { return (unsigned)__builtin_amdgcn_s_getreg((3 << 11) | 20) & 0xFu; }
#define XB_SPIN(cond, bar) do { unsigned _sp = 0; while (cond) { __builtin_amdgcn_s_sleep(1); \
    if ((++_sp & 255u) == 0u) { if (xb_ld(&(bar)[XB_TMO])) break; if (_sp > XB_SPIN_CAP) { atomicAdd(&(bar)[XB_TMO], 1u); break; } } } } while (0)

struct XcdBarrier {
    unsigned* bar; unsigned x;
    volatile LAS unsigned* st;
};

__device__ __forceinline__ XcdBarrier xcd_barrier_post(unsigned* bar, volatile LAS unsigned* st) {
    XcdBarrier b; b.bar = bar; b.x = xb_xcc_id(); b.st = st;
    if (threadIdx.x == 0) (void)xb_add(&bar[XB_XCNT(b.x)], 1u);
    return b;
}
__device__ __forceinline__ void xcd_barrier_complete(unsigned* bar, unsigned x, unsigned& nloc, unsigned& nx) {
    const unsigned G = gridDim.x * gridDim.y * gridDim.z;
    unsigned sum, cnt, mine, sp = 0u;
    for (;;) {
        sum = 0u; cnt = 0u; mine = 0u;
#pragma unroll
        for (unsigned j = 0; j < 16; ++j) { const unsigned c = xb_ld(&bar[XB_XCNT(j)]); sum += c; cnt += (c > 0u) ? 1u : 0u; mine = (j == x) ? c : mine; }
        if (sum == G) break;
        __builtin_amdgcn_s_sleep(1);
        if ((++sp & 255u) == 0u) { if (xb_ld(&bar[XB_TMO])) break; if (sp > XB_SPIN_CAP) { atomicAdd(&bar[XB_TMO], 1u); break; } }
    }
    nloc = mine > 0u ? mine : 1u; nx = cnt > 0u ? cnt : 1u;
}

__device__ __forceinline__ void xcd_barrier(const XcdBarrier& b) {
    asm volatile("s_waitcnt vmcnt(0)" ::: "memory");
    __syncthreads();
    if (threadIdx.x == 0) {
        unsigned* bar = b.bar;
        __builtin_amdgcn_s_waitcnt(0);
        unsigned nloc = b.st[0], nx = b.st[1];
        if (nloc == 0u) { xcd_barrier_complete(bar, b.x, nloc, nx); b.st[0] = nloc; b.st[1] = nx; }
        const unsigned old = xb_add(&bar[XB_XSUB(b.x)], 1u);
        const unsigned gen = old / nloc;
        if (old + 1u == (gen + 1u) * nloc) {
            __builtin_amdgcn_fence(__ATOMIC_RELEASE, "agent");
            asm volatile("s_waitcnt vmcnt(0)" ::: "memory");
            const unsigned og = xb_add(&bar[XB_TOP], 1u);
            const unsigned tg = og / nx;
            if (og + 1u == (tg + 1u) * nx) xb_add(&bar[XB_TOPGEN], 1u);
            else XB_SPIN(xb_ld(&bar[XB_TOPGEN]) == tg, bar);
            __builtin_amdgcn_fence(__ATOMIC_ACQUIRE, "agent");
            xb_add(&bar[XB_XGEN(b.x)], 1u);
            asm volatile("s_waitcnt vmcnt(0)" ::: "memory");
        } else {
            XB_SPIN(xb_ld(&bar[XB_XGEN(b.x)]) == gen, bar);
            __builtin_amdgcn_fence(__ATOMIC_ACQUIRE, "agent");
            asm volatile("s_waitcnt vmcnt(0)" ::: "memory");
        }
    }
    __syncthreads();
}
struct Frame {
    LAS unsigned char* lds;
    volatile LAS unsigned* MISC;
    gu32* ctl;
    int tid, lane, wave, gw, NGW, G;
    float* out; unsigned char* ws;
};
__device__ __forceinline__ float wave_sum(float v) {
#pragma unroll
    for (int o = 1; o < 64; o <<= 1) v += __shfl_xor(v, o);
    return v;
}
__device__ __forceinline__ float bf2f(unsigned short b) { return __uint_as_float((unsigned)b << 16); }
__device__ __forceinline__ void unpack8(v4u w, float* f) {
    f[0] = __uint_as_float(w.x << 16); f[1] = __uint_as_float(w.x & 0xffff0000u); f[2] = __uint_as_float(w.y << 16); f[3] = __uint_as_float(w.y & 0xffff0000u);
    f[4] = __uint_as_float(w.z << 16); f[5] = __uint_as_float(w.z & 0xffff0000u); f[6] = __uint_as_float(w.w << 16); f[7] = __uint_as_float(w.w & 0xffff0000u);
}
typedef unsigned v2u __attribute__((ext_vector_type(2)));
__device__ __forceinline__ void unpack4(v2u w, float* f) {
    f[0] = __uint_as_float(w.x << 16); f[1] = __uint_as_float(w.x & 0xffff0000u); f[2] = __uint_as_float(w.y << 16); f[3] = __uint_as_float(w.y & 0xffff0000u);
}
__device__ __forceinline__ v2u pack4(const float* f) { v2u w; w.x = pk2(f[0], f[1]); w.y = pk2(f[2], f[3]); return w; }
__device__ __forceinline__ v4u pack8(const float* f) { v4u w; w.x = pk2(f[0], f[1]); w.y = pk2(f[2], f[3]); w.z = pk2(f[4], f[5]); w.w = pk2(f[6], f[7]); return w; }
__device__ __forceinline__ bf16x8 as_bf16x8(v4u w) { return __builtin_bit_cast(bf16x8, w); }
__device__ __forceinline__ float sigmoid_f(float x) { return 1.0f / (1.0f + __expf(-x)); }
__device__ __forceinline__ float tanh_f(float x) { const float e = __expf(2.0f * x); return 1.0f - 2.0f / (e + 1.0f); }

__device__ __forceinline__ void transpose_item(const float* W, int K, int N, bf16* WT, int kb, int nb, int orow0, LAS float* scr, int lane) {
    const int k0 = 64 * kb, n0 = 32 * nb;
#pragma unroll 8
    for (int i = 0; i < 32; ++i) { const int kk = 2 * i + (lane >> 5); scr[kk * 33 + (lane & 31)] = W[(size_t)(k0 + kk) * N + n0 + (lane & 31)]; }
    LDS_WAIT(); asm volatile("" ::: "memory");
    const int c = lane & 7;
#pragma unroll
    for (int j = 0; j < 4; ++j) { const int n = (lane >> 3) + 8 * j; const LAS float* s = scr + (8 * c) * 33 + n;
        v4u o; o.x = pk2(s[0 * 33], s[1 * 33]); o.y = pk2(s[2 * 33], s[3 * 33]); o.z = pk2(s[4 * 33], s[5 * 33]); o.w = pk2(s[6 * 33], s[7 * 33]);
        *(GAS v4u*)(WT + (size_t)(orow0 + n) * K + k0 + 8 * c) = o; }
    LDS_WAIT(); asm volatile("" ::: "memory");
}
__device__ __forceinline__ int gu_row(int n0) { return n0 < FF ? 256 * (n0 >> 7) + (n0 & 127) : 256 * ((n0 - FF) >> 7) + 128 + ((n0 - FF) & 127); }
__device__ __forceinline__ void p0_prologue(Frame& F, const Args& A) {
    LAS float* scr = (LAS float*)(F.lds + RING_OFF + F.wave * 16384);
    constexpr int I_GU = 16 * 176, I_DN = 44 * 32, I_IN = 16 * 88, I_OUT = 16 * 32, I_L64 = 16, I_L128 = 32;
    constexpr int NITEMS = 2 * I_GU + 2 * I_DN + I_IN + I_OUT + 2 * I_L64 + I_L128;
    for (int it = F.gw; it < NITEMS; it += F.NGW) {
        int r = it;
        if (r < I_GU) { const int kb = r / 176, nb = r % 176; transpose_item(A.in[8], 1024, 5632, ((bf16*)(F.ws + WS_GU1)), kb, nb, gu_row(32 * nb), scr, F.lane); continue; } r -= I_GU;
        if (r < I_GU) { const int kb = r / 176, nb = r % 176; transpose_item(A.in[27], 1024, 5632, ((bf16*)(F.ws + WS_GU2)), kb, nb, gu_row(32 * nb), scr, F.lane); continue; } r -= I_GU;
        if (r < I_DN) { const int kb = r / 32, nb = r % 32; transpose_item(A.in[9], 2816, 1024, ((bf16*)(F.ws + WS_DN1)), kb, nb, 32 * nb, scr, F.lane); continue; } r -= I_DN;
        if (r < I_DN) { const int kb = r / 32, nb = r % 32; transpose_item(A.in[28], 2816, 1024, ((bf16*)(F.ws + WS_DN2)), kb, nb, 32 * nb, scr, F.lane); continue; } r -= I_DN;
        if (r < I_IN) { const int kb = r / 88, nb = r % 88; transpose_item(A.in[10], 1024, 2816, ((bf16*)(F.ws + WS_WIN)), kb, nb, 32 * nb, scr, F.lane); continue; } r -= I_IN;
        if (r < I_OUT) { const int kb = r / 32, nb = r % 32; transpose_item(A.in[26], 1024, 1024, ((bf16*)(F.ws + WS_WOUT)), kb, nb, 32 * nb, scr, F.lane); continue; } r -= I_OUT;
        if (r < I_L64) { transpose_item(A.in[13], 64, 512, ((bf16*)(F.ws + WS_WLT)), 0, r, 32 * r, scr, F.lane); continue; } r -= I_L64;
        if (r < I_L64) { transpose_item(A.in[15], 64, 512, ((bf16*)(F.ws + WS_ALT)), 0, r, 32 * r, scr, F.lane); continue; } r -= I_L64;
        { const int kb = r / 16, nb = r % 16; transpose_item(A.in[16], 128, 512, ((bf16*)(F.ws + WS_GLT)), kb, nb, 32 * nb, scr, F.lane); }
    }
    const int gt = F.gw * 64 + F.lane, NGT = F.NGW * 64;
    for (int i = gt; i < 144 * 512; i += NGT) { const int s = i >> 9, k = (i & 511) * 2;
        float a = 0.f, b = 0.f;
        if (s < NSEQ) { const float* cr = s < 8 ? A.in[4] + (size_t)s * D : A.in[5] + (size_t)(s - 8) * D; a = cr[k]; b = cr[k + 1]; a = a * sigmoid_f(a); b = b * sigmoid_f(b); }
        ((unsigned*)((bf16*)(F.ws + WS_SILUC)))[i] = pk2(a, b); }
    for (int i = gt; i < 8 * 128 * 64; i += NGT) { const int j = (i & 63) * 2, ii = (i >> 6) & 127;
        const float a = A.in[24][2 * (size_t)i], b = A.in[24][2 * (size_t)i + 1];
        ((unsigned*)((bf16*)(F.ws + WS_WSB)))[i] = pk2(j <= ii ? a : 0.f, (j + 1) <= ii ? b : 0.f); }
}
__device__ __forceinline__ void p1_mod(Frame& F, const Args& A) {
    const int l15 = F.lane & 15, q = F.lane >> 4;
    for (int nt = F.gw; nt < MODW / 16; nt += F.NGW) {
        const int n0 = 16 * nt;
        f32x4 acc[9];
#pragma unroll
        for (int mt = 0; mt < 9; ++mt) acc[mt] = (f32x4){0.f, 0.f, 0.f, 0.f};
        for (int ks = 0; ks < 32; ++ks) {
            const int k0 = 32 * ks + 8 * q;
            const float* wp = A.in[6] + (size_t)k0 * MODW + n0 + l15;
            float wv[8];
#pragma unroll
            for (int j = 0; j < 8; ++j) wv[j] = wp[(size_t)j * MODW];
            const bf16x8 wf = as_bf16x8(pack8(wv));
#pragma unroll
            for (int mt = 0; mt < 9; ++mt) { const bf16x8 sf = *(const bf16x8*)(((bf16*)(F.ws + WS_SILUC)) + (size_t)(16 * mt + l15) * D + k0);
                acc[mt] = __builtin_amdgcn_mfma_f32_16x16x32_bf16(wf, sf, acc[mt], 0, 0, 0); }
        }
        const f32x4 bv = *(const f32x4*)(A.in[7] + n0 + 4 * q);
#pragma unroll
        for (int mt = 0; mt < 9; ++mt) { const int s = 16 * mt + l15; if (s < NSEQ) *(f32x4*)(((float*)(F.ws + WS_MOD)) + (size_t)s * MODW + n0 + 4 * q) = acc[mt] + bv; }
    }
}
__device__ __forceinline__ const float* res_row(const float* pP, const float* pS, int row) { return row < MP ? pP + (size_t)row * D : pS + (size_t)(row - MP) * D; }
__device__ __forceinline__ void norm_rows_bf16(Frame& F, const Args& A, const float* srcP, const float* srcS, int sh_off, int sc_off) {
    for (int row = F.gw; row < M; row += F.NGW) {
        const f32x4* xr = (const f32x4*)res_row(srcP, srcS, row) + F.lane; const int s = pg8::seq_of_row(row);
        f32x4 v[4]; float ss = 0.f;
#pragma unroll
        for (int j = 0; j < 4; ++j) { v[j] = xr[64 * j]; ss += (v[j].x * v[j].x + v[j].y * v[j].y) + (v[j].z * v[j].z + v[j].w * v[j].w); }
        const float rstd = 1.0f / sqrtf(wave_sum(ss) * (1.0f / D) + RMS_EPS);
        const f32x4* sc = (const f32x4*)(((float*)(F.ws + WS_MOD)) + (size_t)s * MODW + sc_off) + F.lane; const f32x4* sh = (const f32x4*)(((float*)(F.ws + WS_MOD)) + (size_t)s * MODW + sh_off) + F.lane;
        v2u* o = (v2u*)(((bf16*)(F.ws + WS_XN)) + (size_t)row * D) + F.lane;
#pragma unroll
        for (int j = 0; j < 4; ++j) { const f32x4 a = sc[64 * j], b = sh[64 * j]; const f32x4 r = v[j] * rstd * (a + 1.0f) + b; float t[4] = {r.x, r.y, r.z, r.w}; o[64 * j] = pack4(t); }
    }
}
__device__ __forceinline__ void final_norm_rows(Frame& F, const Args& A) {
    for (int row = F.gw; row < M; row += F.NGW) {
        f32x4* xr = (f32x4*)(F.out + (size_t)row * D) + F.lane;
        f32x4 v[4]; float ss = 0.f;
#pragma unroll
        for (int j = 0; j < 4; ++j) { v[j] = xr[64 * j]; ss += (v[j].x * v[j].x + v[j].y * v[j].y) + (v[j].z * v[j].z + v[j].w * v[j].w); }
        const float rstd = 1.0f / sqrtf(wave_sum(ss) * (1.0f / D) + RMS_EPS);
        const f32x4* g = (const f32x4*)A.in[29] + F.lane;
#pragma unroll
        for (int j = 0; j < 4; ++j) xr[64 * j] = v[j] * rstd * g[64 * j];
    }
}
struct XmCtx { const bf16* pc; const bf16* pp; const float* ss0; const float* mu; bool first, samp; };
__device__ __forceinline__ void xm8(const XmCtx& c, int col, float* o) {
    float cur[8], prv[8]; unpack8(*(const v4u*)(c.pc + col), cur);
    if (!c.first) unpack8(*(const v4u*)(c.pp + col), prv);
    else if (c.samp) { const f32x4 a = *(const f32x4*)(c.ss0 + col), b = *(const f32x4*)(c.ss0 + col + 4); prv[0] = a.x; prv[1] = a.y; prv[2] = a.z; prv[3] = a.w; prv[4] = b.x; prv[5] = b.y; prv[6] = b.z; prv[7] = b.w; }
    else {
#pragma unroll
        for (int e = 0; e < 8; ++e) prv[e] = 0.f; }
    const f32x4 m0 = *(const f32x4*)(c.mu + col), m1 = *(const f32x4*)(c.mu + col + 4); const float mm[8] = {m0.x, m0.y, m0.z, m0.w, m1.x, m1.y, m1.z, m1.w};
#pragma unroll
    for (int e = 0; e < 8; ++e) o[e] = cur[e] + (prv[e] - cur[e]) * mm[e];
}
__device__ __forceinline__ void xm4(const XmCtx& c, int col, float* o) {
    float cur[4], prv[4]; unpack4(*(const v2u*)(c.pc + col), cur);
    if (!c.first) unpack4(*(const v2u*)(c.pp + col), prv);
    else if (c.samp) { const f32x4 a = *(const f32x4*)(c.ss0 + col); prv[0] = a.x; prv[1] = a.y; prv[2] = a.z; prv[3] = a.w; }
    else { prv[0] = 0.f; prv[1] = 0.f; prv[2] = 0.f; prv[3] = 0.f; }
    const f32x4 m0 = *(const f32x4*)(c.mu + col); const float mm[4] = {m0.x, m0.y, m0.z, m0.w};
#pragma unroll
    for (int e = 0; e < 4; ++e) o[e] = cur[e] + (prv[e] - cur[e]) * mm[e];
}
__device__ __forceinline__ void prep_item(Frame& F, const Args& A, int r0) {
    const int l15 = F.lane & 15, q = F.lane >> 4, row = r0 + l15;
    XmCtx c; c.pc = ((bf16*)(F.ws + WS_ACT)) + (size_t)row * PC; c.pp = c.pc - PC; c.first = pg8::row_is_first(row); c.samp = row >= MP; c.mu = A.in[11];
    c.ss0 = A.in[2] + (size_t)(c.samp ? ((row - MP) >> 3) : 0) * RC;
    bf16x8 fw[2], fa[2], fg[4];
#pragma unroll
    for (int ks = 0; ks < 2; ++ks) { float t[8]; xm8(c, 1536 + 32 * ks + 8 * q, t);
#pragma unroll
        for (int e = 0; e < 8; ++e) t[e] = tanh_f(t[e]);
        fw[ks] = as_bf16x8(pack8(t)); }
#pragma unroll
    for (int ks = 0; ks < 2; ++ks) { float t[8]; xm8(c, 1600 + 32 * ks + 8 * q, t); fa[ks] = as_bf16x8(pack8(t)); }
#pragma unroll
    for (int ks = 0; ks < 4; ++ks) { float t[8]; xm8(c, 1664 + 32 * ks + 8 * q, t);
#pragma unroll
        for (int e = 0; e < 8; ++e) t[e] = sigmoid_f(t[e]);
        fg[ks] = as_bf16x8(pack8(t)); }
#pragma unroll 1
    for (int h = 0; h < 8; ++h) {
        float ss = 0.f, bon = 0.f;
#pragma unroll
        for (int ntl = 0; ntl < 4; ++ntl) { const int c0 = 64 * h + 16 * ntl + 4 * q; float xk[4]; xm4(c, 512 + c0, xk); const f32x4 kkv = *(const f32x4*)(A.in[17] + c0);
#pragma unroll
            for (int e = 0; e < 4; ++e) { const float kr = xk[e] * kkv[e]; ss += kr * kr; } }
        ss += __shfl_xor(ss, 16); ss += __shfl_xor(ss, 32);
        const float inv = 1.0f / fmaxf(sqrtf(ss), 1e-12f);
#pragma unroll 1
        for (int ntl = 0; ntl < 4; ++ntl) {
            const int n0 = 64 * h + 16 * ntl, c0 = n0 + 4 * q;
            f32x4 aw = {0.f, 0.f, 0.f, 0.f}, aa = aw, ag = aw;
#pragma unroll
            for (int ks = 0; ks < 2; ++ks) {
                aw = __builtin_amdgcn_mfma_f32_16x16x32_bf16(*(const bf16x8*)(((bf16*)(F.ws + WS_WLT)) + (size_t)(n0 + l15) * 64 + 32 * ks + 8 * q), fw[ks], aw, 0, 0, 0);
                aa = __builtin_amdgcn_mfma_f32_16x16x32_bf16(*(const bf16x8*)(((bf16*)(F.ws + WS_ALT)) + (size_t)(n0 + l15) * 64 + 32 * ks + 8 * q), fa[ks], aa, 0, 0, 0); }
#pragma unroll
            for (int ks = 0; ks < 4; ++ks)
                ag = __builtin_amdgcn_mfma_f32_16x16x32_bf16(*(const bf16x8*)(((bf16*)(F.ws + WS_GLT)) + (size_t)(n0 + l15) * 128 + 32 * ks + 8 * q), fg[ks], ag, 0, 0, 0);
            float xr[4], xk[4], xv[4]; xm4(c, c0, xr); xm4(c, 512 + c0, xk); xm4(c, 1024 + c0, xv);
            const f32x4 w0v = *(const f32x4*)(A.in[12] + c0), a0v = *(const f32x4*)(A.in[14] + c0), kkv = *(const f32x4*)(A.in[17] + c0), kav = *(const f32x4*)(A.in[18] + c0), rkv = *(const f32x4*)(A.in[19] + c0);
            float omd[4], km[4], gg[4], kk[4], bb[4];
#pragma unroll
            for (int e = 0; e < 4; ++e) {
                const float z = -(w0v[e] + aw[e]);
                const float sp = z > 20.f ? z : __logf(1.0f + __expf(z));
                const float wlog = -sp - 0.5f;
                const float dec = __expf(-__expf(wlog));
                omd[e] = 1.0f - dec;
                const float a = sigmoid_f(a0v[e] + aa[e]);
                kk[e] = xk[e] * kkv[e] * inv; bb[e] = kk[e] * a;
                km[e] = xk[e] * (1.0f + (a - 1.0f) * kav[e]);
                bon += xr[e] * km[e] * rkv[e];
                gg[e] = ag[e];
            }
            const size_t o = (size_t)row * RW + c0;
            *(v2u*)(((bf16*)(F.ws + WS_SC)) + o) = pack4(xr); *(v2u*)(((bf16*)(F.ws + (WS_SC + SC_STRIDE))) + o) = pack4(km); *(v2u*)(((bf16*)(F.ws + (WS_SC + 2 * SC_STRIDE))) + o) = pack4(xv);
            *(v2u*)(((bf16*)(F.ws + (WS_SC + 3 * SC_STRIDE))) + o) = pack4(kk); *(v2u*)(((bf16*)(F.ws + (WS_SC + 4 * SC_STRIDE))) + o) = pack4(bb);
            *(v2u*)(((bf16*)(F.ws + (WS_SC + 5 * SC_STRIDE))) + o) = pack4(omd); *(v2u*)(((bf16*)(F.ws + WS_G)) + o) = pack4(gg);
        }
        bon += __shfl_xor(bon, 16); bon += __shfl_xor(bon, 32);
        if (q == 0) ((float*)(F.ws + WS_BON))[(size_t)row * 8 + h] = bon;
    }
}
__device__ __forceinline__ void lnv_rows(Frame& F, const Args& A) {
    for (int row = F.gw; row < M; row += F.NGW) {
        v4u* pv = (v4u*)(((bf16*)(F.ws + WS_ACT)) + (size_t)row * PC + 2304) + F.lane;
        float x[8]; unpack8(*pv, x);
        float s = 0.f;
#pragma unroll
        for (int e = 0; e < 8; ++e) s += x[e];
        const float mean = wave_sum(s) * (1.0f / 512.0f); float qq = 0.f;
#pragma unroll
        for (int e = 0; e < 8; ++e) { x[e] -= mean; qq += x[e] * x[e]; }
        const float rstd = 1.0f / sqrtf(wave_sum(qq) * (1.0f / 512.0f) + LN_EPS);
        const f32x4 g0 = *(const f32x4*)(A.in[22] + 8 * F.lane), g1 = *(const f32x4*)(A.in[22] + 8 * F.lane + 4), b0 = *(const f32x4*)(A.in[23] + 8 * F.lane), b1 = *(const f32x4*)(A.in[23] + 8 * F.lane + 4);
        const float gg[8] = {g0.x, g0.y, g0.z, g0.w, g1.x, g1.y, g1.z, g1.w}, bb[8] = {b0.x, b0.y, b0.z, b0.w, b1.x, b1.y, b1.z, b1.w};
#pragma unroll
        for (int e = 0; e < 8; ++e) x[e] = x[e] * rstd * gg[e] + bb[e];
        *pv = pack8(x);
        if (row >= MP) { float* o = F.out + O_CVS + (size_t)(row - MP) * 512 + 8 * F.lane; *(f32x4*)o = (f32x4){x[0], x[1], x[2], x[3]}; *(f32x4*)(o + 4) = (f32x4){x[4], x[5], x[6], x[7]}; }
    }
}
template <bool SAMP> __device__ __forceinline__ void gmlp_item(Frame& F, const Args& A, int ci, int h) {
    const int l15 = F.lane & 15, q = F.lane >> 4;
    const int base = SAMP ? MP + 8 * ci : 128 * ci;
    constexpr int NIT = SAMP ? 1 : 8, NKS = SAMP ? 1 : 4;
#pragma unroll 1
    for (int dt = 0; dt < 4; ++dt) {
        const int colv = 2304 + h * 64 + 16 * dt + l15;
        bf16x8 vf[NKS];
#pragma unroll
        for (int ks = 0; ks < NKS; ++ks) {
#pragma unroll
            for (int j = 0; j < 8; ++j) { const int jr = 32 * ks + 8 * q + j; vf[ks][j] = (SAMP && jr >= 8) ? (short)0 : (short)((bf16*)(F.ws + WS_ACT))[(size_t)(base + jr) * PC + colv]; } }
#pragma unroll
        for (int it = 0; it < NIT; ++it) {
            f32x4 acc = {0.f, 0.f, 0.f, 0.f};
#pragma unroll
            for (int ks = 0; ks < NKS; ++ks) if (ks <= (it >> 1))
                acc = __builtin_amdgcn_mfma_f32_16x16x32_bf16(vf[ks], *(const bf16x8*)(((bf16*)(F.ws + WS_WSB)) + ((size_t)(h * 128 + 16 * it + l15)) * 128 + 32 * ks + 8 * q), acc, 0, 0, 0);
            const int i = 16 * it + l15;
            if (!SAMP || i < 8) { const int row = base + i; const float bs = A.in[25][h * 128 + i]; const int cc = h * 64 + 16 * dt + 4 * q;
                float pu[4]; unpack4(*(const v2u*)(((bf16*)(F.ws + WS_ACT)) + (size_t)row * PC + 1792 + cc), pu);
                float o[4];
#pragma unroll
                for (int e = 0; e < 4; ++e) o[e] = pu[e] * (acc[e] + bs);
                *(v2u*)(((bf16*)(F.ws + WS_XN)) + (size_t)row * D + 512 + cc) = pack4(o); }
        }
    }
}
__device__ __forceinline__ float red16(float x) {
    x += __builtin_bit_cast(float, __builtin_amdgcn_update_dpp(0, __builtin_bit_cast(int, x), 0x128, 0xf, 0xf, false));
    x += __builtin_bit_cast(float, __builtin_amdgcn_update_dpp(0, __builtin_bit_cast(int, x), 0x124, 0xf, 0xf, false));
    x += __builtin_bit_cast(float, __builtin_amdgcn_update_dpp(0, __builtin_bit_cast(int, x), 0x122, 0xf, 0xf, false));
    x += __builtin_bit_cast(float, __builtin_amdgcn_update_dpp(0, __builtin_bit_cast(int, x), 0x121, 0xf, 0xf, false));
    return x;
}
__device__ __forceinline__ float wkv_step(f32x4& S, const f32x4 w, const f32x4 kk, const f32x4 bb, const f32x4 k, const f32x4 r, const float vv) {
    float d = (S.x * kk.x + S.y * kk.y) + (S.z * kk.z + S.w * kk.w);
    d = red16(d);
    S = S * w + k * vv - bb * d;
    float y = (S.x * r.x + S.y * r.y) + (S.z * r.z + S.w * r.w);
    return red16(y);
}
constexpr int TC = 32, STEP_F = 336, CHUNK_F = TC * STEP_F, LD_ITEMS = TC * 42;
__device__ __forceinline__ void scan_prompt_unit(Frame& F, const Args& A, int unit) {
    const int bh = unit >> 2, qtr = unit & 3, b = bh >> 3, h = bh & 7;
    const size_t rowbase = (size_t)b * 2048;
    LAS float* buf0 = (LAS float*)(F.lds + RING_OFF); LAS float* buf1 = buf0 + CHUNK_F;
    const int j = F.lane & 15, vloc = 4 * F.wave + (F.lane >> 4), v = 16 * qtr + vloc;
    f32x4 S = {0.f, 0.f, 0.f, 0.f};
    v4u ld[3]; const bf16* srcp[3]; int dsto[3]; bool isw[3], act[3];
#pragma unroll
    for (int i = 0; i < 3; ++i) { const int it = F.tid + 512 * i; act[i] = it < LD_ITEMS; const int st = act[i] ? it / 42 : 0, a = act[i] ? it % 42 : 0;
        const size_t ro = (rowbase + st) * RW + h * 64;
        if (a < 40) { const int ar = a >> 3, seg = a & 7; const bf16* base = ar == 0 ? ((bf16*)(F.ws + (WS_SC + 5 * SC_STRIDE))) : ar == 1 ? ((bf16*)(F.ws + (WS_SC + 3 * SC_STRIDE))) : ar == 2 ? ((bf16*)(F.ws + (WS_SC + 4 * SC_STRIDE))) : ar == 3 ? ((bf16*)(F.ws + (WS_SC + SC_STRIDE))) : ((bf16*)(F.ws + WS_SC)); srcp[i] = base + ro + 8 * seg; }
        else srcp[i] = ((bf16*)(F.ws + (WS_SC + 2 * SC_STRIDE))) + ro + 16 * qtr + 8 * (a - 40);
        dsto[i] = st * STEP_F + (a < 40 ? (a >> 3) * 64 + 8 * (a & 7) : 320 + 8 * (a - 40)); isw[i] = a < 8; }
#define SCAN_ISSUE(c) do { _Pragma("unroll") for (int i = 0; i < 3; ++i) if (act[i]) ld[i] = *(const v4u*)(srcp[i] + (size_t)(c) * TC * RW); } while (0)
#define SCAN_COMMIT(buf) do { _Pragma("unroll") for (int i = 0; i < 3; ++i) if (act[i]) { float f[8]; unpack8(ld[i], f); \
        if (isw[i]) { _Pragma("unroll") for (int e = 0; e < 8; ++e) f[e] = 1.0f - f[e]; } \
        LAS float* dst = (buf) + dsto[i]; *(LAS f32x4*)dst = (f32x4){f[0], f[1], f[2], f[3]}; *(LAS f32x4*)(dst + 4) = (f32x4){f[4], f[5], f[6], f[7]}; } } while (0)
    SCAN_ISSUE(0); SCAN_COMMIT(buf0); __syncthreads();
    for (int c = 0; c < 2048 / TC; ++c) {
        if (c + 1 < 2048 / TC) SCAN_ISSUE(c + 1);
        if (F.wave < 4) {
            const LAS float* bp = (c & 1) ? buf1 : buf0;
            float* yp = ((float*)(F.ws + WS_Y)) + (rowbase + (size_t)c * TC) * RW + h * 64 + v;
#pragma unroll 4
            for (int s = 0; s < TC; ++s) {
                const LAS float* st = bp + s * STEP_F;
                const f32x4 w4 = *(const LAS f32x4*)(st + 4 * j), kk4 = *(const LAS f32x4*)(st + 64 + 4 * j), bb4 = *(const LAS f32x4*)(st + 128 + 4 * j),
                            k4 = *(const LAS f32x4*)(st + 192 + 4 * j), r4 = *(const LAS f32x4*)(st + 256 + 4 * j);
                const float vv = st[320 + vloc];
                const float y = wkv_step(S, w4, kk4, bb4, k4, r4, vv);
                if (j == 0) yp[(size_t)s * RW] = y;
            }
        }
        if (c + 1 < 2048 / TC) { if (c & 1) SCAN_COMMIT(buf0); else SCAN_COMMIT(buf1); }
        __syncthreads();
    }
#undef SCAN_ISSUE
#undef SCAN_COMMIT
    if (F.wave < 4) *(f32x4*)(F.out + O_WKVP + ((size_t)bh * 64 + v) * 64 + 4 * j) = S;
}
__device__ __forceinline__ void scan_sample_item(Frame& F, const Args& A, int it) {
    const int sbh = it >> 4, rg = it & 15, sb = sbh >> 3, h = sbh & 7, j = F.lane & 15, v = 4 * rg + (F.lane >> 4);
    const size_t so = ((size_t)sbh * 64 + v) * 64 + 4 * j;
    f32x4 S = *(const f32x4*)(A.in[3] + so);
#pragma unroll
    for (int t = 0; t < 8; ++t) {
        const size_t ro = (size_t)(MP + 8 * sb + t) * RW + h * 64;
        float w[4], kk[4], bb[4], k[4], r[4];
        unpack4(*(const v2u*)(((bf16*)(F.ws + (WS_SC + 5 * SC_STRIDE))) + ro + 4 * j), w); unpack4(*(const v2u*)(((bf16*)(F.ws + (WS_SC + 3 * SC_STRIDE))) + ro + 4 * j), kk); unpack4(*(const v2u*)(((bf16*)(F.ws + (WS_SC + 4 * SC_STRIDE))) + ro + 4 * j), bb);
        unpack4(*(const v2u*)(((bf16*)(F.ws + (WS_SC + SC_STRIDE))) + ro + 4 * j), k); unpack4(*(const v2u*)(((bf16*)(F.ws + WS_SC)) + ro + 4 * j), r);
        const float vv = bf2f(((bf16*)(F.ws + (WS_SC + 2 * SC_STRIDE)))[ro + v]);
        const float y = wkv_step(S, (f32x4){1.f - w[0], 1.f - w[1], 1.f - w[2], 1.f - w[3]}, (f32x4){kk[0], kk[1], kk[2], kk[3]}, (f32x4){bb[0], bb[1], bb[2], bb[3]},
                                 (f32x4){k[0], k[1], k[2], k[3]}, (f32x4){r[0], r[1], r[2], r[3]}, vv);
        if (j == 0) ((float*)(F.ws + WS_Y))[ro + v] = y;
    }
    *(f32x4*)(F.out + O_WKVS + so) = S;
}
__device__ __forceinline__ void postscan_rows(Frame& F, const Args& A) {
    for (int row = F.gw; row < M; row += F.NGW) {
        const int c = 8 * F.lane, head = F.lane >> 3; const size_t o = (size_t)row * RW + c;
        const f32x4 y0 = *(const f32x4*)(((float*)(F.ws + WS_Y)) + o), y1 = *(const f32x4*)(((float*)(F.ws + WS_Y)) + o + 4);
        float y[8] = {y0.x, y0.y, y0.z, y0.w, y1.x, y1.y, y1.z, y1.w};
        float s = 0.f;
#pragma unroll
        for (int e = 0; e < 8; ++e) s += y[e];
        s += __shfl_xor(s, 1); s += __shfl_xor(s, 2); s += __shfl_xor(s, 4);
        const float mu = s * (1.0f / 64.0f); float qq = 0.f;
#pragma unroll
        for (int e = 0; e < 8; ++e) { y[e] -= mu; qq += y[e] * y[e]; }
        qq += __shfl_xor(qq, 1); qq += __shfl_xor(qq, 2); qq += __shfl_xor(qq, 4);
        const float rstd = 1.0f / sqrtf(qq * (1.0f / 64.0f) + GN_EPS);
        const f32x4 g0 = *(const f32x4*)(A.in[20] + c), g1 = *(const f32x4*)(A.in[20] + c + 4), b0 = *(const f32x4*)(A.in[21] + c), b1 = *(const f32x4*)(A.in[21] + c + 4);
        const float gw[8] = {g0.x, g0.y, g0.z, g0.w, g1.x, g1.y, g1.z, g1.w}, gb[8] = {b0.x, b0.y, b0.z, b0.w, b1.x, b1.y, b1.z, b1.w};
        float vv[8], gg[8]; unpack8(*(const v4u*)(((bf16*)(F.ws + (WS_SC + 2 * SC_STRIDE))) + o), vv); unpack8(*(const v4u*)(((bf16*)(F.ws + WS_G)) + o), gg);
        const float bon = ((float*)(F.ws + WS_BON))[(size_t)row * 8 + head];
#pragma unroll
        for (int e = 0; e < 8; ++e) y[e] = (y[e] * rstd * gw[e] + gb[e] + bon * vv[e]) * gg[e];
        *(v4u*)(((bf16*)(F.ws + WS_XN)) + (size_t)row * D + c) = pack8(y);
    }
}
__global__ void __launch_bounds__(NWAVES * 64, 2) fwd_kernel(Args args) {
    extern __shared__ __attribute__((aligned(16))) unsigned char lds[];
    Frame F;
    F.lds = (LAS unsigned char*)lds;
    F.MISC = (volatile LAS unsigned*)(F.lds + MISC_OFF);
    F.tid = threadIdx.x; F.lane = F.tid & 63; F.wave = __builtin_amdgcn_readfirstlane(F.tid >> 6);
    F.G = gridDim.x; F.gw = blockIdx.x * NWAVES + F.wave; F.NGW = F.G * NWAVES;
    unsigned char* ws = args.ws;
    F.ctl = (gu32*)(ws + WS_CTL);
    F.out = args.out; F.ws = ws;
    for (int u = F.tid; u < (LDS_BYTES - LDSCTL_OFF) / 4; u += NWAVES * 64) ((LAS unsigned*)(F.lds + LDSCTL_OFF))[u] = 0u;
    __syncthreads();
    XcdBarrier bar; bar.bar = (unsigned*)(F.ctl + CW_BAR); bar.x = 0; bar.st = nullptr;
    if (MK_N_LAUNCHES == 1) bar = xcd_barrier_post((unsigned*)(F.ctl + CW_BAR), F.MISC + 8);
    const Args& A = args;
    const int lo = args.ph_lo, hi = args.ph_hi;
#ifndef PH_MASK
#define PH_MASK 0x7fff
#endif
#define IN(k) (((PH_MASK >> (k)) & 1) && lo <= (k) && (k) < hi)
#define SEAM(k) do { if (IN(k) && IN((k) + 1)) xcd_barrier(bar); } while (0)
    float* const H = F.out;

    if (IN(0)) { p0_prologue(F, A); } SEAM(0);
    if (IN(1)) { p1_mod(F, A); } SEAM(1);
    if (IN(2)) { norm_rows_bf16(F, A, A.in[0], A.in[1], 0, 1024); } SEAM(2);
    if (IN(3)) { pg8::Gemm g{((bf16*)(F.ws + WS_XN)), ((bf16*)(F.ws + WS_GU1)), M, 2 * FF, D}; pg8::StaticOrder S; S.init(M, 2 * FF, F.G, (int)blockIdx.x); pg8::EpiSwiglu E{((bf16*)(F.ws + WS_ACT))};
        pg8::gemm_phase<pg8::EpiSwiglu, pg8::StaticOrder, PG8_ALIGN, PG8_SP2>(F.lds + RING_OFF, g, S, E); } SEAM(3);
    if (IN(4)) { pg8::Gemm g{((bf16*)(F.ws + WS_ACT)), ((bf16*)(F.ws + WS_DN1)), M, D, FF}; pg8::StaticOrder S; S.init(M, D, F.G, (int)blockIdx.x); pg8::EpiResid E{A.in[0], A.in[1], H, ((float*)(F.ws + WS_MOD)) + 2048, 0.5f};
        pg8::gemm_phase<pg8::EpiResid, pg8::StaticOrder, PG8_ALIGN, PG8_SP2>(F.lds + RING_OFF, g, S, E); } SEAM(4);
    if (IN(5)) { norm_rows_bf16(F, A, H, H + (size_t)MP * D, 3072, 4096); } SEAM(5);
    if (IN(6)) { pg8::Gemm g{((bf16*)(F.ws + WS_XN)), ((bf16*)(F.ws + WS_WIN)), M, PC, D}; pg8::StaticOrder S; S.init(M, PC, F.G, (int)blockIdx.x); pg8::EpiP E{((bf16*)(F.ws + WS_ACT)), F.out + O_SHP, F.out + O_SHS};
        pg8::gemm_phase<pg8::EpiP, pg8::StaticOrder, PG8_ALIGN, PG8_SP2>(F.lds + RING_OFF, g, S, E); } SEAM(6);
    if (IN(7)) { for (int it = F.gw; it < M / 16; it += F.NGW) prep_item(F, A, 16 * it); lnv_rows(F, A); } SEAM(7);
    if (IN(8)) {
        for (int u = blockIdx.x; u < 256; u += F.G) scan_prompt_unit(F, A, u);
        for (int it = F.gw; it < 128 * 8 * 16; it += F.NGW) scan_sample_item(F, A, it);
        for (int it = F.gw; it < 2048; it += F.NGW) { if (it < 1024) gmlp_item<false>(F, A, it >> 3, it & 7); else gmlp_item<true>(F, A, (it - 1024) >> 3, it & 7); }
    } SEAM(8);
    if (IN(9)) { postscan_rows(F, A); } SEAM(9);
    if (IN(10)) { pg8::Gemm g{((bf16*)(F.ws + WS_XN)), ((bf16*)(F.ws + WS_WOUT)), M, D, D}; pg8::StaticOrder S; S.init(M, D, F.G, (int)blockIdx.x); pg8::EpiResid E{H, H + (size_t)MP * D, H, ((float*)(F.ws + WS_MOD)) + 5120, 1.0f};
        pg8::gemm_phase<pg8::EpiResid, pg8::StaticOrder, PG8_ALIGN, PG8_SP2>(F.lds + RING_OFF, g, S, E); } SEAM(10);
    if (IN(11)) { norm_rows_bf16(F, A, H, H + (size_t)MP * D, 6144, 7168); } SEAM(11);
    if (IN(12)) { pg8::Gemm g{((bf16*)(F.ws + WS_XN)), ((bf16*)(F.ws + WS_GU2)), M, 2 * FF, D}; pg8::StaticOrder S; S.init(M, 2 * FF, F.G, (int)blockIdx.x); pg8::EpiSwiglu E{((bf16*)(F.ws + WS_ACT))};
        pg8::gemm_phase<pg8::EpiSwiglu, pg8::StaticOrder, PG8_ALIGN, PG8_SP2>(F.lds + RING_OFF, g, S, E); } SEAM(12);
    if (IN(13)) { pg8::Gemm g{((bf16*)(F.ws + WS_ACT)), ((bf16*)(F.ws + WS_DN2)), M, D, FF}; pg8::StaticOrder S; S.init(M, D, F.G, (int)blockIdx.x); pg8::EpiResid E{H, H + (size_t)MP * D, H, ((float*)(F.ws + WS_MOD)) + 8192, 0.5f};
        pg8::gemm_phase<pg8::EpiResid, pg8::StaticOrder, PG8_ALIGN, PG8_SP2>(F.lds + RING_OFF, g, S, E); } SEAM(13);
    if (IN(14)) { final_norm_rows(F, A); }
#undef IN
#undef SEAM
}

extern "C" void kernel_launch(void* const* d_in, const int* in_sizes, int n_in, void* d_out, int out_size, void* d_ws, size_t ws_size, hipStream_t stream) {
    static int grid = 0;
    if (grid == 0) {
        if (n_in != 30 || in_sizes[0] != MP * D || (size_t)out_size != O_END || ws_size < WS_END) { fprintf(stderr, "kernel_launch: unexpected problem shape / workspace (%d inputs, out %d, ws %zu); nothing launched\n", n_in, out_size, ws_size); grid = -1; return; }
        int dev = 0, cus = 0, per_cu = 0;
        if (hipGetDevice(&dev) != hipSuccess || hipDeviceGetAttribute(&cus, hipDeviceAttributeMultiprocessorCount, dev) != hipSuccess) { grid = -1; return; }
        if (hipFuncSetAttribute((const void*)fwd_kernel, hipFuncAttributeMaxDynamicSharedMemorySize, LDS_BYTES) != hipSuccess) { fprintf(stderr, "kernel_launch: hipFuncSetAttribute failed\n"); grid = -1; return; }
        if (hipOccupancyMaxActiveBlocksPerMultiprocessor(&per_cu, (const void*)fwd_kernel, NWAVES * 64, LDS_BYTES) != hipSuccess || per_cu < 1) { fprintf(stderr, "kernel_launch: occupancy query says %d blocks per CU\n", per_cu); }
        (void)hipGetLastError();
        grid = cus;
    }
    if (grid < 0) return;
    (void)hipMemsetAsync((char*)d_ws + WS_CTL, 0, CTL_ZERO_BYTES, stream);
    Args a{};
    for (int i = 0; i < 30; ++i) a.in[i] = (const float*)d_in[i];
    a.out = (float*)d_out; a.ws = (unsigned char*)d_ws;
    if (MK_N_LAUNCHES == 1) { a.ph_lo = 0; a.ph_hi = N_PHASES; hipLaunchKernelGGL(fwd_kernel, dim3(grid), dim3(NWAVES * 64), LDS_BYTES, stream, a); }
    else for (int p = 0; p < N_PHASES; ++p) { a.ph_lo = p; a.ph_hi = p + 1; hipLaunchKernelGGL(fwd_kernel, dim3(grid), dim3(NWAVES * 64), LDS_BYTES, stream, a); }
}
```

```cpp
#include <hip/hip_runtime.h>
#include <cstdio>
#include <cstdint>
namespace pg8 {
#define PG8_LAS __attribute__((address_space(3)))
typedef unsigned short bf16_t;
typedef short bf16x8 __attribute__((ext_vector_type(8)));
typedef float f32x4 __attribute__((ext_vector_type(4)));
typedef unsigned u32x4 __attribute__((ext_vector_type(4)));
constexpr int BM = 256, BK = 64, HALF = 128, HTB = HALF * BK * 2  , STAGE_BYTES = 8 * HTB, NXCD = 8, WGM = 8;

__host__ __device__ __forceinline__ int lds_byte(int r, int c) { const int st = (r >> 4) * 2 + (c >> 5), rr = r & 15, cc = c & 31, ob = rr * 64 + cc * 2; return st * 1024 + (ob ^ (((ob >> 9) & 1) << 5)); }
__host__ __device__ __forceinline__ void stage_rc(int b, int& R, int& C) { const int st = b / 1024, sb = b % 1024, swz = sb ^ (((sb >> 9) & 1) << 5); R = (st >> 1) * 16 + swz / 64; C = (st & 1) * 32 + (swz % 64) / 2; }
__host__ __device__ __forceinline__ int perm32(int rho) { const int n = rho >> 4, i = rho & 15; return 8 * (i >> 2) + 4 * n + (i & 3); }

struct Unit { int pm, pn; };
struct Gemm { const bf16_t* A; const bf16_t* Bt; int M, N, K; };

struct StaticOrder {
    int nM, nN, nwg, G, c;
    __host__ __device__ void init(int M, int N, int G_, int c_) { nM = M / BM; nN = N / BM; nwg = nM * nN; G = G_; c = c_; }
    __host__ __device__ bool next(int i, Unit& u) const {
        const long L = (long)i * G + c; if (L >= nwg) return false;
        int wgid = (int)L; { const int q = nwg / NXCD, r = nwg % NXCD, xcd = wgid % NXCD, off = wgid / NXCD; wgid = (xcd < r ? xcd * (q + 1) : r * (q + 1) + (xcd - r) * q) + off; }
        const int nig = WGM * nN, gid = wgid / nig, fm = gid * WGM, gsz = (nM - fm) < WGM ? (nM - fm) : WGM;
        u.pm = fm + ((wgid % nig) % gsz); u.pn = (wgid % nig) / gsz; return true;
    }
    __device__ __forceinline__ void a_ready(const Unit&) const {}
    __device__ __forceinline__ void done(const Unit&) const {}
};

__device__ __forceinline__ unsigned cvt_pk_bf16(float lo, float hi) { unsigned r; asm volatile("v_cvt_pk_bf16_f32 %0, %1, %2" : "=v"(r) : "v"(lo), "v"(hi)); return r; }
typedef float f32x2 __attribute__((ext_vector_type(2)));
constexpr int ROWS_P = 16384, ROWS_ALL = 17408, DM = 1024, MODW = 9216, FFW = 2816, RCOLS = 1792;
__device__ __forceinline__ int seq_of_row(int r) { return r < ROWS_P ? (r >> 11) : 8 + ((r - ROWS_P) >> 3); }
__device__ __forceinline__ bool row_is_first(int r) { return r < ROWS_P ? ((r & 2047) == 0) : (((r - ROWS_P) & 7) == 0); }
__device__ __forceinline__ bool row_is_last(int r) { return r < ROWS_P ? ((r & 2047) == 2047) : (((r - ROWS_P) & 7) == 7); }
__device__ __forceinline__ float silu_f(float x) { return x * __builtin_amdgcn_rcpf(1.0f + __builtin_amdgcn_exp2f(-1.4426950408889634f * x)); }

struct EpiSwiglu {
    static constexpr bool PERM = true, AFTER_DRAIN = false;
    bf16_t* O;
    __device__ __forceinline__ void operator()(const f32x4 (&acc)[2][2][4][2], const Unit& u, int wr, int wc, int fr, int fq) const {
        const int row0 = u.pm * BM + wr * 64 + fr, col0 = u.pn * HALF + wc * 32 + 8 * fq;
#pragma unroll
        for (int ai = 0; ai < 2; ++ai)
#pragma unroll
            for (int m = 0; m < 4; ++m) {
                bf16_t* rowp = O + (size_t)(row0 + ai * HALF + m * 16) * FFW + col0;
                const f32x4 g0 = acc[ai][0][m][0], g1 = acc[ai][0][m][1], u0 = acc[ai][1][m][0], u1 = acc[ai][1][m][1];
                u32x4 w;
                w.x = cvt_pk_bf16(silu_f(g0[0]) * u0[0], silu_f(g0[1]) * u0[1]); w.y = cvt_pk_bf16(silu_f(g0[2]) * u0[2], silu_f(g0[3]) * u0[3]);
                w.z = cvt_pk_bf16(silu_f(g1[0]) * u1[0], silu_f(g1[1]) * u1[1]); w.w = cvt_pk_bf16(silu_f(g1[2]) * u1[2], silu_f(g1[3]) * u1[3]);
                *(u32x4*)rowp = w;
            }
    }
};
struct EpiResid {
    static constexpr bool PERM = false, AFTER_DRAIN = false;
    const float* resP; const float* resS; float* out; const float* gate; float coef;
    __device__ __forceinline__ void operator()(const f32x4 (&acc)[2][2][4][2], const Unit& u, int wr, int wc, int fr, int fq) const {
        const int col0 = u.pn * BM + wc * 32 + 4 * fq;
#pragma unroll
        for (int ai = 0; ai < 2; ++ai)
#pragma unroll
            for (int m = 0; m < 4; ++m) {
                const int row = u.pm * BM + ai * HALF + wr * 64 + m * 16 + fr; const int s = seq_of_row(row);
                const float* rrow = (row < ROWS_P ? resP + (size_t)row * DM : resS + (size_t)(row - ROWS_P) * DM) + col0;
                float* orow = out + (size_t)row * DM + col0; const float* grow = gate + (size_t)s * MODW + col0;
#pragma unroll
                for (int bj = 0; bj < 2; ++bj)
#pragma unroll
                    for (int n = 0; n < 2; ++n) { const int off = bj * HALF + n * 16; const f32x4 r = *(const f32x4*)(rrow + off), g = *(const f32x4*)(grow + off);
                        *(f32x4*)(orow + off) = r + (g * coef) * acc[ai][bj][m][n]; }
            }
    }
};
struct EpiP {
    static constexpr bool PERM = true, AFTER_DRAIN = false;
    bf16_t* P; float* shp; float* shs;
    __device__ __forceinline__ void operator()(const f32x4 (&acc)[2][2][4][2], const Unit& u, int wr, int wc, int fr, int fq) const {
        const int row0 = u.pm * BM + wr * 64 + fr, col0 = u.pn * BM + wc * 32 + 8 * fq;
#pragma unroll
        for (int ai = 0; ai < 2; ++ai)
#pragma unroll
            for (int m = 0; m < 4; ++m) {
                const int row = row0 + ai * HALF + m * 16; const bool last = row_is_last(row);
                bf16_t* rowp = P + (size_t)row * FFW + col0;
#pragma unroll
                for (int bj = 0; bj < 2; ++bj) { const f32x4 v0 = acc[ai][bj][m][0], v1 = acc[ai][bj][m][1]; const int col = col0 + bj * HALF;
                    u32x4 w; w.x = cvt_pk_bf16(v0[0], v0[1]); w.y = cvt_pk_bf16(v0[2], v0[3]); w.z = cvt_pk_bf16(v1[0], v1[1]); w.w = cvt_pk_bf16(v1[2], v1[3]);
                    *(u32x4*)(rowp + bj * HALF) = w;
                    if (last && col < RCOLS) { float* o = (row < ROWS_P ? shp + (size_t)(row >> 11) * RCOLS : shs + (size_t)((row - ROWS_P) >> 3) * RCOLS) + col;
                        *(f32x4*)o = v0; *(f32x4*)(o + 4) = v1; } }
            }
    }
};
template <class Epi, class Sched, bool ALIGN_EPI = false, bool SP2 = false>
__device__ __forceinline__ void gemm_phase(PG8_LAS unsigned char* lds, const Gemm g, const Sched& S, const Epi& E) {
    const int tid = threadIdx.x, wid = __builtin_amdgcn_readfirstlane(tid >> 6), lane = tid & 63, wr = wid >> 2, wc = wid & 3, fr = lane & 15, fq = lane >> 4;
    const int K = g.K, nt = K / BK;
    unsigned voffA[2], voffB[2];
#pragma unroll
    for (int i = 0; i < 2; ++i) { int R, C; stage_rc(tid * 16 + i * 8192, R, C); const int Rb = Epi::PERM ? ((R & ~31) + perm32(R & 31)) : R;
        voffA[i] = (unsigned)(R * K + C) * 2u; voffB[i] = (unsigned)(Rb * K + C) * 2u; }
    const size_t kstep = (size_t)(BK * 2);
    const size_t hstep = (size_t)HALF * K * 2;
    const size_t tstep = 2 * hstep;
    const unsigned ldsw = (unsigned)wid * 1024u;
    const int aoff = lds_byte(wr * 64 + fr, fq * 8), boff = lds_byte(wc * 32 + fr, fq * 8);
#define PG8_SA(b, h) (((b) * 2 + (h)) * HTB)
#define PG8_SB(b, h) ((4 + (b) * 2 + (h)) * HTB)
#define PG8_STAGE(bufoff, gbase, voff) do { _Pragma("unroll") for (int _i = 0; _i < 2; ++_i) \
        __builtin_amdgcn_global_load_lds((const unsigned*)((const char*)(gbase) + (voff)[_i]), (PG8_LAS unsigned*)(lds + (bufoff) + ldsw + _i * 8192), 16, 0, 0); } while (0)
#define PG8_LDA(dst, b, h) do { _Pragma("unroll") for (int m = 0; m < 4; ++m) _Pragma("unroll") for (int k = 0; k < 2; ++k) dst[m][k] = *(const PG8_LAS bf16x8*)(lds + PG8_SA(b, h) + aoff + m * 2048 + k * 1024); } while (0)
#define PG8_LDB(dst, b, h) do { _Pragma("unroll") for (int n = 0; n < 2; ++n) _Pragma("unroll") for (int k = 0; k < 2; ++k) dst[n][k] = *(const PG8_LAS bf16x8*)(lds + PG8_SB(b, h) + boff + n * 2048 + k * 1024); } while (0)
#define PG8_MMA(ai, bj, At, Bt) do { __builtin_amdgcn_s_setprio(1); _Pragma("unroll") for (int m = 0; m < 4; ++m) _Pragma("unroll") for (int n = 0; n < 2; ++n) _Pragma("unroll") for (int k = 0; k < 2; ++k) \
        acc[ai][bj][m][n] = __builtin_amdgcn_mfma_f32_16x16x32_bf16(Bt[n][k], At[m][k], acc[ai][bj][m][n], 0, 0, 0); __builtin_amdgcn_s_setprio(0); } while (0)
#define PG8_WAIT_V(n) asm volatile("s_waitcnt vmcnt(" #n ")" ::: "memory")
#define PG8_WAIT_L(n) asm volatile("s_waitcnt lgkmcnt(" #n ")" ::: "memory")
#define PG8_BAR __builtin_amdgcn_s_barrier()
#define PG8_SCHED __builtin_amdgcn_sched_barrier(0)
    Unit cur, nxt; int ui = 0;
    if (!S.next(0, cur)) return;
    f32x4 acc[2][2][4][2];
#pragma unroll
    for (int a = 0; a < 2; ++a)
#pragma unroll
        for (int b = 0; b < 2; ++b)
#pragma unroll
            for (int m = 0; m < 4; ++m)
#pragma unroll
                for (int n = 0; n < 2; ++n) acc[a][b][m][n] = (f32x4){0.f, 0.f, 0.f, 0.f};
    bf16x8 At[4][2], B0[2][2], B1[2][2];
    const char* cA = (const char*)g.A + (size_t)cur.pm * tstep; const char* cB = (const char*)g.Bt + (size_t)cur.pn * tstep;
    S.a_ready(cur);
    if constexpr (SP2) {
        PG8_STAGE(PG8_SB(0, 0), cB, voffB); PG8_STAGE(PG8_SB(0, 1), cB + hstep, voffB); PG8_STAGE(PG8_SA(0, 0), cA, voffA); PG8_STAGE(PG8_SA(0, 1), cA + hstep, voffA);
        if (wr == 1) PG8_BAR;
        PG8_WAIT_V(2); PG8_BAR;
        PG8_STAGE(PG8_SB(1, 0), cB + kstep, voffB); PG8_STAGE(PG8_SA(1, 0), cA + kstep, voffA); PG8_STAGE(PG8_SB(1, 1), cB + hstep + kstep, voffB);
        PG8_WAIT_V(6); PG8_BAR;
    } else {
        PG8_STAGE(PG8_SB(0, 0), cB, voffB); PG8_STAGE(PG8_SA(0, 0), cA, voffA); PG8_STAGE(PG8_SB(0, 1), cB + hstep, voffB); PG8_STAGE(PG8_SA(0, 1), cA + hstep, voffA);
        if (wr == 1) PG8_BAR;
        PG8_WAIT_V(4); PG8_BAR;
        PG8_STAGE(PG8_SB(1, 0), cB + kstep, voffB); PG8_STAGE(PG8_SA(1, 0), cA + kstep, voffA); PG8_STAGE(PG8_SB(1, 1), cB + hstep + kstep, voffB);
        PG8_WAIT_V(6); PG8_BAR;
    }
    for (;;) {
        const bool has_next = S.next(ui + 1, nxt);
        const char* nA = has_next ? (const char*)g.A + (size_t)nxt.pm * tstep : cA; const char* nB = has_next ? (const char*)g.Bt + (size_t)nxt.pn * tstep : cB;
        for (int t = 0; t < nt; t += 2) {
            const bool last = (t == nt - 2);
            const char* a1 = cA + (size_t)(t + 1) * kstep;
            const char* a2 = last ? nA : cA + (size_t)(t + 2) * kstep; const char* b2 = last ? nB : cB + (size_t)(t + 2) * kstep;
            const char* a3 = a2 + kstep; const char* b3 = b2 + kstep;
            if (last && has_next) S.a_ready(nxt);
            if constexpr (SP2) {
            PG8_LDB(B0, 0, 0); PG8_LDB(B1, 0, 1); PG8_SCHED; PG8_LDA(At, 0, 0); PG8_STAGE(PG8_SA(1, 1), a1 + hstep, voffA);
            PG8_WAIT_V(8); PG8_WAIT_L(0); PG8_BAR; PG8_MMA(0, 0, At, B0); PG8_MMA(0, 1, At, B1); PG8_BAR; PG8_SCHED;
            PG8_LDA(At, 0, 1); PG8_STAGE(PG8_SB(0, 0), b2, voffB); PG8_STAGE(PG8_SB(0, 1), b2 + hstep, voffB); PG8_STAGE(PG8_SA(0, 0), a2, voffA);
            PG8_WAIT_V(8); PG8_WAIT_L(0); PG8_BAR; PG8_MMA(1, 0, At, B0); PG8_MMA(1, 1, At, B1); PG8_BAR; PG8_SCHED;
            PG8_LDB(B0, 1, 0); PG8_LDB(B1, 1, 1); PG8_SCHED; PG8_LDA(At, 1, 0); PG8_STAGE(PG8_SA(0, 1), a2 + hstep, voffA);
            PG8_WAIT_V(8); PG8_WAIT_L(0); PG8_BAR; PG8_MMA(0, 0, At, B0); PG8_MMA(0, 1, At, B1); PG8_BAR; PG8_SCHED;
            PG8_LDA(At, 1, 1); PG8_STAGE(PG8_SB(1, 0), b3, voffB); PG8_STAGE(PG8_SB(1, 1), b3 + hstep, voffB); PG8_STAGE(PG8_SA(1, 0), a3, voffA);
            PG8_WAIT_V(8); PG8_WAIT_L(0); PG8_BAR; PG8_MMA(1, 0, At, B0); PG8_MMA(1, 1, At, B1); PG8_BAR; PG8_SCHED;
            } else {
            PG8_LDB(B0, 0, 0); PG8_SCHED; PG8_LDA(At, 0, 0); PG8_STAGE(PG8_SA(1, 1), a1 + hstep, voffA);
            PG8_WAIT_L(8); PG8_BAR; PG8_WAIT_L(0); PG8_MMA(0, 0, At, B0); PG8_BAR; PG8_SCHED;
            PG8_LDB(B1, 0, 1); PG8_STAGE(PG8_SB(0, 0), b2, voffB);
            PG8_BAR; PG8_WAIT_L(0); PG8_MMA(0, 1, At, B1); PG8_BAR;
            PG8_LDA(At, 0, 1); PG8_STAGE(PG8_SA(0, 0), a2, voffA);
            PG8_BAR; PG8_WAIT_L(0); PG8_MMA(1, 0, At, B0); PG8_BAR; PG8_SCHED;
            PG8_STAGE(PG8_SB(0, 1), b2 + hstep, voffB);
            PG8_WAIT_V(6); PG8_BAR; PG8_MMA(1, 1, At, B1); PG8_BAR;
            PG8_LDB(B0, 1, 0); PG8_SCHED; PG8_LDA(At, 1, 0); PG8_STAGE(PG8_SA(0, 1), a2 + hstep, voffA);
            PG8_WAIT_L(8); PG8_BAR; PG8_WAIT_L(0); PG8_MMA(0, 0, At, B0); PG8_BAR; PG8_SCHED;
            PG8_LDB(B1, 1, 1); PG8_STAGE(PG8_SB(1, 0), b3, voffB);
            PG8_BAR; PG8_WAIT_L(0); PG8_MMA(0, 1, At, B1); PG8_BAR;
            PG8_LDA(At, 1, 1); PG8_STAGE(PG8_SA(1, 0), a3, voffA);
            PG8_BAR; PG8_WAIT_L(0); PG8_MMA(1, 0, At, B0); PG8_BAR; PG8_SCHED;
            PG8_STAGE(PG8_SB(1, 1), b3 + hstep, voffB);
            PG8_WAIT_V(6); PG8_BAR; PG8_MMA(1, 1, At, B1); PG8_BAR;
            }
        }
        if constexpr (ALIGN_EPI) { if (wr == 0) PG8_BAR; }
        if constexpr (!Epi::AFTER_DRAIN) { E(acc, cur, wr, wc, fr, fq); S.done(cur); }
        if (!has_next) break;
#pragma unroll
        for (int a = 0; a < 2; ++a)
#pragma unroll
            for (int b = 0; b < 2; ++b)
#pragma unroll
                for (int m = 0; m < 4; ++m)
#pragma unroll
                    for (int n = 0; n < 2; ++n) acc[a][b][m][n] = (f32x4){0.f, 0.f, 0.f, 0.f};
        cur = nxt; cA = nA; cB = nB; ++ui;
        if constexpr (ALIGN_EPI) { if (wr == 1) PG8_BAR; }
    }
    PG8_WAIT_V(0);
    if constexpr (!ALIGN_EPI) { if (wr == 0) PG8_BAR; }
    PG8_BAR;
    if constexpr (Epi::AFTER_DRAIN) { E.fused(acc, cur, wr, wc, fr, fq, lds, wid, lane); S.done(cur); }
#undef PG8_SA
#undef PG8_SB
#undef PG8_STAGE
#undef PG8_LDA
#undef PG8_LDB
#undef PG8_MMA
#undef PG8_WAIT_V
#undef PG8_WAIT_L
#undef PG8_BAR
#undef PG8_SCHED
}
}
#ifndef PG8_SP2
#define PG8_SP2 true
#endif
#ifndef PG8_ALIGN
#define PG8_ALIGN true
#endif
#ifndef MK_N_LAUNCHES
#define MK_N_LAUNCHES 1
#endif
constexpr int NWAVES = 8;
constexpr int N_PHASES = 15;
constexpr int D = 1024, MP = 16384, MS = 1024, M = MP + MS, NSEQ = 136, FF = 2816, RC = 1792, PC = 2816, RW = 512, MODW = 9216;
constexpr float RMS_EPS = 1e-6f, LN_EPS = 1e-5f, GN_EPS = 64e-5f;
constexpr size_t O_Y = 0, O_SHP = 17825792, O_WKVP = 17840128, O_SHS = 18102272, O_WKVS = 18331648, O_CVS = 22525952, O_END = 23050240;
constexpr size_t MiB = 1u << 20;
constexpr size_t WS_CTL = 0, CTL_ZERO_BYTES = 1 * MiB;
constexpr size_t WS_GU1 = 1 * MiB, WS_DN1 = 12 * MiB, WS_WIN = 18 * MiB, WS_WOUT = 24 * MiB, WS_GU2 = 26 * MiB, WS_DN2 = 37 * MiB;
constexpr size_t WS_SMALL = 43 * MiB;
constexpr size_t WS_WLT = WS_SMALL, WS_ALT = WS_SMALL + 65536, WS_GLT = WS_SMALL + 131072, WS_WSB = WS_SMALL + 262144, WS_SILUC = WS_SMALL + 524288;
constexpr size_t WS_MOD = 44 * MiB;
constexpr size_t WS_BON = 49 * MiB;
constexpr size_t WS_XN = 50 * MiB;
constexpr size_t WS_ACT = 84 * MiB;
constexpr size_t WS_SC = 178 * MiB, SC_STRIDE = 17 * MiB;
constexpr size_t WS_G = 280 * MiB;
constexpr size_t WS_Y = 297 * MiB;
constexpr size_t WS_END = 331 * MiB;
static_assert(WS_DN1 - WS_GU1 >= (size_t)5632 * 1024 * 2 && WS_WIN - WS_DN1 >= (size_t)1024 * 2816 * 2 && WS_WOUT - WS_WIN >= (size_t)2816 * 1024 * 2 && WS_GU2 - WS_WOUT >= (size_t)1024 * 1024 * 2, "ws map a");
static_assert(WS_DN2 - WS_GU2 >= (size_t)5632 * 1024 * 2 && WS_SMALL - WS_DN2 >= (size_t)1024 * 2816 * 2 && WS_BON - WS_MOD >= (size_t)136 * 9216 * 4 && WS_XN - WS_BON >= (size_t)M * 8 * 4, "ws map b");
static_assert(WS_ACT - WS_XN >= (size_t)M * 1024 * 2 && WS_SC - WS_ACT >= (size_t)M * 2816 * 2 && SC_STRIDE >= (size_t)M * 512 * 2 && WS_G - WS_SC >= 6 * SC_STRIDE && WS_Y - WS_G >= (size_t)M * 512 * 2 && WS_END - WS_Y >= (size_t)M * 512 * 4, "ws map c");
constexpr int CW_TMO = 0, CW_CODE = 1, CW_BAR = 4096;
constexpr int RING_OFF = 0, RING_BYTES = 131072;
constexpr int LDSCTL_OFF = RING_BYTES, MISC_OFF = LDSCTL_OFF + 320;
constexpr int LDS_BYTES = 147456;
struct Args { const float* in[30]; float* out; unsigned char* ws; int ph_lo, ph_hi; };
#define GAS __attribute__((address_space(1)))
#define LAS __attribute__((address_space(3)))
typedef unsigned short bf16;
typedef unsigned v4u __attribute__((ext_vector_type(4)));
typedef float f32x4 __attribute__((ext_vector_type(4)));
typedef short bf16x8 __attribute__((ext_vector_type(8)));
typedef GAS unsigned gu32;
typedef GAS unsigned long long gu64;
#define RLX_AGENT __ATOMIC_RELAXED, __HIP_MEMORY_SCOPE_AGENT
#define LDS_WAIT() asm volatile("s_waitcnt lgkmcnt(0)" ::: "memory")
#define VM_WAIT() asm volatile("s_waitcnt vmcnt(0)" ::: "memory")
__device__ __forceinline__ unsigned long long rt() { return __builtin_amdgcn_s_memrealtime(); }
__device__ __forceinline__ unsigned f2bf(float f) { unsigned u = __builtin_bit_cast(unsigned, f); return (u + 0x7fffu + ((u >> 16) & 1u)) >> 16; }
__device__ __forceinline__ unsigned pk2(float lo, float hi) { return f2bf(lo) | (f2bf(hi) << 16); }
#define XB_TMO      128
#define XB_XCNT(j)  (256  + 64 * (j))
#define XB_XSUB(j)  (1280 + 64 * (j))
#define XB_XGEN(j)  (2304 + 64 * (j))
#define XB_TOP      3328
#define XB_TOPGEN   3392
#define XCD_BAR_WORDS 3456
#define XB_SPIN_CAP (1u << 18)

__device__ __forceinline__ unsigned xb_ld(unsigned* p)              { return __hip_atomic_load(p, __ATOMIC_RELAXED, __HIP_MEMORY_SCOPE_AGENT); }
__device__ __forceinline__ unsigned xb_add(unsigned* p, unsigned v) { return __hip_atomic_fetch_add(p, v, __ATOMIC_RELAXED, __HIP_MEMORY_SCOPE_AGENT); }
__device__ __forceinline__ unsigned xb_xcc_id() { return (unsigned)__builtin_amdgcn_s_getreg((3 << 11) | 20) & 0xFu; }
#define XB_SPIN(cond, bar) do { unsigned _sp = 0; while (cond) { __builtin_amdgcn_s_sleep(1); \
    if ((++_sp & 255u) == 0u) { if (xb_ld(&(bar)[XB_TMO])) break; if (_sp > XB_SPIN_CAP) { atomicAdd(&(bar)[XB_TMO], 1u); break; } } } } while (0)

struct XcdBarrier {
    unsigned* bar; unsigned x;
    volatile LAS unsigned* st;
};

__device__ __forceinline__ XcdBarrier xcd_barrier_post(unsigned* bar, volatile LAS unsigned* st) {
    XcdBarrier b; b.bar = bar; b.x = xb_xcc_id(); b.st = st;
    if (threadIdx.x == 0) (void)xb_add(&bar[XB_XCNT(b.x)], 1u);
    return b;
}
__device__ __forceinline__ void xcd_barrier_complete(unsigned* bar, unsigned x, unsigned& nloc, unsigned& nx) {
    const unsigned G = gridDim.x * gridDim.y * gridDim.z;
    unsigned sum, cnt, mine, sp = 0u;
    for (;;) {
        sum = 0u; cnt = 0u; mine = 0u;
#pragma unroll
        for (unsigned j = 0; j < 16; ++j) { const unsigned c = xb_ld(&bar[XB_XCNT(j)]); sum += c; cnt += (c > 0u) ? 1u : 0u; mine = (j == x) ? c : mine; }
        if (sum == G) break;
        __builtin_amdgcn_s_sleep(1);
        if ((++sp & 255u) == 0u) { if (xb_ld(&bar[XB_TMO])) break; if (sp > XB_SPIN_CAP) { atomicAdd(&bar[XB_TMO], 1u); break; } }
    }
    nloc = mine > 0u ? mine : 1u; nx = cnt > 0u ? cnt : 1u;
}

__device__ __forceinline__ void xcd_barrier(const XcdBarrier& b) {
    asm volatile("s_waitcnt vmcnt(0)" ::: "memory");
    __syncthreads();
    if (threadIdx.x == 0) {
        unsigned* bar = b.bar;
        __builtin_amdgcn_s_waitcnt(0);
        unsigned nloc = b.st[0], nx = b.st[1];
        if (nloc == 0u) { xcd_barrier_complete(bar, b.x, nloc, nx); b.st[0] = nloc; b.st[1] = nx; }
        const unsigned old = xb_add(&bar[XB_XSUB(b.x)], 1u);
        const unsigned gen = old / nloc;
        if (old + 1u == (gen + 1u) * nloc) {
            __builtin_amdgcn_fence(__ATOMIC_RELEASE, "agent");
            asm volatile("s_waitcnt vmcnt(0)" ::: "memory");
            const unsigned og = xb_add(&bar[XB_TOP], 1u);
            const unsigned tg = og / nx;
            if (og + 1u == (tg + 1u) * nx) xb_add(&bar[XB_TOPGEN], 1u);
            else XB_SPIN(xb_ld(&bar[XB_TOPGEN]) == tg, bar);
            __builtin_amdgcn_fence(__ATOMIC_ACQUIRE, "agent");
            xb_add(&bar[XB_XGEN(b.x)], 1u);
            asm volatile("s_waitcnt vmcnt(0)" ::: "memory");
        } else {
            XB_SPIN(xb_ld(&bar[XB_XGEN(b.x)]) == gen, bar);
            __builtin_amdgcn_fence(__ATOMIC_ACQUIRE, "agent");
            asm volatile("s_waitcnt vmcnt(0)" ::: "memory");
        }
    }
    __syncthreads();
}
struct Frame {
    LAS unsigned char* lds;
    volatile LAS unsigned* MISC;
    gu32* ctl;
    int tid, lane, wave, gw, NGW, G;
    float* out; unsigned char* ws;
};
__device__ __forceinline__ float wave_sum(float v) {
#pragma unroll
    for (int o = 1; o < 64; o <<= 1) v += __shfl_xor(v, o);
    return v;
}
__device__ __forceinline__ float bf2f(unsigned short b) { return __uint_as_float((unsigned)b << 16); }
__device__ __forceinline__ void unpack8(v4u w, float* f) {
    f[0] = __uint_as_float(w.x << 16); f[1] = __uint_as_float(w.x & 0xffff0000u); f[2] = __uint_as_float(w.y << 16); f[3] = __uint_as_float(w.y & 0xffff0000u);
    f[4] = __uint_as_float(w.z << 16); f[5] = __uint_as_float(w.z & 0xffff0000u); f[6] = __uint_as_float(w.w << 16); f[7] = __uint_as_float(w.w & 0xffff0000u);
}
typedef unsigned v2u __attribute__((ext_vector_type(2)));
__device__ __forceinline__ void unpack4(v2u w, float* f) {
    f[0] = __uint_as_float(w.x << 16); f[1] = __uint_as_float(w.x & 0xffff0000u); f[2] = __uint_as_float(w.y << 16); f[3] = __uint_as_float(w.y & 0xffff0000u);
}
__device__ __forceinline__ v2u pack4(const float* f) { v2u w; w.x = pk2(f[0], f[1]); w.y = pk2(f[2], f[3]); return w; }
__device__ __forceinline__ v4u pack8(const float* f) { v4u w; w.x = pk2(f[0], f[1]); w.y = pk2(f[2], f[3]); w.z = pk2(f[4], f[5]); w.w = pk2(f[6], f[7]); return w; }
__device__ __forceinline__ bf16x8 as_bf16x8(v4u w) { return __builtin_bit_cast(bf16x8, w); }
__device__ __forceinline__ float sigmoid_f(float x) { return 1.0f / (1.0f + __expf(-x)); }
__device__ __forceinline__ float tanh_f(float x) { const float e = __expf(2.0f * x); return 1.0f - 2.0f / (e + 1.0f); }

__device__ __forceinline__ void transpose_item(const float* W, int K, int N, bf16* WT, int kb, int nb, int orow0, LAS float* scr, int lane) {
    const int k0 = 64 * kb, n0 = 32 * nb;
#pragma unroll 8
    for (int i = 0; i < 32; ++i) { const int kk = 2 * i + (lane >> 5); scr[kk * 33 + (lane & 31)] = W[(size_t)(k0 + kk) * N + n0 + (lane & 31)]; }
    LDS_WAIT(); asm volatile("" ::: "memory");
    const int c = lane & 7;
#pragma unroll
    for (int j = 0; j < 4; ++j) { const int n = (lane >> 3) + 8 * j; const LAS float* s = scr + (8 * c) * 33 + n;
        v4u o; o.x = pk2(s[0 * 33], s[1 * 33]); o.y = pk2(s[2 * 33], s[3 * 33]); o.z = pk2(s[4 * 33], s[5 * 33]); o.w = pk2(s[6 * 33], s[7 * 33]);
        *(GAS v4u*)(WT + (size_t)(orow0 + n) * K + k0 + 8 * c) = o; }
    LDS_WAIT(); asm volatile("" ::: "memory");
}
__device__ __forceinline__ int gu_row(int n0) { return n0 < FF ? 256 * (n0 >> 7) + (n0 & 127) : 256 * ((n0 - FF) >> 7) + 128 + ((n0 - FF) & 127); }
__device__ __forceinline__ void p0_prologue(Frame& F, const Args& A) {
    LAS float* scr = (LAS float*)(F.lds + RING_OFF + F.wave * 16384);
    constexpr int I_GU = 16 * 176, I_DN = 44 * 32, I_IN = 16 * 88, I_OUT = 16 * 32, I_L64 = 16, I_L128 = 32;
    constexpr int NITEMS = 2 * I_GU + 2 * I_DN + I_IN + I_OUT + 2 * I_L64 + I_L128;
    for (int it = F.gw; it < NITEMS; it += F.NGW) {
        int r = it;
        if (r < I_GU) { const int kb = r / 176, nb = r % 176; transpose_item(A.in[8], 1024, 5632, ((bf16*)(F.ws + WS_GU1)), kb, nb, gu_row(32 * nb), scr, F.lane); continue; } r -= I_GU;
        if (r < I_GU) { const int kb = r / 176, nb = r % 176; transpose_item(A.in[27], 1024, 5632, ((bf16*)(F.ws + WS_GU2)), kb, nb, gu_row(32 * nb), scr, F.lane); continue; } r -= I_GU;
        if (r < I_DN) { const int kb = r / 32, nb = r % 32; transpose_item(A.in[9], 2816, 1024, ((bf16*)(F.ws + WS_DN1)), kb, nb, 32 * nb, scr, F.lane); continue; } r -= I_DN;
        if (r < I_DN) { const int kb = r / 32, nb = r % 32; transpose_item(A.in[28], 2816, 1024, ((bf16*)(F.ws + WS_DN2)), kb, nb, 32 * nb, scr, F.lane); continue; } r -= I_DN;
        if (r < I_IN) { const int kb = r / 88, nb = r % 88; transpose_item(A.in[10], 1024, 2816, ((bf16*)(F.ws + WS_WIN)), kb, nb, 32 * nb, scr, F.lane); continue; } r -= I_IN;
        if (r < I_OUT) { const int kb = r / 32, nb = r % 32; transpose_item(A.in[26], 1024, 1024, ((bf16*)(F.ws + WS_WOUT)), kb, nb, 32 * nb, scr, F.lane); continue; } r -= I_OUT;
        if (r < I_L64) { transpose_item(A.in[13], 64, 512, ((bf16*)(F.ws + WS_WLT)), 0, r, 32 * r, scr, F.lane); continue; } r -= I_L64;
        if (r < I_L64) { transpose_item(A.in[15], 64, 512, ((bf16*)(F.ws + WS_ALT)), 0, r, 32 * r, scr, F.lane); continue; } r -= I_L64;
        { const int kb = r / 16, nb = r % 16; transpose_item(A.in[16], 128, 512, ((bf16*)(F.ws + WS_GLT)), kb, nb, 32 * nb, scr, F.lane); }
    }
    const int gt = F.gw * 64 + F.lane, NGT = F.NGW * 64;
    for (int i = gt; i < 144 * 512; i += NGT) { const int s = i >> 9, k = (i & 511) * 2;
        float a = 0.f, b = 0.f;
        if (s < NSEQ) { const float* cr = s < 8 ? A.in[4] + (size_t)s * D : A.in[5] + (size_t)(s - 8) * D; a = cr[k]; b = cr[k + 1]; a = a * sigmoid_f(a); b = b * sigmoid_f(b); }
        ((unsigned*)((bf16*)(F.ws + WS_SILUC)))[i] = pk2(a, b); }
    for (int i = gt; i < 8 * 128 * 64; i += NGT) { const int j = (i & 63) * 2, ii = (i >> 6) & 127;
        const float a = A.in[24][2 * (size_t)i], b = A.in[24][2 * (size_t)i + 1];
        ((unsigned*)((bf16*)(F.ws + WS_WSB)))[i] = pk2(j <= ii ? a : 0.f, (j + 1) <= ii ? b : 0.f); }
}
__device__ __forceinline__ void p1_mod(Frame& F, const Args& A) {
    const int l15 = F.lane & 15, q = F.lane >> 4;
    for (int nt = F.gw; nt < MODW / 16; nt += F.NGW) {
        const int n0 = 16 * nt;
        f32x4 acc[9];
#pragma unroll
        for (int mt = 0; mt < 9; ++mt) acc[mt] = (f32x4){0.f, 0.f, 0.f, 0.f};
        for (int ks = 0; ks < 32; ++ks) {
            const int k0 = 32 * ks + 8 * q;
            const float* wp = A.in[6] + (size_t)k0 * MODW + n0 + l15;
            float wv[8];
#pragma unroll
            for (int j = 0; j < 8; ++j) wv[j] = wp[(size_t)j * MODW];
            const bf16x8 wf = as_bf16x8(pack8(wv));
#pragma unroll
            for (int mt = 0; mt < 9; ++mt) { const bf16x8 sf = *(const bf16x8*)(((bf16*)(F.ws + WS_SILUC)) + (size_t)(16 * mt + l15) * D + k0);
                acc[mt] = __builtin_amdgcn_mfma_f32_16x16x32_bf16(wf, sf, acc[mt], 0, 0, 0); }
        }
        const f32x4 bv = *(const f32x4*)(A.in[7] + n0 + 4 * q);
#pragma unroll
        for (int mt = 0; mt < 9; ++mt) { const int s = 16 * mt + l15; if (s < NSEQ) *(f32x4*)(((float*)(F.ws + WS_MOD)) + (size_t)s * MODW + n0 + 4 * q) = acc[mt] + bv; }
    }
}
__device__ __forceinline__ const float* res_row(const float* pP, const float* pS, int row) { return row < MP ? pP + (size_t)row * D : pS + (size_t)(row - MP) * D; }
__device__ __forceinline__ void norm_rows_bf16(Frame& F, const Args& A, const float* srcP, const float* srcS, int sh_off, int sc_off) {
    for (int row = F.gw; row < M; row += F.NGW) {
        const f32x4* xr = (const f32x4*)res_row(srcP, srcS, row) + F.lane; const int s = pg8::seq_of_row(row);
        f32x4 v[4]; float ss = 0.f;
#pragma unroll
        for (int j = 0; j < 4; ++j) { v[j] = xr[64 * j]; ss += (v[j].x * v[j].x + v[j].y * v[j].y) + (v[j].z * v[j].z + v[j].w * v[j].w); }
        const float rstd = 1.0f / sqrtf(wave_sum(ss) * (1.0f / D) + RMS_EPS);
        const f32x4* sc = (const f32x4*)(((float*)(F.ws + WS_MOD)) + (size_t)s * MODW + sc_off) + F.lane; const f32x4* sh = (const f32x4*)(((float*)(F.ws + WS_MOD)) + (size_t)s * MODW + sh_off) + F.lane;
        v2u* o = (v2u*)(((bf16*)(F.ws + WS_XN)) + (size_t)row * D) + F.lane;
#pragma unroll
        for (int j = 0; j < 4; ++j) { const f32x4 a = sc[64 * j], b = sh[64 * j]; const f32x4 r = v[j] * rstd * (a + 1.0f) + b; float t[4] = {r.x, r.y, r.z, r.w}; o[64 * j] = pack4(t); }
    }
}
__device__ __forceinline__ void final_norm_rows(Frame& F, const Args& A) {
    for (int row = F.gw; row < M; row += F.NGW) {
        f32x4* xr = (f32x4*)(F.out + (size_t)row * D) + F.lane;
        f32x4 v[4]; float ss = 0.f;
#pragma unroll
        for (int j = 0; j < 4; ++j) { v[j] = xr[64 * j]; ss += (v[j].x * v[j].x + v[j].y * v[j].y) + (v[j].z * v[j].z + v[j].w * v[j].w); }
        const float rstd = 1.0f / sqrtf(wave_sum(ss) * (1.0f / D) + RMS_EPS);
        const f32x4* g = (const f32x4*)A.in[29] + F.lane;
#pragma unroll
        for (int j = 0; j < 4; ++j) xr[64 * j] = v[j] * rstd * g[64 * j];
    }
}
struct XmCtx { const bf16* pc; const bf16* pp; const float* ss0; const float* mu; bool first, samp; };
__device__ __forceinline__ void xm8(const XmCtx& c, int col, float* o) {
    float cur[8], prv[8]; unpack8(*(const v4u*)(c.pc + col), cur);
    if (!c.first) unpack8(*(const v4u*)(c.pp + col), prv);
    else if (c.samp) { const f32x4 a = *(const f32x4*)(c.ss0 + col), b = *(const f32x4*)(c.ss0 + col + 4); prv[0] = a.x; prv[1] = a.y; prv[2] = a.z; prv[3] = a.w; prv[4] = b.x; prv[5] = b.y; prv[6] = b.z; prv[7] = b.w; }
    else {
#pragma unroll
        for (int e = 0; e < 8; ++e) prv[e] = 0.f; }
    const f32x4 m0 = *(const f32x4*)(c.mu + col), m1 = *(const f32x4*)(c.mu + col + 4); const float mm[8] = {m0.x, m0.y, m0.z, m0.w, m1.x, m1.y, m1.z, m1.w};
#pragma unroll
    for (int e = 0; e < 8; ++e) o[e] = cur[e] + (prv[e] - cur[e]) * mm[e];
}
__device__ __forceinline__ void xm4(const XmCtx& c, int col, float* o) {
    float cur[4], prv[4]; unpack4(*(const v2u*)(c.pc + col), cur);
    if (!c.first) unpack4(*(const v2u*)(c.pp + col), prv);
    else if (c.samp) { const f32x4 a = *(const f32x4*)(c.ss0 + col); prv[0] = a.x; prv[1] = a.y; prv[2] = a.z; prv[3] = a.w; }
    else { prv[0] = 0.f; prv[1] = 0.f; prv[2] = 0.f; prv[3] = 0.f; }
    const f32x4 m0 = *(const f32x4*)(c.mu + col); const float mm[4] = {m0.x, m0.y, m0.z, m0.w};
#pragma unroll
    for (int e = 0; e < 4; ++e) o[e] = cur[e] + (prv[e] - cur[e]) * mm[e];
}
__device__ __forceinline__ void prep_item(Frame& F, const Args& A, int r0) {
    const int l15 = F.lane & 15, q = F.lane >> 4, row = r0 + l15;
    XmCtx c; c.pc = ((bf16*)(F.ws + WS_ACT)) + (size_t)row * PC; c.pp = c.pc - PC; c.first = pg8::row_is_first(row); c.samp = row >= MP; c.mu = A.in[11];
    c.ss0 = A.in[2] + (size_t)(c.samp ? ((row - MP) >> 3) : 0) * RC;
    bf16x8 fw[2], fa[2], fg[4];
#pragma unroll
    for (int ks = 0; ks < 2; ++ks) { float t[8]; xm8(c, 1536 + 32 * ks + 8 * q, t);
#pragma unroll
        for (int e = 0; e < 8; ++e) t[e] = tanh_f(t[e]);
        fw[ks] = as_bf16x8(pack8(t)); }
#pragma unroll
    for (int ks = 0; ks < 2; ++ks) { float t[8]; xm8(c, 1600 + 32 * ks + 8 * q, t); fa[ks] = as_bf16x8(pack8(t)); }
#pragma unroll
    for (int ks = 0; ks < 4; ++ks) { float t[8]; xm8(c, 1664 + 32 * ks + 8 * q, t);
#pragma unroll
        for (int e = 0; e < 8; ++e) t[e] = sigmoid_f(t[e]);
        fg[ks] = as_bf16x8(pack8(t)); }
#pragma unroll 1
    for (int h = 0; h < 8; ++h) {
        float ss = 0.f, bon = 0.f;
#pragma unroll
        for (int ntl = 0; ntl < 4; ++ntl) { const int c0 = 64 * h + 16 * ntl + 4 * q; float xk[4]; xm4(c, 512 + c0, xk); const f32x4 kkv = *(const f32x4*)(A.in[17] + c0);
#pragma unroll
            for (int e = 0; e < 4; ++e) { const float kr = xk[e] * kkv[e]; ss += kr * kr; } }
        ss += __shfl_xor(ss, 16); ss += __shfl_xor(ss, 32);
        const float inv = 1.0f / fmaxf(sqrtf(ss), 1e-12f);
#pragma unroll 1
        for (int ntl = 0; ntl < 4; ++ntl) {
            const int n0 = 64 * h + 16 * ntl, c0 = n0 + 4 * q;
            f32x4 aw = {0.f, 0.f, 0.f, 0.f}, aa = aw, ag = aw;
#pragma unroll
            for (int ks = 0; ks < 2; ++ks) {
                aw = __builtin_amdgcn_mfma_f32_16x16x32_bf16(*(const bf16x8*)(((bf16*)(F.ws + WS_WLT)) + (size_t)(n0 + l15) * 64 + 32 * ks + 8 * q), fw[ks], aw, 0, 0, 0);
                aa = __builtin_amdgcn_mfma_f32_16x16x32_bf16(*(const bf16x8*)(((bf16*)(F.ws + WS_ALT)) + (size_t)(n0 + l15) * 64 + 32 * ks + 8 * q), fa[ks], aa, 0, 0, 0); }
#pragma unroll
            for (int ks = 0; ks < 4; ++ks)
                ag = __builtin_amdgcn_mfma_f32_16x16x32_bf16(*(const bf16x8*)(((bf16*)(F.ws + WS_GLT)) + (size_t)(n0 + l15) * 128 + 32 * ks + 8 * q), fg[ks], ag, 0, 0, 0);
            float xr[4], xk[4], xv[4]; xm4(c, c0, xr); xm4(c, 512 + c0, xk); xm4(c, 1024 + c0, xv);
            const f32x4 w0v = *(const f32x4*)(A.in[12] + c0), a0v = *(const f32x4*)(A.in[14] + c0), kkv = *(const f32x4*)(A.in[17] + c0), kav = *(const f32x4*)(A.in[18] + c0), rkv = *(const f32x4*)(A.in[19] + c0);
            float omd[4], km[4], gg[4], kk[4], bb[4];
#pragma unroll
            for (int e = 0; e < 4; ++e) {
                const float z = -(w0v[e] + aw[e]);
                const float sp = z > 20.f ? z : __logf(1.0f + __expf(z));
                const float wlog = -sp - 0.5f;
                const float dec = __expf(-__expf(wlog));
                omd[e] = 1.0f - dec;
                const float a = sigmoid_f(a0v[e] + aa[e]);
                kk[e] = xk[e] * kkv[e] * inv; bb[e] = kk[e] * a;
                km[e] = xk[e] * (1.0f + (a - 1.0f) * kav[e]);
                bon += xr[e] * km[e] * rkv[e];
                gg[e] = ag[e];
            }
            const size_t o = (size_t)row * RW + c0;
            *(v2u*)(((bf16*)(F.ws + WS_SC)) + o) = pack4(xr); *(v2u*)(((bf16*)(F.ws + (WS_SC + SC_STRIDE))) + o) = pack4(km); *(v2u*)(((bf16*)(F.ws + (WS_SC + 2 * SC_STRIDE))) + o) = pack4(xv);
            *(v2u*)(((bf16*)(F.ws + (WS_SC + 3 * SC_STRIDE))) + o) = pack4(kk); *(v2u*)(((bf16*)(F.ws + (WS_SC + 4 * SC_STRIDE))) + o) = pack4(bb);
            *(v2u*)(((bf16*)(F.ws + (WS_SC + 5 * SC_STRIDE))) + o) = pack4(omd); *(v2u*)(((bf16*)(F.ws + WS_G)) + o) = pack4(gg);
        }
        bon += __shfl_xor(bon, 16); bon += __shfl_xor(bon, 32);
        if (q == 0) ((float*)(F.ws + WS_BON))[(size_t)row * 8 + h] = bon;
    }
}
__device__ __forceinline__ void lnv_rows(Frame& F, const Args& A) {
    for (int row = F.gw; row < M; row += F.NGW) {
        v4u* pv = (v4u*)(((bf16*)(F.ws + WS_ACT)) + (size_t)row * PC + 2304) + F.lane;
        float x[8]; unpack8(*pv, x);
        float s = 0.f;
#pragma unroll
        for (int e = 0; e < 8; ++e) s += x[e];
        const float mean = wave_sum(s) * (1.0f / 512.0f); float qq = 0.f;
#pragma unroll
        for (int e = 0; e < 8; ++e) { x[e] -= mean; qq += x[e] * x[e]; }
        const float rstd = 1.0f / sqrtf(wave_sum(qq) * (1.0f / 512.0f) + LN_EPS);
        const f32x4 g0 = *(const f32x4*)(A.in[22] + 8 * F.lane), g1 = *(const f32x4*)(A.in[22] + 8 * F.lane + 4), b0 = *(const f32x4*)(A.in[23] + 8 * F.lane), b1 = *(const f32x4*)(A.in[23] + 8 * F.lane + 4);
        const float gg[8] = {g0.x, g0.y, g0.z, g0.w, g1.x, g1.y, g1.z, g1.w}, bb[8] = {b0.x, b0.y, b0.z, b0.w, b1.x, b1.y, b1.z, b1.w};
#pragma unroll
        for (int e = 0; e < 8; ++e) x[e] = x[e] * rstd * gg[e] + bb[e];
        *pv = pack8(x);
        if (row >= MP) { float* o = F.out + O_CVS + (size_t)(row - MP) * 512 + 8 * F.lane; *(f32x4*)o = (f32x4){x[0], x[1], x[2], x[3]}; *(f32x4*)(o + 4) = (f32x4){x[4], x[5], x[6], x[7]}; }
    }
}
template <bool SAMP> __device__ __forceinline__ void gmlp_item(Frame& F, const Args& A, int ci, int h) {
    const int l15 = F.lane & 15, q = F.lane >> 4;
    const int base = SAMP ? MP + 8 * ci : 128 * ci;
    constexpr int NIT = SAMP ? 1 : 8, NKS = SAMP ? 1 : 4;
#pragma unroll 1
    for (int dt = 0; dt < 4; ++dt) {
        const int colv = 2304 + h * 64 + 16 * dt + l15;
        bf16x8 vf[NKS];
#pragma unroll
        for (int ks = 0; ks < NKS; ++ks) {
#pragma unroll
            for (int j = 0; j < 8; ++j) { const int jr = 32 * ks + 8 * q + j; vf[ks][j] = (SAMP && jr >= 8) ? (short)0 : (short)((bf16*)(F.ws + WS_ACT))[(size_t)(base + jr) * PC + colv]; } }
#pragma unroll
        for (int it = 0; it < NIT; ++it) {
            f32x4 acc = {0.f, 0.f, 0.f, 0.f};
#pragma unroll
            for (int ks = 0; ks < NKS; ++ks) if (ks <= (it >> 1))
                acc = __builtin_amdgcn_mfma_f32_16x16x32_bf16(vf[ks], *(const bf16x8*)(((bf16*)(F.ws + WS_WSB)) + ((size_t)(h * 128 + 16 * it + l15)) * 128 + 32 * ks + 8 * q), acc, 0, 0, 0);
            const int i = 16 * it + l15;
            if (!SAMP || i < 8) { const int row = base + i; const float bs = A.in[25][h * 128 + i]; const int cc = h * 64 + 16 * dt + 4 * q;
                float pu[4]; unpack4(*(const v2u*)(((bf16*)(F.ws + WS_ACT)) + (size_t)row * PC + 1792 + cc), pu);
                float o[4];
#pragma unroll
                for (int e = 0; e < 4; ++e) o[e] = pu[e] * (acc[e] + bs);
                *(v2u*)(((bf16*)(F.ws + WS_XN)) + (size_t)row * D + 512 + cc) = pack4(o); }
        }
    }
}
__device__ __forceinline__ float red16(float x) {
    x += __builtin_bit_cast(float, __builtin_amdgcn_update_dpp(0, __builtin_bit_cast(int, x), 0x128, 0xf, 0xf, false));
    x += __builtin_bit_cast(float, __builtin_amdgcn_update_dpp(0, __builtin_bit_cast(int, x), 0x124, 0xf, 0xf, false));
    x += __builtin_bit_cast(float, __builtin_amdgcn_update_dpp(0, __builtin_bit_cast(int, x), 0x122, 0xf, 0xf, false));
    x += __builtin_bit_cast(float, __builtin_amdgcn_update_dpp(0, __builtin_bit_cast(int, x), 0x121, 0xf, 0xf, false));
    return x;
}
__device__ __forceinline__ float wkv_step(f32x4& S, const f32x4 w, const f32x4 kk, const f32x4 bb, const f32x4 k, const f32x4 r, const float vv) {
    float d = (S.x * kk.x + S.y * kk.y) + (S.z * kk.z + S.w * kk.w);
    d = red16(d);
    S = S * w + k * vv - bb * d;
    float y = (S.x * r.x + S.y * r.y) + (S.z * r.z + S.w * r.w);
    return red16(y);
}
constexpr int TC = 32, STEP_F = 336, CHUNK_F = TC * STEP_F, LD_ITEMS = TC * 42;
__device__ __forceinline__ void scan_prompt_unit(Frame& F, const Args& A, int unit) {
    const int bh = unit >> 2, qtr = unit & 3, b = bh >> 3, h = bh & 7;
    const size_t rowbase = (size_t)b * 2048;
    LAS float* buf0 = (LAS float*)(F.lds + RING_OFF); LAS float* buf1 = buf0 + CHUNK_F;
    const int j = F.lane & 15, vloc = 4 * F.wave + (F.lane >> 4), v = 16 * qtr + vloc;
    f32x4 S = {0.f, 0.f, 0.f, 0.f};
    v4u ld[3]; const bf16* srcp[3]; int dsto[3]; bool isw[3], act[3];
#pragma unroll
    for (int i = 0; i < 3; ++i) { const int it = F.tid + 512 * i; act[i] = it < LD_ITEMS; const int st = act[i] ? it / 42 : 0, a = act[i] ? it % 42 : 0;
        const size_t ro = (rowbase + st) * RW + h * 64;
        if (a < 40) { const int ar = a >> 3, seg = a & 7; const bf16* base = ar == 0 ? ((bf16*)(F.ws + (WS_SC + 5 * SC_STRIDE))) : ar == 1 ? ((bf16*)(F.ws + (WS_SC + 3 * SC_STRIDE))) : ar == 2 ? ((bf16*)(F.ws + (WS_SC + 4 * SC_STRIDE))) : ar == 3 ? ((bf16*)(F.ws + (WS_SC + SC_STRIDE))) : ((bf16*)(F.ws + WS_SC)); srcp[i] = base + ro + 8 * seg; }
        else srcp[i] = ((bf16*)(F.ws + (WS_SC + 2 * SC_STRIDE))) + ro + 16 * qtr + 8 * (a - 40);
        dsto[i] = st * STEP_F + (a < 40 ? (a >> 3) * 64 + 8 * (a & 7) : 320 + 8 * (a - 40)); isw[i] = a < 8; }
#define SCAN_ISSUE(c) do { _Pragma("unroll") for (int i = 0; i < 3; ++i) if (act[i]) ld[i] = *(const v4u*)(srcp[i] + (size_t)(c) * TC * RW); } while (0)
#define SCAN_COMMIT(buf) do { _Pragma("unroll") for (int i = 0; i < 3; ++i) if (act[i]) { float f[8]; unpack8(ld[i], f); \
        if (isw[i]) { _Pragma("unroll") for (int e = 0; e < 8; ++e) f[e] = 1.0f - f[e]; } \
        LAS float* dst = (buf) + dsto[i]; *(LAS f32x4*)dst = (f32x4){f[0], f[1], f[2], f[3]}; *(LAS f32x4*)(dst + 4) = (f32x4){f[4], f[5], f[6], f[7]}; } } while (0)
    SCAN_ISSUE(0); SCAN_COMMIT(buf0); __syncthreads();
    for (int c = 0; c < 2048 / TC; ++c) {
        if (c + 1 < 2048 / TC) SCAN_ISSUE(c + 1);
        if (F.wave < 4) {
            const LAS float* bp = (c & 1) ? buf1 : buf0;
            float* yp = ((float*)(F.ws + WS_Y)) + (rowbase + (size_t)c * TC) * RW + h * 64 + v;
#pragma unroll 4
            for (int s = 0; s < TC; ++s) {
                const LAS float* st = bp + s * STEP_F;
                const f32x4 w4 = *(const LAS f32x4*)(st + 4 * j), kk4 = *(const LAS f32x4*)(st + 64 + 4 * j), bb4 = *(const LAS f32x4*)(st + 128 + 4 * j),
                            k4 = *(const LAS f32x4*)(st + 192 + 4 * j), r4 = *(const LAS f32x4*)(st + 256 + 4 * j);
                const float vv = st[320 + vloc];
                const float y = wkv_step(S, w4, kk4, bb4, k4, r4, vv);
                if (j == 0) yp[(size_t)s * RW] = y;
            }
        }
        if (c + 1 < 2048 / TC) { if (c & 1) SCAN_COMMIT(buf0); else SCAN_COMMIT(buf1); }
        __syncthreads();
    }
#undef SCAN_ISSUE
#undef SCAN_COMMIT
    if (F.wave < 4) *(f32x4*)(F.out + O_WKVP + ((size_t)bh * 64 + v) * 64 + 4 * j) = S;
}
__device__ __forceinline__ void scan_sample_item(Frame& F, const Args& A, int it) {
    const int sbh = it >> 4, rg = it & 15, sb = sbh >> 3, h = sbh & 7, j = F.lane & 15, v = 4 * rg + (F.lane >> 4);
    const size_t so = ((size_t)sbh * 64 + v) * 64 + 4 * j;
    f32x4 S = *(const f32x4*)(A.in[3] + so);
#pragma unroll
    for (int t = 0; t < 8; ++t) {
        const size_t ro = (size_t)(MP + 8 * sb + t) * RW + h * 64;
        float w[4], kk[4], bb[4], k[4], r[4];
        unpack4(*(const v2u*)(((bf16*)(F.ws + (WS_SC + 5 * SC_STRIDE))) + ro + 4 * j), w); unpack4(*(const v2u*)(((bf16*)(F.ws + (WS_SC + 3 * SC_STRIDE))) + ro + 4 * j), kk); unpack4(*(const v2u*)(((bf16*)(F.ws + (WS_SC + 4 * SC_STRIDE))) + ro + 4 * j), bb);
        unpack4(*(const v2u*)(((bf16*)(F.ws + (WS_SC + SC_STRIDE))) + ro + 4 * j), k); unpack4(*(const v2u*)(((bf16*)(F.ws + WS_SC)) + ro + 4 * j), r);
        const float vv = bf2f(((bf16*)(F.ws + (WS_SC + 2 * SC_STRIDE)))[ro + v]);
        const float y = wkv_step(S, (f32x4){1.f - w[0], 1.f - w[1], 1.f - w[2], 1.f - w[3]}, (f32x4){kk[0], kk[1], kk[2], kk[3]}, (f32x4){bb[0], bb[1], bb[2], bb[3]},
                                 (f32x4){k[0], k[1], k[2], k[3]}, (f32x4){r[0], r[1], r[2], r[3]}, vv);
        if (j == 0) ((float*)(F.ws + WS_Y))[ro + v] = y;
    }
    *(f32x4*)(F.out + O_WKVS + so) = S;
}
__device__ __forceinline__ void postscan_rows(Frame& F, const Args& A) {
    for (int row = F.gw; row < M; row += F.NGW) {
        const int c = 8 * F.lane, head = F.lane >> 3; const size_t o = (size_t)row * RW + c;
        const f32x4 y0 = *(const f32x4*)(((float*)(F.ws + WS_Y)) + o), y1 = *(const f32x4*)(((float*)(F.ws + WS_Y)) + o + 4);
        float y[8] = {y0.x, y0.y, y0.z, y0.w, y1.x, y1.y, y1.z, y1.w};
        float s = 0.f;
#pragma unroll
        for (int e = 0; e < 8; ++e) s += y[e];
        s += __shfl_xor(s, 1); s += __shfl_xor(s, 2); s += __shfl_xor(s, 4);
        const float mu = s * (1.0f / 64.0f); float qq = 0.f;
#pragma unroll
        for (int e = 0; e < 8; ++e) { y[e] -= mu; qq += y[e] * y[e]; }
        qq += __shfl_xor(qq, 1); qq += __shfl_xor(qq, 2); qq += __shfl_xor(qq, 4);
        const float rstd = 1.0f / sqrtf(qq * (1.0f / 64.0f) + GN_EPS);
        const f32x4 g0 = *(const f32x4*)(A.in[20] + c), g1 = *(const f32x4*)(A.in[20] + c + 4), b0 = *(const f32x4*)(A.in[21] + c), b1 = *(const f32x4*)(A.in[21] + c + 4);
        const float gw[8] = {g0.x, g0.y, g0.z, g0.w, g1.x, g1.y, g1.z, g1.w}, gb[8] = {b0.x, b0.y, b0.z, b0.w, b1.x, b1.y, b1.z, b1.w};
        float vv[8], gg[8]; unpack8(*(const v4u*)(((bf16*)(F.ws + (WS_SC + 2 * SC_STRIDE))) + o), vv); unpack8(*(const v4u*)(((bf16*)(F.ws + WS_G)) + o), gg);
        const float bon = ((float*)(F.ws + WS_BON))[(size_t)row * 8 + head];
#pragma unroll
        for (int e = 0; e < 8; ++e) y[e] = (y[e] * rstd * gw[e] + gb[e] + bon * vv[e]) * gg[e];
        *(v4u*)(((bf16*)(F.ws + WS_XN)) + (size_t)row * D + c) = pack8(y);
    }
}
__global__ void __launch_bounds__(NWAVES * 64, 2) fwd_kernel(Args args) {
    extern __shared__ __attribute__((aligned(16))) unsigned char lds[];
    Frame F;
    F.lds = (LAS unsigned char*)lds;
    F.MISC = (volatile LAS unsigned*)(F.lds + MISC_OFF);
    F.tid = threadIdx.x; F.lane = F.tid & 63; F.wave = __builtin_amdgcn_readfirstlane(F.tid >> 6);
    F.G = gridDim.x; F.gw = blockIdx.x * NWAVES + F.wave; F.NGW = F.G * NWAVES;
    unsigned char* ws = args.ws;
    F.ctl = (gu32*)(ws + WS_CTL);
    F.out = args.out; F.ws = ws;
    for (int u = F.tid; u < (LDS_BYTES - LDSCTL_OFF) / 4; u += NWAVES * 64) ((LAS unsigned*)(F.lds + LDSCTL_OFF))[u] = 0u;
    __syncthreads();
    XcdBarrier bar; bar.bar = (unsigned*)(F.ctl + CW_BAR); bar.x = 0; bar.st = nullptr;
    if (MK_N_LAUNCHES == 1) bar = xcd_barrier_post((unsigned*)(F.ctl + CW_BAR), F.MISC + 8);
    const Args& A = args;
    const int lo = args.ph_lo, hi = args.ph_hi;
#ifndef PH_MASK
#define PH_MASK 0x7fff
#endif
#define IN(k) (((PH_MASK >> (k)) & 1) && lo <= (k) && (k) < hi)
#define SEAM(k) do { if (IN(k) && IN((k) + 1)) xcd_barrier(bar); } while (0)
    float* const H = F.out;

    if (IN(0)) { p0_prologue(F, A); } SEAM(0);
    if (IN(1)) { p1_mod(F, A); } SEAM(1);
    if (IN(2)) { norm_rows_bf16(F, A, A.in[0], A.in[1], 0, 1024); } SEAM(2);
    if (IN(3)) { pg8::Gemm g{((bf16*)(F.ws + WS_XN)), ((bf16*)(F.ws + WS_GU1)), M, 2 * FF, D}; pg8::StaticOrder S; S.init(M, 2 * FF, F.G, (int)blockIdx.x); pg8::EpiSwiglu E{((bf16*)(F.ws + WS_ACT))};
        pg8::gemm_phase<pg8::EpiSwiglu, pg8::StaticOrder, PG8_ALIGN, PG8_SP2>(F.lds + RING_OFF, g, S, E); } SEAM(3);
    if (IN(4)) { pg8::Gemm g{((bf16*)(F.ws + WS_ACT)), ((bf16*)(F.ws + WS_DN1)), M, D, FF}; pg8::StaticOrder S; S.init(M, D, F.G, (int)blockIdx.x); pg8::EpiResid E{A.in[0], A.in[1], H, ((float*)(F.ws + WS_MOD)) + 2048, 0.5f};
        pg8::gemm_phase<pg8::EpiResid, pg8::StaticOrder, PG8_ALIGN, PG8_SP2>(F.lds + RING_OFF, g, S, E); } SEAM(4);
    if (IN(5)) { norm_rows_bf16(F, A, H, H + (size_t)MP * D, 3072, 4096); } SEAM(5);
    if (IN(6)) { pg8::Gemm g{((bf16*)(F.ws + WS_XN)), ((bf16*)(F.ws + WS_WIN)), M, PC, D}; pg8::StaticOrder S; S.init(M, PC, F.G, (int)blockIdx.x); pg8::EpiP E{((bf16*)(F.ws + WS_ACT)), F.out + O_SHP, F.out + O_SHS};
        pg8::gemm_phase<pg8::EpiP, pg8::StaticOrder, PG8_ALIGN, PG8_SP2>(F.lds + RING_OFF, g, S, E); } SEAM(6);
    if (IN(7)) { for (int it = F.gw; it < M / 16; it += F.NGW) prep_item(F, A, 16 * it); lnv_rows(F, A); } SEAM(7);
    if (IN(8)) {
        for (int u = blockIdx.x; u < 256; u += F.G) scan_prompt_unit(F, A, u);
        for (int it = F.gw; it < 128 * 8 * 16; it += F.NGW) scan_sample_item(F, A, it);
        for (int it = F.gw; it < 2048; it += F.NGW) { if (it < 1024) gmlp_item<false>(F, A, it >> 3, it & 7); else gmlp_item<true>(F, A, (it - 1024) >> 3, it & 7); }
    } SEAM(8);
    if (IN(9)) { postscan_rows(F, A); } SEAM(9);
    if (IN(10)) { pg8::Gemm g{((bf16*)(F.ws + WS_XN)), ((bf16*)(F.ws + WS_WOUT)), M, D, D}; pg8::StaticOrder S; S.init(M, D, F.G, (int)blockIdx.x); pg8::EpiResid E{H, H + (size_t)MP * D, H, ((float*)(F.ws + WS_MOD)) + 5120, 1.0f};
        pg8::gemm_phase<pg8::EpiResid, pg8::StaticOrder, PG8_ALIGN, PG8_SP2>(F.lds + RING_OFF, g, S, E); } SEAM(10);
    if (IN(11)) { norm_rows_bf16(F, A, H, H + (size_t)MP * D, 6144, 7168); } SEAM(11);
    if (IN(12)) { pg8::Gemm g{((bf16*)(F.ws + WS_XN)), ((bf16*)(F.ws + WS_GU2)), M, 2 * FF, D}; pg8::StaticOrder S; S.init(M, 2 * FF, F.G, (int)blockIdx.x); pg8::EpiSwiglu E{((bf16*)(F.ws + WS_ACT))};
        pg8::gemm_phase<pg8::EpiSwiglu, pg8::StaticOrder, PG8_ALIGN, PG8_SP2>(F.lds + RING_OFF, g, S, E); } SEAM(12);
    if (IN(13)) { pg8::Gemm g{((bf16*)(F.ws + WS_ACT)), ((bf16*)(F.ws + WS_DN2)), M, D, FF}; pg8::StaticOrder S; S.init(M, D, F.G, (int)blockIdx.x); pg8::EpiResid E{H, H + (size_t)MP * D, H, ((float*)(F.ws + WS_MOD)) + 8192, 0.5f};
        pg8::gemm_phase<pg8::EpiResid, pg8::StaticOrder, PG8_ALIGN, PG8_SP2>(F.lds + RING_OFF, g, S, E); } SEAM(13);
    if (IN(14)) { final_norm_rows(F, A); }
#undef IN
#undef SEAM
}

extern "C" void kernel_launch(void* const* d_in, const int* in_sizes, int n_in, void* d_out, int out_size, void* d_ws, size_t ws_size, hipStream_t stream) {
    static int grid = 0;
    if (grid == 0) {
        if (n_in != 30 || in_sizes[0] != MP * D || (size_t)out_size != O_END || ws_size < WS_END) { fprintf(stderr, "kernel_launch: unexpected problem shape / workspace (%d inputs, out %d, ws %zu); nothing launched\n", n_in, out_size, ws_size); grid = -1; return; }
        int dev = 0, cus = 0, per_cu = 0;
        if (hipGetDevice(&dev) != hipSuccess || hipDeviceGetAttribute(&cus, hipDeviceAttributeMultiprocessorCount, dev) != hipSuccess) { grid = -1; return; }
        if (hipFuncSetAttribute((const void*)fwd_kernel, hipFuncAttributeMaxDynamicSharedMemorySize, LDS_BYTES) != hipSuccess) { fprintf(stderr, "kernel_launch: hipFuncSetAttribute failed\n"); grid = -1; return; }
        if (hipOccupancyMaxActiveBlocksPerMultiprocessor(&per_cu, (const void*)fwd_kernel, NWAVES * 64, LDS_BYTES) != hipSuccess || per_cu < 1) { fprintf(stderr, "kernel_launch: occupancy query says %d blocks per CU\n", per_cu); }
        (void)hipGetLastError();
        grid = cus;
    }
    if (grid < 0) return;
    (void)hipMemsetAsync((char*)d_ws + WS_CTL, 0, CTL_ZERO_BYTES, stream);
    Args a{};
    for (int i = 0; i < 30; ++i) a.in[i] = (const float*)d_in[i];
    a.out = (float*)d_out; a.ws = (unsigned char*)d_ws;
    if (MK_N_LAUNCHES == 1) { a.ph_lo = 0; a.ph_hi = N_PHASES; hipLaunchKernelGGL(fwd_kernel, dim3(grid), dim3(NWAVES * 64), LDS_BYTES, stream, a); }
    else for (int p = 0; p < N_PHASES; ++p) { a.ph_lo = p; a.ph_hi = p + 1; hipLaunchKernelGGL(fwd_kernel, dim3(grid), dim3(NWAVES * 64), LDS_BYTES, stream, a); }
}
```

```cpp
#include <hip/hip_runtime.h>
#include <cstdio>
#include <cstdint>
namespace pg8 {
#define PG8_LAS __attribute__((address_space(3)))
typedef unsigned short bf16_t;
typedef short bf16x8 __attribute__((ext_vector_type(8)));
typedef float f32x4 __attribute__((ext_vector_type(4)));
typedef unsigned u32x4 __attribute__((ext_vector_type(4)));
constexpr int BM = 256, BK = 64, HALF = 128, HTB = HALF * BK * 2  , STAGE_BYTES = 8 * HTB, NXCD = 8, WGM = 8;

__host__ __device__ __forceinline__ int lds_byte(int r, int c) { const int st = (r >> 4) * 2 + (c >> 5), rr = r & 15, cc = c & 31, ob = rr * 64 + cc * 2; return st * 1024 + (ob ^ (((ob >> 9) & 1) << 5)); }
__host__ __device__ __forceinline__ void stage_rc(int b, int& R, int& C) { const int st = b / 1024, sb = b % 1024, swz = sb ^ (((sb >> 9) & 1) << 5); R = (st >> 1) * 16 + swz / 64; C = (st & 1) * 32 + (swz % 64) / 2; }
__host__ __device__ __forceinline__ int perm32(int rho) { const int n = rho >> 4, i = rho & 15; return 8 * (i >> 2) + 4 * n + (i & 3); }

struct Unit { int pm, pn; };
struct Gemm { const bf16_t* A; const bf16_t* Bt; int M, N, K; };

struct StaticOrder {
    int nM, nN, nwg, G, c;
    __host__ __device__ void init(int M, int N, int G_, int c_) { nM = M / BM; nN = N / BM; nwg = nM * nN; G = G_; c = c_; }
    __host__ __device__ bool next(int i, Unit& u) const {
        const long L = (long)i * G + c; if (L >= nwg) return false;
        int wgid = (int)L; { const int q = nwg / NXCD, r = nwg % NXCD, xcd = wgid % NXCD, off = wgid / NXCD; wgid = (xcd < r ? xcd * (q + 1) : r * (q + 1) + (xcd - r) * q) + off; }
        const int nig = WGM * nN, gid = wgid / nig, fm = gid * WGM, gsz = (nM - fm) < WGM ? (nM - fm) : WGM;
        u.pm = fm + ((wgid % nig) % gsz); u.pn = (wgid % nig) / gsz; return true;
    }
    __device__ __forceinline__ void a_ready(const Unit&) const {}
    __device__ __forceinline__ void done(const Unit&) const {}
};

__device__ __forceinline__ unsigned cvt_pk_bf16(float lo, float hi) { unsigned r; asm volatile("v_cvt_pk_bf16_f32 %0, %1, %2" : "=v"(r) : "v"(lo), "v"(hi)); return r; }
typedef float f32x2 __attribute__((ext_vector_type(2)));
constexpr int ROWS_P = 16384, ROWS_ALL = 17408, DM = 1024, MODW = 9216, FFW = 2816, RCOLS = 1792;
__device__ __forceinline__ int seq_of_row(int r) { return r < ROWS_P ? (r >> 11) : 8 + ((r - ROWS_P) >> 3); }
__device__ __forceinline__ bool row_is_first(int r) { return r < ROWS_P ? ((r & 2047) == 0) : (((r - ROWS_P) & 7) == 0); }
__device__ __forceinline__ bool row_is_last(int r) { return r < ROWS_P ? ((r & 2047) == 2047) : (((r - ROWS_P) & 7) == 7); }
__device__ __forceinline__ float silu_f(float x) { return x * __builtin_amdgcn_rcpf(1.0f + __builtin_amdgcn_exp2f(-1.4426950408889634f * x)); }

struct EpiSwiglu {
    static constexpr bool PERM = true, AFTER_DRAIN = false;
    bf16_t* O;
    __device__ __forceinline__ void operator()(const f32x4 (&acc)[2][2][4][2], const Unit& u, int wr, int wc, int fr, int fq) const {
        const int row0 = u.pm * BM + wr * 64 + fr, col0 = u.pn * HALF + wc * 32 + 8 * fq;
#pragma unroll
        for (int ai = 0; ai < 2; ++ai)
#pragma unroll
            for (int m = 0; m < 4; ++m) {
                bf16_t* rowp = O + (size_t)(row0 + ai * HALF + m * 16) * FFW + col0;
                const f32x4 g0 = acc[ai][0][m][0], g1 = acc[ai][0][m][1], u0 = acc[ai][1][m][0], u1 = acc[ai][1][m][1];
                u32x4 w;
                w.x = cvt_pk_bf16(silu_f(g0[0]) * u0[0], silu_f(g0[1]) * u0[1]); w.y = cvt_pk_bf16(silu_f(g0[2]) * u0[2], silu_f(g0[3]) * u0[3]);
                w.z = cvt_pk_bf16(silu_f(g1[0]) * u1[0], silu_f(g1[1]) * u1[1]); w.w = cvt_pk_bf16(silu_f(g1[2]) * u1[2], silu_f(g1[3]) * u1[3]);
                *(u32x4*)rowp = w;
            }
    }
};
struct EpiResid {
    static constexpr bool PERM = false, AFTER_DRAIN = false;
    const float* resP; const float* resS; float* out; const float* gate; float coef;
    __device__ __forceinline__ void operator()(const f32x4 (&acc)[2][2][4][2], const Unit& u, int wr, int wc, int fr, int fq) const {
        const int col0 = u.pn * BM + wc * 32 + 4 * fq;
#pragma unroll
        for (int ai = 0; ai < 2; ++ai)
#pragma unroll
            for (int m = 0; m < 4; ++m) {
                const int row = u.pm * BM + ai * HALF + wr * 64 + m * 16 + fr; const int s = seq_of_row(row);
                const float* rrow = (row < ROWS_P ? resP + (size_t)row * DM : resS + (size_t)(row - ROWS_P) * DM) + col0;
                float* orow = out + (size_t)row * DM + col0; const float* grow = gate + (size_t)s * MODW + col0;
#pragma unroll
                for (int bj = 0; bj < 2; ++bj)
#pragma unroll
                    for (int n = 0; n < 2; ++n) { const int off = bj * HALF + n * 16; const f32x4 r = *(const f32x4*)(rrow + off), g = *(const f32x4*)(grow + off);
                        *(f32x4*)(orow + off) = r + (g * coef) * acc[ai][bj][m][n]; }
            }
    }
};
struct EpiP {
    static constexpr bool PERM = true, AFTER_DRAIN = false;
    bf16_t* P; float* shp; float* shs;
    __device__ __forceinline__ void operator()(const f32x4 (&acc)[2][2][4][2], const Unit& u, int wr, int wc, int fr, int fq) const {
        const int row0 = u.pm * BM + wr * 64 + fr, col0 = u.pn * BM + wc * 32 + 8 * fq;
#pragma unroll
        for (int ai = 0; ai < 2; ++ai)
#pragma unroll
            for (int m = 0; m < 4; ++m) {
                const int row = row0 + ai * HALF + m * 16; const bool last = row_is_last(row);
                bf16_t* rowp = P + (size_t)row * FFW + col0;
#pragma unroll
                for (int bj = 0; bj < 2; ++bj) { const f32x4 v0 = acc[ai][bj][m][0], v1 = acc[ai][bj][m][1]; const int col = col0 + bj * HALF;
                    u32x4 w; w.x = cvt_pk_bf16(v0[0], v0[1]); w.y = cvt_pk_bf16(v0[2], v0[3]); w.z = cvt_pk_bf16(v1[0], v1[1]); w.w = cvt_pk_bf16(v1[2], v1[3]);
                    *(u32x4*)(rowp + bj * HALF) = w;
                    if (last && col < RCOLS) { float* o = (row < ROWS_P ? shp + (size_t)(row >> 11) * RCOLS : shs + (size_t)((row - ROWS_P) >> 3) * RCOLS) + col;
                        *(f32x4*)o = v0; *(f32x4*)(o + 4) = v1; } }
            }
    }
};
template <class Epi, class Sched, bool ALIGN_EPI = false, bool SP2 = false>
__device__ __forceinline__ void gemm_phase(PG8_LAS unsigned char* lds, const Gemm g, const Sched& S, const Epi& E) {
    const int tid = threadIdx.x, wid = __builtin_amdgcn_readfirstlane(tid >> 6), lane = tid & 63, wr = wid >> 2, wc = wid & 3, fr = lane & 15, fq = lane >> 4;
    const int K = g.K, nt = K / BK;
    unsigned voffA[2], voffB[2];
#pragma unroll
    for (int i = 0; i < 2; ++i) { int R, C; stage_rc(tid * 16 + i * 8192, R, C); const int Rb = Epi::PERM ? ((R & ~31) + perm32(R & 31)) : R;
        voffA[i] = (unsigned)(R * K + C) * 2u; voffB[i] = (unsigned)(Rb * K + C) * 2u; }
    const size_t kstep = (size_t)(BK * 2);
    const size_t hstep = (size_t)HALF * K * 2;
    const size_t tstep = 2 * hstep;
    const unsigned ldsw = (unsigned)wid * 1024u;
    const int aoff = lds_byte(wr * 64 + fr, fq * 8), boff = lds_byte(wc * 32 + fr, fq * 8);
#define PG8_SA(b, h) (((b) * 2 + (h)) * HTB)
#define PG8_SB(b, h) ((4 + (b) * 2 + (h)) * HTB)
#define PG8_STAGE(bufoff, gbase, voff) do { _Pragma("unroll") for (int _i = 0; _i < 2; ++_i) \
        __builtin_amdgcn_global_load_lds((const unsigned*)((const char*)(gbase) + (voff)[_i]), (PG8_LAS unsigned*)(lds + (bufoff) + ldsw + _i * 8192), 16, 0, 0); } while (0)
#define PG8_LDA(dst, b, h) do { _Pragma("unroll") for (int m = 0; m < 4; ++m) _Pragma("unroll") for (int k = 0; k < 2; ++k) dst[m][k] = *(const PG8_LAS bf16x8*)(lds + PG8_SA(b, h) + aoff + m * 2048 + k * 1024); } while (0)
#define PG8_LDB(dst, b, h) do { _Pragma("unroll") for (int n = 0; n < 2; ++n) _Pragma("unroll") for (int k = 0; k < 2; ++k) dst[n][k] = *(const PG8_LAS bf16x8*)(lds + PG8_SB(b, h) + boff + n * 2048 + k * 1024); } while (0)
#define PG8_MMA(ai, bj, At, Bt) do { __builtin_amdgcn_s_setprio(1); _Pragma("unroll") for (int m = 0; m < 4; ++m) _Pragma("unroll") for (int n = 0; n < 2; ++n) _Pragma("unroll") for (int k = 0; k < 2; ++k) \
        acc[ai][bj][m][n] = __builtin_amdgcn_mfma_f32_16x16x32_bf16(Bt[n][k], At[m][k], acc[ai][bj][m][n], 0, 0, 0); __builtin_amdgcn_s_setprio(0); } while (0)
#define PG8_WAIT_V(n) asm volatile("s_waitcnt vmcnt(" #n ")" ::: "memory")
#define PG8_WAIT_L(n) asm volatile("s_waitcnt lgkmcnt(" #n ")" ::: "memory")
#define PG8_BAR __builtin_amdgcn_s_barrier()
#define PG8_SCHED __builtin_amdgcn_sched_barrier(0)
    Unit cur, nxt; int ui = 0;
    if (!S.next(0, cur)) return;
    f32x4 acc[2][2][4][2];
#pragma unroll
    for (int a = 0; a < 2; ++a)
#pragma unroll
        for (int b = 0; b < 2; ++b)
#pragma unroll
            for (int m = 0; m < 4; ++m)
#pragma unroll
                for (int n = 0; n < 2; ++n) acc[a][b][m][n] = (f32x4){0.f, 0.f, 0.f, 0.f};
    bf16x8 At[4][2], B0[2][2], B1[2][2];
    const char* cA = (const char*)g.A + (size_t)cur.pm * tstep; const char* cB = (const char*)g.Bt + (size_t)cur.pn * tstep;
    S.a_ready(cur);
    if constexpr (SP2) {
        PG8_STAGE(PG8_SB(0, 0), cB, voffB); PG8_STAGE(PG8_SB(0, 1), cB + hstep, voffB); PG8_STAGE(PG8_SA(0, 0), cA, voffA); PG8_STAGE(PG8_SA(0, 1), cA + hstep, voffA);
        if (wr == 1) PG8_BAR;
        PG8_WAIT_V(2); PG8_BAR;
        PG8_STAGE(PG8_SB(1, 0), cB + kstep, voffB); PG8_STAGE(PG8_SA(1, 0), cA + kstep, voffA); PG8_STAGE(PG8_SB(1, 1), cB + hstep + kstep, voffB);
        PG8_WAIT_V(6); PG8_BAR;
    } else {
        PG8_STAGE(PG8_SB(0, 0), cB, voffB); PG8_STAGE(PG8_SA(0, 0), cA, voffA); PG8_STAGE(PG8_SB(0, 1), cB + hstep, voffB); PG8_STAGE(PG8_SA(0, 1), cA + hstep, voffA);
        if (wr == 1) PG8_BAR;
        PG8_WAIT_V(4); PG8_BAR;
        PG8_STAGE(PG8_SB(1, 0), cB + kstep, voffB); PG8_STAGE(PG8_SA(1, 0), cA + kstep, voffA); PG8_STAGE(PG8_SB(1, 1), cB + hstep + kstep, voffB);
        PG8_WAIT_V(6); PG8_BAR;
    }
    for (;;) {
        const bool has_next = S.next(ui + 1, nxt);
        const char* nA = has_next ? (const char*)g.A + (size_t)nxt.pm * tstep : cA; const char* nB = has_next ? (const char*)g.Bt + (size_t)nxt.pn * tstep : cB;
        for (int t = 0; t < nt; t += 2) {
            const bool last = (t == nt - 2);
            const char* a1 = cA + (size_t)(t + 1) * kstep;
            const char* a2 = last ? nA : cA + (size_t)(t + 2) * kstep; const char* b2 = last ? nB : cB + (size_t)(t + 2) * kstep;
            const char* a3 = a2 + kstep; const char* b3 = b2 + kstep;
            if (last && has_next) S.a_ready(nxt);
            if constexpr (SP2) {
            PG8_LDB(B0, 0, 0); PG8_LDB(B1, 0, 1); PG8_SCHED; PG8_LDA(At, 0, 0); PG8_STAGE(PG8_SA(1, 1), a1 + hstep, voffA);
            PG8_WAIT_V(8); PG8_WAIT_L(0); PG8_BAR; PG8_MMA(0, 0, At, B0); PG8_MMA(0, 1, At, B1); PG8_BAR; PG8_SCHED;
            PG8_LDA(At, 0, 1); PG8_STAGE(PG8_SB(0, 0), b2, voffB); PG8_STAGE(PG8_SB(0, 1), b2 + hstep, voffB); PG8_STAGE(PG8_SA(0, 0), a2, voffA);
            PG8_WAIT_V(8); PG8_WAIT_L(0); PG8_BAR; PG8_MMA(1, 0, At, B0); PG8_MMA(1, 1, At, B1); PG8_BAR; PG8_SCHED;
            PG8_LDB(B0, 1, 0); PG8_LDB(B1, 1, 1); PG8_SCHED; PG8_LDA(At, 1, 0); PG8_STAGE(PG8_SA(0, 1), a2 + hstep, voffA);
            PG8_WAIT_V(8); PG8_WAIT_L(0); PG8_BAR; PG8_MMA(0, 0, At, B0); PG8_MMA(0, 1, At, B1); PG8_BAR; PG8_SCHED;
            PG8_LDA(At, 1, 1); PG8_STAGE(PG8_SB(1, 0), b3, voffB); PG8_STAGE(PG8_SB(1, 1), b3 + hstep, voffB); PG8_STAGE(PG8_SA(1, 0), a3, voffA);
            PG8_WAIT_V(8); PG8_WAIT_L(0); PG8_BAR; PG8_MMA(1, 0, At, B0); PG8_MMA(1, 1, At, B1); PG8_BAR; PG8_SCHED;
            } else {
            PG8_LDB(B0, 0, 0); PG8_SCHED; PG8_LDA(At, 0, 0); PG8_STAGE(PG8_SA(1, 1), a1 + hstep, voffA);
            PG8_WAIT_L(8); PG8_BAR; PG8_WAIT_L(0); PG8_MMA(0, 0, At, B0); PG8_BAR; PG8_SCHED;
            PG8_LDB(B1, 0, 1); PG8_STAGE(PG8_SB(0, 0), b2, voffB);
            PG8_BAR; PG8_WAIT_L(0); PG8_MMA(0, 1, At, B1); PG8_BAR;
            PG8_LDA(At, 0, 1); PG8_STAGE(PG8_SA(0, 0), a2, voffA);
            PG8_BAR; PG8_WAIT_L(0); PG8_MMA(1, 0, At, B0); PG8_BAR; PG8_SCHED;
            PG8_STAGE(PG8_SB(0, 1), b2 + hstep, voffB);
            PG8_WAIT_V(6); PG8_BAR; PG8_MMA(1, 1, At, B1); PG8_BAR;
            PG8_LDB(B0, 1, 0); PG8_SCHED; PG8_LDA(At, 1, 0); PG8_STAGE(PG8_SA(0, 1), a2 + hstep, voffA);
            PG8_WAIT_L(8); PG8_BAR; PG8_WAIT_L(0); PG8_MMA(0, 0, At, B0); PG8_BAR; PG8_SCHED;
            PG8_LDB(B1, 1, 1); PG8_STAGE(PG8_SB(1, 0), b3, voffB);
            PG8_BAR; PG8_WAIT_L(0); PG8_MMA(0, 1, At, B1); PG8_BAR;
            PG8_LDA(At, 1, 1); PG8_STAGE(PG8_SA(1, 0), a3, voffA);
            PG8_BAR; PG8_WAIT_L(0); PG8_MMA(1, 0, At, B0); PG8_BAR; PG8_SCHED;
            PG8_STAGE(PG8_SB(1, 1), b3 + hstep, voffB);
            PG8_WAIT_V(6); PG8_BAR; PG8_MMA(1, 1, At, B1); PG8_BAR;
            }
        }
        if constexpr (ALIGN_EPI) { if (wr == 0) PG8_BAR; }
        if constexpr (!Epi::AFTER_DRAIN) { E(acc, cur, wr, wc, fr, fq); S.done(cur); }
        if (!has_next) break;
#pragma unroll
        for (int a = 0; a < 2; ++a)
#pragma unroll
            for (int b = 0; b < 2; ++b)
#pragma unroll
                for (int m = 0; m < 4; ++m)
#pragma unroll
                    for (int n = 0; n < 2; ++n) acc[a][b][m][n] = (f32x4){0.f, 0.f, 0.f, 0.f};
        cur = nxt; cA = nA; cB = nB; ++ui;
        if constexpr (ALIGN_EPI) { if (wr == 1) PG8_BAR; }
    }
    PG8_WAIT_V(0);
    if constexpr (!ALIGN_EPI) { if (wr == 0) PG8_BAR; }
    PG8_BAR;
    if constexpr (Epi::AFTER_DRAIN) { E.fused(acc, cur, wr, wc, fr, fq, lds, wid, lane); S.done(cur); }
#undef PG8_SA
#undef PG8_SB
#undef PG8_STAGE
#undef PG8_LDA
#undef PG8_LDB
#undef PG8_MMA
#undef PG8_WAIT_V
#undef PG8_WAIT_L
#undef PG8_BAR
#undef PG8_SCHED
}
}
#ifndef PG8_SP2
#define PG8_SP2 true
#endif
#ifndef PG8_ALIGN
#define PG8_ALIGN true
#endif
#ifndef MK_N_LAUNCHES
#define MK_N_LAUNCHES 1
#endif
constexpr int NWAVES = 8;
constexpr int N_PHASES = 15;
constexpr int D = 1024, MP = 16384, MS = 1024, M = MP + MS, NSEQ = 136, FF = 2816, RC = 1792, PC = 2816, RW = 512, MODW = 9216;
constexpr float RMS_EPS = 1e-6f, LN_EPS = 1e-5f, GN_EPS = 64e-5f;
constexpr size_t O_Y = 0, O_SHP = 17825792, O_WKVP = 17840128, O_SHS = 18102272, O_WKVS = 18331648, O_CVS = 22525952, O_END = 23050240;
constexpr size_t MiB = 1u << 20;
constexpr size_t WS_CTL = 0, CTL_ZERO_BYTES = 1 * MiB;
constexpr size_t WS_GU1 = 1 * MiB, WS_DN1 = 12 * MiB, WS_WIN = 18 * MiB, WS_WOUT = 24 * MiB, WS_GU2 = 26 * MiB, WS_DN2 = 37 * MiB;
constexpr size_t WS_SMALL = 43 * MiB;
constexpr size_t WS_WLT = WS_SMALL, WS_ALT = WS_SMALL + 65536, WS_GLT = WS_SMALL + 131072, WS_WSB = WS_SMALL + 262144, WS_SILUC = WS_SMALL + 524288;
constexpr size_t WS_MOD = 44 * MiB;
constexpr size_t WS_BON = 49 * MiB;
constexpr size_t WS_FP = WS_BON + 557056;
static_assert(WS_FP + (size_t)136 * 1792 * 2 <= 50 * MiB, "ws map fp");
constexpr size_t WS_XN = 50 * MiB;
constexpr size_t WS_ACT = 84 * MiB;
constexpr size_t WS_SC = 178 * MiB, SC_STRIDE = 17 * MiB;
constexpr size_t WS_G = 280 * MiB;
constexpr size_t WS_Y = 297 * MiB;
constexpr size_t WS_END = 331 * MiB;
static_assert(WS_DN1 - WS_GU1 >= (size_t)5632 * 1024 * 2 && WS_WIN - WS_DN1 >= (size_t)1024 * 2816 * 2 && WS_WOUT - WS_WIN >= (size_t)2816 * 1024 * 2 && WS_GU2 - WS_WOUT >= (size_t)1024 * 1024 * 2, "ws map a");
static_assert(WS_DN2 - WS_GU2 >= (size_t)5632 * 1024 * 2 && WS_SMALL - WS_DN2 >= (size_t)1024 * 2816 * 2 && WS_BON - WS_MOD >= (size_t)136 * 9216 * 4 && WS_XN - WS_BON >= (size_t)M * 8 * 4, "ws map b");
static_assert(WS_ACT - WS_XN >= (size_t)M * 1024 * 2 && WS_SC - WS_ACT >= (size_t)M * 2816 * 2 && SC_STRIDE >= (size_t)M * 512 * 2 && WS_G - WS_SC >= 6 * SC_STRIDE && WS_Y - WS_G >= (size_t)M * 512 * 2 && WS_END - WS_Y >= (size_t)M * 512 * 4, "ws map c");
constexpr int CW_TMO = 0, CW_CODE = 1, CW_BAR = 4096;
constexpr int RING_OFF = 0, RING_BYTES = 139264;
constexpr int LDSCTL_OFF = RING_BYTES, MISC_OFF = LDSCTL_OFF + 320;
constexpr int LDS_BYTES = 147456;
struct Args { const float* in[30]; float* out; unsigned char* ws; int ph_lo, ph_hi; };
constexpr int PTRS_OFF = MISC_OFF + 128;
#ifndef USE_PTR_TABLE
#define USE_PTR_TABLE 0
#endif
#if !USE_PTR_TABLE
struct InAcc { const float* in[30]; };
#else
struct InPtrs { __attribute__((address_space(3))) unsigned* t;
    __device__ __forceinline__ const float* operator[](int i) const { const unsigned lo = __builtin_amdgcn_readfirstlane(t[2 * i]), hi = __builtin_amdgcn_readfirstlane(t[2 * i + 1]); return (const float*)(((unsigned long long)hi << 32) | lo); } };
struct InAcc { InPtrs in; };
#endif
#define GAS __attribute__((address_space(1)))
#define LAS __attribute__((address_space(3)))
typedef unsigned short bf16;
typedef unsigned v4u __attribute__((ext_vector_type(4)));
typedef float f32x4 __attribute__((ext_vector_type(4)));
typedef short bf16x8 __attribute__((ext_vector_type(8)));
typedef GAS unsigned gu32;
typedef GAS unsigned long long gu64;
#define RLX_AGENT __ATOMIC_RELAXED, __HIP_MEMORY_SCOPE_AGENT
#define LDS_WAIT() asm volatile("s_waitcnt lgkmcnt(0)" ::: "memory")
#define VM_WAIT() asm volatile("s_waitcnt vmcnt(0)" ::: "memory")
__device__ __forceinline__ unsigned long long rt() { return __builtin_amdgcn_s_memrealtime(); }
__device__ __forceinline__ unsigned f2bf(float f) { unsigned u = __builtin_bit_cast(unsigned, f); return (u + 0x7fffu + ((u >> 16) & 1u)) >> 16; }
__device__ __forceinline__ unsigned pk2(float lo, float hi) { return f2bf(lo) | (f2bf(hi) << 16); }
#define XB_TMO      128
#define XB_XCNT(j)  (256  + 64 * (j))
#define XB_XSUB(j)  (1280 + 64 * (j))
#define XB_XGEN(j)  (2304 + 64 * (j))
#define XB_TOP      3328
#define XB_TOPGEN   3392
#define XCD_BAR_WORDS 3456
#define XB_SPIN_CAP (1u << 18)

__device__ __forceinline__ unsigned xb_ld(unsigned* p)              { return __hip_atomic_load(p, __ATOMIC_RELAXED, __HIP_MEMORY_SCOPE_AGENT); }
__device__ __forceinline__ unsigned xb_add(unsigned* p, unsigned v) { return __hip_atomic_fetch_add(p, v, __ATOMIC_RELAXED, __HIP_MEMORY_SCOPE_AGENT); }
__device__ __forceinline__ unsigned xb_xcc_id() { return (unsigned)__builtin_amdgcn_s_getreg((3 << 11) | 20) & 0xFu; }
#define XB_SPIN(cond, bar) do { unsigned _sp = 0; while (cond) { __builtin_amdgcn_s_sleep(1); \
    if ((++_sp & 255u) == 0u) { if (xb_ld(&(bar)[XB_TMO])) break; if (_sp > XB_SPIN_CAP) { atomicAdd(&(bar)[XB_TMO], 1u); break; } } } } while (0)

struct XcdBarrier {
    unsigned* bar; unsigned x;
    volatile LAS unsigned* st;
};

__device__ __forceinline__ XcdBarrier xcd_barrier_post(unsigned* bar, volatile LAS unsigned* st) {
    XcdBarrier b; b.bar = bar; b.x = xb_xcc_id(); b.st = st;
    if (threadIdx.x == 0) (void)xb_add(&bar[XB_XCNT(b.x)], 1u);
    return b;
}
__device__ __forceinline__ void xcd_barrier_complete(unsigned* bar, unsigned x, unsigned& nloc, unsigned& nx) {
    const unsigned G = gridDim.x * gridDim.y * gridDim.z;
    unsigned sum, cnt, mine, sp = 0u;
    for (;;) {
        sum = 0u; cnt = 0u; mine = 0u;
#pragma unroll
        for (unsigned j = 0; j < 16; ++j) { const unsigned c = xb_ld(&bar[XB_XCNT(j)]); sum += c; cnt += (c > 0u) ? 1u : 0u; mine = (j == x) ? c : mine; }
        if (sum == G) break;
        __builtin_amdgcn_s_sleep(1);
        if ((++sp & 255u) == 0u) { if (xb_ld(&bar[XB_TMO])) break; if (sp > XB_SPIN_CAP) { atomicAdd(&bar[XB_TMO], 1u); break; } }
    }
    nloc = mine > 0u ? mine : 1u; nx = cnt > 0u ? cnt : 1u;
}

__device__ __forceinline__ void xcd_barrier(const XcdBarrier& b) {
    asm volatile("s_waitcnt vmcnt(0)" ::: "memory");
    __syncthreads();
    if (threadIdx.x == 0) {
        unsigned* bar = b.bar;
        __builtin_amdgcn_s_waitcnt(0);
        unsigned nloc = b.st[0], nx = b.st[1];
        if (nloc == 0u) { xcd_barrier_complete(bar, b.x, nloc, nx); b.st[0] = nloc; b.st[1] = nx; }
        const unsigned old = xb_add(&bar[XB_XSUB(b.x)], 1u);
        const unsigned gen = old / nloc;
        if (old + 1u == (gen + 1u) * nloc) {
            __builtin_amdgcn_fence(__ATOMIC_RELEASE, "agent");
            asm volatile("s_waitcnt vmcnt(0)" ::: "memory");
            const unsigned og = xb_add(&bar[XB_TOP], 1u);
            const unsigned tg = og / nx;
            if (og + 1u == (tg + 1u) * nx) xb_add(&bar[XB_TOPGEN], 1u);
            else XB_SPIN(xb_ld(&bar[XB_TOPGEN]) == tg, bar);
            __builtin_amdgcn_fence(__ATOMIC_ACQUIRE, "agent");
            xb_add(&bar[XB_XGEN(b.x)], 1u);
            asm volatile("s_waitcnt vmcnt(0)" ::: "memory");
        } else {
            XB_SPIN(xb_ld(&bar[XB_XGEN(b.x)]) == gen, bar);
            __builtin_amdgcn_fence(__ATOMIC_ACQUIRE, "agent");
            asm volatile("s_waitcnt vmcnt(0)" ::: "memory");
        }
    }
    __syncthreads();
}
struct Frame {
    LAS unsigned char* lds;
    volatile LAS unsigned* MISC;
    gu32* ctl;
    int tid, lane, wave, gw, NGW, G;
    float* out; unsigned char* ws;
};
__device__ __forceinline__ float wave_sum(float v) {
#pragma unroll
    for (int o = 1; o < 64; o <<= 1) v += __shfl_xor(v, o);
    return v;
}
__device__ __forceinline__ float bf2f(unsigned short b) { return __uint_as_float((unsigned)b << 16); }
__device__ __forceinline__ void unpack8(v4u w, float* f) {
    f[0] = __uint_as_float(w.x << 16); f[1] = __uint_as_float(w.x & 0xffff0000u); f[2] = __uint_as_float(w.y << 16); f[3] = __uint_as_float(w.y & 0xffff0000u);
    f[4] = __uint_as_float(w.z << 16); f[5] = __uint_as_float(w.z & 0xffff0000u); f[6] = __uint_as_float(w.w << 16); f[7] = __uint_as_float(w.w & 0xffff0000u);
}
typedef unsigned v2u __attribute__((ext_vector_type(2)));
__device__ __forceinline__ void unpack4(v2u w, float* f) {
    f[0] = __uint_as_float(w.x << 16); f[1] = __uint_as_float(w.x & 0xffff0000u); f[2] = __uint_as_float(w.y << 16); f[3] = __uint_as_float(w.y & 0xffff0000u);
}
__device__ __forceinline__ v2u pack4(const float* f) { v2u w; w.x = pk2(f[0], f[1]); w.y = pk2(f[2], f[3]); return w; }
__device__ __forceinline__ v4u pack8(const float* f) { v4u w; w.x = pk2(f[0], f[1]); w.y = pk2(f[2], f[3]); w.z = pk2(f[4], f[5]); w.w = pk2(f[6], f[7]); return w; }
__device__ __forceinline__ bf16x8 as_bf16x8(v4u w) { return __builtin_bit_cast(bf16x8, w); }
__device__ __forceinline__ float sigmoid_f(float x) { return 1.0f / (1.0f + __expf(-x)); }
__device__ __forceinline__ float tanh_f(float x) { const float e = __expf(2.0f * x); return 1.0f - 2.0f / (e + 1.0f); }

__device__ __forceinline__ void transpose_item(const float* W, int K, int N, bf16* WT, int kb, int nb, int orow0, LAS float* scr, int lane) {
    const int k0 = 64 * kb, n0 = 32 * nb;
#pragma unroll 8
    for (int i = 0; i < 32; ++i) { const int kk = 2 * i + (lane >> 5); scr[kk * 33 + (lane & 31)] = W[(size_t)(k0 + kk) * N + n0 + (lane & 31)]; }
    LDS_WAIT(); asm volatile("" ::: "memory");
    const int c = lane & 7;
#pragma unroll
    for (int j = 0; j < 4; ++j) { const int n = (lane >> 3) + 8 * j; const LAS float* s = scr + (8 * c) * 33 + n;
        v4u o; o.x = pk2(s[0 * 33], s[1 * 33]); o.y = pk2(s[2 * 33], s[3 * 33]); o.z = pk2(s[4 * 33], s[5 * 33]); o.w = pk2(s[6 * 33], s[7 * 33]);
        *(GAS v4u*)(WT + (size_t)(orow0 + n) * K + k0 + 8 * c) = o; }
    LDS_WAIT(); asm volatile("" ::: "memory");
}
__device__ __forceinline__ int gu_row(int n0) { return n0 < FF ? 256 * (n0 >> 7) + (n0 & 127) : 256 * ((n0 - FF) >> 7) + 128 + ((n0 - FF) & 127); }
__device__ __forceinline__ void p0_prologue(Frame& F, const InAcc& A) {
    LAS float* scr = (LAS float*)(F.lds + RING_OFF + F.wave * 16384);
    constexpr int I_GU = 16 * 176, I_DN = 44 * 32, I_IN = 16 * 88, I_OUT = 16 * 32, I_L64 = 16, I_L128 = 32;
    constexpr int NITEMS = 2 * I_GU + 2 * I_DN + I_IN + I_OUT + 2 * I_L64 + I_L128;
    for (int it = F.gw; it < NITEMS; it += F.NGW) {
        int r = it;
        if (r < I_GU) { const int kb = r / 176, nb = r % 176; transpose_item(A.in[8], 1024, 5632, ((bf16*)(F.ws + WS_GU1)), kb, nb, gu_row(32 * nb), scr, F.lane); continue; } r -= I_GU;
        if (r < I_GU) { const int kb = r / 176, nb = r % 176; transpose_item(A.in[27], 1024, 5632, ((bf16*)(F.ws + WS_GU2)), kb, nb, gu_row(32 * nb), scr, F.lane); continue; } r -= I_GU;
        if (r < I_DN) { const int kb = r / 32, nb = r % 32; transpose_item(A.in[9], 2816, 1024, ((bf16*)(F.ws + WS_DN1)), kb, nb, 32 * nb, scr, F.lane); continue; } r -= I_DN;
        if (r < I_DN) { const int kb = r / 32, nb = r % 32; transpose_item(A.in[28], 2816, 1024, ((bf16*)(F.ws + WS_DN2)), kb, nb, 32 * nb, scr, F.lane); continue; } r -= I_DN;
        if (r < I_IN) { const int kb = r / 88, nb = r % 88; transpose_item(A.in[10], 1024, 2816, ((bf16*)(F.ws + WS_WIN)), kb, nb, 32 * nb, scr, F.lane); continue; } r -= I_IN;
        if (r < I_OUT) { const int kb = r / 32, nb = r % 32; transpose_item(A.in[26], 1024, 1024, ((bf16*)(F.ws + WS_WOUT)), kb, nb, 32 * nb, scr, F.lane); continue; } r -= I_OUT;
        if (r < I_L64) { transpose_item(A.in[13], 64, 512, ((bf16*)(F.ws + WS_WLT)), 0, r, 32 * r, scr, F.lane); continue; } r -= I_L64;
        if (r < I_L64) { transpose_item(A.in[15], 64, 512, ((bf16*)(F.ws + WS_ALT)), 0, r, 32 * r, scr, F.lane); continue; } r -= I_L64;
        { const int kb = r / 16, nb = r % 16; transpose_item(A.in[16], 128, 512, ((bf16*)(F.ws + WS_GLT)), kb, nb, 32 * nb, scr, F.lane); }
    }
    const int gt = F.gw * 64 + F.lane, NGT = F.NGW * 64;
    for (int i = gt; i < 144 * 512; i += NGT) { const int s = i >> 9, k = (i & 511) * 2;
        float a = 0.f, b = 0.f;
        if (s < NSEQ) { const float* cr = s < 8 ? A.in[4] + (size_t)s * D : A.in[5] + (size_t)(s - 8) * D; a = cr[k]; b = cr[k + 1]; a = a * sigmoid_f(a); b = b * sigmoid_f(b); }
        ((unsigned*)((bf16*)(F.ws + WS_SILUC)))[i] = pk2(a, b); }
    for (int i = gt; i < NSEQ * (RC / 2); i += NGT) { const int sq = i / (RC / 2), k = (i % (RC / 2)) * 2;
        float a = 0.f, b = 0.f; if (sq >= 8) { a = A.in[2][(size_t)(sq - 8) * RC + k]; b = A.in[2][(size_t)(sq - 8) * RC + k + 1]; }
        ((unsigned*)(F.ws + WS_FP))[i] = pk2(a, b); }
    for (int i = gt; i < 8 * 128 * 64; i += NGT) { const int j = (i & 63) * 2, ii = (i >> 6) & 127;
        const float a = A.in[24][2 * (size_t)i], b = A.in[24][2 * (size_t)i + 1];
        ((unsigned*)((bf16*)(F.ws + WS_WSB)))[i] = pk2(j <= ii ? a : 0.f, (j + 1) <= ii ? b : 0.f); }
}
__device__ __forceinline__ void p1_mod(Frame& F, const InAcc& A) {
    const int l15 = F.lane & 15, q = F.lane >> 4;
    for (int nt = F.gw; nt < MODW / 16; nt += F.NGW) {
        const int n0 = 16 * nt;
        f32x4 acc[9];
#pragma unroll
        for (int mt = 0; mt < 9; ++mt) acc[mt] = (f32x4){0.f, 0.f, 0.f, 0.f};
#pragma unroll 8
        for (int ks = 0; ks < 32; ++ks) {
            const int k0 = 32 * ks + 8 * q;
            const float* wp = A.in[6] + (size_t)k0 * MODW + n0 + l15;
            float wv[8];
#pragma unroll
            for (int j = 0; j < 8; ++j) wv[j] = wp[(size_t)j * MODW];
            const bf16x8 wf = as_bf16x8(pack8(wv));
#pragma unroll
            for (int mt = 0; mt < 9; ++mt) { const bf16x8 sf = *(const bf16x8*)(((bf16*)(F.ws + WS_SILUC)) + (size_t)(16 * mt + l15) * D + k0);
                acc[mt] = __builtin_amdgcn_mfma_f32_16x16x32_bf16(wf, sf, acc[mt], 0, 0, 0); }
        }
        const f32x4 bv = *(const f32x4*)(A.in[7] + n0 + 4 * q);
#pragma unroll
        for (int mt = 0; mt < 9; ++mt) { const int s = 16 * mt + l15; if (s < NSEQ) *(f32x4*)(((float*)(F.ws + WS_MOD)) + (size_t)s * MODW + n0 + 4 * q) = acc[mt] + bv; }
    }
}
__device__ __forceinline__ const float* res_row(const float* pP, const float* pS, int row) { return row < MP ? pP + (size_t)row * D : pS + (size_t)(row - MP) * D; }
__device__ __forceinline__ void norm_rows_bf16(Frame& F, const InAcc& A, const float* srcP, const float* srcS, int sh_off, int sc_off) {
    for (int row = F.gw; row < M; row += F.NGW) {
        const f32x4* xr = (const f32x4*)res_row(srcP, srcS, row) + F.lane; const int s = pg8::seq_of_row(row);
        f32x4 v[4]; float ss = 0.f;
#pragma unroll
        for (int j = 0; j < 4; ++j) { v[j] = xr[64 * j]; ss += (v[j].x * v[j].x + v[j].y * v[j].y) + (v[j].z * v[j].z + v[j].w * v[j].w); }
        const float rstd = 1.0f / sqrtf(wave_sum(ss) * (1.0f / D) + RMS_EPS);
        const f32x4* sc = (const f32x4*)(((float*)(F.ws + WS_MOD)) + (size_t)s * MODW + sc_off) + F.lane; const f32x4* sh = (const f32x4*)(((float*)(F.ws + WS_MOD)) + (size_t)s * MODW + sh_off) + F.lane;
        v2u* o = (v2u*)(((bf16*)(F.ws + WS_XN)) + (size_t)row * D) + F.lane;
#pragma unroll
        for (int j = 0; j < 4; ++j) { const f32x4 a = sc[64 * j], b = sh[64 * j]; const f32x4 r = v[j] * rstd * (a + 1.0f) + b; float t[4] = {r.x, r.y, r.z, r.w}; o[64 * j] = pack4(t); }
    }
}
__device__ __forceinline__ void final_norm_rows(Frame& F, const InAcc& A) {
    for (int row = F.gw; row < M; row += F.NGW) {
        f32x4* xr = (f32x4*)(F.out + (size_t)row * D) + F.lane;
        f32x4 v[4]; float ss = 0.f;
#pragma unroll
        for (int j = 0; j < 4; ++j) { v[j] = xr[64 * j]; ss += (v[j].x * v[j].x + v[j].y * v[j].y) + (v[j].z * v[j].z + v[j].w * v[j].w); }
        const float rstd = 1.0f / sqrtf(wave_sum(ss) * (1.0f / D) + RMS_EPS);
        const f32x4* g = (const f32x4*)A.in[29] + F.lane;
#pragma unroll
        for (int j = 0; j < 4; ++j) xr[64 * j] = v[j] * rstd * g[64 * j];
    }
}
__device__ __forceinline__ void prep_item(Frame& F, const InAcc& A, int r0, int h) {
    const int l15 = F.lane & 15, q = F.lane >> 4, row = r0 + l15;
    const bf16* P = (bf16*)(F.ws + WS_ACT);
    const bf16* pc = P + (size_t)row * PC;
    const bf16* pp = pg8::row_is_first(row) ? (const bf16*)(F.ws + WS_FP) + (size_t)pg8::seq_of_row(row) * RC : pc - PC;
    const float* mu = A.in[11];
    v4u lc[8], lp[8]; v2u xc[4][3], xp[4][3];
#pragma unroll
    for (int g = 0; g < 8; ++g) { const int col = 1536 + 32 * g + 8 * q; lc[g] = *(const v4u*)(pc + col); lp[g] = *(const v4u*)(pp + col); }
#pragma unroll
    for (int ntl = 0; ntl < 4; ++ntl)
#pragma unroll
        for (int sct = 0; sct < 3; ++sct) { const int col = 512 * sct + 64 * h + 16 * ntl + 4 * q; xc[ntl][sct] = *(const v2u*)(pc + col); xp[ntl][sct] = *(const v2u*)(pp + col); }
    __builtin_amdgcn_sched_barrier(0);
    bf16x8 fr[8];
#pragma unroll
    for (int g = 0; g < 8; ++g) { const int col = 1536 + 32 * g + 8 * q; float cur[8], prv[8]; unpack8(lc[g], cur); unpack8(lp[g], prv);
        const f32x4 m0 = *(const f32x4*)(mu + col), m1 = *(const f32x4*)(mu + col + 4); const float mm[8] = {m0.x, m0.y, m0.z, m0.w, m1.x, m1.y, m1.z, m1.w};
        float t[8];
#pragma unroll
        for (int e = 0; e < 8; ++e) { const float x = cur[e] + (prv[e] - cur[e]) * mm[e]; t[e] = g < 2 ? tanh_f(x) : (g < 4 ? x : sigmoid_f(x)); }
        fr[g] = as_bf16x8(pack8(t)); __builtin_amdgcn_sched_barrier(0); }
    float xr[4][4], xk[4][4], xv[4][4];
#pragma unroll
    for (int ntl = 0; ntl < 4; ++ntl)
#pragma unroll
        for (int sct = 0; sct < 3; ++sct) { const int col = 512 * sct + 64 * h + 16 * ntl + 4 * q; float cur[4], prv[4]; unpack4(xc[ntl][sct], cur); unpack4(xp[ntl][sct], prv);
            const f32x4 m0 = *(const f32x4*)(mu + col);
#pragma unroll
            for (int e = 0; e < 4; ++e) { const float x = cur[e] + (prv[e] - cur[e]) * m0[e]; if (sct == 0) xr[ntl][e] = x; else if (sct == 1) xk[ntl][e] = x; else xv[ntl][e] = x; } }
    __builtin_amdgcn_sched_barrier(0);
    float ss = 0.f, bon = 0.f;
#pragma unroll
    for (int ntl = 0; ntl < 4; ++ntl) { const f32x4 kkv = *(const f32x4*)(A.in[17] + 64 * h + 16 * ntl + 4 * q);
#pragma unroll
        for (int e = 0; e < 4; ++e) { const float kr = xk[ntl][e] * kkv[e]; ss += kr * kr; } }
    ss += __shfl_xor(ss, 16); ss += __shfl_xor(ss, 32);
    const float inv = 1.0f / fmaxf(sqrtf(ss), 1e-12f);
    const bf16* WLT = (const bf16*)(F.ws + WS_WLT); const bf16* ALT = (const bf16*)(F.ws + WS_ALT); const bf16* GLT = (const bf16*)(F.ws + WS_GLT);
#pragma unroll 1
    for (int ntl = 0; ntl < 4; ++ntl) {
        const int n0 = 64 * h + 16 * ntl, c0 = n0 + 4 * q;
        f32x4 aw = {0.f, 0.f, 0.f, 0.f}, aa = aw, ag = aw;
#pragma unroll
        for (int ks = 0; ks < 2; ++ks) {
            aw = __builtin_amdgcn_mfma_f32_16x16x32_bf16(*(const bf16x8*)(WLT + (size_t)(n0 + l15) * 64 + 32 * ks + 8 * q), fr[ks], aw, 0, 0, 0);
            aa = __builtin_amdgcn_mfma_f32_16x16x32_bf16(*(const bf16x8*)(ALT + (size_t)(n0 + l15) * 64 + 32 * ks + 8 * q), fr[2 + ks], aa, 0, 0, 0); }
#pragma unroll
        for (int ks = 0; ks < 4; ++ks)
            ag = __builtin_amdgcn_mfma_f32_16x16x32_bf16(*(const bf16x8*)(GLT + (size_t)(n0 + l15) * 128 + 32 * ks + 8 * q), fr[4 + ks], ag, 0, 0, 0);
        const f32x4 w0v = *(const f32x4*)(A.in[12] + c0), a0v = *(const f32x4*)(A.in[14] + c0), kkv = *(const f32x4*)(A.in[17] + c0), kav = *(const f32x4*)(A.in[18] + c0), rkv = *(const f32x4*)(A.in[19] + c0);
        float omd[4], km[4], gg[4], kk[4], bb[4];
#pragma unroll
        for (int e = 0; e < 4; ++e) {
            const float z = -(w0v[e] + aw[e]);
            const float sp = z > 20.f ? z : __logf(1.0f + __expf(z));
            const float wlog = -sp - 0.5f;
            const float dec = __expf(-__expf(wlog));
            omd[e] = 1.0f - dec;
            const float a = sigmoid_f(a0v[e] + aa[e]);
            kk[e] = xk[0][e] * kkv[e] * inv; bb[e] = kk[e] * a;
            km[e] = xk[0][e] * (1.0f + (a - 1.0f) * kav[e]);
            bon += xr[0][e] * km[e] * rkv[e];
            gg[e] = ag[e];
        }
        const size_t o = (size_t)row * RW + c0;
        *(v2u*)(((bf16*)(F.ws + WS_SC)) + o) = pack4(xr[0]); *(v2u*)(((bf16*)(F.ws + (WS_SC + SC_STRIDE))) + o) = pack4(km); *(v2u*)(((bf16*)(F.ws + (WS_SC + 2 * SC_STRIDE))) + o) = pack4(xv[0]);
        *(v2u*)(((bf16*)(F.ws + (WS_SC + 3 * SC_STRIDE))) + o) = pack4(kk); *(v2u*)(((bf16*)(F.ws + (WS_SC + 4 * SC_STRIDE))) + o) = pack4(bb);
        *(v2u*)(((bf16*)(F.ws + (WS_SC + 5 * SC_STRIDE))) + o) = pack4(omd); *(v2u*)(((bf16*)(F.ws + WS_G)) + o) = pack4(gg);
#pragma unroll
        for (int i = 0; i < 3; ++i)
#pragma unroll
            for (int e = 0; e < 4; ++e) { xr[i][e] = xr[i + 1][e]; xk[i][e] = xk[i + 1][e]; xv[i][e] = xv[i + 1][e]; }
    }
    bon += __shfl_xor(bon, 16); bon += __shfl_xor(bon, 32);
    if (q == 0) ((float*)(F.ws + WS_BON))[(size_t)row * 8 + h] = bon;
}
__device__ __forceinline__ void prep_all(Frame& F, const InAcc& A) {
    const int w = blockIdx.x, h = w & 7; const int nslots = (F.G >> 3) * NWAVES;
    if (F.G & 7) { for (int it = F.gw; it < (M / 16) * 8; it += F.NGW) { const int r0 = 16 * (it >> 3); prep_item(F, A, r0, it & 7); } return; }
    for (int tt = (w >> 3) * NWAVES + F.wave; tt < M / 16; tt += nslots) { const int r0 = 16 * tt; prep_item(F, A, r0, h); }
}
__device__ __forceinline__ void lnv_rows(Frame& F, const InAcc& A) {
    for (int row = F.gw; row < M; row += F.NGW) {
        v4u* pv = (v4u*)(((bf16*)(F.ws + WS_ACT)) + (size_t)row * PC + 2304) + F.lane;
        float x[8]; unpack8(*pv, x);
        float s = 0.f;
#pragma unroll
        for (int e = 0; e < 8; ++e) s += x[e];
        const float mean = wave_sum(s) * (1.0f / 512.0f); float qq = 0.f;
#pragma unroll
        for (int e = 0; e < 8; ++e) { x[e] -= mean; qq += x[e] * x[e]; }
        const float rstd = 1.0f / sqrtf(wave_sum(qq) * (1.0f / 512.0f) + LN_EPS);
        const f32x4 g0 = *(const f32x4*)(A.in[22] + 8 * F.lane), g1 = *(const f32x4*)(A.in[22] + 8 * F.lane + 4), b0 = *(const f32x4*)(A.in[23] + 8 * F.lane), b1 = *(const f32x4*)(A.in[23] + 8 * F.lane + 4);
        const float gg[8] = {g0.x, g0.y, g0.z, g0.w, g1.x, g1.y, g1.z, g1.w}, bb[8] = {b0.x, b0.y, b0.z, b0.w, b1.x, b1.y, b1.z, b1.w};
#pragma unroll
        for (int e = 0; e < 8; ++e) x[e] = x[e] * rstd * gg[e] + bb[e];
        *pv = pack8(x);
        if (row >= MP) { float* o = F.out + O_CVS + (size_t)(row - MP) * 512 + 8 * F.lane; *(f32x4*)o = (f32x4){x[0], x[1], x[2], x[3]}; *(f32x4*)(o + 4) = (f32x4){x[4], x[5], x[6], x[7]}; }
    }
}
template <bool SAMP> __device__ __forceinline__ void gmlp_item(Frame& F, const InAcc& A, int ci, int h) {
    const int l15 = F.lane & 15, q = F.lane >> 4;
    const int base = SAMP ? MP + 8 * ci : 128 * ci;
    const bf16* P = (const bf16*)(F.ws + WS_ACT);
    const bf16* WSB = (const bf16*)(F.ws + WS_WSB);
    const float* b_s = A.in[25];
    LAS unsigned short* tile = (LAS unsigned short*)(F.lds + RING_OFF + F.wave * 17408);
    constexpr int NIT = SAMP ? 1 : 8, NKS = SAMP ? 1 : 4;
#pragma unroll
    for (int i = 0; i < (SAMP ? 1 : 16); ++i) { const int r = 8 * i + (F.lane >> 3), c8 = (F.lane & 7) * 8;
        const v4u x = *(const v4u*)(P + (size_t)(base + r) * PC + 2304 + h * 64 + c8);
        LAS unsigned* d = (LAS unsigned*)(tile + r * 66 + c8); d[0] = x.x; d[1] = x.y; d[2] = x.z; d[3] = x.w; }
    LDS_WAIT(); asm volatile("" ::: "memory");
#pragma unroll 1
    for (int dt = 0; dt < 4; ++dt) {
        bf16x8 vf[NKS];
#pragma unroll
        for (int ks = 0; ks < NKS; ++ks)
#pragma unroll
            for (int jj = 0; jj < 8; ++jj) { const int jr = 32 * ks + 8 * q + jj; vf[ks][jj] = (SAMP && jr >= 8) ? (short)0 : (short)tile[jr * 66 + 16 * dt + l15]; }
        const int cc = h * 64 + 16 * dt + 4 * q;
#pragma unroll
        for (int it = 0; it < NIT; ++it) {
            f32x4 acc = {0.f, 0.f, 0.f, 0.f};
#pragma unroll
            for (int ks = 0; ks < NKS; ++ks) if (ks <= (it >> 1))
                acc = __builtin_amdgcn_mfma_f32_16x16x32_bf16(vf[ks], *(const bf16x8*)(WSB + ((size_t)(h * 128 + 16 * it + l15)) * 128 + 32 * ks + 8 * q), acc, 0, 0, 0);
            const int i = 16 * it + l15;
            if (!SAMP || i < 8) { const int row = base + i; const float bs = b_s[h * 128 + i];
                float pu[4]; unpack4(*(const v2u*)(P + (size_t)row * PC + 1792 + cc), pu);
                float o[4];
#pragma unroll
                for (int e = 0; e < 4; ++e) o[e] = pu[e] * (acc[e] + bs);
                *(v2u*)(((bf16*)(F.ws + WS_XN)) + (size_t)row * D + 512 + cc) = pack4(o); }
        }
    }
    LDS_WAIT(); asm volatile("" ::: "memory");
}
__device__ __forceinline__ float red16(float x) {
    x += __builtin_bit_cast(float, __builtin_amdgcn_update_dpp(0, __builtin_bit_cast(int, x), 0x128, 0xf, 0xf, false));
    x += __builtin_bit_cast(float, __builtin_amdgcn_update_dpp(0, __builtin_bit_cast(int, x), 0x124, 0xf, 0xf, false));
    x += __builtin_bit_cast(float, __builtin_amdgcn_update_dpp(0, __builtin_bit_cast(int, x), 0x122, 0xf, 0xf, false));
    x += __builtin_bit_cast(float, __builtin_amdgcn_update_dpp(0, __builtin_bit_cast(int, x), 0x121, 0xf, 0xf, false));
    return x;
}
typedef float f32x2 __attribute__((ext_vector_type(2)));
#define DPP_ROR(x, n) __builtin_bit_cast(float, __builtin_amdgcn_update_dpp(0, __builtin_bit_cast(int, (x)), 0x120 + (n), 0xf, 0xf, false))
__device__ __forceinline__ void red16x2(float& a, float& b) {
    a += DPP_ROR(a, 8); b += DPP_ROR(b, 8); a += DPP_ROR(a, 4); b += DPP_ROR(b, 4); a += DPP_ROR(a, 2); b += DPP_ROR(b, 2); a += DPP_ROR(a, 1); b += DPP_ROR(b, 1);
}
__device__ __forceinline__ float wkv_step(f32x4& S, const f32x4 w, const f32x4 kk, const f32x4 bb, const f32x4 k, const f32x4 r, const float vv, float& ypend) {
    f32x2 Sa = {S.x, S.y}, Sb = {S.z, S.w};
    f32x2 p = Sa * (f32x2){kk.x, kk.y}; p = Sb * (f32x2){kk.z, kk.w} + p;
    float d = p.x + p.y;
    red16x2(d, ypend);
    const f32x2 v2 = {vv, vv};
    f32x2 Ta = (f32x2){k.x, k.y} * v2, Tb = (f32x2){k.z, k.w} * v2;
    Ta = Sa * (f32x2){w.x, w.y} + Ta; Tb = Sb * (f32x2){w.z, w.w} + Tb;
    const f32x2 nd = {-d, -d};
    Sa = (f32x2){bb.x, bb.y} * nd + Ta; Sb = (f32x2){bb.z, bb.w} * nd + Tb;
    f32x2 yv = Sa * (f32x2){r.x, r.y}; yv = Sb * (f32x2){r.z, r.w} + yv;
    S = (f32x4){Sa.x, Sa.y, Sb.x, Sb.y};
    return yv.x + yv.y;
}
constexpr int TC = 32, STEP_F = 336, CHUNK_F = TC * STEP_F, LD_ITEMS = TC * 42, NCHUNK = 2048 / TC;
constexpr int YB_OFF_F = 2 * CHUNK_F;
__device__ __forceinline__ void scan_prompt_unit(Frame& F, const InAcc& A, int unit) {
    const int bh = unit >> 2, qtr = unit & 3, b = bh >> 3, h = bh & 7;
    const size_t rowbase = (size_t)b * 2048;
    LAS float* const lf = (LAS float*)(F.lds + RING_OFF);
    const int j = F.lane & 15, vloc = 4 * (F.wave & 3) + (F.lane >> 4), v = 16 * qtr + vloc;
    f32x4 S = {0.f, 0.f, 0.f, 0.f};
    v4u ld[3]; const bf16* srcp[3]; int dsto[3]; bool isw[3], act[3];
#pragma unroll
    for (int i = 0; i < 3; ++i) { const int it = F.tid + 512 * i; act[i] = it < LD_ITEMS; const int st = act[i] ? it / 42 : 0, a = act[i] ? it % 42 : 0;
        const size_t ro = (rowbase + st) * RW + h * 64;
        if (a < 40) { const int ar = a >> 3, seg = a & 7; const bf16* base = (const bf16*)(F.ws + WS_SC) + (size_t)(ar == 0 ? 5 : ar == 1 ? 3 : ar == 2 ? 4 : ar == 3 ? 1 : 0) * (SC_STRIDE / 2); srcp[i] = base + ro + 8 * seg; }
        else srcp[i] = (const bf16*)(F.ws + WS_SC + 2 * SC_STRIDE) + ro + 16 * qtr + 8 * (a - 40);
        dsto[i] = st * STEP_F + (a < 40 ? (a >> 3) * 64 + 8 * (a & 7) : 320 + 8 * (a - 40)); isw[i] = a < 8; }
#define SCAN_ISSUE(c) do { _Pragma("unroll") for (int i = 0; i < 3; ++i) if (act[i]) ld[i] = *(const v4u*)(srcp[i] + (size_t)(c) * TC * RW); } while (0)
#define SCAN_COMMIT(bufo) do { _Pragma("unroll") for (int i = 0; i < 3; ++i) if (act[i]) { float f[8]; unpack8(ld[i], f); \
        if (isw[i]) { _Pragma("unroll") for (int e = 0; e < 8; ++e) f[e] = 1.0f - f[e]; } \
        LAS float* dst = lf + (bufo) + dsto[i]; *(LAS f32x4*)dst = (f32x4){f[0], f[1], f[2], f[3]}; *(LAS f32x4*)(dst + 4) = (f32x4){f[4], f[5], f[6], f[7]}; } } while (0)
#define SCAN_FLUSH(c) do { const LAS float* yb_ = lf + YB_OFF_F + ((c) & 1) * (TC * 16); float* yg_ = ((float*)(F.ws + WS_Y)) + (rowbase + (size_t)(c) * TC) * RW + h * 64 + 16 * qtr; \
        yg_[(size_t)(F.tid >> 4) * RW + (F.tid & 15)] = yb_[F.tid]; } while (0)
    SCAN_ISSUE(0); SCAN_COMMIT(0); __syncthreads();
    for (int c = 0; c < NCHUNK; ++c) {
        if (c + 1 < NCHUNK) SCAN_ISSUE(c + 1);
        if (c > 0) SCAN_FLUSH(c - 1);
        if (F.wave < 4) {
            const LAS float* bp = lf + (c & 1) * CHUNK_F + 4 * j; const LAS float* vp = lf + (c & 1) * CHUNK_F + 320 + vloc; LAS float* yb = lf + YB_OFF_F + (c & 1) * (TC * 16) + vloc;
            f32x4 w4 = *(const LAS f32x4*)(bp), kk4 = *(const LAS f32x4*)(bp + 64), bb4 = *(const LAS f32x4*)(bp + 128), k4 = *(const LAS f32x4*)(bp + 192), r4 = *(const LAS f32x4*)(bp + 256); float vv = vp[0];
            float ypend = 0.f;
#pragma unroll 8
            for (int s = 0; s < TC; ++s) {
                const int sn = (s + 1 < TC) ? s + 1 : s;
                const f32x4 w4n = *(const LAS f32x4*)(bp + sn * STEP_F), kk4n = *(const LAS f32x4*)(bp + sn * STEP_F + 64), bb4n = *(const LAS f32x4*)(bp + sn * STEP_F + 128),
                            k4n = *(const LAS f32x4*)(bp + sn * STEP_F + 192), r4n = *(const LAS f32x4*)(bp + sn * STEP_F + 256); const float vvn = vp[sn * STEP_F];
                const float yp = wkv_step(S, w4, kk4, bb4, k4, r4, vv, ypend);
                if (s > 0) yb[(s - 1) * 16] = ypend;
                ypend = yp;
                __builtin_amdgcn_sched_barrier(0);
                w4 = w4n; kk4 = kk4n; bb4 = bb4n; k4 = k4n; r4 = r4n; vv = vvn;
            }
            yb[(TC - 1) * 16] = red16(ypend);
        }
        if (c + 1 < NCHUNK) SCAN_COMMIT(((c + 1) & 1) * CHUNK_F);
        __syncthreads();
    }
    SCAN_FLUSH(NCHUNK - 1);
    __syncthreads();
#undef SCAN_ISSUE
#undef SCAN_COMMIT
#undef SCAN_FLUSH
    if (F.wave < 4) *(f32x4*)(F.out + O_WKVP + ((size_t)bh * 64 + v) * 64 + 4 * j) = S;
}
__device__ __forceinline__ void scan_sample_item(Frame& F, const InAcc& A, int it) {
    const int sbh = it >> 3, rp = it & 7, sb = sbh >> 3, h = sbh & 7, j = F.lane & 15, v0 = 8 * rp + (F.lane >> 4), v1 = v0 + 4;
    const size_t so0 = ((size_t)sbh * 64 + v0) * 64 + 4 * j, so1 = so0 + 4 * 64;
    f32x4 S0 = *(const f32x4*)(A.in[3] + so0), S1 = *(const f32x4*)(A.in[3] + so1);
    const size_t ro0 = (size_t)(MP + 8 * sb) * RW + h * 64;
    const bf16* scr = (const bf16*)(F.ws + WS_SC);
    v2u lw[8], lkk[8], lbb[8], lk[8], lr[8]; unsigned short lv0[8], lv1[8];
#pragma unroll
    for (int t = 0; t < 8; ++t) { const size_t ro = ro0 + (size_t)t * RW;
        lw[t] = *(const v2u*)(scr + 5 * (SC_STRIDE / 2) + ro + 4 * j); lkk[t] = *(const v2u*)(scr + 3 * (SC_STRIDE / 2) + ro + 4 * j); lbb[t] = *(const v2u*)(scr + 4 * (SC_STRIDE / 2) + ro + 4 * j);
        lk[t] = *(const v2u*)(scr + 1 * (SC_STRIDE / 2) + ro + 4 * j); lr[t] = *(const v2u*)(scr + ro + 4 * j); lv0[t] = scr[2 * (SC_STRIDE / 2) + ro + v0]; lv1[t] = scr[2 * (SC_STRIDE / 2) + ro + v1]; }
    float yk0 = 0.f, yk1 = 0.f;
#pragma unroll
    for (int t = 0; t < 8; ++t) {
        float w[4], kk[4], bb[4], k[4], r[4];
        unpack4(lw[t], w); unpack4(lkk[t], kk); unpack4(lbb[t], bb); unpack4(lk[t], k); unpack4(lr[t], r);
        const f32x4 w4 = {1.f - w[0], 1.f - w[1], 1.f - w[2], 1.f - w[3]}, kk4 = {kk[0], kk[1], kk[2], kk[3]}, bb4 = {bb[0], bb[1], bb[2], bb[3]}, k4 = {k[0], k[1], k[2], k[3]}, r4 = {r[0], r[1], r[2], r[3]};
        float dm0 = 0.f; const float y0 = red16(wkv_step(S0, w4, kk4, bb4, k4, r4, bf2f(lv0[t]), dm0));
        float dm1 = 0.f; const float y1 = red16(wkv_step(S1, w4, kk4, bb4, k4, r4, bf2f(lv1[t]), dm1));
        yk0 = (j == t) ? y0 : yk0; yk1 = (j == t) ? y1 : yk1;
    }
    if (j < 8) { float* yg = ((float*)(F.ws + WS_Y)) + ro0 + (size_t)j * RW; yg[v0] = yk0; yg[v1] = yk1; }
    *(f32x4*)(F.out + O_WKVS + so0) = S0; *(f32x4*)(F.out + O_WKVS + so1) = S1;
}
__device__ __forceinline__ void postscan_rows(Frame& F, const InAcc& A) {
    for (int row = F.gw; row < M; row += F.NGW) {
        const int c = 8 * F.lane, head = F.lane >> 3; const size_t o = (size_t)row * RW + c;
        const f32x4 y0 = *(const f32x4*)(((float*)(F.ws + WS_Y)) + o), y1 = *(const f32x4*)(((float*)(F.ws + WS_Y)) + o + 4);
        float y[8] = {y0.x, y0.y, y0.z, y0.w, y1.x, y1.y, y1.z, y1.w};
        float s = 0.f;
#pragma unroll
        for (int e = 0; e < 8; ++e) s += y[e];
        s += __shfl_xor(s, 1); s += __shfl_xor(s, 2); s += __shfl_xor(s, 4);
        const float mu = s * (1.0f / 64.0f); float qq = 0.f;
#pragma unroll
        for (int e = 0; e < 8; ++e) { y[e] -= mu; qq += y[e] * y[e]; }
        qq += __shfl_xor(qq, 1); qq += __shfl_xor(qq, 2); qq += __shfl_xor(qq, 4);
        const float rstd = 1.0f / sqrtf(qq * (1.0f / 64.0f) + GN_EPS);
        const f32x4 g0 = *(const f32x4*)(A.in[20] + c), g1 = *(const f32x4*)(A.in[20] + c + 4), b0 = *(const f32x4*)(A.in[21] + c), b1 = *(const f32x4*)(A.in[21] + c + 4);
        const float gw[8] = {g0.x, g0.y, g0.z, g0.w, g1.x, g1.y, g1.z, g1.w}, gb[8] = {b0.x, b0.y, b0.z, b0.w, b1.x, b1.y, b1.z, b1.w};
        float vv[8], gg[8]; unpack8(*(const v4u*)(((bf16*)(F.ws + (WS_SC + 2 * SC_STRIDE))) + o), vv); unpack8(*(const v4u*)(((bf16*)(F.ws + WS_G)) + o), gg);
        const float bon = ((float*)(F.ws + WS_BON))[(size_t)row * 8 + head];
#pragma unroll
        for (int e = 0; e < 8; ++e) y[e] = (y[e] * rstd * gw[e] + gb[e] + bon * vv[e]) * gg[e];
        *(v4u*)(((bf16*)(F.ws + WS_XN)) + (size_t)row * D + c) = pack8(y);
    }
}
__global__ void __launch_bounds__(NWAVES * 64, 2) fwd_kernel(Args args) {
    extern __shared__ __attribute__((aligned(16))) unsigned char lds[];
    Frame F;
    F.lds = (LAS unsigned char*)lds;
    F.MISC = (volatile LAS unsigned*)(F.lds + MISC_OFF);
    F.tid = threadIdx.x; F.lane = F.tid & 63; F.wave = __builtin_amdgcn_readfirstlane(F.tid >> 6);
    F.G = gridDim.x; F.gw = blockIdx.x * NWAVES + F.wave; F.NGW = F.G * NWAVES;
    unsigned char* ws = args.ws;
    F.ctl = (gu32*)(ws + WS_CTL);
    F.out = args.out; F.ws = ws;
    for (int u = F.tid; u < (LDS_BYTES - LDSCTL_OFF) / 4; u += NWAVES * 64) ((LAS unsigned*)(F.lds + LDSCTL_OFF))[u] = 0u;
    __syncthreads();
    if (F.tid == 0) { LAS unsigned long long* pt = (LAS unsigned long long*)(F.lds + PTRS_OFF);
#pragma unroll
        for (int i = 0; i < 30; ++i) pt[i] = (unsigned long long)args.in[i]; }
    __syncthreads();
#if USE_PTR_TABLE
    InAcc A; A.in.t = (LAS unsigned*)(F.lds + PTRS_OFF);
#else
    InAcc A;
#pragma unroll
    for (int i = 0; i < 30; ++i) A.in[i] = args.in[i];
#endif
    XcdBarrier bar; bar.bar = (unsigned*)(F.ctl + CW_BAR); bar.x = 0; bar.st = nullptr;
    if (MK_N_LAUNCHES == 1) bar = xcd_barrier_post((unsigned*)(F.ctl + CW_BAR), F.MISC + 8);
    const int lo = args.ph_lo, hi = args.ph_hi;
#ifndef PH_MASK
#define PH_MASK 0x7fff
#endif
#define IN(k) (((PH_MASK >> (k)) & 1) && lo <= (k) && (k) < hi)
#ifndef DUP_ID
#define DUP_ID -1
#endif
#define DUPN(id) ((DUP_ID == (id)) ? 2 : 1)
#define DUPBAR(r) do { if (r) xcd_barrier(bar); } while (0)
#define SEAM(k) do { if (IN(k) && IN((k) + 1)) xcd_barrier(bar); } while (0)
    float* const H = F.out;

    if (IN(0)) for (int rep_ = 0; rep_ < DUPN(0); ++rep_) { DUPBAR(rep_); p0_prologue(F, A); } SEAM(0);
    if (IN(1)) for (int rep_ = 0; rep_ < DUPN(1); ++rep_) { DUPBAR(rep_); p1_mod(F, A); } SEAM(1);
    if (IN(2)) for (int rep_ = 0; rep_ < DUPN(2); ++rep_) { DUPBAR(rep_); norm_rows_bf16(F, A, A.in[0], A.in[1], 0, 1024); } SEAM(2);
    if (IN(3)) for (int rep_ = 0; rep_ < DUPN(3); ++rep_) { DUPBAR(rep_); pg8::Gemm g{((bf16*)(F.ws + WS_XN)), ((bf16*)(F.ws + WS_GU1)), M, 2 * FF, D}; pg8::StaticOrder S; S.init(M, 2 * FF, F.G, (int)blockIdx.x); pg8::EpiSwiglu E{((bf16*)(F.ws + WS_ACT))};
        pg8::gemm_phase<pg8::EpiSwiglu, pg8::StaticOrder, PG8_ALIGN, PG8_SP2>(F.lds + RING_OFF, g, S, E); } SEAM(3);
    if (IN(4)) for (int rep_ = 0; rep_ < DUPN(4); ++rep_) { DUPBAR(rep_); pg8::Gemm g{((bf16*)(F.ws + WS_ACT)), ((bf16*)(F.ws + WS_DN1)), M, D, FF}; pg8::StaticOrder S; S.init(M, D, F.G, (int)blockIdx.x); pg8::EpiResid E{A.in[0], A.in[1], H, ((float*)(F.ws + WS_MOD)) + 2048, 0.5f};
        pg8::gemm_phase<pg8::EpiResid, pg8::StaticOrder, PG8_ALIGN, PG8_SP2>(F.lds + RING_OFF, g, S, E); } SEAM(4);
    if (IN(5)) for (int rep_ = 0; rep_ < DUPN(5); ++rep_) { DUPBAR(rep_); norm_rows_bf16(F, A, H, H + (size_t)MP * D, 3072, 4096); } SEAM(5);
    if (IN(6)) for (int rep_ = 0; rep_ < DUPN(6); ++rep_) { DUPBAR(rep_); pg8::Gemm g{((bf16*)(F.ws + WS_XN)), ((bf16*)(F.ws + WS_WIN)), M, PC, D}; pg8::StaticOrder S; S.init(M, PC, F.G, (int)blockIdx.x); pg8::EpiP E{((bf16*)(F.ws + WS_ACT)), F.out + O_SHP, F.out + O_SHS};
        pg8::gemm_phase<pg8::EpiP, pg8::StaticOrder, PG8_ALIGN, PG8_SP2>(F.lds + RING_OFF, g, S, E); } SEAM(6);
    if (IN(7)) { for (int rep_ = 0; rep_ < DUPN(70); ++rep_) { DUPBAR(rep_); prep_all(F, A); } lnv_rows(F, A); } SEAM(7);
    if (IN(8)) {
        for (int rep_ = 0; rep_ < DUPN(80); ++rep_) for (int u = blockIdx.x; u < 256; u += F.G) scan_prompt_unit(F, A, u);
        for (int rep_ = 0; rep_ < DUPN(81); ++rep_) for (int it = F.gw; it < 2048; it += F.NGW) { if (it < 1024) gmlp_item<false>(F, A, it >> 3, it & 7); else gmlp_item<true>(F, A, (it - 1024) >> 3, it & 7); }
        for (int rep_ = 0; rep_ < DUPN(82); ++rep_) for (int it = F.gw; it < 128 * 8 * 8; it += F.NGW) scan_sample_item(F, A, it);
    } SEAM(8);
    if (IN(9)) for (int rep_ = 0; rep_ < DUPN(9); ++rep_) { DUPBAR(rep_); postscan_rows(F, A); } SEAM(9);
    if (IN(10)) { pg8::Gemm g{((bf16*)(F.ws + WS_XN)), ((bf16*)(F.ws + WS_WOUT)), M, D, D}; pg8::StaticOrder S; S.init(M, D, F.G, (int)blockIdx.x); pg8::EpiResid E{H, H + (size_t)MP * D, H, ((float*)(F.ws + WS_MOD)) + 5120, 1.0f};
        pg8::gemm_phase<pg8::EpiResid, pg8::StaticOrder, PG8_ALIGN, PG8_SP2>(F.lds + RING_OFF, g, S, E); } SEAM(10);
    if (IN(11)) for (int rep_ = 0; rep_ < DUPN(11); ++rep_) { DUPBAR(rep_); norm_rows_bf16(F, A, H, H + (size_t)MP * D, 6144, 7168); } SEAM(11);
    if (IN(12)) { pg8::Gemm g{((bf16*)(F.ws + WS_XN)), ((bf16*)(F.ws + WS_GU2)), M, 2 * FF, D}; pg8::StaticOrder S; S.init(M, 2 * FF, F.G, (int)blockIdx.x); pg8::EpiSwiglu E{((bf16*)(F.ws + WS_ACT))};
        pg8::gemm_phase<pg8::EpiSwiglu, pg8::StaticOrder, PG8_ALIGN, PG8_SP2>(F.lds + RING_OFF, g, S, E); } SEAM(12);
    if (IN(13)) { pg8::Gemm g{((bf16*)(F.ws + WS_ACT)), ((bf16*)(F.ws + WS_DN2)), M, D, FF}; pg8::StaticOrder S; S.init(M, D, F.G, (int)blockIdx.x); pg8::EpiResid E{H, H + (size_t)MP * D, H, ((float*)(F.ws + WS_MOD)) + 8192, 0.5f};
        pg8::gemm_phase<pg8::EpiResid, pg8::StaticOrder, PG8_ALIGN, PG8_SP2>(F.lds + RING_OFF, g, S, E); } SEAM(13);
    if (IN(14)) { final_norm_rows(F, A); }
#undef IN
#undef SEAM
}

extern "C" void kernel_launch(void* const* d_in, const int* in_sizes, int n_in, void* d_out, int out_size, void* d_ws, size_t ws_size, hipStream_t stream) {
    static int grid = 0;
    if (grid == 0) {
        if (n_in != 30 || in_sizes[0] != MP * D || (size_t)out_size != O_END || ws_size < WS_END) { fprintf(stderr, "kernel_launch: unexpected problem shape / workspace (%d inputs, out %d, ws %zu); nothing launched\n", n_in, out_size, ws_size); grid = -1; return; }
        int dev = 0, cus = 0, per_cu = 0;
        if (hipGetDevice(&dev) != hipSuccess || hipDeviceGetAttribute(&cus, hipDeviceAttributeMultiprocessorCount, dev) != hipSuccess) { grid = -1; return; }
        if (hipFuncSetAttribute((const void*)fwd_kernel, hipFuncAttributeMaxDynamicSharedMemorySize, LDS_BYTES) != hipSuccess) { fprintf(stderr, "kernel_launch: hipFuncSetAttribute failed\n"); grid = -1; return; }
        if (hipOccupancyMaxActiveBlocksPerMultiprocessor(&per_cu, (const void*)fwd_kernel, NWAVES * 64, LDS_BYTES) != hipSuccess || per_cu < 1) { fprintf(stderr, "kernel_launch: occupancy query says %d blocks per CU\n", per_cu); }
        (void)hipGetLastError();
        grid = cus;
    }
    if (grid < 0) return;
    (void)hipMemsetAsync((char*)d_ws + WS_CTL, 0, CTL_ZERO_BYTES, stream);
    Args a{};
    for (int i = 0; i < 30; ++i) a.in[i] = (const float*)d_in[i];
    a.out = (float*)d_out; a.ws = (unsigned char*)d_ws;
    if (MK_N_LAUNCHES == 1) { a.ph_lo = 0; a.ph_hi = N_PHASES; hipLaunchKernelGGL(fwd_kernel, dim3(grid), dim3(NWAVES * 64), LDS_BYTES, stream, a); }
    else for (int p = 0; p < N_PHASES; ++p) { a.ph_lo = p; a.ph_hi = p + 1; hipLaunchKernelGGL(fwd_kernel, dim3(grid), dim3(NWAVES * 64), LDS_BYTES, stream, a); }
}
```

```cpp
#include <hip/hip_runtime.h>
#include <cstdio>
#include <cstdint>
namespace pg8 {
#define PG8_LAS __attribute__((address_space(3)))
typedef unsigned short bf16_t;
typedef short bf16x8 __attribute__((ext_vector_type(8)));
typedef float f32x4 __attribute__((ext_vector_type(4)));
typedef unsigned u32x4 __attribute__((ext_vector_type(4)));
constexpr int BM = 256, BK = 64, HALF = 128, HTB = HALF * BK * 2  , STAGE_BYTES = 8 * HTB, NXCD = 8, WGM = 8;

__host__ __device__ __forceinline__ int lds_byte(int r, int c) { const int st = (r >> 4) * 2 + (c >> 5), rr = r & 15, cc = c & 31, ob = rr * 64 + cc * 2; return st * 1024 + (ob ^ (((ob >> 9) & 1) << 5)); }
__host__ __device__ __forceinline__ void stage_rc(int b, int& R, int& C) { const int st = b / 1024, sb = b % 1024, swz = sb ^ (((sb >> 9) & 1) << 5); R = (st >> 1) * 16 + swz / 64; C = (st & 1) * 32 + (swz % 64) / 2; }
__host__ __device__ __forceinline__ int perm32(int rho) { const int n = rho >> 4, i = rho & 15; return 8 * (i >> 2) + 4 * n + (i & 3); }

struct Unit { int pm, pn, kb, nt, ks; };
struct Gemm { const bf16_t* A; const bf16_t* Bt; int M, N, K, ld; };

struct StaticOrder {
    int nM, nN, nwg, G, c, knt;
    __host__ __device__ void init(int M, int N, int K, int G_, int c_) { nM = M / BM; nN = N / BM; nwg = nM * nN; G = G_; c = c_; knt = K / BK; }
    __host__ __device__ __forceinline__ bool next(int i, Unit& u) const {
        const long L = (long)i * G + c; if (L >= nwg) return false;
        int wgid = (int)L; { const int q = nwg / NXCD, r = nwg % NXCD, xcd = wgid % NXCD, off = wgid / NXCD; wgid = (xcd < r ? xcd * (q + 1) : r * (q + 1) + (xcd - r) * q) + off; }
        const int nig = WGM * nN, gid = wgid / nig, fm = gid * WGM, gsz = (nM - fm) < WGM ? (nM - fm) : WGM;
        u.pm = fm + ((wgid % nig) % gsz); u.pn = (wgid % nig) / gsz; u.kb = 0; u.nt = knt; u.ks = -1; return true;
    }
    __device__ __forceinline__ void a_ready(const Unit&) const {}
    __device__ __forceinline__ void done(const Unit&) const {}
};
struct SplitOrder {
    StaticOrder so; int ns, c, G;
    __host__ __device__ void init(int Mmain, int N, int K, int ns_, int G_, int c_) { so.init(Mmain, N, K, G_, c_); ns = ns_; c = c_; G = G_; }
    __host__ __device__ __forceinline__ bool next(int i, Unit& u) const {
        const int nsub = 16 * ns, mine = c < nsub ? (nsub - 1 - c) / G + 1 : 0;
        const bool sub = i < mine; const int s = c + i * G;
        Unit m; m.pm = 0; m.pn = 0; m.kb = 0; m.nt = so.knt; m.ks = -1;
        const bool okm = so.next(sub ? 0 : i - mine, m);
        u.pm = sub ? so.nM + s / (4 * ns) : m.pm; u.pn = sub ? ((s / ns) & 3) : m.pn; u.ks = sub ? s % ns : -1; u.kb = sub ? (s % ns) * 4 * BK * 2 : 0; u.nt = sub ? 4 : so.knt;
        return sub || okm;
    }
    __device__ __forceinline__ void a_ready(const Unit&) const {}
    __device__ __forceinline__ void done(const Unit&) const {}
};
__device__ __forceinline__ unsigned cvt_pk_bf16(float lo, float hi) { unsigned r; asm volatile("v_cvt_pk_bf16_f32 %0, %1, %2" : "=v"(r) : "v"(lo), "v"(hi)); return r; }
typedef float f32x2 __attribute__((ext_vector_type(2)));
constexpr int ROWS_P = 16384, ROWS_ALL = 17408, DM = 1024, MODW = 9216, FFW = 2816, RCOLS = 1792;
__device__ __forceinline__ int seq_of_row(int r) { return r < ROWS_P ? (r >> 11) : 8 + ((r - ROWS_P) >> 3); }
__device__ __forceinline__ bool row_is_first(int r) { return r < ROWS_P ? ((r & 2047) == 0) : (((r - ROWS_P) & 7) == 0); }
__device__ __forceinline__ bool row_is_last(int r) { return r < ROWS_P ? ((r & 2047) == 2047) : (((r - ROWS_P) & 7) == 7); }
__device__ __forceinline__ float silu_f(float x) { return x * __builtin_amdgcn_rcpf(1.0f + __builtin_amdgcn_exp2f(-1.4426950408889634f * x)); }

struct EpiSwiglu {
    static constexpr bool PERM = true, AFTER_DRAIN = false;
    bf16_t* O;
    __device__ __forceinline__ void operator()(const f32x4 (&acc)[2][2][4][2], const Unit& u, int wr, int wc, int fr, int fq) const {
        const int row0 = u.pm * BM + wr * 64 + fr, col0 = u.pn * HALF + wc * 32 + 8 * fq;
#pragma unroll
        for (int ai = 0; ai < 2; ++ai)
#pragma unroll
            for (int m = 0; m < 4; ++m) {
                bf16_t* rowp = O + (size_t)(row0 + ai * HALF + m * 16) * FFW + col0;
                const f32x4 g0 = acc[ai][0][m][0], g1 = acc[ai][0][m][1], u0 = acc[ai][1][m][0], u1 = acc[ai][1][m][1];
                u32x4 w;
                w.x = cvt_pk_bf16(silu_f(g0[0]) * u0[0], silu_f(g0[1]) * u0[1]); w.y = cvt_pk_bf16(silu_f(g0[2]) * u0[2], silu_f(g0[3]) * u0[3]);
                w.z = cvt_pk_bf16(silu_f(g1[0]) * u1[0], silu_f(g1[1]) * u1[1]); w.w = cvt_pk_bf16(silu_f(g1[2]) * u1[2], silu_f(g1[3]) * u1[3]);
                *(u32x4*)rowp = w;
            }
    }
};
struct EpiResid {
    static constexpr bool PERM = false, AFTER_DRAIN = false;
    const float* resP; const float* resS; float* out; const float* gate; float coef; float* slab;
    __device__ __forceinline__ void operator()(const f32x4 (&acc)[2][2][4][2], const Unit& u, int wr, int wc, int fr, int fq) const {
        const int col0 = u.pn * BM + wc * 32 + 4 * fq;
        if (u.ks >= 0) {
#pragma unroll
            for (int ai = 0; ai < 2; ++ai)
#pragma unroll
                for (int m = 0; m < 4; ++m) { float* srow = slab + ((size_t)u.ks * 1024 + (size_t)(u.pm * BM + ai * HALF + wr * 64 + m * 16 + fr - ROWS_P)) * DM + col0;
#pragma unroll
                    for (int bj = 0; bj < 2; ++bj)
#pragma unroll
                        for (int n = 0; n < 2; ++n) *(f32x4*)(srow + bj * HALF + n * 16) = acc[ai][bj][m][n]; }
            return; }
#pragma unroll
        for (int ai = 0; ai < 2; ++ai)
#pragma unroll
            for (int m = 0; m < 4; ++m) {
                const int row = u.pm * BM + ai * HALF + wr * 64 + m * 16 + fr; const int s = seq_of_row(row);
                const float* rrow = (row < ROWS_P ? resP + (size_t)row * DM : resS + (size_t)(row - ROWS_P) * DM) + col0;
                float* orow = out + (size_t)row * DM + col0; const float* grow = gate + (size_t)s * MODW + col0;
#pragma unroll
                for (int bj = 0; bj < 2; ++bj)
#pragma unroll
                    for (int n = 0; n < 2; ++n) { const int off = bj * HALF + n * 16; const f32x4 r = *(const f32x4*)(rrow + off), g = *(const f32x4*)(grow + off);
                        *(f32x4*)(orow + off) = r + (g * coef) * acc[ai][bj][m][n]; }
            }
    }
};
struct EpiP {
    static constexpr bool PERM = true, AFTER_DRAIN = false;
    bf16_t* PB; bf16_t* PUV; float* shp; float* shs;
    __device__ __forceinline__ void operator()(const f32x4 (&acc)[2][2][4][2], const Unit& u, int wr, int wc, int fr, int fq) const {
        typedef unsigned u32x2 __attribute__((ext_vector_type(2)));
        const int row0 = u.pm * BM + wr * 64 + fr, col0 = u.pn * BM + wc * 32 + 8 * fq;
#pragma unroll
        for (int ai = 0; ai < 2; ++ai)
#pragma unroll
            for (int m = 0; m < 4; ++m) {
                const int row = row0 + ai * HALF + m * 16; const bool last = row_is_last(row);
#pragma unroll
                for (int bj = 0; bj < 2; ++bj) { const f32x4 v0 = acc[ai][bj][m][0], v1 = acc[ai][bj][m][1]; const int col = col0 + bj * HALF;
                    u32x4 w; w.x = cvt_pk_bf16(v0[0], v0[1]); w.y = cvt_pk_bf16(v0[2], v0[3]); w.z = cvt_pk_bf16(v1[0], v1[1]); w.w = cvt_pk_bf16(v1[2], v1[3]);
                    if (u.pn < 7) { bf16_t* p = PB + ((size_t)((row >> 4) * 448 + (col >> 2)) * 16 + (row & 15)) * 4; *(u32x2*)p = (u32x2){w.x, w.y}; *(u32x2*)(p + 64) = (u32x2){w.z, w.w};
                        if (last) { float* o = (row < ROWS_P ? shp + (size_t)(row >> 11) * RCOLS : shs + (size_t)((row - ROWS_P) >> 3) * RCOLS) + col; *(f32x4*)o = v0; *(f32x4*)(o + 4) = v1; } }
                    else *(u32x4*)(PUV + (size_t)row * 1024 + (col - RCOLS)) = w; }
            }
    }
};
template <class Epi, class Sched, bool ALIGN_EPI = false, bool SP2 = false>
__device__ __forceinline__ void gemm_phase(PG8_LAS unsigned char* lds, const Gemm g, const Sched& S, const Epi& E) {
    const int tid = threadIdx.x, wid = __builtin_amdgcn_readfirstlane(tid >> 6), lane = tid & 63, wr = wid >> 2, wc = wid & 3, fr = lane & 15, fq = lane >> 4;
    const int K = g.ld;
    unsigned voffA[2], voffB[2];
#pragma unroll
    for (int i = 0; i < 2; ++i) { int R, C; stage_rc(tid * 16 + i * 8192, R, C); const int Rb = Epi::PERM ? ((R & ~31) + perm32(R & 31)) : R;
        voffA[i] = (unsigned)(R * K + C) * 2u; voffB[i] = (unsigned)(Rb * K + C) * 2u; }
    const size_t kstep = (size_t)(BK * 2);
    const size_t hstep = (size_t)HALF * K * 2;
    const size_t tstep = 2 * hstep;
    const unsigned ldsw = (unsigned)wid * 1024u;
    const int aoff = lds_byte(wr * 64 + fr, fq * 8), boff = lds_byte(wc * 32 + fr, fq * 8);
#define PG8_SA(b, h) (((b) * 2 + (h)) * HTB)
#define PG8_SB(b, h) ((4 + (b) * 2 + (h)) * HTB)
#define PG8_STAGE(bufoff, gbase, voff) do { _Pragma("unroll") for (int _i = 0; _i < 2; ++_i) \
        __builtin_amdgcn_global_load_lds((const unsigned*)((const char*)(gbase) + (voff)[_i]), (PG8_LAS unsigned*)(lds + (bufoff) + ldsw + _i * 8192), 16, 0, 0); } while (0)
#define PG8_LDA(dst, b, h) do { _Pragma("unroll") for (int m = 0; m < 4; ++m) _Pragma("unroll") for (int k = 0; k < 2; ++k) dst[m][k] = *(const PG8_LAS bf16x8*)(lds + PG8_SA(b, h) + aoff + m * 2048 + k * 1024); } while (0)
#define PG8_LDB(dst, b, h) do { _Pragma("unroll") for (int n = 0; n < 2; ++n) _Pragma("unroll") for (int k = 0; k < 2; ++k) dst[n][k] = *(const PG8_LAS bf16x8*)(lds + PG8_SB(b, h) + boff + n * 2048 + k * 1024); } while (0)
#define PG8_MMA(ai, bj, At, Bt) do { __builtin_amdgcn_s_setprio(1); _Pragma("unroll") for (int m = 0; m < 4; ++m) _Pragma("unroll") for (int n = 0; n < 2; ++n) _Pragma("unroll") for (int k = 0; k < 2; ++k) \
        acc[ai][bj][m][n] = __builtin_amdgcn_mfma_f32_16x16x32_bf16(Bt[n][k], At[m][k], acc[ai][bj][m][n], 0, 0, 0); __builtin_amdgcn_s_setprio(0); } while (0)
#define PG8_WAIT_V(n) asm volatile("s_waitcnt vmcnt(" #n ")" ::: "memory")
#define PG8_WAIT_L(n) asm volatile("s_waitcnt lgkmcnt(" #n ")" ::: "memory")
#define PG8_BAR __builtin_amdgcn_s_barrier()
#define PG8_SCHED __builtin_amdgcn_sched_barrier(0)
    Unit cur, nxt; int ui = 0;
    if (!S.next(0, cur)) return;
    f32x4 acc[2][2][4][2];
#pragma unroll
    for (int a = 0; a < 2; ++a)
#pragma unroll
        for (int b = 0; b < 2; ++b)
#pragma unroll
            for (int m = 0; m < 4; ++m)
#pragma unroll
                for (int n = 0; n < 2; ++n) acc[a][b][m][n] = (f32x4){0.f, 0.f, 0.f, 0.f};
    bf16x8 At[4][2], B0[2][2], B1[2][2];
    const char* cA = (const char*)g.A + (size_t)cur.pm * tstep + cur.kb; const char* cB = (const char*)g.Bt + (size_t)cur.pn * tstep + cur.kb;
    S.a_ready(cur);
    if constexpr (SP2) {
        PG8_STAGE(PG8_SB(0, 0), cB, voffB); PG8_STAGE(PG8_SB(0, 1), cB + hstep, voffB); PG8_STAGE(PG8_SA(0, 0), cA, voffA); PG8_STAGE(PG8_SA(0, 1), cA + hstep, voffA);
        if (wr == 1) PG8_BAR;
        PG8_WAIT_V(2); PG8_BAR;
        PG8_STAGE(PG8_SB(1, 0), cB + kstep, voffB); PG8_STAGE(PG8_SA(1, 0), cA + kstep, voffA); PG8_STAGE(PG8_SB(1, 1), cB + hstep + kstep, voffB);
        PG8_WAIT_V(6); PG8_BAR;
    } else {
        PG8_STAGE(PG8_SB(0, 0), cB, voffB); PG8_STAGE(PG8_SA(0, 0), cA, voffA); PG8_STAGE(PG8_SB(0, 1), cB + hstep, voffB); PG8_STAGE(PG8_SA(0, 1), cA + hstep, voffA);
        if (wr == 1) PG8_BAR;
        PG8_WAIT_V(4); PG8_BAR;
        PG8_STAGE(PG8_SB(1, 0), cB + kstep, voffB); PG8_STAGE(PG8_SA(1, 0), cA + kstep, voffA); PG8_STAGE(PG8_SB(1, 1), cB + hstep + kstep, voffB);
        PG8_WAIT_V(6); PG8_BAR;
    }
    for (;;) {
        const bool has_next = S.next(ui + 1, nxt);
        const char* nA = has_next ? (const char*)g.A + (size_t)nxt.pm * tstep + nxt.kb : cA; const char* nB = has_next ? (const char*)g.Bt + (size_t)nxt.pn * tstep + nxt.kb : cB;
        const int nt = cur.nt;
        for (int t = 0; t < nt; t += 2) {
            const bool last = (t == nt - 2);
            const char* a1 = cA + (size_t)(t + 1) * kstep;
            const char* a2 = last ? nA : cA + (size_t)(t + 2) * kstep; const char* b2 = last ? nB : cB + (size_t)(t + 2) * kstep;
            const char* a3 = a2 + kstep; const char* b3 = b2 + kstep;
            if (last && has_next) S.a_ready(nxt);
            if constexpr (SP2) {
            PG8_LDB(B0, 0, 0); PG8_LDB(B1, 0, 1); PG8_SCHED; PG8_LDA(At, 0, 0); PG8_STAGE(PG8_SA(1, 1), a1 + hstep, voffA);
            PG8_WAIT_V(8); PG8_WAIT_L(0); PG8_BAR; PG8_MMA(0, 0, At, B0); PG8_MMA(0, 1, At, B1); PG8_BAR; PG8_SCHED;
            PG8_LDA(At, 0, 1); PG8_STAGE(PG8_SB(0, 0), b2, voffB); PG8_STAGE(PG8_SB(0, 1), b2 + hstep, voffB); PG8_STAGE(PG8_SA(0, 0), a2, voffA);
            PG8_WAIT_V(8); PG8_WAIT_L(0); PG8_BAR; PG8_MMA(1, 0, At, B0); PG8_MMA(1, 1, At, B1); PG8_BAR; PG8_SCHED;
            PG8_LDB(B0, 1, 0); PG8_LDB(B1, 1, 1); PG8_SCHED; PG8_LDA(At, 1, 0); PG8_STAGE(PG8_SA(0, 1), a2 + hstep, voffA);
            PG8_WAIT_V(8); PG8_WAIT_L(0); PG8_BAR; PG8_MMA(0, 0, At, B0); PG8_MMA(0, 1, At, B1); PG8_BAR; PG8_SCHED;
            PG8_LDA(At, 1, 1); PG8_STAGE(PG8_SB(1, 0), b3, voffB); PG8_STAGE(PG8_SB(1, 1), b3 + hstep, voffB); PG8_STAGE(PG8_SA(1, 0), a3, voffA);
            PG8_WAIT_V(8); PG8_WAIT_L(0); PG8_BAR; PG8_MMA(1, 0, At, B0); PG8_MMA(1, 1, At, B1); PG8_BAR; PG8_SCHED;
            } else {
            PG8_LDB(B0, 0, 0); PG8_SCHED; PG8_LDA(At, 0, 0); PG8_STAGE(PG8_SA(1, 1), a1 + hstep, voffA);
            PG8_WAIT_L(8); PG8_BAR; PG8_WAIT_L(0); PG8_MMA(0, 0, At, B0); PG8_BAR; PG8_SCHED;
            PG8_LDB(B1, 0, 1); PG8_STAGE(PG8_SB(0, 0), b2, voffB);
            PG8_BAR; PG8_WAIT_L(0); PG8_MMA(0, 1, At, B1); PG8_BAR;
            PG8_LDA(At, 0, 1); PG8_STAGE(PG8_SA(0, 0), a2, voffA);
            PG8_BAR; PG8_WAIT_L(0); PG8_MMA(1, 0, At, B0); PG8_BAR; PG8_SCHED;
            PG8_STAGE(PG8_SB(0, 1), b2 + hstep, voffB);
            PG8_WAIT_V(6); PG8_BAR; PG8_MMA(1, 1, At, B1); PG8_BAR;
            PG8_LDB(B0, 1, 0); PG8_SCHED; PG8_LDA(At, 1, 0); PG8_STAGE(PG8_SA(0, 1), a2 + hstep, voffA);
            PG8_WAIT_L(8); PG8_BAR; PG8_WAIT_L(0); PG8_MMA(0, 0, At, B0); PG8_BAR; PG8_SCHED;
            PG8_LDB(B1, 1, 1); PG8_STAGE(PG8_SB(1, 0), b3, voffB);
            PG8_BAR; PG8_WAIT_L(0); PG8_MMA(0, 1, At, B1); PG8_BAR;
            PG8_LDA(At, 1, 1); PG8_STAGE(PG8_SA(1, 0), a3, voffA);
            PG8_BAR; PG8_WAIT_L(0); PG8_MMA(1, 0, At, B0); PG8_BAR; PG8_SCHED;
            PG8_STAGE(PG8_SB(1, 1), b3 + hstep, voffB);
            PG8_WAIT_V(6); PG8_BAR; PG8_MMA(1, 1, At, B1); PG8_BAR;
            }
        }
        if constexpr (ALIGN_EPI) { if (wr == 0) PG8_BAR; }
        if constexpr (!Epi::AFTER_DRAIN) { E(acc, cur, wr, wc, fr, fq); S.done(cur); }
        if (!has_next) break;
#pragma unroll
        for (int a = 0; a < 2; ++a)
#pragma unroll
            for (int b = 0; b < 2; ++b)
#pragma unroll
                for (int m = 0; m < 4; ++m)
#pragma unroll
                    for (int n = 0; n < 2; ++n) acc[a][b][m][n] = (f32x4){0.f, 0.f, 0.f, 0.f};
        cur = nxt; cA = nA; cB = nB; ++ui;
        if constexpr (ALIGN_EPI) { if (wr == 1) PG8_BAR; }
    }
    PG8_WAIT_V(0);
    if constexpr (!ALIGN_EPI) { if (wr == 0) PG8_BAR; }
    PG8_BAR;
    if constexpr (Epi::AFTER_DRAIN) { E.fused(acc, cur, wr, wc, fr, fq, lds, wid, lane); S.done(cur); }
#undef PG8_SA
#undef PG8_SB
#undef PG8_STAGE
#undef PG8_LDA
#undef PG8_LDB
#undef PG8_MMA
#undef PG8_WAIT_V
#undef PG8_WAIT_L
#undef PG8_BAR
#undef PG8_SCHED
}
}
#ifndef PG8_SP2
#define PG8_SP2 true
#endif
#ifndef PG8_ALIGN
#define PG8_ALIGN true
#endif
#ifndef MK_N_LAUNCHES
#define MK_N_LAUNCHES 1
#endif
constexpr int NWAVES = 8;
constexpr int N_PHASES = 15;
constexpr int D = 1024, MP = 16384, MS = 1024, M = MP + MS, NSEQ = 136, FF = 2816, RC = 1792, PC = 2816, RW = 512, MODW = 9216;
constexpr float RMS_EPS = 1e-6f, LN_EPS = 1e-5f, GN_EPS = 64e-5f;
constexpr size_t O_Y = 0, O_SHP = 17825792, O_WKVP = 17840128, O_SHS = 18102272, O_WKVS = 18331648, O_CVS = 22525952, O_END = 23050240;
constexpr size_t MiB = 1u << 20;
constexpr size_t WS_CTL = 0, CTL_ZERO_BYTES = 1 * MiB;
constexpr size_t WS_GU1 = 1 * MiB, WS_DN1 = 12 * MiB, WS_WIN = 18 * MiB, WS_WOUT = 24 * MiB, WS_GU2 = 26 * MiB, WS_DN2 = 37 * MiB;
constexpr size_t WS_SMALL = 43 * MiB;
constexpr size_t WS_WLT = WS_SMALL, WS_ALT = WS_SMALL + 65536, WS_GLT = WS_SMALL + 131072, WS_WSB = WS_SMALL + 262144, WS_SILUC = WS_SMALL + 524288;
constexpr size_t WS_MOD = 44 * MiB;
constexpr size_t WS_BON = 49 * MiB;
constexpr size_t WS_FP = 331 * MiB;
constexpr size_t WS_XN = 50 * MiB;
constexpr size_t WS_ACT = 84 * MiB;
constexpr size_t WS_PUV = WS_ACT + 60 * MiB;
static_assert((size_t)M * 1792 * 2 <= 60 * MiB && WS_PUV + (size_t)M * 1024 * 2 <= 178 * MiB, "ws map puv");
constexpr size_t WS_SC = 178 * MiB, SC_STRIDE = 17 * MiB;
constexpr size_t WS_G = 280 * MiB;
constexpr size_t WS_Y = 297 * MiB;
constexpr size_t WS_FRG = 339 * MiB;
constexpr size_t WS_END = 348 * MiB;
static_assert(WS_FRG + (size_t)M * 256 * 2 <= WS_END, "ws map frg");
static_assert(WS_FP + (size_t)136 * 448 * 64 * 2 <= WS_END, "ws map fp");
static_assert(WS_DN1 - WS_GU1 >= (size_t)5632 * 1024 * 2 && WS_WIN - WS_DN1 >= (size_t)1024 * 2816 * 2 && WS_WOUT - WS_WIN >= (size_t)2816 * 1024 * 2 && WS_GU2 - WS_WOUT >= (size_t)1024 * 1024 * 2, "ws map a");
static_assert(WS_DN2 - WS_GU2 >= (size_t)5632 * 1024 * 2 && WS_SMALL - WS_DN2 >= (size_t)1024 * 2816 * 2 && WS_BON - WS_MOD >= (size_t)136 * 9216 * 4 && WS_XN - WS_BON >= (size_t)M * 8 * 4, "ws map b");
static_assert(WS_ACT - WS_XN >= (size_t)M * 1024 * 2 && WS_SC - WS_ACT >= (size_t)M * 2816 * 2 && SC_STRIDE >= (size_t)M * 512 * 2 && WS_G - WS_SC >= 6 * SC_STRIDE && WS_Y - WS_G >= (size_t)M * 512 * 2 && WS_END - WS_Y >= (size_t)M * 512 * 4, "ws map c");
constexpr int CW_TMO = 0, CW_CODE = 1, CW_BAR = 4096;
constexpr int RING_OFF = 0, RING_BYTES = 139264;
constexpr int LDSCTL_OFF = RING_BYTES, MISC_OFF = LDSCTL_OFF + 320;
constexpr int LDS_BYTES = 147456;
struct Args { const float* in[30]; float* out; unsigned char* ws; int ph_lo, ph_hi; };
constexpr int PTRS_OFF = MISC_OFF + 128;
#ifndef USE_PTR_TABLE
#define USE_PTR_TABLE 0
#endif
#if !USE_PTR_TABLE
struct InAcc { const float* in[30]; };
#else
struct InPtrs { __attribute__((address_space(3))) unsigned* t;
    __device__ __forceinline__ const float* operator[](int i) const { const unsigned lo = __builtin_amdgcn_readfirstlane(t[2 * i]), hi = __builtin_amdgcn_readfirstlane(t[2 * i + 1]); return (const float*)(((unsigned long long)hi << 32) | lo); } };
struct InAcc { InPtrs in; };
#endif
#define GAS __attribute__((address_space(1)))
#define LAS __attribute__((address_space(3)))
typedef unsigned short bf16;
typedef unsigned v4u __attribute__((ext_vector_type(4)));
typedef float f32x4 __attribute__((ext_vector_type(4)));
typedef short bf16x8 __attribute__((ext_vector_type(8)));
typedef GAS unsigned gu32;
typedef GAS unsigned long long gu64;
#define RLX_AGENT __ATOMIC_RELAXED, __HIP_MEMORY_SCOPE_AGENT
#define LDS_WAIT() asm volatile("s_waitcnt lgkmcnt(0)" ::: "memory")
#define VM_WAIT() asm volatile("s_waitcnt vmcnt(0)" ::: "memory")
__device__ __forceinline__ unsigned long long rt() { return __builtin_amdgcn_s_memrealtime(); }
__device__ __forceinline__ unsigned f2bf(float f) { unsigned u = __builtin_bit_cast(unsigned, f); return (u + 0x7fffu + ((u >> 16) & 1u)) >> 16; }
__device__ __forceinline__ unsigned pk2(float lo, float hi) { return f2bf(lo) | (f2bf(hi) << 16); }
#define XB_TMO      128
#define XB_XCNT(j)  (256  + 64 * (j))
#define XB_XSUB(j)  (1280 + 64 * (j))
#define XB_XGEN(j)  (2304 + 64 * (j))
#define XB_TOP      3328
#define XB_TOPGEN   3392
#define XCD_BAR_WORDS 3456
#define XB_SPIN_CAP (1u << 18)

__device__ __forceinline__ unsigned xb_ld(unsigned* p)              { return __hip_atomic_load(p, __ATOMIC_RELAXED, __HIP_MEMORY_SCOPE_AGENT); }
__device__ __forceinline__ unsigned xb_add(unsigned* p, unsigned v) { return __hip_atomic_fetch_add(p, v, __ATOMIC_RELAXED, __HIP_MEMORY_SCOPE_AGENT); }
__device__ __forceinline__ unsigned xb_xcc_id() { return (unsigned)__builtin_amdgcn_s_getreg((3 << 11) | 20) & 0xFu; }
#define XB_SPIN(cond, bar) do { unsigned _sp = 0; while (cond) { __builtin_amdgcn_s_sleep(1); \
    if ((++_sp & 255u) == 0u) { if (xb_ld(&(bar)[XB_TMO])) break; if (_sp > XB_SPIN_CAP) { atomicAdd(&(bar)[XB_TMO], 1u); break; } } } } while (0)

struct XcdBarrier {
    unsigned* bar; unsigned x;
    volatile LAS unsigned* st;
};

__device__ __forceinline__ XcdBarrier xcd_barrier_post(unsigned* bar, volatile LAS unsigned* st) {
    XcdBarrier b; b.bar = bar; b.x = xb_xcc_id(); b.st = st;
    if (threadIdx.x == 0) (void)xb_add(&bar[XB_XCNT(b.x)], 1u);
    return b;
}
__device__ __forceinline__ void xcd_barrier_complete(unsigned* bar, unsigned x, unsigned& nloc, unsigned& nx) {
    const unsigned G = gridDim.x * gridDim.y * gridDim.z;
    unsigned sum, cnt, mine, sp = 0u;
    for (;;) {
        sum = 0u; cnt = 0u; mine = 0u;
#pragma unroll
        for (unsigned j = 0; j < 16; ++j) { const unsigned c = xb_ld(&bar[XB_XCNT(j)]); sum += c; cnt += (c > 0u) ? 1u : 0u; mine = (j == x) ? c : mine; }
        if (sum == G) break;
        __builtin_amdgcn_s_sleep(1);
        if ((++sp & 255u) == 0u) { if (xb_ld(&bar[XB_TMO])) break; if (sp > XB_SPIN_CAP) { atomicAdd(&bar[XB_TMO], 1u); break; } }
    }
    nloc = mine > 0u ? mine : 1u; nx = cnt > 0u ? cnt : 1u;
}

__device__ __forceinline__ void xcd_barrier(const XcdBarrier& b) {
    asm volatile("s_waitcnt vmcnt(0)" ::: "memory");
    __syncthreads();
    if (threadIdx.x == 0) {
        unsigned* bar = b.bar;
        __builtin_amdgcn_s_waitcnt(0);
        unsigned nloc = b.st[0], nx = b.st[1];
        if (nloc == 0u) { xcd_barrier_complete(bar, b.x, nloc, nx); b.st[0] = nloc; b.st[1] = nx; }
        const unsigned old = xb_add(&bar[XB_XSUB(b.x)], 1u);
        const unsigned gen = old / nloc;
        if (old + 1u == (gen + 1u) * nloc) {
            __builtin_amdgcn_fence(__ATOMIC_RELEASE, "agent");
            asm volatile("s_waitcnt vmcnt(0)" ::: "memory");
            const unsigned og = xb_add(&bar[XB_TOP], 1u);
            const unsigned tg = og / nx;
            if (og + 1u == (tg + 1u) * nx) xb_add(&bar[XB_TOPGEN], 1u);
            else XB_SPIN(xb_ld(&bar[XB_TOPGEN]) == tg, bar);
            __builtin_amdgcn_fence(__ATOMIC_ACQUIRE, "agent");
            xb_add(&bar[XB_XGEN(b.x)], 1u);
            asm volatile("s_waitcnt vmcnt(0)" ::: "memory");
        } else {
            XB_SPIN(xb_ld(&bar[XB_XGEN(b.x)]) == gen, bar);
            __builtin_amdgcn_fence(__ATOMIC_ACQUIRE, "agent");
            asm volatile("s_waitcnt vmcnt(0)" ::: "memory");
        }
    }
    __syncthreads();
}
struct Frame {
    LAS unsigned char* lds;
    volatile LAS unsigned* MISC;
    gu32* ctl;
    int tid, lane, wave, gw, NGW, G;
    float* out; unsigned char* ws;
};
__device__ __forceinline__ float wave_sum(float v) {
#pragma unroll
    for (int o = 1; o < 64; o <<= 1) v += __shfl_xor(v, o);
    return v;
}
__device__ __forceinline__ float bf2f(unsigned short b) { return __uint_as_float((unsigned)b << 16); }
__device__ __forceinline__ void unpack8(v4u w, float* f) {
    f[0] = __uint_as_float(w.x << 16); f[1] = __uint_as_float(w.x & 0xffff0000u); f[2] = __uint_as_float(w.y << 16); f[3] = __uint_as_float(w.y & 0xffff0000u);
    f[4] = __uint_as_float(w.z << 16); f[5] = __uint_as_float(w.z & 0xffff0000u); f[6] = __uint_as_float(w.w << 16); f[7] = __uint_as_float(w.w & 0xffff0000u);
}
typedef unsigned v2u __attribute__((ext_vector_type(2)));
__device__ __forceinline__ void unpack4(v2u w, float* f) {
    f[0] = __uint_as_float(w.x << 16); f[1] = __uint_as_float(w.x & 0xffff0000u); f[2] = __uint_as_float(w.y << 16); f[3] = __uint_as_float(w.y & 0xffff0000u);
}
__device__ __forceinline__ v2u pack4(const float* f) { v2u w; w.x = pk2(f[0], f[1]); w.y = pk2(f[2], f[3]); return w; }
__device__ __forceinline__ v4u pack8(const float* f) { v4u w; w.x = pk2(f[0], f[1]); w.y = pk2(f[2], f[3]); w.z = pk2(f[4], f[5]); w.w = pk2(f[6], f[7]); return w; }
__device__ __forceinline__ bf16x8 as_bf16x8(v4u w) { return __builtin_bit_cast(bf16x8, w); }
__device__ __forceinline__ float sigmoid_f(float x) { return 1.0f / (1.0f + __expf(-x)); }
__device__ __forceinline__ float tanh_f(float x) { const float e = __expf(2.0f * x); return 1.0f - 2.0f / (e + 1.0f); }

__device__ __forceinline__ void transpose_item(const float* W, int K, int N, bf16* WT, int kb, int nb, int orow0, LAS float* scr, int lane) {
    const int k0 = 64 * kb, n0 = 32 * nb;
#pragma unroll 8
    for (int i = 0; i < 32; ++i) { const int kk = 2 * i + (lane >> 5); scr[kk * 33 + (lane & 31)] = W[(size_t)(k0 + kk) * N + n0 + (lane & 31)]; }
    LDS_WAIT(); asm volatile("" ::: "memory");
    const int c = lane & 7;
#pragma unroll
    for (int j = 0; j < 4; ++j) { const int n = (lane >> 3) + 8 * j; const LAS float* s = scr + (8 * c) * 33 + n;
        v4u o; o.x = pk2(s[0 * 33], s[1 * 33]); o.y = pk2(s[2 * 33], s[3 * 33]); o.z = pk2(s[4 * 33], s[5 * 33]); o.w = pk2(s[6 * 33], s[7 * 33]);
        *(GAS v4u*)(WT + (size_t)(orow0 + n) * K + k0 + 8 * c) = o; }
    LDS_WAIT(); asm volatile("" ::: "memory");
}
__device__ __forceinline__ int gu_row(int n0) { return n0 < FF ? 256 * (n0 >> 7) + (n0 & 127) : 256 * ((n0 - FF) >> 7) + 128 + ((n0 - FF) & 127); }
__device__ __forceinline__ void p0_prologue(Frame& F, const InAcc& A) {
    LAS float* scr = (LAS float*)(F.lds + RING_OFF + F.wave * 16384);
    constexpr int I_GU = 16 * 176, I_DN = 44 * 32, I_IN = 16 * 88, I_OUT = 16 * 32, I_L64 = 16, I_L128 = 32;
    constexpr int NITEMS = 2 * I_GU + 2 * I_DN + I_IN + I_OUT + 2 * I_L64 + I_L128;
    for (int it = F.gw; it < NITEMS; it += F.NGW) {
        int r = it;
        if (r < I_GU) { const int kb = r / 176, nb = r % 176; transpose_item(A.in[8], 1024, 5632, ((bf16*)(F.ws + WS_GU1)), kb, nb, gu_row(32 * nb), scr, F.lane); continue; } r -= I_GU;
        if (r < I_GU) { const int kb = r / 176, nb = r % 176; transpose_item(A.in[27], 1024, 5632, ((bf16*)(F.ws + WS_GU2)), kb, nb, gu_row(32 * nb), scr, F.lane); continue; } r -= I_GU;
        if (r < I_DN) { const int kb = r / 32, nb = r % 32; transpose_item(A.in[9], 2816, 1024, ((bf16*)(F.ws + WS_DN1)), kb, nb, 32 * nb, scr, F.lane); continue; } r -= I_DN;
        if (r < I_DN) { const int kb = r / 32, nb = r % 32; transpose_item(A.in[28], 2816, 1024, ((bf16*)(F.ws + WS_DN2)), kb, nb, 32 * nb, scr, F.lane); continue; } r -= I_DN;
        if (r < I_IN) { const int kb = r / 88, nb = r % 88; transpose_item(A.in[10], 1024, 2816, ((bf16*)(F.ws + WS_WIN)), kb, nb, 32 * nb, scr, F.lane); continue; } r -= I_IN;
        if (r < I_OUT) { const int kb = r / 32, nb = r % 32; transpose_item(A.in[26], 1024, 1024, ((bf16*)(F.ws + WS_WOUT)), kb, nb, 32 * nb, scr, F.lane); continue; } r -= I_OUT;
        if (r < I_L64) { transpose_item(A.in[13], 64, 512, ((bf16*)(F.ws + WS_WLT)), 0, r, 32 * r, scr, F.lane); continue; } r -= I_L64;
        if (r < I_L64) { transpose_item(A.in[15], 64, 512, ((bf16*)(F.ws + WS_ALT)), 0, r, 32 * r, scr, F.lane); continue; } r -= I_L64;
        { const int kb = r / 16, nb = r % 16; transpose_item(A.in[16], 128, 512, ((bf16*)(F.ws + WS_GLT)), kb, nb, 32 * nb, scr, F.lane); }
    }
    const int gt = F.gw * 64 + F.lane, NGT = F.NGW * 64;
    for (int i = gt; i < 144 * 512; i += NGT) { const int s = i >> 9, k = (i & 511) * 2;
        float a = 0.f, b = 0.f;
        if (s < NSEQ) { const float* cr = s < 8 ? A.in[4] + (size_t)s * D : A.in[5] + (size_t)(s - 8) * D; a = cr[k]; b = cr[k + 1]; a = a * sigmoid_f(a); b = b * sigmoid_f(b); }
        ((unsigned*)((bf16*)(F.ws + WS_SILUC)))[i] = pk2(a, b); }
    for (int i = gt; i < NSEQ * 448; i += NGT) { const int sq = i / 448, cg = i % 448;
        f32x4 v = {0.f, 0.f, 0.f, 0.f}; if (sq >= 8) v = *(const f32x4*)(A.in[2] + (size_t)(sq - 8) * RC + 4 * cg);
        v2u w; w.x = pk2(v.x, v.y); w.y = pk2(v.z, v.w); *(v2u*)((bf16*)(F.ws + WS_FP) + (size_t)i * 64) = w; }
    for (int i = gt; i < 8 * 128 * 64; i += NGT) { const int j = (i & 63) * 2, ii = (i >> 6) & 127;
        const float a = A.in[24][2 * (size_t)i], b = A.in[24][2 * (size_t)i + 1];
        ((unsigned*)((bf16*)(F.ws + WS_WSB)))[i] = pk2(j <= ii ? a : 0.f, (j + 1) <= ii ? b : 0.f); }
}
__device__ __forceinline__ void p1_mod(Frame& F, const InAcc& A) {
    const int l15 = F.lane & 15, q = F.lane >> 4;
    const float* w_ada = A.in[6]; const float* b_ada = A.in[7];
    const bf16* SILUC = (const bf16*)(F.ws + WS_SILUC);
    LAS f32x4* red = (LAS f32x4*)(F.lds + RING_OFF);
    for (int nt = blockIdx.x; nt < MODW / 16; nt += F.G) {
        const int n0 = 16 * nt, kb = 128 * F.wave + 8 * q;
        float wv[4][8];
        const float* wp = w_ada + (size_t)kb * MODW + n0 + l15;
#pragma unroll
        for (int ks = 0; ks < 4; ++ks) {
#pragma unroll
            for (int j = 0; j < 8; ++j) { wv[ks][j] = *wp; wp += MODW; asm volatile("" : "+v"(wp)); }
            wp += 24 * MODW; }
        f32x4 acc[9];
#pragma unroll
        for (int mt = 0; mt < 9; ++mt) acc[mt] = (f32x4){0.f, 0.f, 0.f, 0.f};
        const bf16* sp = SILUC + (size_t)l15 * D + kb;
#pragma unroll
        for (int ks = 0; ks < 4; ++ks) {
            bf16x8 sf[9];
#pragma unroll
            for (int mt = 0; mt < 9; ++mt) sf[mt] = *(const bf16x8*)(sp + (size_t)(16 * mt) * D + 32 * ks);
            __builtin_amdgcn_sched_barrier(0);
            const bf16x8 wf = as_bf16x8(pack8(wv[ks]));
#pragma unroll
            for (int mt = 0; mt < 9; ++mt) acc[mt] = __builtin_amdgcn_mfma_f32_16x16x32_bf16(wf, sf[mt], acc[mt], 0, 0, 0);
            __builtin_amdgcn_sched_barrier(0);
        }
#pragma unroll
        for (int mt = 0; mt < 9; ++mt) red[(F.wave * 9 + mt) * 64 + F.lane] = acc[mt];
        __syncthreads();
        const f32x4 bv = *(const f32x4*)(b_ada + n0 + 4 * q);
#pragma unroll
        for (int rr = 0; rr < 2; ++rr) { const int mt = F.wave + 8 * rr; if (mt < 9) { f32x4 s = bv;
#pragma unroll
                for (int w2 = 0; w2 < 8; ++w2) s += red[(w2 * 9 + mt) * 64 + F.lane];
                const int sq = 16 * mt + l15; if (sq < NSEQ) *(f32x4*)(((float*)(F.ws + WS_MOD)) + (size_t)sq * MODW + n0 + 4 * q) = s; } }
        __syncthreads();
    }
}
__device__ __forceinline__ const float* res_row(const float* pP, const float* pS, int row) { return row < MP ? pP + (size_t)row * D : pS + (size_t)(row - MP) * D; }
__device__ __forceinline__ void norm_rows_bf16(Frame& F, const InAcc& A, const float* srcP, const float* srcS, int sh_off, int sc_off, int ns, int g_off, float coef) {
    const float* MODp = (const float*)(F.ws + WS_MOD);
    for (int row = F.gw; row < M; row += F.NGW) {
        const f32x4* xr = (const f32x4*)res_row(srcP, srcS, row) + F.lane; const int s = pg8::seq_of_row(row);
        f32x4 v[4];
#pragma unroll
        for (int j = 0; j < 4; ++j) v[j] = xr[64 * j];
        if (ns > 0 && row >= MP) { const f32x4* sl = (const f32x4*)(F.ws + WS_SC) + (size_t)(row - MP) * (D / 4) + F.lane; const f32x4* gp = (const f32x4*)(MODp + (size_t)s * MODW + g_off) + F.lane;
            f32x4* hr = (f32x4*)(F.out + (size_t)row * D) + F.lane;
#pragma unroll
            for (int j = 0; j < 4; ++j) { f32x4 t = {0.f, 0.f, 0.f, 0.f}; for (int k = 0; k < ns; ++k) t += sl[(size_t)k * (1024 * D / 4) + 64 * j]; v[j] = v[j] + (gp[64 * j] * coef) * t; hr[64 * j] = v[j]; } }
        float ss = 0.f;
#pragma unroll
        for (int j = 0; j < 4; ++j) ss += (v[j].x * v[j].x + v[j].y * v[j].y) + (v[j].z * v[j].z + v[j].w * v[j].w);
        const float rstd = 1.0f / sqrtf(wave_sum(ss) * (1.0f / D) + RMS_EPS);
        const f32x4* sc = (const f32x4*)(MODp + (size_t)s * MODW + sc_off) + F.lane; const f32x4* sh = (const f32x4*)(MODp + (size_t)s * MODW + sh_off) + F.lane;
        v2u* o = (v2u*)(((bf16*)(F.ws + WS_XN)) + (size_t)row * D) + F.lane;
#pragma unroll
        for (int j = 0; j < 4; ++j) { const f32x4 a = sc[64 * j], bb = sh[64 * j]; const f32x4 r = v[j] * rstd * (a + 1.0f) + bb; float t[4] = {r.x, r.y, r.z, r.w}; o[64 * j] = pack4(t); }
    }
}
__device__ __forceinline__ void final_norm_rows(Frame& F, const InAcc& A, int ns, int g_off, float coef) {
    const float* MODp = (const float*)(F.ws + WS_MOD);
    for (int row = F.gw; row < M; row += F.NGW) {
        f32x4* xr = (f32x4*)(F.out + (size_t)row * D) + F.lane;
        f32x4 v[4];
#pragma unroll
        for (int j = 0; j < 4; ++j) v[j] = xr[64 * j];
        if (ns > 0 && row >= MP) { const int s = pg8::seq_of_row(row); const f32x4* sl = (const f32x4*)(F.ws + WS_SC) + (size_t)(row - MP) * (D / 4) + F.lane; const f32x4* gp = (const f32x4*)(MODp + (size_t)s * MODW + g_off) + F.lane;
#pragma unroll
            for (int j = 0; j < 4; ++j) { f32x4 t = {0.f, 0.f, 0.f, 0.f}; for (int k = 0; k < ns; ++k) t += sl[(size_t)k * (1024 * D / 4) + 64 * j]; v[j] = v[j] + (gp[64 * j] * coef) * t; } }
        float ss = 0.f;
#pragma unroll
        for (int j = 0; j < 4; ++j) ss += (v[j].x * v[j].x + v[j].y * v[j].y) + (v[j].z * v[j].z + v[j].w * v[j].w);
        const float rstd = 1.0f / sqrtf(wave_sum(ss) * (1.0f / D) + RMS_EPS);
        const f32x4* g = (const f32x4*)A.in[29] + F.lane;
#pragma unroll
        for (int j = 0; j < 4; ++j) xr[64 * j] = v[j] * rstd * g[64 * j];
    }
}
__device__ __forceinline__ unsigned dpp_shr1(unsigned x) { return (unsigned)__builtin_amdgcn_update_dpp(0, (int)x, 0x111, 0xf, 0xf, false); }
__device__ __forceinline__ size_t sc_off(int row, int c) { return ((size_t)((row >> 4) * 128 + (c >> 2)) * 16 + (row & 15)) * 4 + (c & 3); }
__device__ __forceinline__ void frag_item(Frame& F, const InAcc& A, int r0) {
    const int l15 = F.lane & 15, q = F.lane >> 4, row = r0 + l15, tile = r0 >> 4;
    const bf16* PB = (const bf16*)(F.ws + WS_ACT);
    const bf16* pcur = PB + ((size_t)tile * 448 * 16 + l15) * 4;
    const bool first = pg8::row_is_first(row);
    const bf16* fp = (const bf16*)(F.ws + WS_FP) + (size_t)pg8::seq_of_row(row) * 448 * 64;
    const bf16* pprv = PB + ((size_t)(tile > 0 ? tile - 1 : 0) * 448 * 16 + 15) * 4;
    const bf16* pb = first ? fp : (l15 == 0 ? pprv : pcur - 4);
    const float* mu = A.in[11];
    v2u lc[16], lp[16];
#pragma unroll
    for (int i = 0; i < 16; ++i) { const size_t o = (size_t)(384 + 8 * (i >> 1) + 2 * q + (i & 1)) * 64; lc[i] = *(const v2u*)(pcur + o); lp[i] = *(const v2u*)(pb + o); }
#pragma unroll
    for (int g = 0; g < 8; ++g) { const int col = 1536 + 32 * g + 8 * q; float cur[8], prv[8]; unpack4(lc[2 * g], cur); unpack4(lc[2 * g + 1], cur + 4); unpack4(lp[2 * g], prv); unpack4(lp[2 * g + 1], prv + 4);
        const f32x4 m0 = *(const f32x4*)(mu + col), m1 = *(const f32x4*)(mu + col + 4); const float mm[8] = {m0.x, m0.y, m0.z, m0.w, m1.x, m1.y, m1.z, m1.w};
        float t[8];
#pragma unroll
        for (int e = 0; e < 8; ++e) { const float x = cur[e] + (prv[e] - cur[e]) * mm[e]; t[e] = g < 2 ? tanh_f(x) : (g < 4 ? x : sigmoid_f(x)); }
        *(v4u*)((bf16*)(F.ws + WS_FRG) + ((size_t)((tile * 8 + g) * 4 + q) * 16 + l15) * 8) = pack8(t); }
}
__device__ __forceinline__ void prep_item(Frame& F, const InAcc& A, int r0, int h) {
    const int l15 = F.lane & 15, q = F.lane >> 4, row = r0 + l15, tile = r0 >> 4;
    const bf16* PB = (const bf16*)(F.ws + WS_ACT);
    const bf16* pcur = PB + ((size_t)tile * 448 * 16 + l15) * 4;
    const bool first = pg8::row_is_first(row);
    const bf16* fp = (const bf16*)(F.ws + WS_FP) + (size_t)pg8::seq_of_row(row) * 448 * 64;
    const bf16* pprv = PB + ((size_t)(tile > 0 ? tile - 1 : 0) * 448 * 16 + 15) * 4;
    const float* mu = A.in[11];
    v2u xc[4][3], xp[4][3];
    const bf16* pb = first ? fp : (l15 == 0 ? pprv : pcur - 4); constexpr int pmul = 64;
    bf16x8 fr[8];
#pragma unroll
    for (int g = 0; g < 8; ++g) fr[g] = *(const bf16x8*)((const bf16*)(F.ws + WS_FRG) + ((size_t)((tile * 8 + g) * 4 + q) * 16 + l15) * 8);
#pragma unroll
    for (int ntl = 0; ntl < 4; ++ntl)
#pragma unroll
        for (int sct = 0; sct < 3; ++sct) xc[ntl][sct] = *(const v2u*)(pcur + (size_t)(128 * sct + 16 * h + 4 * ntl + q) * 64);
#pragma unroll
    for (int ntl = 0; ntl < 4; ++ntl)
#pragma unroll
        for (int sct = 0; sct < 3; ++sct) xp[ntl][sct] = *(const v2u*)(pb + (size_t)(128 * sct + 16 * h + 4 * ntl + q) * pmul);
    v2u xm[4][3];
    const float* k_k = A.in[17];
    float ss = 0.f, bon = 0.f;
#pragma unroll
    for (int ntl = 0; ntl < 4; ++ntl)
#pragma unroll
        for (int sct = 0; sct < 3; ++sct) { const int col = 512 * sct + 64 * h + 16 * ntl + 4 * q; float cur[4], prv[4], x[4]; unpack4(xc[ntl][sct], cur); unpack4(xp[ntl][sct], prv);
            const f32x4 m0 = *(const f32x4*)(mu + col);
#pragma unroll
            for (int e = 0; e < 4; ++e) x[e] = cur[e] + (prv[e] - cur[e]) * m0[e];
            xm[ntl][sct] = pack4(x);
            if (sct == 1) { float xb[4]; unpack4(xm[ntl][sct], xb); const f32x4 kkv = *(const f32x4*)(k_k + 64 * h + 16 * ntl + 4 * q);
#pragma unroll
                for (int e = 0; e < 4; ++e) { const float kr = xb[e] * kkv[e]; ss += kr * kr; } } }
    __builtin_amdgcn_sched_barrier(0);
    ss += __shfl_xor(ss, 16); ss += __shfl_xor(ss, 32);
    const float inv = 1.0f / fmaxf(sqrtf(ss), 1e-12f);
    const LAS bf16x8* wl = (const LAS bf16x8*)(F.lds + RING_OFF) + F.lane;
    const LAS float* hp = (const LAS float*)(F.lds + RING_OFF + 32768);
#pragma unroll 1
    for (int ntl = 0; ntl < 4; ++ntl) {
        const int n0 = 64 * h + 16 * ntl, c0 = n0 + 4 * q;
        f32x4 aw = {0.f, 0.f, 0.f, 0.f}, aa = aw, ag = aw;
#pragma unroll
        for (int ks = 0; ks < 2; ++ks) {
            aw = __builtin_amdgcn_mfma_f32_16x16x32_bf16(wl[(2 * ntl + ks) * 64], fr[ks], aw, 0, 0, 0);
            aa = __builtin_amdgcn_mfma_f32_16x16x32_bf16(wl[(8 + 2 * ntl + ks) * 64], fr[2 + ks], aa, 0, 0, 0); }
#pragma unroll
        for (int ks = 0; ks < 4; ++ks)
            ag = __builtin_amdgcn_mfma_f32_16x16x32_bf16(wl[(16 + 4 * ntl + ks) * 64], fr[4 + ks], ag, 0, 0, 0);
        const int cl = 16 * ntl + 4 * q;
        const f32x4 w0v = *(const LAS f32x4*)(hp + cl), a0v = *(const LAS f32x4*)(hp + 64 + cl), kkv = *(const LAS f32x4*)(hp + 128 + cl), kav = *(const LAS f32x4*)(hp + 192 + cl), rkv = *(const LAS f32x4*)(hp + 256 + cl);
        float omd[4], km[4], gg[4], kk[4], bb[4], xrf[4], xkf[4]; unpack4(xm[0][0], xrf); unpack4(xm[0][1], xkf);
#pragma unroll
        for (int e = 0; e < 4; ++e) {
            const float z = -(w0v[e] + aw[e]);
            const float sp = z > 20.f ? z : __logf(1.0f + __expf(z));
            const float wlog = -sp - 0.5f;
            const float dec = __expf(-__expf(wlog));
            omd[e] = 1.0f - dec;
            const float a = sigmoid_f(a0v[e] + aa[e]);
            kk[e] = xkf[e] * kkv[e] * inv; bb[e] = kk[e] * a;
            km[e] = xkf[e] * (1.0f + (a - 1.0f) * kav[e]);
            bon += xrf[e] * km[e] * rkv[e];
            gg[e] = ag[e];
        }
        const size_t o = sc_off(row, c0);
        *(v2u*)(((bf16*)(F.ws + WS_SC)) + o) = xm[0][0]; *(v2u*)(((bf16*)(F.ws + (WS_SC + SC_STRIDE))) + o) = pack4(km); *(v2u*)(((bf16*)(F.ws + (WS_SC + 2 * SC_STRIDE))) + o) = xm[0][2];
        *(v2u*)(((bf16*)(F.ws + (WS_SC + 3 * SC_STRIDE))) + o) = pack4(kk); *(v2u*)(((bf16*)(F.ws + (WS_SC + 4 * SC_STRIDE))) + o) = pack4(bb);
        *(v2u*)(((bf16*)(F.ws + (WS_SC + 5 * SC_STRIDE))) + o) = pack4(omd); *(v2u*)(((bf16*)(F.ws + WS_G)) + o) = pack4(gg);
#pragma unroll
        for (int i = 0; i < 3; ++i)
#pragma unroll
            for (int e = 0; e < 3; ++e) xm[i][e] = xm[i + 1][e];
    }
    bon += __shfl_xor(bon, 16); bon += __shfl_xor(bon, 32);
    if (q == 0) ((float*)(F.ws + WS_BON))[(size_t)row * 8 + h] = bon;
}
__device__ __forceinline__ void prep_all(Frame& F, const InAcc& A) {
    const int w = blockIdx.x, h = w & 7; const int nslots = (F.G >> 3) * NWAVES;
    if (F.G & 7) return;
    { const bf16* WLT = (const bf16*)(F.ws + WS_WLT); const bf16* ALT = (const bf16*)(F.ws + WS_ALT); const bf16* GLT = (const bf16*)(F.ws + WS_GLT);
      LAS v4u* dst = (LAS v4u*)(F.lds + RING_OFF);
#pragma unroll
      for (int i = 0; i < 4; ++i) { const int p = F.tid + 512 * i, f = p >> 6, L = p & 63, l15 = L & 15, q = L >> 4;
          const bf16* src;
          if (f < 8) src = WLT + (size_t)(64 * h + 16 * (f >> 1) + l15) * 64 + 32 * (f & 1) + 8 * q;
          else if (f < 16) src = ALT + (size_t)(64 * h + 16 * ((f - 8) >> 1) + l15) * 64 + 32 * (f & 1) + 8 * q;
          else src = GLT + (size_t)(64 * h + 16 * ((f - 16) >> 2) + l15) * 128 + 32 * (f & 3) + 8 * q;
          dst[p] = *(const v4u*)src; }
      if (F.tid < 320) { const int a = F.tid >> 6, i = F.tid & 63; const float* src = a == 0 ? A.in[12] : a == 1 ? A.in[14] : a == 2 ? A.in[17] : a == 3 ? A.in[18] : A.in[19];
          ((LAS float*)(F.lds + RING_OFF + 32768))[F.tid] = src[64 * h + i]; }
      __syncthreads(); }
    for (int tt = (w >> 3) * NWAVES + F.wave; tt < M / 16; tt += nslots) prep_item(F, A, 16 * tt, h);
    __syncthreads();
}
__device__ __forceinline__ void lnv_rows(Frame& F, const InAcc& A) {
    for (int row = F.gw; row < M; row += F.NGW) {
        v4u* pv = (v4u*)(((bf16*)(F.ws + WS_PUV)) + (size_t)row * 1024 + 512) + F.lane;
        float x[8]; unpack8(*pv, x);
        float s = 0.f;
#pragma unroll
        for (int e = 0; e < 8; ++e) s += x[e];
        const float mean = wave_sum(s) * (1.0f / 512.0f); float qq = 0.f;
#pragma unroll
        for (int e = 0; e < 8; ++e) { x[e] -= mean; qq += x[e] * x[e]; }
        const float rstd = 1.0f / sqrtf(wave_sum(qq) * (1.0f / 512.0f) + LN_EPS);
        const f32x4 g0 = *(const f32x4*)(A.in[22] + 8 * F.lane), g1 = *(const f32x4*)(A.in[22] + 8 * F.lane + 4), b0 = *(const f32x4*)(A.in[23] + 8 * F.lane), b1 = *(const f32x4*)(A.in[23] + 8 * F.lane + 4);
        const float gg[8] = {g0.x, g0.y, g0.z, g0.w, g1.x, g1.y, g1.z, g1.w}, bb[8] = {b0.x, b0.y, b0.z, b0.w, b1.x, b1.y, b1.z, b1.w};
#pragma unroll
        for (int e = 0; e < 8; ++e) x[e] = x[e] * rstd * gg[e] + bb[e];
        *pv = pack8(x);
        if (row >= MP) { float* o = F.out + O_CVS + (size_t)(row - MP) * 512 + 8 * F.lane; *(f32x4*)o = (f32x4){x[0], x[1], x[2], x[3]}; *(f32x4*)(o + 4) = (f32x4){x[4], x[5], x[6], x[7]}; }
    }
}
template <bool SAMP> __device__ __forceinline__ void gmlp_item(Frame& F, const InAcc& A, int ci, int h) {
    const int l15 = F.lane & 15, q = F.lane >> 4;
    const int base = SAMP ? MP + 8 * ci : 128 * ci;
    const bf16* P = (const bf16*)(F.ws + WS_PUV);
    const bf16* WSB = (const bf16*)(F.ws + WS_WSB);
    const float* b_s = A.in[25];
    LAS unsigned short* tile = (LAS unsigned short*)(F.lds + RING_OFF + F.wave * 17408);
    constexpr int NIT = SAMP ? 1 : 8, NKS = SAMP ? 1 : 4;
#pragma unroll
    for (int i = 0; i < (SAMP ? 1 : 16); ++i) { const int r = 8 * i + (F.lane >> 3), c8 = (F.lane & 7) * 8;
        const v4u x = *(const v4u*)(P + (size_t)(base + r) * 1024 + 512 + h * 64 + c8);
        LAS unsigned* d = (LAS unsigned*)(tile + r * 66 + c8); d[0] = x.x; d[1] = x.y; d[2] = x.z; d[3] = x.w; }
    LDS_WAIT(); asm volatile("" ::: "memory");
#pragma unroll 1
    for (int dt = 0; dt < 4; ++dt) {
        bf16x8 vf[NKS];
#pragma unroll
        for (int ks = 0; ks < NKS; ++ks)
#pragma unroll
            for (int jj = 0; jj < 8; ++jj) { const int jr = 32 * ks + 8 * q + jj; vf[ks][jj] = (SAMP && jr >= 8) ? (short)0 : (short)tile[jr * 66 + 16 * dt + l15]; }
        const int cc = h * 64 + 16 * dt + 4 * q;
#pragma unroll
        for (int it = 0; it < NIT; ++it) {
            f32x4 acc = {0.f, 0.f, 0.f, 0.f};
#pragma unroll
            for (int ks = 0; ks < NKS; ++ks) if (ks <= (it >> 1))
                acc = __builtin_amdgcn_mfma_f32_16x16x32_bf16(vf[ks], *(const bf16x8*)(WSB + ((size_t)(h * 128 + 16 * it + l15)) * 128 + 32 * ks + 8 * q), acc, 0, 0, 0);
            const int i = 16 * it + l15;
            if (!SAMP || i < 8) { const int row = base + i; const float bs = b_s[h * 128 + i];
                float pu[4]; unpack4(*(const v2u*)(P + (size_t)row * 1024 + cc), pu);
                float o[4];
#pragma unroll
                for (int e = 0; e < 4; ++e) o[e] = pu[e] * (acc[e] + bs);
                *(v2u*)(((bf16*)(F.ws + WS_XN)) + (size_t)row * D + 512 + cc) = pack4(o); }
        }
    }
    LDS_WAIT(); asm volatile("" ::: "memory");
}
__device__ __forceinline__ float red16(float x) {
    x += __builtin_bit_cast(float, __builtin_amdgcn_update_dpp(0, __builtin_bit_cast(int, x), 0x128, 0xf, 0xf, false));
    x += __builtin_bit_cast(float, __builtin_amdgcn_update_dpp(0, __builtin_bit_cast(int, x), 0x124, 0xf, 0xf, false));
    x += __builtin_bit_cast(float, __builtin_amdgcn_update_dpp(0, __builtin_bit_cast(int, x), 0x122, 0xf, 0xf, false));
    x += __builtin_bit_cast(float, __builtin_amdgcn_update_dpp(0, __builtin_bit_cast(int, x), 0x121, 0xf, 0xf, false));
    return x;
}
typedef float f32x2 __attribute__((ext_vector_type(2)));
#define DPP_ROR(x, n) __builtin_bit_cast(float, __builtin_amdgcn_update_dpp(0, __builtin_bit_cast(int, (x)), 0x120 + (n), 0xf, 0xf, false))
__device__ __forceinline__ void red16x2(float& a, float& b) {
    a += DPP_ROR(a, 8); b += DPP_ROR(b, 8); a += DPP_ROR(a, 4); b += DPP_ROR(b, 4); a += DPP_ROR(a, 2); b += DPP_ROR(b, 2); a += DPP_ROR(a, 1); b += DPP_ROR(b, 1);
}
__device__ __forceinline__ float wkv_step(f32x4& S, const f32x4 w, const f32x4 kk, const f32x4 bb, const f32x4 k, const f32x4 r, const float vv, float& ypend) {
    f32x2 Sa = {S.x, S.y}, Sb = {S.z, S.w};
    f32x2 p = Sa * (f32x2){kk.x, kk.y}; p = Sb * (f32x2){kk.z, kk.w} + p;
    float d = p.x + p.y;
    red16x2(d, ypend);
    const f32x2 v2 = {vv, vv};
    f32x2 Ta = (f32x2){k.x, k.y} * v2, Tb = (f32x2){k.z, k.w} * v2;
    Ta = Sa * (f32x2){w.x, w.y} + Ta; Tb = Sb * (f32x2){w.z, w.w} + Tb;
    const f32x2 nd = {-d, -d};
    Sa = (f32x2){bb.x, bb.y} * nd + Ta; Sb = (f32x2){bb.z, bb.w} * nd + Tb;
    f32x2 yv = Sa * (f32x2){r.x, r.y}; yv = Sb * (f32x2){r.z, r.w} + yv;
    S = (f32x4){Sa.x, Sa.y, Sb.x, Sb.y};
    return yv.x + yv.y;
}
constexpr int TC = 32, STEP_F = 336, CHUNK_F = TC * STEP_F, LD_ITEMS = TC * 42, NCHUNK = 2048 / TC;
constexpr int YB_OFF_F = 2 * CHUNK_F;
__device__ __forceinline__ void scan_prompt_unit(Frame& F, const InAcc& A, int unit) {
    const int bh = unit >> 2, qtr = unit & 3, b = bh >> 3, h = bh & 7;
    const size_t rowbase = (size_t)b * 2048;
    LAS float* const lf = (LAS float*)(F.lds + RING_OFF);
    const int j = F.lane & 15, vloc = 4 * (F.wave & 3) + (F.lane >> 4), v = 16 * qtr + vloc;
    f32x4 S = {0.f, 0.f, 0.f, 0.f};
    v4u ld[3]; const bf16* srcp[3]; int dsto[3]; bool isw[3], act[3];
    const size_t tile0 = rowbase >> 4;
#pragma unroll
    for (int i = 0; i < 3; ++i) { const int it = F.tid + 512 * i; act[i] = it < LD_ITEMS;
        if (it < 1280) { const int a = it >> 8, ti = (it >> 7) & 1, p = it & 127;
            srcp[i] = (const bf16*)(F.ws + WS_SC) + (size_t)(a == 0 ? 5 : a == 1 ? 3 : a == 2 ? 4 : a == 3 ? 1 : 0) * (SC_STRIDE / 2) + ((tile0 + ti) * 128 + 16 * h) * 64 + p * 8;
            dsto[i] = (16 * ti + 2 * (p & 7)) * STEP_F + a * 64 + 4 * (p >> 3); isw[i] = a == 0; }
        else { const int r2 = act[i] ? it - 1280 : 0, ti = r2 >> 5, p = r2 & 31;
            srcp[i] = (const bf16*)(F.ws + WS_SC + 2 * SC_STRIDE) + ((tile0 + ti) * 128 + 16 * h + 4 * qtr) * 64 + p * 8;
            dsto[i] = (16 * ti + 2 * (p & 7)) * STEP_F + 320 + 4 * (p >> 3); isw[i] = false; } }
#define SCAN_ISSUE(c) do { _Pragma("unroll") for (int i = 0; i < 3; ++i) if (act[i]) ld[i] = *(const v4u*)(srcp[i] + (size_t)(c) * (TC / 16) * 128 * 64); } while (0)
#define SCAN_COMMIT(bufo) do { _Pragma("unroll") for (int i = 0; i < 3; ++i) if (act[i]) { float f[8]; unpack8(ld[i], f); \
        if (isw[i]) { _Pragma("unroll") for (int e = 0; e < 8; ++e) f[e] = 1.0f - f[e]; } \
        LAS float* dst = lf + (bufo) + dsto[i]; *(LAS f32x4*)dst = (f32x4){f[0], f[1], f[2], f[3]}; *(LAS f32x4*)(dst + STEP_F) = (f32x4){f[4], f[5], f[6], f[7]}; } } while (0)
#define SCAN_FLUSH(c) do { const LAS float* yb_ = lf + YB_OFF_F + ((c) & 1) * (TC * 16); float* yg_ = ((float*)(F.ws + WS_Y)) + (rowbase + (size_t)(c) * TC) * RW + h * 64 + 16 * qtr; \
        yg_[(size_t)(F.tid >> 4) * RW + (F.tid & 15)] = yb_[F.tid]; } while (0)
    SCAN_ISSUE(0); SCAN_COMMIT(0); __syncthreads();
    for (int c = 0; c < NCHUNK; ++c) {
        if (c + 1 < NCHUNK) SCAN_ISSUE(c + 1);
        if (c > 0) SCAN_FLUSH(c - 1);
        if (F.wave < 4) {
            const LAS float* bp = lf + (c & 1) * CHUNK_F + 4 * j; const LAS float* vp = lf + (c & 1) * CHUNK_F + 320 + vloc; LAS float* yb = lf + YB_OFF_F + (c & 1) * (TC * 16) + vloc;
            f32x4 w4 = *(const LAS f32x4*)(bp), kk4 = *(const LAS f32x4*)(bp + 64), bb4 = *(const LAS f32x4*)(bp + 128), k4 = *(const LAS f32x4*)(bp + 192), r4 = *(const LAS f32x4*)(bp + 256); float vv = vp[0];
            float ypend = 0.f;
#pragma unroll 8
            for (int s = 0; s < TC; ++s) {
                const int sn = (s + 1 < TC) ? s + 1 : s;
                const f32x4 w4n = *(const LAS f32x4*)(bp + sn * STEP_F), kk4n = *(const LAS f32x4*)(bp + sn * STEP_F + 64), bb4n = *(const LAS f32x4*)(bp + sn * STEP_F + 128),
                            k4n = *(const LAS f32x4*)(bp + sn * STEP_F + 192), r4n = *(const LAS f32x4*)(bp + sn * STEP_F + 256); const float vvn = vp[sn * STEP_F];
                const float yp = wkv_step(S, w4, kk4, bb4, k4, r4, vv, ypend);
                if (s > 0) yb[(s - 1) * 16] = ypend;
                ypend = yp;
                __builtin_amdgcn_sched_barrier(0);
                w4 = w4n; kk4 = kk4n; bb4 = bb4n; k4 = k4n; r4 = r4n; vv = vvn;
            }
            yb[(TC - 1) * 16] = red16(ypend);
        }
        if (c + 1 < NCHUNK) SCAN_COMMIT(((c + 1) & 1) * CHUNK_F);
        __syncthreads();
    }
    SCAN_FLUSH(NCHUNK - 1);
    __syncthreads();
#undef SCAN_ISSUE
#undef SCAN_COMMIT
#undef SCAN_FLUSH
    if (F.wave < 4) *(f32x4*)(F.out + O_WKVP + ((size_t)bh * 64 + v) * 64 + 4 * j) = S;
}
__device__ __forceinline__ void scan_sample_item(Frame& F, const InAcc& A, int it) {
    const int sbh = it >> 3, rp = it & 7, sb = sbh >> 3, h = sbh & 7, j = F.lane & 15, v0 = 8 * rp + (F.lane >> 4), v1 = v0 + 4;
    const size_t so0 = ((size_t)sbh * 64 + v0) * 64 + 4 * j, so1 = so0 + 4 * 64;
    f32x4 S0 = *(const f32x4*)(A.in[3] + so0), S1 = *(const f32x4*)(A.in[3] + so1);
    const size_t ro0 = (size_t)(MP + 8 * sb) * RW + h * 64;
    const bf16* scr = (const bf16*)(F.ws + WS_SC);
    v2u lw[8], lkk[8], lbb[8], lk[8], lr[8]; unsigned short lv0[8], lv1[8];
#pragma unroll
    for (int t = 0; t < 8; ++t) { const int row = MP + 8 * sb + t; const size_t ro = sc_off(row, h * 64 + 4 * j);
        lw[t] = *(const v2u*)(scr + 5 * (SC_STRIDE / 2) + ro); lkk[t] = *(const v2u*)(scr + 3 * (SC_STRIDE / 2) + ro); lbb[t] = *(const v2u*)(scr + 4 * (SC_STRIDE / 2) + ro);
        lk[t] = *(const v2u*)(scr + 1 * (SC_STRIDE / 2) + ro); lr[t] = *(const v2u*)(scr + ro); lv0[t] = scr[2 * (SC_STRIDE / 2) + sc_off(row, h * 64 + v0)]; lv1[t] = scr[2 * (SC_STRIDE / 2) + sc_off(row, h * 64 + v1)]; }
    float yk0 = 0.f, yk1 = 0.f;
#pragma unroll
    for (int t = 0; t < 8; ++t) {
        float w[4], kk[4], bb[4], k[4], r[4];
        unpack4(lw[t], w); unpack4(lkk[t], kk); unpack4(lbb[t], bb); unpack4(lk[t], k); unpack4(lr[t], r);
        const f32x4 w4 = {1.f - w[0], 1.f - w[1], 1.f - w[2], 1.f - w[3]}, kk4 = {kk[0], kk[1], kk[2], kk[3]}, bb4 = {bb[0], bb[1], bb[2], bb[3]}, k4 = {k[0], k[1], k[2], k[3]}, r4 = {r[0], r[1], r[2], r[3]};
        float dm0 = 0.f; const float y0 = red16(wkv_step(S0, w4, kk4, bb4, k4, r4, bf2f(lv0[t]), dm0));
        float dm1 = 0.f; const float y1 = red16(wkv_step(S1, w4, kk4, bb4, k4, r4, bf2f(lv1[t]), dm1));
        yk0 = (j == t) ? y0 : yk0; yk1 = (j == t) ? y1 : yk1;
    }
    if (j < 8) { float* yg = ((float*)(F.ws + WS_Y)) + ro0 + (size_t)j * RW; yg[v0] = yk0; yg[v1] = yk1; }
    *(f32x4*)(F.out + O_WKVS + so0) = S0; *(f32x4*)(F.out + O_WKVS + so1) = S1;
}
__device__ __forceinline__ void postscan_item(Frame& F, const InAcc& A, int r0, int h) {
    const int l15 = F.lane & 15, q = F.lane >> 4, row = r0 + l15;
    const float* Y = (const float*)(F.ws + WS_Y); const bf16* V = (const bf16*)(F.ws + WS_SC + 2 * SC_STRIDE); const bf16* G = (const bf16*)(F.ws + WS_G);
    const float* gn_w = A.in[20]; const float* gn_b = A.in[21];
    float y[4][4]; float s = 0.f;
#pragma unroll
    for (int ntl = 0; ntl < 4; ++ntl) { const f32x4 t = *(const f32x4*)(Y + (size_t)row * RW + 64 * h + 16 * ntl + 4 * q); y[ntl][0] = t.x; y[ntl][1] = t.y; y[ntl][2] = t.z; y[ntl][3] = t.w; s += (t.x + t.y) + (t.z + t.w); }
    s += __shfl_xor(s, 16); s += __shfl_xor(s, 32);
    const float mu = s * (1.0f / 64.0f); float qq = 0.f;
#pragma unroll
    for (int ntl = 0; ntl < 4; ++ntl)
#pragma unroll
        for (int e = 0; e < 4; ++e) { y[ntl][e] -= mu; qq += y[ntl][e] * y[ntl][e]; }
    qq += __shfl_xor(qq, 16); qq += __shfl_xor(qq, 32);
    const float rstd = 1.0f / sqrtf(qq * (1.0f / 64.0f) + GN_EPS);
    const float bon = ((const float*)(F.ws + WS_BON))[(size_t)row * 8 + h];
#pragma unroll
    for (int ntl = 0; ntl < 4; ++ntl) { const int c0 = 64 * h + 16 * ntl + 4 * q; const size_t o = sc_off(row, c0);
        const f32x4 gw = *(const f32x4*)(gn_w + c0), gb = *(const f32x4*)(gn_b + c0);
        float vv[4], gg[4], ov[4]; unpack4(*(const v2u*)(V + o), vv); unpack4(*(const v2u*)(G + o), gg);
#pragma unroll
        for (int e = 0; e < 4; ++e) ov[e] = (y[ntl][e] * rstd * gw[e] + gb[e] + bon * vv[e]) * gg[e];
        *(v2u*)(((bf16*)(F.ws + WS_XN)) + (size_t)row * D + c0) = pack4(ov); }
}
__device__ __forceinline__ void postscan_rows(Frame& F, const InAcc& A) { for (int it = F.gw; it < (M / 16) * 8; it += F.NGW) postscan_item(F, A, 16 * (it >> 3), it & 7); }
__global__ void __launch_bounds__(NWAVES * 64, 2) fwd_kernel(Args args) {
    extern __shared__ __attribute__((aligned(16))) unsigned char lds[];
    Frame F;
    F.lds = (LAS unsigned char*)lds;
    F.MISC = (volatile LAS unsigned*)(F.lds + MISC_OFF);
    F.tid = threadIdx.x; F.lane = F.tid & 63; F.wave = __builtin_amdgcn_readfirstlane(F.tid >> 6);
    F.G = gridDim.x; F.gw = blockIdx.x * NWAVES + F.wave; F.NGW = F.G * NWAVES;
    unsigned char* ws = args.ws;
    F.ctl = (gu32*)(ws + WS_CTL);
    F.out = args.out; F.ws = ws;
    for (int u = F.tid; u < (LDS_BYTES - LDSCTL_OFF) / 4; u += NWAVES * 64) ((LAS unsigned*)(F.lds + LDSCTL_OFF))[u] = 0u;
    __syncthreads();
    if (F.tid == 0) { LAS unsigned long long* pt = (LAS unsigned long long*)(F.lds + PTRS_OFF);
#pragma unroll
        for (int i = 0; i < 30; ++i) pt[i] = (unsigned long long)args.in[i]; }
    __syncthreads();
#if USE_PTR_TABLE
    InAcc A; A.in.t = (LAS unsigned*)(F.lds + PTRS_OFF);
#else
    InAcc A;
#pragma unroll
    for (int i = 0; i < 30; ++i) A.in[i] = args.in[i];
#endif
    XcdBarrier bar; bar.bar = (unsigned*)(F.ctl + CW_BAR); bar.x = 0; bar.st = nullptr;
    if (MK_N_LAUNCHES == 1) bar = xcd_barrier_post((unsigned*)(F.ctl + CW_BAR), F.MISC + 8);
    const int lo = args.ph_lo, hi = args.ph_hi;
#ifndef PH_MASK
#define PH_MASK 0x7fff
#endif
#define IN(k) (((PH_MASK >> (k)) & 1) && lo <= (k) && (k) < hi)
#ifndef DUP_ID
#define DUP_ID -1
#endif
#define DUPN(id) ((DUP_ID == (id)) ? 2 : 1)
#define DUPBAR(r) do { if (r) xcd_barrier(bar); } while (0)
#define SEAM(k) do { if (IN(k) && IN((k) + 1)) xcd_barrier(bar); } while (0)
    float* const H = F.out;

    if (IN(0)) for (int rep_ = 0; rep_ < DUPN(0); ++rep_) { DUPBAR(rep_); p0_prologue(F, A); } SEAM(0);
    if (IN(1)) for (int rep_ = 0; rep_ < DUPN(1); ++rep_) { DUPBAR(rep_); p1_mod(F, A); } SEAM(1);
    if (IN(2)) for (int rep_ = 0; rep_ < DUPN(2); ++rep_) { DUPBAR(rep_); norm_rows_bf16(F, A, A.in[0], A.in[1], 0, 1024, 0, 0, 0.f); } SEAM(2);
    if (IN(3)) for (int rep_ = 0; rep_ < DUPN(3); ++rep_) { DUPBAR(rep_); pg8::Gemm g{((bf16*)(F.ws + WS_XN)), ((bf16*)(F.ws + WS_GU1)), M, 2 * FF, D, D}; pg8::StaticOrder S; S.init(M, 2 * FF, D, F.G, (int)blockIdx.x); pg8::EpiSwiglu E{((bf16*)(F.ws + WS_ACT))};
        pg8::gemm_phase<pg8::EpiSwiglu, pg8::StaticOrder, PG8_ALIGN, PG8_SP2>(F.lds + RING_OFF, g, S, E); } SEAM(3);
    if (IN(4)) for (int rep_ = 0; rep_ < DUPN(4); ++rep_) { DUPBAR(rep_); pg8::Gemm g{((bf16*)(F.ws + WS_ACT)), ((bf16*)(F.ws + WS_DN1)), M, D, FF, FF}; pg8::SplitOrder S; S.init(MP, D, FF, 11, F.G, (int)blockIdx.x); pg8::EpiResid E{A.in[0], A.in[1], H, ((float*)(F.ws + WS_MOD)) + 2048, 0.5f, (float*)(F.ws + WS_SC)};
        pg8::gemm_phase<pg8::EpiResid, pg8::SplitOrder, PG8_ALIGN, PG8_SP2>(F.lds + RING_OFF, g, S, E); } SEAM(4);
    if (IN(5)) for (int rep_ = 0; rep_ < DUPN(5); ++rep_) { DUPBAR(rep_); norm_rows_bf16(F, A, H, A.in[1], 3072, 4096, 11, 2048, 0.5f); } SEAM(5);
    if (IN(6)) for (int rep_ = 0; rep_ < DUPN(6); ++rep_) { DUPBAR(rep_); pg8::Gemm g{((bf16*)(F.ws + WS_XN)), ((bf16*)(F.ws + WS_WIN)), M, PC, D, D}; pg8::StaticOrder S; S.init(M, PC, D, F.G, (int)blockIdx.x); pg8::EpiP E{((bf16*)(F.ws + WS_ACT)), ((bf16*)(F.ws + WS_PUV)), F.out + O_SHP, F.out + O_SHS};
        pg8::gemm_phase<pg8::EpiP, pg8::StaticOrder, PG8_ALIGN, PG8_SP2>(F.lds + RING_OFF, g, S, E); } SEAM(6);
    if (IN(7)) { for (int it = F.gw; it < M / 16; it += F.NGW) frag_item(F, A, 16 * it); lnv_rows(F, A); xcd_barrier(bar);
        for (int rep_ = 0; rep_ < DUPN(70); ++rep_) { DUPBAR(rep_); prep_all(F, A); } } SEAM(7);
    if (IN(8)) {
        for (int rep_ = 0; rep_ < DUPN(80); ++rep_) for (int u = blockIdx.x; u < 256; u += F.G) scan_prompt_unit(F, A, u);
        for (int rep_ = 0; rep_ < DUPN(81); ++rep_) for (int it = F.gw; it < 2048; it += F.NGW) { if (it < 1024) gmlp_item<false>(F, A, it >> 3, it & 7); else gmlp_item<true>(F, A, (it - 1024) >> 3, it & 7); }
        for (int rep_ = 0; rep_ < DUPN(82); ++rep_) for (int it = F.gw; it < 128 * 8 * 8; it += F.NGW) scan_sample_item(F, A, it);
    } SEAM(8);
    if (IN(9)) for (int rep_ = 0; rep_ < DUPN(9); ++rep_) { DUPBAR(rep_); postscan_rows(F, A); } SEAM(9);
    if (IN(10)) { pg8::Gemm g{((bf16*)(F.ws + WS_XN)), ((bf16*)(F.ws + WS_WOUT)), M, D, D, D}; pg8::SplitOrder S; S.init(MP, D, D, 4, F.G, (int)blockIdx.x); pg8::EpiResid E{H, H + (size_t)MP * D, H, ((float*)(F.ws + WS_MOD)) + 5120, 1.0f, (float*)(F.ws + WS_SC)};
        pg8::gemm_phase<pg8::EpiResid, pg8::SplitOrder, PG8_ALIGN, PG8_SP2>(F.lds + RING_OFF, g, S, E); } SEAM(10);
    if (IN(11)) for (int rep_ = 0; rep_ < DUPN(11); ++rep_) { DUPBAR(rep_); norm_rows_bf16(F, A, H, H + (size_t)MP * D, 6144, 7168, 4, 5120, 1.0f); } SEAM(11);
    if (IN(12)) { pg8::Gemm g{((bf16*)(F.ws + WS_XN)), ((bf16*)(F.ws + WS_GU2)), M, 2 * FF, D, D}; pg8::StaticOrder S; S.init(M, 2 * FF, D, F.G, (int)blockIdx.x); pg8::EpiSwiglu E{((bf16*)(F.ws + WS_ACT))};
        pg8::gemm_phase<pg8::EpiSwiglu, pg8::StaticOrder, PG8_ALIGN, PG8_SP2>(F.lds + RING_OFF, g, S, E); } SEAM(12);
    if (IN(13)) { pg8::Gemm g{((bf16*)(F.ws + WS_ACT)), ((bf16*)(F.ws + WS_DN2)), M, D, FF, FF}; pg8::SplitOrder S; S.init(MP, D, FF, 11, F.G, (int)blockIdx.x); pg8::EpiResid E{H, H + (size_t)MP * D, H, ((float*)(F.ws + WS_MOD)) + 8192, 0.5f, (float*)(F.ws + WS_SC)};
        pg8::gemm_phase<pg8::EpiResid, pg8::SplitOrder, PG8_ALIGN, PG8_SP2>(F.lds + RING_OFF, g, S, E); } SEAM(13);
    if (IN(14)) { final_norm_rows(F, A, 11, 8192, 0.5f); }
#undef IN
#undef SEAM
}

extern "C" void kernel_launch(void* const* d_in, const int* in_sizes, int n_in, void* d_out, int out_size, void* d_ws, size_t ws_size, hipStream_t stream) {
    static int grid = 0;
    if (grid == 0) {
        if (n_in != 30 || in_sizes[0] != MP * D || (size_t)out_size != O_END || ws_size < WS_END) { fprintf(stderr, "kernel_launch: unexpected problem shape / workspace (%d inputs, out %d, ws %zu); nothing launched\n", n_in, out_size, ws_size); grid = -1; return; }
        int dev = 0, cus = 0, per_cu = 0;
        if (hipGetDevice(&dev) != hipSuccess || hipDeviceGetAttribute(&cus, hipDeviceAttributeMultiprocessorCount, dev) != hipSuccess) { grid = -1; return; }
        if (hipFuncSetAttribute((const void*)fwd_kernel, hipFuncAttributeMaxDynamicSharedMemorySize, LDS_BYTES) != hipSuccess) { fprintf(stderr, "kernel_launch: hipFuncSetAttribute failed\n"); grid = -1; return; }
        if (hipOccupancyMaxActiveBlocksPerMultiprocessor(&per_cu, (const void*)fwd_kernel, NWAVES * 64, LDS_BYTES) != hipSuccess || per_cu < 1) { fprintf(stderr, "kernel_launch: occupancy query says %d blocks per CU\n", per_cu); }
        (void)hipGetLastError();
        grid = cus;
    }
    if (grid < 0) return;
    (void)hipMemsetAsync((char*)d_ws + WS_CTL, 0, CTL_ZERO_BYTES, stream);
    Args a{};
    for (int i = 0; i < 30; ++i) a.in[i] = (const float*)d_in[i];
    a.out = (float*)d_out; a.ws = (unsigned char*)d_ws;
    if (MK_N_LAUNCHES == 1) { a.ph_lo = 0; a.ph_hi = N_PHASES; hipLaunchKernelGGL(fwd_kernel, dim3(grid), dim3(NWAVES * 64), LDS_BYTES, stream, a); }
    else for (int p = 0; p < N_PHASES; ++p) { a.ph_lo = p; a.ph_hi = p + 1; hipLaunchKernelGGL(fwd_kernel, dim3(grid), dim3(NWAVES * 64), LDS_BYTES, stream, a); }
}
```

```cpp
#include <hip/hip_runtime.h>
#include <cstdio>
#include <cstdint>
namespace pg8 {
#define PG8_LAS __attribute__((address_space(3)))
typedef unsigned short bf16_t;
typedef short bf16x8 __attribute__((ext_vector_type(8)));
typedef float f32x4 __attribute__((ext_vector_type(4)));
typedef unsigned u32x4 __attribute__((ext_vector_type(4)));
constexpr int BM = 256, BK = 64, HALF = 128, HTB = HALF * BK * 2  , STAGE_BYTES = 8 * HTB, NXCD = 8, WGM = 8;

__host__ __device__ __forceinline__ int lds_byte(int r, int c) { const int st = (r >> 4) * 2 + (c >> 5), rr = r & 15, cc = c & 31, ob = rr * 64 + cc * 2; return st * 1024 + (ob ^ (((ob >> 9) & 1) << 5)); }
__host__ __device__ __forceinline__ void stage_rc(int b, int& R, int& C) { const int st = b / 1024, sb = b % 1024, swz = sb ^ (((sb >> 9) & 1) << 5); R = (st >> 1) * 16 + swz / 64; C = (st & 1) * 32 + (swz % 64) / 2; }
__host__ __device__ __forceinline__ int perm32(int rho) { const int n = rho >> 4, i = rho & 15; return 8 * (i >> 2) + 4 * n + (i & 3); }

struct Unit { int pm, pn, kb, nt, ks; };
struct Gemm { const bf16_t* A; const bf16_t* Bt; int M, N, K, ld; };

struct StaticOrder {
    int nM, nN, nwg, G, c, knt;
    __host__ __device__ void init(int M, int N, int K, int G_, int c_) { nM = M / BM; nN = N / BM; nwg = nM * nN; G = G_; c = c_; knt = K / BK; }
    __host__ __device__ __forceinline__ bool next(int i, Unit& u) const {
        const long L = (long)i * G + c; if (L >= nwg) return false;
        int wgid = (int)L; { const int q = nwg / NXCD, r = nwg % NXCD, xcd = wgid % NXCD, off = wgid / NXCD; wgid = (xcd < r ? xcd * (q + 1) : r * (q + 1) + (xcd - r) * q) + off; }
        const int nig = WGM * nN, gid = wgid / nig, fm = gid * WGM, gsz = (nM - fm) < WGM ? (nM - fm) : WGM;
        u.pm = fm + ((wgid % nig) % gsz); u.pn = (wgid % nig) / gsz; u.kb = 0; u.nt = knt; u.ks = -1; return true;
    }
    __device__ __forceinline__ void a_ready(const Unit&) const {}
    __device__ __forceinline__ void done(const Unit&) const {}
};
struct SplitOrder {
    StaticOrder so; int ns, c, G;
    __host__ __device__ void init(int Mmain, int N, int K, int ns_, int G_, int c_) { so.init(Mmain, N, K, G_, c_); ns = ns_; c = c_; G = G_; }
    __host__ __device__ __forceinline__ bool next(int i, Unit& u) const {
        const int nsub = 16 * ns, mine = c < nsub ? (nsub - 1 - c) / G + 1 : 0;
        const bool sub = i < mine; const int s = c + i * G;
        Unit m; m.pm = 0; m.pn = 0; m.kb = 0; m.nt = so.knt; m.ks = -1;
        const bool okm = so.next(sub ? 0 : i - mine, m);
        u.pm = sub ? so.nM + s / (4 * ns) : m.pm; u.pn = sub ? ((s / ns) & 3) : m.pn; u.ks = sub ? s % ns : -1; u.kb = sub ? (s % ns) * 4 * BK * 2 : 0; u.nt = sub ? 4 : so.knt;
        return sub || okm;
    }
    __device__ __forceinline__ void a_ready(const Unit&) const {}
    __device__ __forceinline__ void done(const Unit&) const {}
};
__device__ __forceinline__ unsigned cvt_pk_bf16(float lo, float hi) { unsigned r; asm volatile("v_cvt_pk_bf16_f32 %0, %1, %2" : "=v"(r) : "v"(lo), "v"(hi)); return r; }
typedef float f32x2 __attribute__((ext_vector_type(2)));
constexpr int ROWS_P = 16384, ROWS_ALL = 17408, DM = 1024, MODW = 9216, FFW = 2816, RCOLS = 1792;
__device__ __forceinline__ int seq_of_row(int r) { return r < ROWS_P ? (r >> 11) : 8 + ((r - ROWS_P) >> 3); }
__device__ __forceinline__ bool row_is_first(int r) { return r < ROWS_P ? ((r & 2047) == 0) : (((r - ROWS_P) & 7) == 0); }
__device__ __forceinline__ bool row_is_last(int r) { return r < ROWS_P ? ((r & 2047) == 2047) : (((r - ROWS_P) & 7) == 7); }
__device__ __forceinline__ float silu_f(float x) { return x * __builtin_amdgcn_rcpf(1.0f + __builtin_amdgcn_exp2f(-1.4426950408889634f * x)); }

struct EpiSwiglu {
    static constexpr bool PERM = true, AFTER_DRAIN = false;
    bf16_t* O;
    __device__ __forceinline__ void operator()(const f32x4 (&acc)[2][2][4][2], const Unit& u, int wr, int wc, int fr, int fq) const {
        const int row0 = u.pm * BM + wr * 64 + fr, col0 = u.pn * HALF + wc * 32 + 8 * fq;
#pragma unroll
        for (int ai = 0; ai < 2; ++ai)
#pragma unroll
            for (int m = 0; m < 4; ++m) {
                bf16_t* rowp = O + (size_t)(row0 + ai * HALF + m * 16) * FFW + col0;
                const f32x4 g0 = acc[ai][0][m][0], g1 = acc[ai][0][m][1], u0 = acc[ai][1][m][0], u1 = acc[ai][1][m][1];
                u32x4 w;
                w.x = cvt_pk_bf16(silu_f(g0[0]) * u0[0], silu_f(g0[1]) * u0[1]); w.y = cvt_pk_bf16(silu_f(g0[2]) * u0[2], silu_f(g0[3]) * u0[3]);
                w.z = cvt_pk_bf16(silu_f(g1[0]) * u1[0], silu_f(g1[1]) * u1[1]); w.w = cvt_pk_bf16(silu_f(g1[2]) * u1[2], silu_f(g1[3]) * u1[3]);
                *(u32x4*)rowp = w;
            }
    }
};
struct EpiResid {
    static constexpr bool PERM = false, AFTER_DRAIN = false;
    const float* resP; const float* resS; float* out; const float* gate; float coef; float* slab;
    __device__ __forceinline__ void operator()(const f32x4 (&acc)[2][2][4][2], const Unit& u, int wr, int wc, int fr, int fq) const {
        const int col0 = u.pn * BM + wc * 32 + 4 * fq;
        if (u.ks >= 0) {
#pragma unroll
            for (int ai = 0; ai < 2; ++ai)
#pragma unroll
                for (int m = 0; m < 4; ++m) { float* srow = slab + ((size_t)u.ks * 1024 + (size_t)(u.pm * BM + ai * HALF + wr * 64 + m * 16 + fr - ROWS_P)) * DM + col0;
#pragma unroll
                    for (int bj = 0; bj < 2; ++bj)
#pragma unroll
                        for (int n = 0; n < 2; ++n) *(f32x4*)(srow + bj * HALF + n * 16) = acc[ai][bj][m][n]; }
            return; }
#pragma unroll
        for (int ai = 0; ai < 2; ++ai)
#pragma unroll
            for (int m = 0; m < 4; ++m) {
                const int row = u.pm * BM + ai * HALF + wr * 64 + m * 16 + fr; const int s = seq_of_row(row);
                const float* rrow = (row < ROWS_P ? resP + (size_t)row * DM : resS + (size_t)(row - ROWS_P) * DM) + col0;
                float* orow = out + (size_t)row * DM + col0; const float* grow = gate + (size_t)s * MODW + col0;
#pragma unroll
                for (int bj = 0; bj < 2; ++bj)
#pragma unroll
                    for (int n = 0; n < 2; ++n) { const int off = bj * HALF + n * 16; const f32x4 r = *(const f32x4*)(rrow + off), g = *(const f32x4*)(grow + off);
                        *(f32x4*)(orow + off) = r + (g * coef) * acc[ai][bj][m][n]; }
            }
    }
};
struct EpiP {
    static constexpr bool PERM = true, AFTER_DRAIN = false;
    bf16_t* PB; bf16_t* PUV; float* shp; float* shs;
    __device__ __forceinline__ void operator()(const f32x4 (&acc)[2][2][4][2], const Unit& u, int wr, int wc, int fr, int fq) const {
        typedef unsigned u32x2 __attribute__((ext_vector_type(2)));
        const int row0 = u.pm * BM + wr * 64 + fr, col0 = u.pn * BM + wc * 32 + 8 * fq;
#pragma unroll
        for (int ai = 0; ai < 2; ++ai)
#pragma unroll
            for (int m = 0; m < 4; ++m) {
                const int row = row0 + ai * HALF + m * 16; const bool last = row_is_last(row);
#pragma unroll
                for (int bj = 0; bj < 2; ++bj) { const f32x4 v0 = acc[ai][bj][m][0], v1 = acc[ai][bj][m][1]; const int col = col0 + bj * HALF;
                    u32x4 w; w.x = cvt_pk_bf16(v0[0], v0[1]); w.y = cvt_pk_bf16(v0[2], v0[3]); w.z = cvt_pk_bf16(v1[0], v1[1]); w.w = cvt_pk_bf16(v1[2], v1[3]);
                    if (u.pn < 7) { bf16_t* p = PB + ((size_t)((row >> 4) * 448 + (col >> 2)) * 16 + (row & 15)) * 4; *(u32x2*)p = (u32x2){w.x, w.y}; *(u32x2*)(p + 64) = (u32x2){w.z, w.w};
                        if (last) { float* o = (row < ROWS_P ? shp + (size_t)(row >> 11) * RCOLS : shs + (size_t)((row - ROWS_P) >> 3) * RCOLS) + col; *(f32x4*)o = v0; *(f32x4*)(o + 4) = v1; } }
                    else *(u32x4*)(PUV + (size_t)row * 1024 + (col - RCOLS)) = w; }
            }
    }
};
template <class Epi, class Sched, bool ALIGN_EPI = false, bool SP2 = false>
__device__ __forceinline__ void gemm_phase(PG8_LAS unsigned char* lds, const Gemm g, const Sched& S, const Epi& E) {
    const int tid = threadIdx.x, wid = __builtin_amdgcn_readfirstlane(tid >> 6), lane = tid & 63, wr = wid >> 2, wc = wid & 3, fr = lane & 15, fq = lane >> 4;
    const int K = g.ld;
    unsigned voffA[2], voffB[2];
#pragma unroll
    for (int i = 0; i < 2; ++i) { int R, C; stage_rc(tid * 16 + i * 8192, R, C); const int Rb = Epi::PERM ? ((R & ~31) + perm32(R & 31)) : R;
        voffA[i] = (unsigned)(R * K + C) * 2u; voffB[i] = (unsigned)(Rb * K + C) * 2u; }
    const size_t kstep = (size_t)(BK * 2);
    const size_t hstep = (size_t)HALF * K * 2;
    const size_t tstep = 2 * hstep;
    const unsigned ldsw = (unsigned)wid * 1024u;
    const int aoff = lds_byte(wr * 64 + fr, fq * 8), boff = lds_byte(wc * 32 + fr, fq * 8);
#define PG8_SA(b, h) (((b) * 2 + (h)) * HTB)
#define PG8_SB(b, h) ((4 + (b) * 2 + (h)) * HTB)
#define PG8_STAGE(bufoff, gbase, voff) do { _Pragma("unroll") for (int _i = 0; _i < 2; ++_i) \
        __builtin_amdgcn_global_load_lds((const unsigned*)((const char*)(gbase) + (voff)[_i]), (PG8_LAS unsigned*)(lds + (bufoff) + ldsw + _i * 8192), 16, 0, 0); } while (0)
#define PG8_LDA(dst, b, h) do { _Pragma("unroll") for (int m = 0; m < 4; ++m) _Pragma("unroll") for (int k = 0; k < 2; ++k) dst[m][k] = *(const PG8_LAS bf16x8*)(lds + PG8_SA(b, h) + aoff + m * 2048 + k * 1024); } while (0)
#define PG8_LDB(dst, b, h) do { _Pragma("unroll") for (int n = 0; n < 2; ++n) _Pragma("unroll") for (int k = 0; k < 2; ++k) dst[n][k] = *(const PG8_LAS bf16x8*)(lds + PG8_SB(b, h) + boff + n * 2048 + k * 1024); } while (0)
#define PG8_MMA(ai, bj, At, Bt) do { __builtin_amdgcn_s_setprio(1); _Pragma("unroll") for (int m = 0; m < 4; ++m) _Pragma("unroll") for (int n = 0; n < 2; ++n) _Pragma("unroll") for (int k = 0; k < 2; ++k) \
        acc[ai][bj][m][n] = __builtin_amdgcn_mfma_f32_16x16x32_bf16(Bt[n][k], At[m][k], acc[ai][bj][m][n], 0, 0, 0); __builtin_amdgcn_s_setprio(0); } while (0)
#define PG8_WAIT_V(n) asm volatile("s_waitcnt vmcnt(" #n ")" ::: "memory")
#define PG8_WAIT_L(n) asm volatile("s_waitcnt lgkmcnt(" #n ")" ::: "memory")
#define PG8_BAR __builtin_amdgcn_s_barrier()
#define PG8_SCHED __builtin_amdgcn_sched_barrier(0)
    Unit cur, nxt; int ui = 0;
    if (!S.next(0, cur)) return;
    f32x4 acc[2][2][4][2];
#pragma unroll
    for (int a = 0; a < 2; ++a)
#pragma unroll
        for (int b = 0; b < 2; ++b)
#pragma unroll
            for (int m = 0; m < 4; ++m)
#pragma unroll
                for (int n = 0; n < 2; ++n) acc[a][b][m][n] = (f32x4){0.f, 0.f, 0.f, 0.f};
    bf16x8 At[4][2], B0[2][2], B1[2][2];
    const char* cA = (const char*)g.A + (size_t)cur.pm * tstep + cur.kb; const char* cB = (const char*)g.Bt + (size_t)cur.pn * tstep + cur.kb;
    S.a_ready(cur);
    if constexpr (SP2) {
        PG8_STAGE(PG8_SB(0, 0), cB, voffB); PG8_STAGE(PG8_SB(0, 1), cB + hstep, voffB); PG8_STAGE(PG8_SA(0, 0), cA, voffA); PG8_STAGE(PG8_SA(0, 1), cA + hstep, voffA);
        if (wr == 1) PG8_BAR;
        PG8_WAIT_V(2); PG8_BAR;
        PG8_STAGE(PG8_SB(1, 0), cB + kstep, voffB); PG8_STAGE(PG8_SA(1, 0), cA + kstep, voffA); PG8_STAGE(PG8_SB(1, 1), cB + hstep + kstep, voffB);
        PG8_WAIT_V(6); PG8_BAR;
    } else {
        PG8_STAGE(PG8_SB(0, 0), cB, voffB); PG8_STAGE(PG8_SA(0, 0), cA, voffA); PG8_STAGE(PG8_SB(0, 1), cB + hstep, voffB); PG8_STAGE(PG8_SA(0, 1), cA + hstep, voffA);
        if (wr == 1) PG8_BAR;
        PG8_WAIT_V(4); PG8_BAR;
        PG8_STAGE(PG8_SB(1, 0), cB + kstep, voffB); PG8_STAGE(PG8_SA(1, 0), cA + kstep, voffA); PG8_STAGE(PG8_SB(1, 1), cB + hstep + kstep, voffB);
        PG8_WAIT_V(6); PG8_BAR;
    }
    for (;;) {
        const bool has_next = S.next(ui + 1, nxt);
        const char* nA = has_next ? (const char*)g.A + (size_t)nxt.pm * tstep + nxt.kb : cA; const char* nB = has_next ? (const char*)g.Bt + (size_t)nxt.pn * tstep + nxt.kb : cB;
        const int nt = cur.nt;
        for (int t = 0; t < nt; t += 2) {
            const bool last = (t == nt - 2);
            const char* a1 = cA + (size_t)(t + 1) * kstep;
            const char* a2 = last ? nA : cA + (size_t)(t + 2) * kstep; const char* b2 = last ? nB : cB + (size_t)(t + 2) * kstep;
            const char* a3 = a2 + kstep; const char* b3 = b2 + kstep;
            if (last && has_next) S.a_ready(nxt);
            if constexpr (SP2) {
            PG8_LDB(B0, 0, 0); PG8_LDB(B1, 0, 1); PG8_SCHED; PG8_LDA(At, 0, 0); PG8_STAGE(PG8_SA(1, 1), a1 + hstep, voffA);
            PG8_WAIT_V(8); PG8_WAIT_L(0); PG8_BAR; PG8_MMA(0, 0, At, B0); PG8_MMA(0, 1, At, B1); PG8_BAR; PG8_SCHED;
            PG8_LDA(At, 0, 1); PG8_STAGE(PG8_SB(0, 0), b2, voffB); PG8_STAGE(PG8_SB(0, 1), b2 + hstep, voffB); PG8_STAGE(PG8_SA(0, 0), a2, voffA);
            PG8_WAIT_V(8); PG8_WAIT_L(0); PG8_BAR; PG8_MMA(1, 0, At, B0); PG8_MMA(1, 1, At, B1); PG8_BAR; PG8_SCHED;
            PG8_LDB(B0, 1, 0); PG8_LDB(B1, 1, 1); PG8_SCHED; PG8_LDA(At, 1, 0); PG8_STAGE(PG8_SA(0, 1), a2 + hstep, voffA);
            PG8_WAIT_V(8); PG8_WAIT_L(0); PG8_BAR; PG8_MMA(0, 0, At, B0); PG8_MMA(0, 1, At, B1); PG8_BAR; PG8_SCHED;
            PG8_LDA(At, 1, 1); PG8_STAGE(PG8_SB(1, 0), b3, voffB); PG8_STAGE(PG8_SB(1, 1), b3 + hstep, voffB); PG8_STAGE(PG8_SA(1, 0), a3, voffA);
            PG8_WAIT_V(8); PG8_WAIT_L(0); PG8_BAR; PG8_MMA(1, 0, At, B0); PG8_MMA(1, 1, At, B1); PG8_BAR; PG8_SCHED;
            } else {
            PG8_LDB(B0, 0, 0); PG8_SCHED; PG8_LDA(At, 0, 0); PG8_STAGE(PG8_SA(1, 1), a1 + hstep, voffA);
            PG8_WAIT_L(8); PG8_BAR; PG8_WAIT_L(0); PG8_MMA(0, 0, At, B0); PG8_BAR; PG8_SCHED;
            PG8_LDB(B1, 0, 1); PG8_STAGE(PG8_SB(0, 0), b2, voffB);
            PG8_BAR; PG8_WAIT_L(0); PG8_MMA(0, 1, At, B1); PG8_BAR;
            PG8_LDA(At, 0, 1); PG8_STAGE(PG8_SA(0, 0), a2, voffA);
            PG8_BAR; PG8_WAIT_L(0); PG8_MMA(1, 0, At, B0); PG8_BAR; PG8_SCHED;
            PG8_STAGE(PG8_SB(0, 1), b2 + hstep, voffB);
            PG8_WAIT_V(6); PG8_BAR; PG8_MMA(1, 1, At, B1); PG8_BAR;
            PG8_LDB(B0, 1, 0); PG8_SCHED; PG8_LDA(At, 1, 0); PG8_STAGE(PG8_SA(0, 1), a2 + hstep, voffA);
            PG8_WAIT_L(8); PG8_BAR; PG8_WAIT_L(0); PG8_MMA(0, 0, At, B0); PG8_BAR; PG8_SCHED;
            PG8_LDB(B1, 1, 1); PG8_STAGE(PG8_SB(1, 0), b3, voffB);
            PG8_BAR; PG8_WAIT_L(0); PG8_MMA(0, 1, At, B1); PG8_BAR;
            PG8_LDA(At, 1, 1); PG8_STAGE(PG8_SA(1, 0), a3, voffA);
            PG8_BAR; PG8_WAIT_L(0); PG8_MMA(1, 0, At, B0); PG8_BAR; PG8_SCHED;
            PG8_STAGE(PG8_SB(1, 1), b3 + hstep, voffB);
            PG8_WAIT_V(6); PG8_BAR; PG8_MMA(1, 1, At, B1); PG8_BAR;
            }
        }
        if constexpr (ALIGN_EPI) { if (wr == 0) PG8_BAR; }
        if constexpr (!Epi::AFTER_DRAIN) { E(acc, cur, wr, wc, fr, fq); S.done(cur); }
        if (!has_next) break;
#pragma unroll
        for (int a = 0; a < 2; ++a)
#pragma unroll
            for (int b = 0; b < 2; ++b)
#pragma unroll
                for (int m = 0; m < 4; ++m)
#pragma unroll
                    for (int n = 0; n < 2; ++n) acc[a][b][m][n] = (f32x4){0.f, 0.f, 0.f, 0.f};
        cur = nxt; cA = nA; cB = nB; ++ui;
        if constexpr (ALIGN_EPI) { if (wr == 1) PG8_BAR; }
    }
    PG8_WAIT_V(0);
    if constexpr (!ALIGN_EPI) { if (wr == 0) PG8_BAR; }
    PG8_BAR;
    if constexpr (Epi::AFTER_DRAIN) { E.fused(acc, cur, wr, wc, fr, fq, lds, wid, lane); S.done(cur); }
#undef PG8_SA
#undef PG8_SB
#undef PG8_STAGE
#undef PG8_LDA
#undef PG8_LDB
#undef PG8_MMA
#undef PG8_WAIT_V
#undef PG8_WAIT_L
#undef PG8_BAR
#undef PG8_SCHED
}
}
#ifndef PG8_SP2
#define PG8_SP2 true
#endif
#ifndef PG8_ALIGN
#define PG8_ALIGN true
#endif
#ifndef MK_N_LAUNCHES
#define MK_N_LAUNCHES 1
#endif
constexpr int NWAVES = 8;
constexpr int N_PHASES = 15;
constexpr int D = 1024, MP = 16384, MS = 1024, M = MP + MS, NSEQ = 136, FF = 2816, RC = 1792, PC = 2816, RW = 512, MODW = 9216;
constexpr float RMS_EPS = 1e-6f, LN_EPS = 1e-5f, GN_EPS = 64e-5f;
constexpr size_t O_Y = 0, O_SHP = 17825792, O_WKVP = 17840128, O_SHS = 18102272, O_WKVS = 18331648, O_CVS = 22525952, O_END = 23050240;
constexpr size_t MiB = 1u << 20;
constexpr size_t WS_CTL = 0, CTL_ZERO_BYTES = 1 * MiB;
constexpr size_t WS_GU1 = 1 * MiB, WS_DN1 = 12 * MiB, WS_WIN = 18 * MiB, WS_WOUT = 24 * MiB, WS_GU2 = 26 * MiB, WS_DN2 = 37 * MiB;
constexpr size_t WS_SMALL = 43 * MiB;
constexpr size_t WS_WLT = WS_SMALL, WS_ALT = WS_SMALL + 65536, WS_GLT = WS_SMALL + 131072, WS_WSB = WS_SMALL + 262144, WS_SILUC = WS_SMALL + 524288;
constexpr size_t WS_MOD = 44 * MiB;
constexpr size_t WS_BON = 49 * MiB;
constexpr size_t WS_FP = 331 * MiB;
constexpr size_t WS_XN = 50 * MiB;
constexpr size_t WS_ACT = 84 * MiB;
constexpr size_t WS_PUV = WS_ACT + 60 * MiB;
static_assert((size_t)M * 1792 * 2 <= 60 * MiB && WS_PUV + (size_t)M * 1024 * 2 <= 178 * MiB, "ws map puv");
constexpr size_t WS_SC = 178 * MiB, SC_STRIDE = 17 * MiB;
constexpr size_t WS_G = 280 * MiB;
constexpr size_t WS_Y = 297 * MiB;
constexpr size_t WS_FRG = 339 * MiB;
constexpr size_t WS_END = 348 * MiB;
static_assert(WS_FRG + (size_t)M * 256 * 2 <= WS_END, "ws map frg");
static_assert(WS_FP + (size_t)136 * 448 * 64 * 2 <= WS_END, "ws map fp");
static_assert(WS_DN1 - WS_GU1 >= (size_t)5632 * 1024 * 2 && WS_WIN - WS_DN1 >= (size_t)1024 * 2816 * 2 && WS_WOUT - WS_WIN >= (size_t)2816 * 1024 * 2 && WS_GU2 - WS_WOUT >= (size_t)1024 * 1024 * 2, "ws map a");
static_assert(WS_DN2 - WS_GU2 >= (size_t)5632 * 1024 * 2 && WS_SMALL - WS_DN2 >= (size_t)1024 * 2816 * 2 && WS_BON - WS_MOD >= (size_t)136 * 9216 * 4 && WS_XN - WS_BON >= (size_t)M * 8 * 4, "ws map b");
static_assert(WS_ACT - WS_XN >= (size_t)M * 1024 * 2 && WS_SC - WS_ACT >= (size_t)M * 2816 * 2 && SC_STRIDE >= (size_t)M * 512 * 2 && WS_G - WS_SC >= 6 * SC_STRIDE && WS_Y - WS_G >= (size_t)M * 512 * 2 && WS_END - WS_Y >= (size_t)M * 512 * 4, "ws map c");
constexpr int CW_TMO = 0, CW_CODE = 1, CW_BAR = 4096;
constexpr int RING_OFF = 0, RING_BYTES = 139264;
constexpr int LDSCTL_OFF = RING_BYTES, MISC_OFF = LDSCTL_OFF + 320;
constexpr int LDS_BYTES = 147456;
struct Args { const float* in[30]; float* out; unsigned char* ws; int ph_lo, ph_hi; };
constexpr int PTRS_OFF = MISC_OFF + 128;
#ifndef USE_PTR_TABLE
#define USE_PTR_TABLE 1
#endif
#if !USE_PTR_TABLE
struct InAcc { const float* in[30]; };
#else
struct InPtrs { __attribute__((address_space(3))) unsigned* t;
    __device__ __forceinline__ const float* operator[](int i) const { const unsigned lo = __builtin_amdgcn_readfirstlane(t[2 * i]), hi = __builtin_amdgcn_readfirstlane(t[2 * i + 1]); return (const float*)(const __attribute__((address_space(1))) float*)(((unsigned long long)hi << 32) | lo); } };
struct InAcc { InPtrs in; };
#endif
#define GAS __attribute__((address_space(1)))
#define LAS __attribute__((address_space(3)))
typedef unsigned short bf16;
typedef unsigned v4u __attribute__((ext_vector_type(4)));
typedef float f32x4 __attribute__((ext_vector_type(4)));
typedef short bf16x8 __attribute__((ext_vector_type(8)));
typedef GAS unsigned gu32;
typedef GAS unsigned long long gu64;
#define RLX_AGENT __ATOMIC_RELAXED, __HIP_MEMORY_SCOPE_AGENT
#define LDS_WAIT() asm volatile("s_waitcnt lgkmcnt(0)" ::: "memory")
#define VM_WAIT() asm volatile("s_waitcnt vmcnt(0)" ::: "memory")
__device__ __forceinline__ unsigned long long rt() { return __builtin_amdgcn_s_memrealtime(); }
__device__ __forceinline__ unsigned f2bf(float f) { unsigned u = __builtin_bit_cast(unsigned, f); return (u + 0x7fffu + ((u >> 16) & 1u)) >> 16; }
__device__ __forceinline__ unsigned pk2(float lo, float hi) { return f2bf(lo) | (f2bf(hi) << 16); }
#define XB_TMO      128
#define XB_XCNT(j)  (256  + 64 * (j))
#define XB_XSUB(j)  (1280 + 64 * (j))
#define XB_XGEN(j)  (2304 + 64 * (j))
#define XB_TOP      3328
#define XB_TOPGEN   3392
#define XCD_BAR_WORDS 3456
#define XB_SPIN_CAP (1u << 18)

__device__ __forceinline__ unsigned xb_ld(unsigned* p)              { return __hip_atomic_load(p, __ATOMIC_RELAXED, __HIP_MEMORY_SCOPE_AGENT); }
__device__ __forceinline__ unsigned xb_add(unsigned* p, unsigned v) { return __hip_atomic_fetch_add(p, v, __ATOMIC_RELAXED, __HIP_MEMORY_SCOPE_AGENT); }
__device__ __forceinline__ unsigned xb_xcc_id() { return (unsigned)__builtin_amdgcn_s_getreg((3 << 11) | 20) & 0xFu; }
#define XB_SPIN(cond, bar) do { unsigned _sp = 0; while (cond) { __builtin_amdgcn_s_sleep(1); \
    if ((++_sp & 255u) == 0u) { if (xb_ld(&(bar)[XB_TMO])) break; if (_sp > XB_SPIN_CAP) { atomicAdd(&(bar)[XB_TMO], 1u); break; } } } } while (0)

struct XcdBarrier {
    unsigned* bar; unsigned x;
    volatile LAS unsigned* st;
};

__device__ __forceinline__ XcdBarrier xcd_barrier_post(unsigned* bar, volatile LAS unsigned* st) {
    XcdBarrier b; b.bar = bar; b.x = xb_xcc_id(); b.st = st;
    if (threadIdx.x == 0) (void)xb_add(&bar[XB_XCNT(b.x)], 1u);
    return b;
}
__device__ __forceinline__ void xcd_barrier_complete(unsigned* bar, unsigned x, unsigned& nloc, unsigned& nx) {
    const unsigned G = gridDim.x * gridDim.y * gridDim.z;
    unsigned sum, cnt, mine, sp = 0u;
    for (;;) {
        sum = 0u; cnt = 0u; mine = 0u;
#pragma unroll
        for (unsigned j = 0; j < 16; ++j) { const unsigned c = xb_ld(&bar[XB_XCNT(j)]); sum += c; cnt += (c > 0u) ? 1u : 0u; mine = (j == x) ? c : mine; }
        if (sum == G) break;
        __builtin_amdgcn_s_sleep(1);
        if ((++sp & 255u) == 0u) { if (xb_ld(&bar[XB_TMO])) break; if (sp > XB_SPIN_CAP) { atomicAdd(&bar[XB_TMO], 1u); break; } }
    }
    nloc = mine > 0u ? mine : 1u; nx = cnt > 0u ? cnt : 1u;
}

__device__ __forceinline__ void xcd_barrier(const XcdBarrier& b) {
    asm volatile("s_waitcnt vmcnt(0)" ::: "memory");
    __syncthreads();
    if (threadIdx.x == 0) {
        unsigned* bar = b.bar;
        __builtin_amdgcn_s_waitcnt(0);
        unsigned nloc = b.st[0], nx = b.st[1];
        if (nloc == 0u) { xcd_barrier_complete(bar, b.x, nloc, nx); b.st[0] = nloc; b.st[1] = nx; }
        const unsigned old = xb_add(&bar[XB_XSUB(b.x)], 1u);
        const unsigned gen = old / nloc;
        if (old + 1u == (gen + 1u) * nloc) {
            __builtin_amdgcn_fence(__ATOMIC_RELEASE, "agent");
            asm volatile("s_waitcnt vmcnt(0)" ::: "memory");
            const unsigned og = xb_add(&bar[XB_TOP], 1u);
            const unsigned tg = og / nx;
            if (og + 1u == (tg + 1u) * nx) xb_add(&bar[XB_TOPGEN], 1u);
            else XB_SPIN(xb_ld(&bar[XB_TOPGEN]) == tg, bar);
            __builtin_amdgcn_fence(__ATOMIC_ACQUIRE, "agent");
            xb_add(&bar[XB_XGEN(b.x)], 1u);
            asm volatile("s_waitcnt vmcnt(0)" ::: "memory");
        } else {
            XB_SPIN(xb_ld(&bar[XB_XGEN(b.x)]) == gen, bar);
            __builtin_amdgcn_fence(__ATOMIC_ACQUIRE, "agent");
            asm volatile("s_waitcnt vmcnt(0)" ::: "memory");
        }
    }
    __syncthreads();
}
struct Frame {
    LAS unsigned char* lds;
    volatile LAS unsigned* MISC;
    gu32* ctl;
    int tid, lane, wave, gw, NGW, G;
    float* out; unsigned char* ws;
};
__device__ __forceinline__ float wave_sum(float v) {
#pragma unroll
    for (int o = 1; o < 64; o <<= 1) v += __shfl_xor(v, o);
    return v;
}
__device__ __forceinline__ float bf2f(unsigned short b) { return __uint_as_float((unsigned)b << 16); }
__device__ __forceinline__ void unpack8(v4u w, float* f) {
    f[0] = __uint_as_float(w.x << 16); f[1] = __uint_as_float(w.x & 0xffff0000u); f[2] = __uint_as_float(w.y << 16); f[3] = __uint_as_float(w.y & 0xffff0000u);
    f[4] = __uint_as_float(w.z << 16); f[5] = __uint_as_float(w.z & 0xffff0000u); f[6] = __uint_as_float(w.w << 16); f[7] = __uint_as_float(w.w & 0xffff0000u);
}
typedef unsigned v2u __attribute__((ext_vector_type(2)));
__device__ __forceinline__ void unpack4(v2u w, float* f) {
    f[0] = __uint_as_float(w.x << 16); f[1] = __uint_as_float(w.x & 0xffff0000u); f[2] = __uint_as_float(w.y << 16); f[3] = __uint_as_float(w.y & 0xffff0000u);
}
__device__ __forceinline__ v2u pack4(const float* f) { v2u w; w.x = pk2(f[0], f[1]); w.y = pk2(f[2], f[3]); return w; }
__device__ __forceinline__ v4u pack8(const float* f) { v4u w; w.x = pk2(f[0], f[1]); w.y = pk2(f[2], f[3]); w.z = pk2(f[4], f[5]); w.w = pk2(f[6], f[7]); return w; }
__device__ __forceinline__ bf16x8 as_bf16x8(v4u w) { return __builtin_bit_cast(bf16x8, w); }
__device__ __forceinline__ float sigmoid_f(float x) { return 1.0f / (1.0f + __expf(-x)); }
__device__ __forceinline__ float tanh_f(float x) { const float e = __expf(2.0f * x); return 1.0f - 2.0f / (e + 1.0f); }

__device__ __forceinline__ void transpose_item(const float* W, int K, int N, bf16* WT, int kb, int nb, int orow0, LAS float* scr, int lane) {
    const int k0 = 64 * kb, n0 = 32 * nb;
#pragma unroll 8
    for (int i = 0; i < 32; ++i) { const int kk = 2 * i + (lane >> 5); scr[kk * 33 + (lane & 31)] = W[(size_t)(k0 + kk) * N + n0 + (lane & 31)]; }
    LDS_WAIT(); asm volatile("" ::: "memory");
    const int c = lane & 7;
#pragma unroll
    for (int j = 0; j < 4; ++j) { const int n = (lane >> 3) + 8 * j; const LAS float* s = scr + (8 * c) * 33 + n;
        v4u o; o.x = pk2(s[0 * 33], s[1 * 33]); o.y = pk2(s[2 * 33], s[3 * 33]); o.z = pk2(s[4 * 33], s[5 * 33]); o.w = pk2(s[6 * 33], s[7 * 33]);
        *(GAS v4u*)(WT + (size_t)(orow0 + n) * K + k0 + 8 * c) = o; }
    LDS_WAIT(); asm volatile("" ::: "memory");
}
__device__ __forceinline__ int gu_row(int n0) { return n0 < FF ? 256 * (n0 >> 7) + (n0 & 127) : 256 * ((n0 - FF) >> 7) + 128 + ((n0 - FF) & 127); }
__device__ __forceinline__ void p0_prologue(Frame& F, const InAcc& A) {
    LAS float* scr = (LAS float*)(F.lds + RING_OFF + F.wave * 16384);
    constexpr int I_GU = 16 * 176, I_DN = 44 * 32, I_IN = 16 * 88, I_OUT = 16 * 32, I_L64 = 16, I_L128 = 32;
    constexpr int NITEMS = 2 * I_GU + 2 * I_DN + I_IN + I_OUT + 2 * I_L64 + I_L128;
    for (int it = F.gw; it < NITEMS; it += F.NGW) {
        int r = it;
        if (r < I_GU) { const int kb = r / 176, nb = r % 176; transpose_item(A.in[8], 1024, 5632, ((bf16*)(F.ws + WS_GU1)), kb, nb, gu_row(32 * nb), scr, F.lane); continue; } r -= I_GU;
        if (r < I_GU) { const int kb = r / 176, nb = r % 176; transpose_item(A.in[27], 1024, 5632, ((bf16*)(F.ws + WS_GU2)), kb, nb, gu_row(32 * nb), scr, F.lane); continue; } r -= I_GU;
        if (r < I_DN) { const int kb = r / 32, nb = r % 32; transpose_item(A.in[9], 2816, 1024, ((bf16*)(F.ws + WS_DN1)), kb, nb, 32 * nb, scr, F.lane); continue; } r -= I_DN;
        if (r < I_DN) { const int kb = r / 32, nb = r % 32; transpose_item(A.in[28], 2816, 1024, ((bf16*)(F.ws + WS_DN2)), kb, nb, 32 * nb, scr, F.lane); continue; } r -= I_DN;
        if (r < I_IN) { const int kb = r / 88, nb = r % 88; transpose_item(A.in[10], 1024, 2816, ((bf16*)(F.ws + WS_WIN)), kb, nb, 32 * nb, scr, F.lane); continue; } r -= I_IN;
        if (r < I_OUT) { const int kb = r / 32, nb = r % 32; transpose_item(A.in[26], 1024, 1024, ((bf16*)(F.ws + WS_WOUT)), kb, nb, 32 * nb, scr, F.lane); continue; } r -= I_OUT;
        if (r < I_L64) { transpose_item(A.in[13], 64, 512, ((bf16*)(F.ws + WS_WLT)), 0, r, 32 * r, scr, F.lane); continue; } r -= I_L64;
        if (r < I_L64) { transpose_item(A.in[15], 64, 512, ((bf16*)(F.ws + WS_ALT)), 0, r, 32 * r, scr, F.lane); continue; } r -= I_L64;
        { const int kb = r / 16, nb = r % 16; transpose_item(A.in[16], 128, 512, ((bf16*)(F.ws + WS_GLT)), kb, nb, 32 * nb, scr, F.lane); }
    }
    const int gt = F.gw * 64 + F.lane, NGT = F.NGW * 64;
    for (int i = gt; i < NSEQ * 448; i += NGT) { const int sq = i / 448, cg = i % 448;
        f32x4 v = {0.f, 0.f, 0.f, 0.f}; if (sq >= 8) v = *(const f32x4*)(A.in[2] + (size_t)(sq - 8) * RC + 4 * cg);
        v2u w; w.x = pk2(v.x, v.y); w.y = pk2(v.z, v.w); *(v2u*)((bf16*)(F.ws + WS_FP) + (size_t)i * 64) = w; }
    for (int i = gt; i < 8 * 128 * 64; i += NGT) { const int j = (i & 63) * 2, ii = (i >> 6) & 127;
        const float a = A.in[24][2 * (size_t)i], b = A.in[24][2 * (size_t)i + 1];
        ((unsigned*)((bf16*)(F.ws + WS_WSB)))[i] = pk2(j <= ii ? a : 0.f, (j + 1) <= ii ? b : 0.f); }
}
__device__ __forceinline__ void p1_mod(Frame& F, const InAcc& A) {
    const int l15 = F.lane & 15, q = F.lane >> 4;
    const float* w_ada = A.in[6]; const float* b_ada = A.in[7];
    const float* c_p = A.in[4]; const float* c_s = A.in[5];
    LAS f32x4* red = (LAS f32x4*)(F.lds + RING_OFF);
    for (int nt = blockIdx.x; nt < MODW / 16; nt += F.G) {
        const int n0 = 16 * nt, kb = 128 * F.wave + 8 * q;
        float wv[4][8];
        const float* wp = w_ada + (size_t)kb * MODW + n0 + l15;
#pragma unroll
        for (int ks = 0; ks < 4; ++ks) {
#pragma unroll
            for (int j = 0; j < 8; ++j) { wv[ks][j] = *wp; wp += MODW; asm volatile("" : "+v"(wp)); }
            wp += 24 * MODW; }
        f32x4 acc[9];
#pragma unroll
        for (int mt = 0; mt < 9; ++mt) acc[mt] = (f32x4){0.f, 0.f, 0.f, 0.f};
#pragma unroll 1
        for (int ks = 0; ks < 4; ++ks) {
            f32x4 raw[9][2];
#pragma unroll
            for (int mt = 0; mt < 9; ++mt) { const int sq = 16 * mt + l15; const int sc = sq < NSEQ ? sq : 0;
                const float* cr = (sc < 8 ? c_p + (size_t)sc * D : c_s + (size_t)(sc - 8) * D) + kb + 32 * ks; raw[mt][0] = *(const f32x4*)cr; raw[mt][1] = *(const f32x4*)(cr + 4); }
            __builtin_amdgcn_sched_barrier(0);
            const bf16x8 wf = as_bf16x8(pack8(wv[0]));
#pragma unroll
            for (int mt = 0; mt < 9; ++mt) { const bool ok = 16 * mt + l15 < NSEQ; float t[8];
#pragma unroll
                for (int e = 0; e < 4; ++e) { t[e] = ok ? pg8::silu_f(raw[mt][0][e]) : 0.f; t[4 + e] = ok ? pg8::silu_f(raw[mt][1][e]) : 0.f; }
                acc[mt] = __builtin_amdgcn_mfma_f32_16x16x32_bf16(wf, as_bf16x8(pack8(t)), acc[mt], 0, 0, 0); }
            __builtin_amdgcn_sched_barrier(0);
#pragma unroll
            for (int i = 0; i < 3; ++i)
#pragma unroll
                for (int j = 0; j < 8; ++j) wv[i][j] = wv[i + 1][j];
        }
#pragma unroll
        for (int mt = 0; mt < 9; ++mt) red[(F.wave * 9 + mt) * 64 + F.lane] = acc[mt];
        __syncthreads();
        const f32x4 bv = *(const f32x4*)(b_ada + n0 + 4 * q);
#pragma unroll
        for (int rr = 0; rr < 2; ++rr) { const int mt = F.wave + 8 * rr; if (mt < 9) { f32x4 s = bv;
#pragma unroll
                for (int w2 = 0; w2 < 8; ++w2) s += red[(w2 * 9 + mt) * 64 + F.lane];
                const int sq = 16 * mt + l15; if (sq < NSEQ) *(f32x4*)(((float*)(F.ws + WS_MOD)) + (size_t)sq * MODW + n0 + 4 * q) = s; } }
        __syncthreads();
    }
}
__device__ __forceinline__ const float* res_row(const float* pP, const float* pS, int row) { return row < MP ? pP + (size_t)row * D : pS + (size_t)(row - MP) * D; }
__device__ __forceinline__ void norm_rows_bf16(Frame& F, const InAcc& A, const float* srcP, const float* srcS, int sh_off, int sc_off, int ns, int g_off, float coef) {
    const float* MODp = (const float*)(F.ws + WS_MOD);
    for (int row = F.gw; row < M; row += F.NGW) {
        const f32x4* xr = (const f32x4*)res_row(srcP, srcS, row) + F.lane; const int s = pg8::seq_of_row(row);
        f32x4 v[4];
#pragma unroll
        for (int j = 0; j < 4; ++j) v[j] = xr[64 * j];
        if (ns > 0 && row >= MP) { const f32x4* sl = (const f32x4*)(F.ws + WS_SC) + (size_t)(row - MP) * (D / 4) + F.lane; const f32x4* gp = (const f32x4*)(MODp + (size_t)s * MODW + g_off) + F.lane;
            f32x4* hr = (f32x4*)(F.out + (size_t)row * D) + F.lane;
#pragma unroll
            for (int j = 0; j < 4; ++j) { f32x4 t = {0.f, 0.f, 0.f, 0.f}; for (int k = 0; k < ns; ++k) t += sl[(size_t)k * (1024 * D / 4) + 64 * j]; v[j] = v[j] + (gp[64 * j] * coef) * t; hr[64 * j] = v[j]; } }
        float ss = 0.f;
#pragma unroll
        for (int j = 0; j < 4; ++j) ss += (v[j].x * v[j].x + v[j].y * v[j].y) + (v[j].z * v[j].z + v[j].w * v[j].w);
        const float rstd = 1.0f / sqrtf(wave_sum(ss) * (1.0f / D) + RMS_EPS);
        const f32x4* sc = (const f32x4*)(MODp + (size_t)s * MODW + sc_off) + F.lane; const f32x4* sh = (const f32x4*)(MODp + (size_t)s * MODW + sh_off) + F.lane;
        v2u* o = (v2u*)(((bf16*)(F.ws + WS_XN)) + (size_t)row * D) + F.lane;
#pragma unroll
        for (int j = 0; j < 4; ++j) { const f32x4 a = sc[64 * j], bb = sh[64 * j]; const f32x4 r = v[j] * rstd * (a + 1.0f) + bb; float t[4] = {r.x, r.y, r.z, r.w}; o[64 * j] = pack4(t); }
    }
}
__device__ __forceinline__ void final_norm_rows(Frame& F, const InAcc& A, int ns, int g_off, float coef) {
    const float* MODp = (const float*)(F.ws + WS_MOD);
    for (int row = F.gw; row < M; row += F.NGW) {
        f32x4* xr = (f32x4*)(F.out + (size_t)row * D) + F.lane;
        f32x4 v[4];
#pragma unroll
        for (int j = 0; j < 4; ++j) v[j] = xr[64 * j];
        if (ns > 0 && row >= MP) { const int s = pg8::seq_of_row(row); const f32x4* sl = (const f32x4*)(F.ws + WS_SC) + (size_t)(row - MP) * (D / 4) + F.lane; const f32x4* gp = (const f32x4*)(MODp + (size_t)s * MODW + g_off) + F.lane;
#pragma unroll
            for (int j = 0; j < 4; ++j) { f32x4 t = {0.f, 0.f, 0.f, 0.f}; for (int k = 0; k < ns; ++k) t += sl[(size_t)k * (1024 * D / 4) + 64 * j]; v[j] = v[j] + (gp[64 * j] * coef) * t; } }
        float ss = 0.f;
#pragma unroll
        for (int j = 0; j < 4; ++j) ss += (v[j].x * v[j].x + v[j].y * v[j].y) + (v[j].z * v[j].z + v[j].w * v[j].w);
        const float rstd = 1.0f / sqrtf(wave_sum(ss) * (1.0f / D) + RMS_EPS);
        const f32x4* g = (const f32x4*)A.in[29] + F.lane;
#pragma unroll
        for (int j = 0; j < 4; ++j) xr[64 * j] = v[j] * rstd * g[64 * j];
    }
}
__device__ __forceinline__ unsigned dpp_shr1(unsigned x) { return (unsigned)__builtin_amdgcn_update_dpp(0, (int)x, 0x111, 0xf, 0xf, false); }
__device__ __forceinline__ size_t sc_off(int row, int c) { return ((size_t)((row >> 4) * 128 + (c >> 2)) * 16 + (row & 15)) * 4 + (c & 3); }
__device__ __forceinline__ void frag_item(Frame& F, const InAcc& A, int r0) {
    const int l15 = F.lane & 15, q = F.lane >> 4, row = r0 + l15, tile = r0 >> 4;
    const bf16* PB = (const bf16*)(F.ws + WS_ACT);
    const bf16* pcur = PB + ((size_t)tile * 448 * 16 + l15) * 4;
    const bool first = pg8::row_is_first(row);
    const bf16* fp = (const bf16*)(F.ws + WS_FP) + (size_t)pg8::seq_of_row(row) * 448 * 64;
    const bf16* pprv = PB + ((size_t)(tile > 0 ? tile - 1 : 0) * 448 * 16 + 15) * 4;
    const bf16* pb = first ? fp : (l15 == 0 ? pprv : pcur - 4);
    const float* mu = A.in[11];
    v2u lc[16], lp[16];
#pragma unroll
    for (int i = 0; i < 16; ++i) { const size_t o = (size_t)(384 + 8 * (i >> 1) + 2 * q + (i & 1)) * 64; lc[i] = *(const v2u*)(pcur + o); lp[i] = *(const v2u*)(pb + o); }
#pragma unroll
    for (int g = 0; g < 8; ++g) { const int col = 1536 + 32 * g + 8 * q; float cur[8], prv[8]; unpack4(lc[2 * g], cur); unpack4(lc[2 * g + 1], cur + 4); unpack4(lp[2 * g], prv); unpack4(lp[2 * g + 1], prv + 4);
        const f32x4 m0 = *(const f32x4*)(mu + col), m1 = *(const f32x4*)(mu + col + 4); const float mm[8] = {m0.x, m0.y, m0.z, m0.w, m1.x, m1.y, m1.z, m1.w};
        float t[8];
#pragma unroll
        for (int e = 0; e < 8; ++e) { const float x = cur[e] + (prv[e] - cur[e]) * mm[e]; t[e] = g < 2 ? tanh_f(x) : (g < 4 ? x : sigmoid_f(x)); }
        *(v4u*)((bf16*)(F.ws + WS_FRG) + ((size_t)((tile * 8 + g) * 4 + q) * 16 + l15) * 8) = pack8(t); }
}
__device__ __forceinline__ void prep_item(Frame& F, const InAcc& A, int r0, int h) {
    const int l15 = F.lane & 15, q = F.lane >> 4, row = r0 + l15, tile = r0 >> 4;
    const bf16* PB = (const bf16*)(F.ws + WS_ACT);
    const bf16* pcur = PB + ((size_t)tile * 448 * 16 + l15) * 4;
    const bool first = pg8::row_is_first(row);
    const bf16* fp = (const bf16*)(F.ws + WS_FP) + (size_t)pg8::seq_of_row(row) * 448 * 64;
    const bf16* pprv = PB + ((size_t)(tile > 0 ? tile - 1 : 0) * 448 * 16 + 15) * 4;
    const float* mu = A.in[11];
    v2u xc[4][3], xp[4][3];
    const bf16* pb = first ? fp : (l15 == 0 ? pprv : pcur - 4); constexpr int pmul = 64;
    bf16x8 fr[8];
#pragma unroll
    for (int g = 0; g < 8; ++g) fr[g] = *(const bf16x8*)((const bf16*)(F.ws + WS_FRG) + ((size_t)((tile * 8 + g) * 4 + q) * 16 + l15) * 8);
#pragma unroll
    for (int ntl = 0; ntl < 4; ++ntl)
#pragma unroll
        for (int sct = 0; sct < 3; ++sct) xc[ntl][sct] = *(const v2u*)(pcur + (size_t)(128 * sct + 16 * h + 4 * ntl + q) * 64);
#pragma unroll
    for (int ntl = 0; ntl < 4; ++ntl)
#pragma unroll
        for (int sct = 0; sct < 3; ++sct) xp[ntl][sct] = *(const v2u*)(pb + (size_t)(128 * sct + 16 * h + 4 * ntl + q) * pmul);
    v2u xm[4][3];
    const float* k_k = A.in[17];
    float ss = 0.f, bon = 0.f;
#pragma unroll
    for (int ntl = 0; ntl < 4; ++ntl)
#pragma unroll
        for (int sct = 0; sct < 3; ++sct) { const int col = 512 * sct + 64 * h + 16 * ntl + 4 * q; float cur[4], prv[4], x[4]; unpack4(xc[ntl][sct], cur); unpack4(xp[ntl][sct], prv);
            const f32x4 m0 = *(const f32x4*)(mu + col);
#pragma unroll
            for (int e = 0; e < 4; ++e) x[e] = cur[e] + (prv[e] - cur[e]) * m0[e];
            xm[ntl][sct] = pack4(x);
            if (sct == 1) { float xb[4]; unpack4(xm[ntl][sct], xb); const f32x4 kkv = *(const f32x4*)(k_k + 64 * h + 16 * ntl + 4 * q);
#pragma unroll
                for (int e = 0; e < 4; ++e) { const float kr = xb[e] * kkv[e]; ss += kr * kr; } } }
    __builtin_amdgcn_sched_barrier(0);
    ss += __shfl_xor(ss, 16); ss += __shfl_xor(ss, 32);
    const float inv = 1.0f / fmaxf(sqrtf(ss), 1e-12f);
    const LAS bf16x8* wl = (const LAS bf16x8*)(F.lds + RING_OFF) + F.lane;
    const LAS float* hp = (const LAS float*)(F.lds + RING_OFF + 32768);
#pragma unroll 1
    for (int ntl = 0; ntl < 4; ++ntl) {
        const int n0 = 64 * h + 16 * ntl, c0 = n0 + 4 * q;
        f32x4 aw = {0.f, 0.f, 0.f, 0.f}, aa = aw, ag = aw;
#pragma unroll
        for (int ks = 0; ks < 2; ++ks) {
            aw = __builtin_amdgcn_mfma_f32_16x16x32_bf16(wl[(2 * ntl + ks) * 64], fr[ks], aw, 0, 0, 0);
            aa = __builtin_amdgcn_mfma_f32_16x16x32_bf16(wl[(8 + 2 * ntl + ks) * 64], fr[2 + ks], aa, 0, 0, 0); }
#pragma unroll
        for (int ks = 0; ks < 4; ++ks)
            ag = __builtin_amdgcn_mfma_f32_16x16x32_bf16(wl[(16 + 4 * ntl + ks) * 64], fr[4 + ks], ag, 0, 0, 0);
        const int cl = 16 * ntl + 4 * q;
        const f32x4 w0v = *(const LAS f32x4*)(hp + cl), a0v = *(const LAS f32x4*)(hp + 64 + cl), kkv = *(const LAS f32x4*)(hp + 128 + cl), kav = *(const LAS f32x4*)(hp + 192 + cl), rkv = *(const LAS f32x4*)(hp + 256 + cl);
        float omd[4], km[4], gg[4], kk[4], bb[4], xrf[4], xkf[4]; unpack4(xm[0][0], xrf); unpack4(xm[0][1], xkf);
#pragma unroll
        for (int e = 0; e < 4; ++e) {
            const float z = -(w0v[e] + aw[e]);
            const float sp = z > 20.f ? z : __logf(1.0f + __expf(z));
            const float wlog = -sp - 0.5f;
            const float dec = __expf(-__expf(wlog));
            omd[e] = 1.0f - dec;
            const float a = sigmoid_f(a0v[e] + aa[e]);
            kk[e] = xkf[e] * kkv[e] * inv; bb[e] = kk[e] * a;
            km[e] = xkf[e] * (1.0f + (a - 1.0f) * kav[e]);
            bon += xrf[e] * km[e] * rkv[e];
            gg[e] = ag[e];
        }
        const size_t o = sc_off(row, c0);
        *(v2u*)(((bf16*)(F.ws + WS_SC)) + o) = xm[0][0]; *(v2u*)(((bf16*)(F.ws + (WS_SC + SC_STRIDE))) + o) = pack4(km); *(v2u*)(((bf16*)(F.ws + (WS_SC + 2 * SC_STRIDE))) + o) = xm[0][2];
        *(v2u*)(((bf16*)(F.ws + (WS_SC + 3 * SC_STRIDE))) + o) = pack4(kk); *(v2u*)(((bf16*)(F.ws + (WS_SC + 4 * SC_STRIDE))) + o) = pack4(bb);
        *(v2u*)(((bf16*)(F.ws + (WS_SC + 5 * SC_STRIDE))) + o) = pack4(omd); *(v2u*)(((bf16*)(F.ws + WS_G)) + o) = pack4(gg);
#pragma unroll
        for (int i = 0; i < 3; ++i)
#pragma unroll
            for (int e = 0; e < 3; ++e) xm[i][e] = xm[i + 1][e];
    }
    bon += __shfl_xor(bon, 16); bon += __shfl_xor(bon, 32);
    if (q == 0) ((float*)(F.ws + WS_BON))[(size_t)row * 8 + h] = bon;
}
__device__ __forceinline__ void prep_all(Frame& F, const InAcc& A) {
    const int w = blockIdx.x, h = w & 7; const int nslots = (F.G >> 3) * NWAVES;
    if (F.G & 7) return;
    { const bf16* WLT = (const bf16*)(F.ws + WS_WLT); const bf16* ALT = (const bf16*)(F.ws + WS_ALT); const bf16* GLT = (const bf16*)(F.ws + WS_GLT);
      LAS v4u* dst = (LAS v4u*)(F.lds + RING_OFF);
#pragma unroll
      for (int i = 0; i < 4; ++i) { const int p = F.tid + 512 * i, f = p >> 6, L = p & 63, l15 = L & 15, q = L >> 4;
          const bf16* src;
          if (f < 8) src = WLT + (size_t)(64 * h + 16 * (f >> 1) + l15) * 64 + 32 * (f & 1) + 8 * q;
          else if (f < 16) src = ALT + (size_t)(64 * h + 16 * ((f - 8) >> 1) + l15) * 64 + 32 * (f & 1) + 8 * q;
          else src = GLT + (size_t)(64 * h + 16 * ((f - 16) >> 2) + l15) * 128 + 32 * (f & 3) + 8 * q;
          dst[p] = *(const v4u*)src; }
      if (F.tid < 320) { const int a = F.tid >> 6, i = F.tid & 63; const float* src = a == 0 ? A.in[12] : a == 1 ? A.in[14] : a == 2 ? A.in[17] : a == 3 ? A.in[18] : A.in[19];
          ((LAS float*)(F.lds + RING_OFF + 32768))[F.tid] = src[64 * h + i]; }
      __syncthreads(); }
    for (int tt = (w >> 3) * NWAVES + F.wave; tt < M / 16; tt += nslots) prep_item(F, A, 16 * tt, h);
    __syncthreads();
}
__device__ __forceinline__ void lnv_rows(Frame& F, const InAcc& A) {
    for (int row = F.gw; row < M; row += F.NGW) {
        v4u* pv = (v4u*)(((bf16*)(F.ws + WS_PUV)) + (size_t)row * 1024 + 512) + F.lane;
        float x[8]; unpack8(*pv, x);
        float s = 0.f;
#pragma unroll
        for (int e = 0; e < 8; ++e) s += x[e];
        const float mean = wave_sum(s) * (1.0f / 512.0f); float qq = 0.f;
#pragma unroll
        for (int e = 0; e < 8; ++e) { x[e] -= mean; qq += x[e] * x[e]; }
        const float rstd = 1.0f / sqrtf(wave_sum(qq) * (1.0f / 512.0f) + LN_EPS);
        const f32x4 g0 = *(const f32x4*)(A.in[22] + 8 * F.lane), g1 = *(const f32x4*)(A.in[22] + 8 * F.lane + 4), b0 = *(const f32x4*)(A.in[23] + 8 * F.lane), b1 = *(const f32x4*)(A.in[23] + 8 * F.lane + 4);
        const float gg[8] = {g0.x, g0.y, g0.z, g0.w, g1.x, g1.y, g1.z, g1.w}, bb[8] = {b0.x, b0.y, b0.z, b0.w, b1.x, b1.y, b1.z, b1.w};
#pragma unroll
        for (int e = 0; e < 8; ++e) x[e] = x[e] * rstd * gg[e] + bb[e];
        *pv = pack8(x);
        if (row >= MP) { float* o = F.out + O_CVS + (size_t)(row - MP) * 512 + 8 * F.lane; *(f32x4*)o = (f32x4){x[0], x[1], x[2], x[3]}; *(f32x4*)(o + 4) = (f32x4){x[4], x[5], x[6], x[7]}; }
    }
}
template <bool SAMP> __device__ __forceinline__ void gmlp_item(Frame& F, const InAcc& A, int ci, int h) {
    const int l15 = F.lane & 15, q = F.lane >> 4;
    const int base = SAMP ? MP + 8 * ci : 128 * ci;
    const bf16* P = (const bf16*)(F.ws + WS_PUV);
    const bf16* WSB = (const bf16*)(F.ws + WS_WSB);
    const float* b_s = A.in[25];
    LAS unsigned short* tile = (LAS unsigned short*)(F.lds + RING_OFF + F.wave * 17408);
    constexpr int NIT = SAMP ? 1 : 8, NKS = SAMP ? 1 : 4;
#pragma unroll
    for (int i = 0; i < (SAMP ? 1 : 16); ++i) { const int r = 8 * i + (F.lane >> 3), c8 = (F.lane & 7) * 8;
        const v4u x = *(const v4u*)(P + (size_t)(base + r) * 1024 + 512 + h * 64 + c8);
        LAS unsigned* d = (LAS unsigned*)(tile + r * 66 + c8); d[0] = x.x; d[1] = x.y; d[2] = x.z; d[3] = x.w; }
    LDS_WAIT(); asm volatile("" ::: "memory");
#pragma unroll 1
    for (int dt = 0; dt < 4; ++dt) {
        bf16x8 vf[NKS];
#pragma unroll
        for (int ks = 0; ks < NKS; ++ks)
#pragma unroll
            for (int jj = 0; jj < 8; ++jj) { const int jr = 32 * ks + 8 * q + jj; vf[ks][jj] = (SAMP && jr >= 8) ? (short)0 : (short)tile[jr * 66 + 16 * dt + l15]; }
        const int cc = h * 64 + 16 * dt + 4 * q;
#pragma unroll
        for (int it = 0; it < NIT; ++it) {
            f32x4 acc = {0.f, 0.f, 0.f, 0.f};
#pragma unroll
            for (int ks = 0; ks < NKS; ++ks) if (ks <= (it >> 1))
                acc = __builtin_amdgcn_mfma_f32_16x16x32_bf16(vf[ks], *(const bf16x8*)(WSB + ((size_t)(h * 128 + 16 * it + l15)) * 128 + 32 * ks + 8 * q), acc, 0, 0, 0);
            const int i = 16 * it + l15;
            if (!SAMP || i < 8) { const int row = base + i; const float bs = b_s[h * 128 + i];
                float pu[4]; unpack4(*(const v2u*)(P + (size_t)row * 1024 + cc), pu);
                float o[4];
#pragma unroll
                for (int e = 0; e < 4; ++e) o[e] = pu[e] * (acc[e] + bs);
                *(v2u*)(((bf16*)(F.ws + WS_XN)) + (size_t)row * D + 512 + cc) = pack4(o); }
        }
    }
    LDS_WAIT(); asm volatile("" ::: "memory");
}
__device__ __forceinline__ float red16(float x) {
    x += __builtin_bit_cast(float, __builtin_amdgcn_update_dpp(0, __builtin_bit_cast(int, x), 0x128, 0xf, 0xf, false));
    x += __builtin_bit_cast(float, __builtin_amdgcn_update_dpp(0, __builtin_bit_cast(int, x), 0x124, 0xf, 0xf, false));
    x += __builtin_bit_cast(float, __builtin_amdgcn_update_dpp(0, __builtin_bit_cast(int, x), 0x122, 0xf, 0xf, false));
    x += __builtin_bit_cast(float, __builtin_amdgcn_update_dpp(0, __builtin_bit_cast(int, x), 0x121, 0xf, 0xf, false));
    return x;
}
typedef float f32x2 __attribute__((ext_vector_type(2)));
#define DPP_ROR(x, n) __builtin_bit_cast(float, __builtin_amdgcn_update_dpp(0, __builtin_bit_cast(int, (x)), 0x120 + (n), 0xf, 0xf, false))
__device__ __forceinline__ void red16x2(float& a, float& b) {
    a += DPP_ROR(a, 8); b += DPP_ROR(b, 8); a += DPP_ROR(a, 4); b += DPP_ROR(b, 4); a += DPP_ROR(a, 2); b += DPP_ROR(b, 2); a += DPP_ROR(a, 1); b += DPP_ROR(b, 1);
}
__device__ __forceinline__ float wkv_step(f32x4& S, const f32x4 w, const f32x4 kk, const f32x4 bb, const f32x4 k, const f32x4 r, const float vv, float& ypend) {
    f32x2 Sa = {S.x, S.y}, Sb = {S.z, S.w};
    f32x2 p = Sa * (f32x2){kk.x, kk.y}; p = Sb * (f32x2){kk.z, kk.w} + p;
    float d = p.x + p.y;
    red16x2(d, ypend);
    const f32x2 v2 = {vv, vv};
    f32x2 Ta = (f32x2){k.x, k.y} * v2, Tb = (f32x2){k.z, k.w} * v2;
    Ta = Sa * (f32x2){w.x, w.y} + Ta; Tb = Sb * (f32x2){w.z, w.w} + Tb;
    const f32x2 nd = {-d, -d};
    Sa = (f32x2){bb.x, bb.y} * nd + Ta; Sb = (f32x2){bb.z, bb.w} * nd + Tb;
    f32x2 yv = Sa * (f32x2){r.x, r.y}; yv = Sb * (f32x2){r.z, r.w} + yv;
    S = (f32x4){Sa.x, Sa.y, Sb.x, Sb.y};
    return yv.x + yv.y;
}
__device__ __forceinline__ void scan_sample_item(Frame& F, const InAcc& A, int it) {
    const int sbh = it >> 3, rp = it & 7, sb = sbh >> 3, h = sbh & 7, j = F.lane & 15, v0 = 8 * rp + (F.lane >> 4), v1 = v0 + 4;
    const size_t so0 = ((size_t)sbh * 64 + v0) * 64 + 4 * j, so1 = so0 + 4 * 64;
    f32x4 S0 = *(const f32x4*)(A.in[3] + so0), S1 = *(const f32x4*)(A.in[3] + so1);
    const size_t ro0 = (size_t)(MP + 8 * sb) * RW + h * 64;
    const bf16* scr = (const bf16*)(F.ws + WS_SC);
    v2u lw[8], lkk[8], lbb[8], lk[8], lr[8]; unsigned short lv0[8], lv1[8];
#pragma unroll
    for (int t = 0; t < 8; ++t) { const int row = MP + 8 * sb + t; const size_t ro = sc_off(row, h * 64 + 4 * j);
        lw[t] = *(const v2u*)(scr + 5 * (SC_STRIDE / 2) + ro); lkk[t] = *(const v2u*)(scr + 3 * (SC_STRIDE / 2) + ro); lbb[t] = *(const v2u*)(scr + 4 * (SC_STRIDE / 2) + ro);
        lk[t] = *(const v2u*)(scr + 1 * (SC_STRIDE / 2) + ro); lr[t] = *(const v2u*)(scr + ro); lv0[t] = scr[2 * (SC_STRIDE / 2) + sc_off(row, h * 64 + v0)]; lv1[t] = scr[2 * (SC_STRIDE / 2) + sc_off(row, h * 64 + v1)]; }
    float yk0 = 0.f, yk1 = 0.f;
#pragma unroll
    for (int t = 0; t < 8; ++t) {
        float w[4], kk[4], bb[4], k[4], r[4];
        unpack4(lw[t], w); unpack4(lkk[t], kk); unpack4(lbb[t], bb); unpack4(lk[t], k); unpack4(lr[t], r);
        const f32x4 w4 = {1.f - w[0], 1.f - w[1], 1.f - w[2], 1.f - w[3]}, kk4 = {kk[0], kk[1], kk[2], kk[3]}, bb4 = {bb[0], bb[1], bb[2], bb[3]}, k4 = {k[0], k[1], k[2], k[3]}, r4 = {r[0], r[1], r[2], r[3]};
        float dm0 = 0.f; const float y0 = red16(wkv_step(S0, w4, kk4, bb4, k4, r4, bf2f(lv0[t]), dm0));
        float dm1 = 0.f; const float y1 = red16(wkv_step(S1, w4, kk4, bb4, k4, r4, bf2f(lv1[t]), dm1));
        yk0 = (j == t) ? y0 : yk0; yk1 = (j == t) ? y1 : yk1;
    }
    if (j < 8) { float* yg = ((float*)(F.ws + WS_Y)) + ro0 + (size_t)j * RW; yg[v0] = yk0; yg[v1] = yk1; }
    *(f32x4*)(F.out + O_WKVS + so0) = S0; *(f32x4*)(F.out + O_WKVS + so1) = S1;
}
constexpr int TC = 32, STEP_F = 336, CHUNK_F = TC * STEP_F, LD_ITEMS = TC * 42, NCHUNK = 2048 / TC;
constexpr int YB_OFF_F = 2 * CHUNK_F;
__device__ __forceinline__ void scan_prompt_unit(Frame& F, const InAcc& A, int unit) {
    const int bh = unit >> 2, qtr = unit & 3, b = bh >> 3, h = bh & 7;
    const size_t rowbase = (size_t)b * 2048;
    LAS float* const lf = (LAS float*)(F.lds + RING_OFF);
    const int j = F.lane & 15, vloc = 4 * (F.wave & 3) + (F.lane >> 4), v = 16 * qtr + vloc;
    f32x4 S = {0.f, 0.f, 0.f, 0.f};
    v4u ld[3]; const bf16* srcp[3]; int dsto[3]; bool isw[3], act[3];
    const size_t tile0 = rowbase >> 4;
#pragma unroll
    for (int i = 0; i < 3; ++i) { const int it = F.tid + 512 * i; act[i] = it < LD_ITEMS;
        if (it < 1280) { const int a = it >> 8, ti = (it >> 7) & 1, p = it & 127;
            srcp[i] = (const bf16*)(F.ws + WS_SC) + (size_t)(a == 0 ? 5 : a == 1 ? 3 : a == 2 ? 4 : a == 3 ? 1 : 0) * (SC_STRIDE / 2) + ((tile0 + ti) * 128 + 16 * h) * 64 + p * 8;
            dsto[i] = (16 * ti + 2 * (p & 7)) * STEP_F + a * 64 + 4 * (p >> 3); isw[i] = a == 0; }
        else { const int r2 = act[i] ? it - 1280 : 0, ti = r2 >> 5, p = r2 & 31;
            srcp[i] = (const bf16*)(F.ws + WS_SC + 2 * SC_STRIDE) + ((tile0 + ti) * 128 + 16 * h + 4 * qtr) * 64 + p * 8;
            dsto[i] = (16 * ti + 2 * (p & 7)) * STEP_F + 320 + 4 * (p >> 3); isw[i] = false; } }
#define SCAN_ISSUE(c) do { _Pragma("unroll") for (int i = 0; i < 3; ++i) if (act[i]) ld[i] = *(const v4u*)(srcp[i] + (size_t)(c) * (TC / 16) * 128 * 64); } while (0)
#define SCAN_COMMIT(bufo) do { _Pragma("unroll") for (int i = 0; i < 3; ++i) if (act[i]) { float f[8]; unpack8(ld[i], f); \
        if (isw[i]) { _Pragma("unroll") for (int e = 0; e < 8; ++e) f[e] = 1.0f - f[e]; } \
        LAS float* dst = lf + (bufo) + dsto[i]; *(LAS f32x4*)dst = (f32x4){f[0], f[1], f[2], f[3]}; *(LAS f32x4*)(dst + STEP_F) = (f32x4){f[4], f[5], f[6], f[7]}; } } while (0)
#define SCAN_FLUSH(c) do { const LAS float* yb_ = lf + YB_OFF_F + ((c) & 1) * (TC * 16); float* yg_ = ((float*)(F.ws + WS_Y)) + (rowbase + (size_t)(c) * TC) * RW + h * 64 + 16 * qtr; \
        yg_[(size_t)(F.tid >> 4) * RW + (F.tid & 15)] = yb_[F.tid]; } while (0)
    SCAN_ISSUE(0); SCAN_COMMIT(0); __syncthreads();
    for (int c = 0; c < NCHUNK; ++c) {
        if (c + 1 < NCHUNK) SCAN_ISSUE(c + 1);
        if (c > 0) SCAN_FLUSH(c - 1);
        if (F.wave < 4) {
            const LAS float* bp = lf + (c & 1) * CHUNK_F + 4 * j; const LAS float* vp = lf + (c & 1) * CHUNK_F + 320 + vloc; LAS float* yb = lf + YB_OFF_F + (c & 1) * (TC * 16) + vloc;
            f32x4 w4 = *(const LAS f32x4*)(bp), kk4 = *(const LAS f32x4*)(bp + 64), bb4 = *(const LAS f32x4*)(bp + 128), k4 = *(const LAS f32x4*)(bp + 192), r4 = *(const LAS f32x4*)(bp + 256); float vv = vp[0];
            float ypend = 0.f;
#pragma unroll 8
            for (int s = 0; s < TC; ++s) {
                const int sn = (s + 1 < TC) ? s + 1 : s;
                const f32x4 w4n = *(const LAS f32x4*)(bp + sn * STEP_F), kk4n = *(const LAS f32x4*)(bp + sn * STEP_F + 64), bb4n = *(const LAS f32x4*)(bp + sn * STEP_F + 128),
                            k4n = *(const LAS f32x4*)(bp + sn * STEP_F + 192), r4n = *(const LAS f32x4*)(bp + sn * STEP_F + 256); const float vvn = vp[sn * STEP_F];
                const float yp = wkv_step(S, w4, kk4, bb4, k4, r4, vv, ypend);
                if (s > 0) yb[(s - 1) * 16] = ypend;
                ypend = yp;
                __builtin_amdgcn_sched_barrier(0);
                w4 = w4n; kk4 = kk4n; bb4 = bb4n; k4 = k4n; r4 = r4n; vv = vvn;
            }
            yb[(TC - 1) * 16] = red16(ypend);
        }
        else { const int bi = (unit * 4 + (F.wave - 4)) + c * 1024; if (bi < 128 * 8 * 8) scan_sample_item(F, A, bi); }
        if (c + 1 < NCHUNK) SCAN_COMMIT(((c + 1) & 1) * CHUNK_F);
        __syncthreads();
    }
    SCAN_FLUSH(NCHUNK - 1);
    __syncthreads();
#undef SCAN_ISSUE
#undef SCAN_COMMIT
#undef SCAN_FLUSH
    if (F.wave < 4) *(f32x4*)(F.out + O_WKVP + ((size_t)bh * 64 + v) * 64 + 4 * j) = S;
}
__device__ __forceinline__ void postscan_item(Frame& F, const InAcc& A, int r0, int h) {
    const int l15 = F.lane & 15, q = F.lane >> 4, row = r0 + l15;
    const float* Y = (const float*)(F.ws + WS_Y); const bf16* V = (const bf16*)(F.ws + WS_SC + 2 * SC_STRIDE); const bf16* G = (const bf16*)(F.ws + WS_G);
    const float* gn_w = A.in[20]; const float* gn_b = A.in[21];
    float y[4][4]; float s = 0.f;
#pragma unroll
    for (int ntl = 0; ntl < 4; ++ntl) { const f32x4 t = *(const f32x4*)(Y + (size_t)row * RW + 64 * h + 16 * ntl + 4 * q); y[ntl][0] = t.x; y[ntl][1] = t.y; y[ntl][2] = t.z; y[ntl][3] = t.w; s += (t.x + t.y) + (t.z + t.w); }
    s += __shfl_xor(s, 16); s += __shfl_xor(s, 32);
    const float mu = s * (1.0f / 64.0f); float qq = 0.f;
#pragma unroll
    for (int ntl = 0; ntl < 4; ++ntl)
#pragma unroll
        for (int e = 0; e < 4; ++e) { y[ntl][e] -= mu; qq += y[ntl][e] * y[ntl][e]; }
    qq += __shfl_xor(qq, 16); qq += __shfl_xor(qq, 32);
    const float rstd = 1.0f / sqrtf(qq * (1.0f / 64.0f) + GN_EPS);
    const float bon = ((const float*)(F.ws + WS_BON))[(size_t)row * 8 + h];
#pragma unroll
    for (int ntl = 0; ntl < 4; ++ntl) { const int c0 = 64 * h + 16 * ntl + 4 * q; const size_t o = sc_off(row, c0);
        const f32x4 gw = *(const f32x4*)(gn_w + c0), gb = *(const f32x4*)(gn_b + c0);
        float vv[4], gg[4], ov[4]; unpack4(*(const v2u*)(V + o), vv); unpack4(*(const v2u*)(G + o), gg);
#pragma unroll
        for (int e = 0; e < 4; ++e) ov[e] = (y[ntl][e] * rstd * gw[e] + gb[e] + bon * vv[e]) * gg[e];
        *(v2u*)(((bf16*)(F.ws + WS_XN)) + (size_t)row * D + c0) = pack4(ov); }
}
__device__ __forceinline__ void postscan_rows(Frame& F, const InAcc& A) { for (int it = F.gw; it < (M / 16) * 8; it += F.NGW) postscan_item(F, A, 16 * (it >> 3), it & 7); }
__global__ void __launch_bounds__(NWAVES * 64, 2) fwd_kernel(Args args) {
    extern __shared__ __attribute__((aligned(16))) unsigned char lds[];
    Frame F;
    F.lds = (LAS unsigned char*)lds;
    F.MISC = (volatile LAS unsigned*)(F.lds + MISC_OFF);
    F.tid = threadIdx.x; F.lane = F.tid & 63; F.wave = __builtin_amdgcn_readfirstlane(F.tid >> 6);
    F.G = gridDim.x; F.gw = blockIdx.x * NWAVES + F.wave; F.NGW = F.G * NWAVES;
    unsigned char* ws = args.ws;
    F.ctl = (gu32*)(ws + WS_CTL);
    F.out = args.out; F.ws = ws;
    for (int u = F.tid; u < (LDS_BYTES - LDSCTL_OFF) / 4; u += NWAVES * 64) ((LAS unsigned*)(F.lds + LDSCTL_OFF))[u] = 0u;
    __syncthreads();
    if (F.tid == 0) { LAS unsigned long long* pt = (LAS unsigned long long*)(F.lds + PTRS_OFF);
#pragma unroll
        for (int i = 0; i < 30; ++i) pt[i] = (unsigned long long)args.in[i]; }
    __syncthreads();
#if USE_PTR_TABLE
    InAcc A; A.in.t = (LAS unsigned*)(F.lds + PTRS_OFF);
#else
    InAcc A;
#pragma unroll
    for (int i = 0; i < 30; ++i) A.in[i] = args.in[i];
#endif
    XcdBarrier bar; bar.bar = (unsigned*)(F.ctl + CW_BAR); bar.x = 0; bar.st = nullptr;
    if (MK_N_LAUNCHES == 1) bar = xcd_barrier_post((unsigned*)(F.ctl + CW_BAR), F.MISC + 8);
    const int lo = args.ph_lo, hi = args.ph_hi;
#ifndef PH_MASK
#define PH_MASK 0x7fff
#endif
#define IN(k) (((PH_MASK >> (k)) & 1) && lo <= (k) && (k) < hi)
#ifndef DUP_ID
#define DUP_ID -1
#endif
#define DUPN(id) ((DUP_ID == (id)) ? 2 : 1)
#define DUPBAR(r) do { if (r) xcd_barrier(bar); } while (0)
#define SEAM(k) do { if (IN(k) && IN((k) + 1)) xcd_barrier(bar); } while (0)
    float* const H = F.out;

    if (IN(0)) for (int rep_ = 0; rep_ < DUPN(0); ++rep_) { DUPBAR(rep_); p1_mod(F, A); p0_prologue(F, A); }
    SEAM(1);
    if (IN(2)) for (int rep_ = 0; rep_ < DUPN(2); ++rep_) { DUPBAR(rep_); norm_rows_bf16(F, A, A.in[0], A.in[1], 0, 1024, 0, 0, 0.f); } SEAM(2);
    if (IN(3)) for (int rep_ = 0; rep_ < DUPN(3); ++rep_) { DUPBAR(rep_); pg8::Gemm g{((bf16*)(F.ws + WS_XN)), ((bf16*)(F.ws + WS_GU1)), M, 2 * FF, D, D}; pg8::StaticOrder S; S.init(M, 2 * FF, D, F.G, (int)blockIdx.x); pg8::EpiSwiglu E{((bf16*)(F.ws + WS_ACT))};
        pg8::gemm_phase<pg8::EpiSwiglu, pg8::StaticOrder, PG8_ALIGN, PG8_SP2>(F.lds + RING_OFF, g, S, E); } SEAM(3);
    if (IN(4)) for (int rep_ = 0; rep_ < DUPN(4); ++rep_) { DUPBAR(rep_); pg8::Gemm g{((bf16*)(F.ws + WS_ACT)), ((bf16*)(F.ws + WS_DN1)), M, D, FF, FF}; pg8::SplitOrder S; S.init(MP, D, FF, 11, F.G, (int)blockIdx.x); pg8::EpiResid E{A.in[0], A.in[1], H, ((float*)(F.ws + WS_MOD)) + 2048, 0.5f, (float*)(F.ws + WS_SC)};
        pg8::gemm_phase<pg8::EpiResid, pg8::SplitOrder, PG8_ALIGN, PG8_SP2>(F.lds + RING_OFF, g, S, E); } SEAM(4);
    if (IN(5)) for (int rep_ = 0; rep_ < DUPN(5); ++rep_) { DUPBAR(rep_); norm_rows_bf16(F, A, H, A.in[1], 3072, 4096, 11, 2048, 0.5f); } SEAM(5);
    if (IN(6)) for (int rep_ = 0; rep_ < DUPN(6); ++rep_) { DUPBAR(rep_); pg8::Gemm g{((bf16*)(F.ws + WS_XN)), ((bf16*)(F.ws + WS_WIN)), M, PC, D, D}; pg8::StaticOrder S; S.init(M, PC, D, F.G, (int)blockIdx.x); pg8::EpiP E{((bf16*)(F.ws + WS_ACT)), ((bf16*)(F.ws + WS_PUV)), F.out + O_SHP, F.out + O_SHS};
        pg8::gemm_phase<pg8::EpiP, pg8::StaticOrder, PG8_ALIGN, PG8_SP2>(F.lds + RING_OFF, g, S, E); } SEAM(6);
    if (IN(7)) { for (int it = F.gw; it < M / 16; it += F.NGW) frag_item(F, A, 16 * it); lnv_rows(F, A); xcd_barrier(bar);
        for (int rep_ = 0; rep_ < DUPN(70); ++rep_) { DUPBAR(rep_); prep_all(F, A); } } SEAM(7);
    if (IN(8)) {
        for (int rep_ = 0; rep_ < DUPN(80); ++rep_) for (int u = blockIdx.x; u < 256; u += F.G) scan_prompt_unit(F, A, u);
        for (int rep_ = 0; rep_ < DUPN(81); ++rep_) for (int it = F.gw; it < 2048; it += F.NGW) { if (it < 1024) gmlp_item<false>(F, A, it >> 3, it & 7); else gmlp_item<true>(F, A, (it - 1024) >> 3, it & 7); }
        if (F.G != 256) for (int it = F.gw; it < 128 * 8 * 8; it += F.NGW) scan_sample_item(F, A, it);
    } SEAM(8);
    if (IN(9)) for (int rep_ = 0; rep_ < DUPN(9); ++rep_) { DUPBAR(rep_); postscan_rows(F, A); } SEAM(9);
    if (IN(10)) { pg8::Gemm g{((bf16*)(F.ws + WS_XN)), ((bf16*)(F.ws + WS_WOUT)), M, D, D, D}; pg8::SplitOrder S; S.init(MP, D, D, 4, F.G, (int)blockIdx.x); pg8::EpiResid E{H, H + (size_t)MP * D, H, ((float*)(F.ws + WS_MOD)) + 5120, 1.0f, (float*)(F.ws + WS_SC)};
        pg8::gemm_phase<pg8::EpiResid, pg8::SplitOrder, PG8_ALIGN, PG8_SP2>(F.lds + RING_OFF, g, S, E); } SEAM(10);
    if (IN(11)) for (int rep_ = 0; rep_ < DUPN(11); ++rep_) { DUPBAR(rep_); norm_rows_bf16(F, A, H, H + (size_t)MP * D, 6144, 7168, 4, 5120, 1.0f); } SEAM(11);
    if (IN(12)) { pg8::Gemm g{((bf16*)(F.ws + WS_XN)), ((bf16*)(F.ws + WS_GU2)), M, 2 * FF, D, D}; pg8::StaticOrder S; S.init(M, 2 * FF, D, F.G, (int)blockIdx.x); pg8::EpiSwiglu E{((bf16*)(F.ws + WS_ACT))};
        pg8::gemm_phase<pg8::EpiSwiglu, pg8::StaticOrder, PG8_ALIGN, PG8_SP2>(F.lds + RING_OFF, g, S, E); } SEAM(12);
    if (IN(13)) { pg8::Gemm g{((bf16*)(F.ws + WS_ACT)), ((bf16*)(F.ws + WS_DN2)), M, D, FF, FF}; pg8::SplitOrder S; S.init(MP, D, FF, 11, F.G, (int)blockIdx.x); pg8::EpiResid E{H, H + (size_t)MP * D, H, ((float*)(F.ws + WS_MOD)) + 8192, 0.5f, (float*)(F.ws + WS_SC)};
        pg8::gemm_phase<pg8::EpiResid, pg8::SplitOrder, PG8_ALIGN, PG8_SP2>(F.lds + RING_OFF, g, S, E); } SEAM(13);
    if (IN(14)) { final_norm_rows(F, A, 11, 8192, 0.5f); }
#undef IN
#undef SEAM
}

extern "C" void kernel_launch(void* const* d_in, const int* in_sizes, int n_in, void* d_out, int out_size, void* d_ws, size_t ws_size, hipStream_t stream) {
    static int grid = 0;
    if (grid == 0) {
        if (n_in != 30 || in_sizes[0] != MP * D || (size_t)out_size != O_END || ws_size < WS_END) { fprintf(stderr, "kernel_launch: unexpected problem shape / workspace (%d inputs, out %d, ws %zu); nothing launched\n", n_in, out_size, ws_size); grid = -1; return; }
        int dev = 0, cus = 0, per_cu = 0;
        if (hipGetDevice(&dev) != hipSuccess || hipDeviceGetAttribute(&cus, hipDeviceAttributeMultiprocessorCount, dev) != hipSuccess) { grid = -1; return; }
        if (hipFuncSetAttribute((const void*)fwd_kernel, hipFuncAttributeMaxDynamicSharedMemorySize, LDS_BYTES) != hipSuccess) { fprintf(stderr, "kernel_launch: hipFuncSetAttribute failed\n"); grid = -1; return; }
        if (hipOccupancyMaxActiveBlocksPerMultiprocessor(&per_cu, (const void*)fwd_kernel, NWAVES * 64, LDS_BYTES) != hipSuccess || per_cu < 1) { fprintf(stderr, "kernel_launch: occupancy query says %d blocks per CU\n", per_cu); }
        (void)hipGetLastError();
        grid = cus;
    }
    if (grid < 0) return;
    (void)hipMemsetAsync((char*)d_ws + WS_CTL, 0, CTL_ZERO_BYTES, stream);
    Args a{};
    for (int i = 0; i < 30; ++i) a.in[i] = (const float*)d_in[i];
    a.out = (float*)d_out; a.ws = (unsigned char*)d_ws;
    if (MK_N_LAUNCHES == 1) { a.ph_lo = 0; a.ph_hi = N_PHASES; hipLaunchKernelGGL(fwd_kernel, dim3(grid), dim3(NWAVES * 64), LDS_BYTES, stream, a); }
    else for (int p = 0; p < N_PHASES; ++p) { a.ph_lo = p; a.ph_hi = p + 1; hipLaunchKernelGGL(fwd_kernel, dim3(grid), dim3(NWAVES * 64), LDS_BYTES, stream, a); }
}
```

```cpp
#include <hip/hip_runtime.h>
#include <cstdio>
#include <cstdint>
namespace pg8 {
#define PG8_LAS __attribute__((address_space(3)))
typedef unsigned short bf16_t;
typedef short bf16x8 __attribute__((ext_vector_type(8)));
typedef float f32x4 __attribute__((ext_vector_type(4)));
typedef unsigned u32x4 __attribute__((ext_vector_type(4)));
constexpr int BM = 256, BK = 64, HALF = 128, HTB = HALF * BK * 2  , STAGE_BYTES = 8 * HTB, NXCD = 8, WGM = 8;

__host__ __device__ __forceinline__ int lds_byte(int r, int c) { const int st = (r >> 4) * 2 + (c >> 5), rr = r & 15, cc = c & 31, ob = rr * 64 + cc * 2; return st * 1024 + (ob ^ (((ob >> 9) & 1) << 5)); }
__host__ __device__ __forceinline__ void stage_rc(int b, int& R, int& C) { const int st = b / 1024, sb = b % 1024, swz = sb ^ (((sb >> 9) & 1) << 5); R = (st >> 1) * 16 + swz / 64; C = (st & 1) * 32 + (swz % 64) / 2; }
__host__ __device__ __forceinline__ int perm32(int rho) { const int n = rho >> 4, i = rho & 15; return 8 * (i >> 2) + 4 * n + (i & 3); }

struct Unit { int pm, pn, kb, nt, ks; };
struct Gemm { const bf16_t* A; const bf16_t* Bt; int M, N, K, ld; };

struct StaticOrder {
    int nM, nN, nwg, G, c, knt;
    __host__ __device__ void init(int M, int N, int K, int G_, int c_) { nM = M / BM; nN = N / BM; nwg = nM * nN; G = G_; c = c_; knt = K / BK; }
    __host__ __device__ __forceinline__ bool next(int i, Unit& u) const {
        const long L = (long)i * G + c; if (L >= nwg) return false;
        int wgid = (int)L; { const int q = nwg / NXCD, r = nwg % NXCD, xcd = wgid % NXCD, off = wgid / NXCD; wgid = (xcd < r ? xcd * (q + 1) : r * (q + 1) + (xcd - r) * q) + off; }
        const int nig = WGM * nN, gid = wgid / nig, fm = gid * WGM, gsz = (nM - fm) < WGM ? (nM - fm) : WGM;
        u.pm = fm + ((wgid % nig) % gsz); u.pn = (wgid % nig) / gsz; u.kb = 0; u.nt = knt; u.ks = -1; return true;
    }
    __device__ __forceinline__ void a_ready(const Unit&) const {}
    __device__ __forceinline__ void done(const Unit&) const {}
};
struct SplitOrder {
    StaticOrder so; int ns, c, G;
    __host__ __device__ void init(int Mmain, int N, int K, int ns_, int G_, int c_) { so.init(Mmain, N, K, G_, c_); ns = ns_; c = c_; G = G_; }
    __host__ __device__ __forceinline__ bool next(int i, Unit& u) const {
        const int nsub = 16 * ns, mine = c < nsub ? (nsub - 1 - c) / G + 1 : 0;
        const bool sub = i < mine; const int s = c + i * G;
        Unit m; m.pm = 0; m.pn = 0; m.kb = 0; m.nt = so.knt; m.ks = -1;
        const bool okm = so.next(sub ? 0 : i - mine, m);
        u.pm = sub ? so.nM + s / (4 * ns) : m.pm; u.pn = sub ? ((s / ns) & 3) : m.pn; u.ks = sub ? s % ns : -1; u.kb = sub ? (s % ns) * 4 * BK * 2 : 0; u.nt = sub ? 4 : so.knt;
        return sub || okm;
    }
    __device__ __forceinline__ void a_ready(const Unit&) const {}
    __device__ __forceinline__ void done(const Unit&) const {}
};
__device__ __forceinline__ unsigned cvt_pk_bf16(float lo, float hi) { unsigned r; asm volatile("v_cvt_pk_bf16_f32 %0, %1, %2" : "=v"(r) : "v"(lo), "v"(hi)); return r; }
typedef float f32x2 __attribute__((ext_vector_type(2)));
constexpr int ROWS_P = 16384, ROWS_ALL = 17408, DM = 1024, MODW = 9216, FFW = 2816, RCOLS = 1792;
__device__ __forceinline__ int seq_of_row(int r) { return r < ROWS_P ? (r >> 11) : 8 + ((r - ROWS_P) >> 3); }
__device__ __forceinline__ bool row_is_first(int r) { return r < ROWS_P ? ((r & 2047) == 0) : (((r - ROWS_P) & 7) == 0); }
__device__ __forceinline__ bool row_is_last(int r) { return r < ROWS_P ? ((r & 2047) == 2047) : (((r - ROWS_P) & 7) == 7); }
__device__ __forceinline__ float silu_f(float x) { return x * __builtin_amdgcn_rcpf(1.0f + __builtin_amdgcn_exp2f(-1.4426950408889634f * x)); }

struct EpiSwiglu {
    static constexpr bool PERM = true, AFTER_DRAIN = false;
    bf16_t* O;
    __device__ __forceinline__ void operator()(const f32x4 (&acc)[2][2][4][2], const Unit& u, int wr, int wc, int fr, int fq) const {
        const int row0 = u.pm * BM + wr * 64 + fr, col0 = u.pn * HALF + wc * 32 + 8 * fq;
#pragma unroll
        for (int ai = 0; ai < 2; ++ai)
#pragma unroll
            for (int m = 0; m < 4; ++m) {
                bf16_t* rowp = O + (size_t)(row0 + ai * HALF + m * 16) * FFW + col0;
                const f32x4 g0 = acc[ai][0][m][0], g1 = acc[ai][0][m][1], u0 = acc[ai][1][m][0], u1 = acc[ai][1][m][1];
                u32x4 w;
                w.x = cvt_pk_bf16(silu_f(g0[0]) * u0[0], silu_f(g0[1]) * u0[1]); w.y = cvt_pk_bf16(silu_f(g0[2]) * u0[2], silu_f(g0[3]) * u0[3]);
                w.z = cvt_pk_bf16(silu_f(g1[0]) * u1[0], silu_f(g1[1]) * u1[1]); w.w = cvt_pk_bf16(silu_f(g1[2]) * u1[2], silu_f(g1[3]) * u1[3]);
                *(u32x4*)rowp = w;
            }
    }
};
struct EpiResid {
    static constexpr bool PERM = false, AFTER_DRAIN = false;
    const float* resP; const float* resS; float* out; const float* gate; float coef; float* slab;
    __device__ __forceinline__ void operator()(const f32x4 (&acc)[2][2][4][2], const Unit& u, int wr, int wc, int fr, int fq) const {
        const int col0 = u.pn * BM + wc * 32 + 4 * fq;
        if (u.ks >= 0) {
#pragma unroll
            for (int ai = 0; ai < 2; ++ai)
#pragma unroll
                for (int m = 0; m < 4; ++m) { float* srow = slab + ((size_t)u.ks * 1024 + (size_t)(u.pm * BM + ai * HALF + wr * 64 + m * 16 + fr - ROWS_P)) * DM + col0;
#pragma unroll
                    for (int bj = 0; bj < 2; ++bj)
#pragma unroll
                        for (int n = 0; n < 2; ++n) *(f32x4*)(srow + bj * HALF + n * 16) = acc[ai][bj][m][n]; }
            return; }
#pragma unroll
        for (int ai = 0; ai < 2; ++ai)
#pragma unroll
            for (int m = 0; m < 4; ++m) {
                const int row = u.pm * BM + ai * HALF + wr * 64 + m * 16 + fr; const int s = seq_of_row(row);
                const float* rrow = (row < ROWS_P ? resP + (size_t)row * DM : resS + (size_t)(row - ROWS_P) * DM) + col0;
                float* orow = out + (size_t)row * DM + col0; const float* grow = gate + (size_t)s * MODW + col0;
#pragma unroll
                for (int bj = 0; bj < 2; ++bj)
#pragma unroll
                    for (int n = 0; n < 2; ++n) { const int off = bj * HALF + n * 16; const f32x4 r = *(const f32x4*)(rrow + off), g = *(const f32x4*)(grow + off);
                        *(f32x4*)(orow + off) = r + (g * coef) * acc[ai][bj][m][n]; }
            }
    }
};
struct EpiP {
    static constexpr bool PERM = true, AFTER_DRAIN = false;
    bf16_t* PB; bf16_t* PUV; float* shp; float* shs;
    __device__ __forceinline__ void operator()(const f32x4 (&acc)[2][2][4][2], const Unit& u, int wr, int wc, int fr, int fq) const {
        typedef unsigned u32x2 __attribute__((ext_vector_type(2)));
        const int row0 = u.pm * BM + wr * 64 + fr, col0 = u.pn * BM + wc * 32 + 8 * fq;
#pragma unroll
        for (int ai = 0; ai < 2; ++ai)
#pragma unroll
            for (int m = 0; m < 4; ++m) {
                const int row = row0 + ai * HALF + m * 16; const bool last = row_is_last(row);
#pragma unroll
                for (int bj = 0; bj < 2; ++bj) { const f32x4 v0 = acc[ai][bj][m][0], v1 = acc[ai][bj][m][1]; const int col = col0 + bj * HALF;
                    u32x4 w; w.x = cvt_pk_bf16(v0[0], v0[1]); w.y = cvt_pk_bf16(v0[2], v0[3]); w.z = cvt_pk_bf16(v1[0], v1[1]); w.w = cvt_pk_bf16(v1[2], v1[3]);
                    if (u.pn < 7) { bf16_t* p = PB + ((size_t)((row >> 4) * 448 + (col >> 2)) * 16 + (row & 15)) * 4; *(u32x2*)p = (u32x2){w.x, w.y}; *(u32x2*)(p + 64) = (u32x2){w.z, w.w};
                        if (last) { float* o = (row < ROWS_P ? shp + (size_t)(row >> 11) * RCOLS : shs + (size_t)((row - ROWS_P) >> 3) * RCOLS) + col; *(f32x4*)o = v0; *(f32x4*)(o + 4) = v1; } }
                    else *(u32x4*)(PUV + (size_t)row * 1024 + (col - RCOLS)) = w; }
            }
    }
};
template <class Epi, class Sched, bool ALIGN_EPI = false, bool SP2 = false>
__device__ __forceinline__ void gemm_phase(PG8_LAS unsigned char* lds, const Gemm g, const Sched& S, const Epi& E) {
    const int tid = threadIdx.x, wid = __builtin_amdgcn_readfirstlane(tid >> 6), lane = tid & 63, wr = wid >> 2, wc = wid & 3, fr = lane & 15, fq = lane >> 4;
    const int K = g.ld;
    unsigned voffA[2], voffB[2];
#pragma unroll
    for (int i = 0; i < 2; ++i) { int R, C; stage_rc(tid * 16 + i * 8192, R, C); const int Rb = Epi::PERM ? ((R & ~31) + perm32(R & 31)) : R;
        voffA[i] = (unsigned)(R * K + C) * 2u; voffB[i] = (unsigned)(Rb * K + C) * 2u; }
    const size_t kstep = (size_t)(BK * 2);
    const size_t hstep = (size_t)HALF * K * 2;
    const size_t tstep = 2 * hstep;
    const unsigned ldsw = (unsigned)wid * 1024u;
    const int aoff = lds_byte(wr * 64 + fr, fq * 8), boff = lds_byte(wc * 32 + fr, fq * 8);
#define PG8_SA(b, h) (((b) * 2 + (h)) * HTB)
#define PG8_SB(b, h) ((4 + (b) * 2 + (h)) * HTB)
#define PG8_STAGE(bufoff, gbase, voff) do { _Pragma("unroll") for (int _i = 0; _i < 2; ++_i) \
        __builtin_amdgcn_global_load_lds((const unsigned*)((const char*)(gbase) + (voff)[_i]), (PG8_LAS unsigned*)(lds + (bufoff) + ldsw + _i * 8192), 16, 0, 0); } while (0)
#define PG8_LDA(dst, b, h) do { _Pragma("unroll") for (int m = 0; m < 4; ++m) _Pragma("unroll") for (int k = 0; k < 2; ++k) dst[m][k] = *(const PG8_LAS bf16x8*)(lds + PG8_SA(b, h) + aoff + m * 2048 + k * 1024); } while (0)
#define PG8_LDB(dst, b, h) do { _Pragma("unroll") for (int n = 0; n < 2; ++n) _Pragma("unroll") for (int k = 0; k < 2; ++k) dst[n][k] = *(const PG8_LAS bf16x8*)(lds + PG8_SB(b, h) + boff + n * 2048 + k * 1024); } while (0)
#define PG8_MMA(ai, bj, At, Bt) do { __builtin_amdgcn_s_setprio(1); _Pragma("unroll") for (int m = 0; m < 4; ++m) _Pragma("unroll") for (int n = 0; n < 2; ++n) _Pragma("unroll") for (int k = 0; k < 2; ++k) \
        acc[ai][bj][m][n] = __builtin_amdgcn_mfma_f32_16x16x32_bf16(Bt[n][k], At[m][k], acc[ai][bj][m][n], 0, 0, 0); __builtin_amdgcn_s_setprio(0); } while (0)
#define PG8_WAIT_V(n) asm volatile("s_waitcnt vmcnt(" #n ")" ::: "memory")
#define PG8_WAIT_L(n) asm volatile("s_waitcnt lgkmcnt(" #n ")" ::: "memory")
#define PG8_BAR __builtin_amdgcn_s_barrier()
#define PG8_SCHED __builtin_amdgcn_sched_barrier(0)
    Unit cur, nxt; int ui = 0;
    if (!S.next(0, cur)) return;
    f32x4 acc[2][2][4][2];
#pragma unroll
    for (int a = 0; a < 2; ++a)
#pragma unroll
        for (int b = 0; b < 2; ++b)
#pragma unroll
            for (int m = 0; m < 4; ++m)
#pragma unroll
                for (int n = 0; n < 2; ++n) acc[a][b][m][n] = (f32x4){0.f, 0.f, 0.f, 0.f};
    bf16x8 At[4][2], B0[2][2], B1[2][2];
    const char* cA = (const char*)g.A + (size_t)cur.pm * tstep + cur.kb; const char* cB = (const char*)g.Bt + (size_t)cur.pn * tstep + cur.kb;
    S.a_ready(cur);
    if constexpr (SP2) {
        PG8_STAGE(PG8_SB(0, 0), cB, voffB); PG8_STAGE(PG8_SB(0, 1), cB + hstep, voffB); PG8_STAGE(PG8_SA(0, 0), cA, voffA); PG8_STAGE(PG8_SA(0, 1), cA + hstep, voffA);
        if (wr == 1) PG8_BAR;
        PG8_WAIT_V(2); PG8_BAR;
        PG8_STAGE(PG8_SB(1, 0), cB + kstep, voffB); PG8_STAGE(PG8_SA(1, 0), cA + kstep, voffA); PG8_STAGE(PG8_SB(1, 1), cB + hstep + kstep, voffB);
        PG8_WAIT_V(6); PG8_BAR;
    } else {
        PG8_STAGE(PG8_SB(0, 0), cB, voffB); PG8_STAGE(PG8_SA(0, 0), cA, voffA); PG8_STAGE(PG8_SB(0, 1), cB + hstep, voffB); PG8_STAGE(PG8_SA(0, 1), cA + hstep, voffA);
        if (wr == 1) PG8_BAR;
        PG8_WAIT_V(4); PG8_BAR;
        PG8_STAGE(PG8_SB(1, 0), cB + kstep, voffB); PG8_STAGE(PG8_SA(1, 0), cA + kstep, voffA); PG8_STAGE(PG8_SB(1, 1), cB + hstep + kstep, voffB);
        PG8_WAIT_V(6); PG8_BAR;
    }
    for (;;) {
        const bool has_next = S.next(ui + 1, nxt);
        const char* nA = has_next ? (const char*)g.A + (size_t)nxt.pm * tstep + nxt.kb : cA; const char* nB = has_next ? (const char*)g.Bt + (size_t)nxt.pn * tstep + nxt.kb : cB;
        const int nt = cur.nt;
        for (int t = 0; t < nt; t += 2) {
            const bool last = (t == nt - 2);
            const char* a1 = cA + (size_t)(t + 1) * kstep;
            const char* a2 = last ? nA : cA + (size_t)(t + 2) * kstep; const char* b2 = last ? nB : cB + (size_t)(t + 2) * kstep;
            const char* a3 = a2 + kstep; const char* b3 = b2 + kstep;
            if (last && has_next) S.a_ready(nxt);
            if constexpr (SP2) {
            PG8_LDB(B0, 0, 0); PG8_LDB(B1, 0, 1); PG8_SCHED; PG8_LDA(At, 0, 0); PG8_STAGE(PG8_SA(1, 1), a1 + hstep, voffA);
            PG8_WAIT_V(8); PG8_WAIT_L(0); PG8_BAR; PG8_MMA(0, 0, At, B0); PG8_MMA(0, 1, At, B1); PG8_BAR; PG8_SCHED;
            PG8_LDA(At, 0, 1); PG8_STAGE(PG8_SB(0, 0), b2, voffB); PG8_STAGE(PG8_SB(0, 1), b2 + hstep, voffB); PG8_STAGE(PG8_SA(0, 0), a2, voffA);
            PG8_WAIT_V(8); PG8_WAIT_L(0); PG8_BAR; PG8_MMA(1, 0, At, B0); PG8_MMA(1, 1, At, B1); PG8_BAR; PG8_SCHED;
            PG8_LDB(B0, 1, 0); PG8_LDB(B1, 1, 1); PG8_SCHED; PG8_LDA(At, 1, 0); PG8_STAGE(PG8_SA(0, 1), a2 + hstep, voffA);
            PG8_WAIT_V(8); PG8_WAIT_L(0); PG8_BAR; PG8_MMA(0, 0, At, B0); PG8_MMA(0, 1, At, B1); PG8_BAR; PG8_SCHED;
            PG8_LDA(At, 1, 1); PG8_STAGE(PG8_SB(1, 0), b3, voffB); PG8_STAGE(PG8_SB(1, 1), b3 + hstep, voffB); PG8_STAGE(PG8_SA(1, 0), a3, voffA);
            PG8_WAIT_V(8); PG8_WAIT_L(0); PG8_BAR; PG8_MMA(1, 0, At, B0); PG8_MMA(1, 1, At, B1); PG8_BAR; PG8_SCHED;
            } else {
            PG8_LDB(B0, 0, 0); PG8_SCHED; PG8_LDA(At, 0, 0); PG8_STAGE(PG8_SA(1, 1), a1 + hstep, voffA);
            PG8_WAIT_L(8); PG8_BAR; PG8_WAIT_L(0); PG8_MMA(0, 0, At, B0); PG8_BAR; PG8_SCHED;
            PG8_LDB(B1, 0, 1); PG8_STAGE(PG8_SB(0, 0), b2, voffB);
            PG8_BAR; PG8_WAIT_L(0); PG8_MMA(0, 1, At, B1); PG8_BAR;
            PG8_LDA(At, 0, 1); PG8_STAGE(PG8_SA(0, 0), a2, voffA);
            PG8_BAR; PG8_WAIT_L(0); PG8_MMA(1, 0, At, B0); PG8_BAR; PG8_SCHED;
            PG8_STAGE(PG8_SB(0, 1), b2 + hstep, voffB);
            PG8_WAIT_V(6); PG8_BAR; PG8_MMA(1, 1, At, B1); PG8_BAR;
            PG8_LDB(B0, 1, 0); PG8_SCHED; PG8_LDA(At, 1, 0); PG8_STAGE(PG8_SA(0, 1), a2 + hstep, voffA);
            PG8_WAIT_L(8); PG8_BAR; PG8_WAIT_L(0); PG8_MMA(0, 0, At, B0); PG8_BAR; PG8_SCHED;
            PG8_LDB(B1, 1, 1); PG8_STAGE(PG8_SB(1, 0), b3, voffB);
            PG8_BAR; PG8_WAIT_L(0); PG8_MMA(0, 1, At, B1); PG8_BAR;
            PG8_LDA(At, 1, 1); PG8_STAGE(PG8_SA(1, 0), a3, voffA);
            PG8_BAR; PG8_WAIT_L(0); PG8_MMA(1, 0, At, B0); PG8_BAR; PG8_SCHED;
            PG8_STAGE(PG8_SB(1, 1), b3 + hstep, voffB);
            PG8_WAIT_V(6); PG8_BAR; PG8_MMA(1, 1, At, B1); PG8_BAR;
            }
        }
        if constexpr (ALIGN_EPI) { if (wr == 0) PG8_BAR; }
        if constexpr (!Epi::AFTER_DRAIN) { E(acc, cur, wr, wc, fr, fq); S.done(cur); }
        if (!has_next) break;
#pragma unroll
        for (int a = 0; a < 2; ++a)
#pragma unroll
            for (int b = 0; b < 2; ++b)
#pragma unroll
                for (int m = 0; m < 4; ++m)
#pragma unroll
                    for (int n = 0; n < 2; ++n) acc[a][b][m][n] = (f32x4){0.f, 0.f, 0.f, 0.f};
        cur = nxt; cA = nA; cB = nB; ++ui;
        if constexpr (ALIGN_EPI) { if (wr == 1) PG8_BAR; }
    }
    PG8_WAIT_V(0);
    if constexpr (!ALIGN_EPI) { if (wr == 0) PG8_BAR; }
    PG8_BAR;
    if constexpr (Epi::AFTER_DRAIN) { E.fused(acc, cur, wr, wc, fr, fq, lds, wid, lane); S.done(cur); }
#undef PG8_SA
#undef PG8_SB
#undef PG8_STAGE
#undef PG8_LDA
#undef PG8_LDB
#undef PG8_MMA
#undef PG8_WAIT_V
#undef PG8_WAIT_L
#undef PG8_BAR
#undef PG8_SCHED
}
}
#ifndef PG8_SP2
#define PG8_SP2 true
#endif
#ifndef PG8_ALIGN
#define PG8_ALIGN true
#endif
#ifndef MK_N_LAUNCHES
#define MK_N_LAUNCHES 1
#endif
constexpr int NWAVES = 8;
constexpr int N_PHASES = 15;
constexpr int D = 1024, MP = 16384, MS = 1024, M = MP + MS, NSEQ = 136, FF = 2816, RC = 1792, PC = 2816, RW = 512, MODW = 9216;
constexpr float RMS_EPS = 1e-6f, LN_EPS = 1e-5f, GN_EPS = 64e-5f;
constexpr size_t O_Y = 0, O_SHP = 17825792, O_WKVP = 17840128, O_SHS = 18102272, O_WKVS = 18331648, O_CVS = 22525952, O_END = 23050240;
constexpr size_t MiB = 1u << 20;
constexpr size_t WS_CTL = 0, CTL_ZERO_BYTES = 1 * MiB;
constexpr size_t WS_GU1 = 1 * MiB, WS_DN1 = 12 * MiB, WS_WIN = 18 * MiB, WS_WOUT = 24 * MiB, WS_GU2 = 26 * MiB, WS_DN2 = 37 * MiB;
constexpr size_t WS_SMALL = 43 * MiB;
constexpr size_t WS_WLT = WS_SMALL, WS_ALT = WS_SMALL + 65536, WS_GLT = WS_SMALL + 131072, WS_WSB = WS_SMALL + 262144, WS_SILUC = WS_SMALL + 524288;
constexpr size_t WS_MOD = 44 * MiB;
constexpr size_t WS_BON = 49 * MiB;
constexpr size_t WS_FP = 331 * MiB;
constexpr size_t WS_XN = 50 * MiB;
constexpr size_t WS_ACT = 84 * MiB;
constexpr size_t WS_PUV = WS_ACT + 60 * MiB;
static_assert((size_t)M * 1792 * 2 <= 60 * MiB && WS_PUV + (size_t)M * 1024 * 2 <= 178 * MiB, "ws map puv");
constexpr size_t WS_SC = 178 * MiB, SC_STRIDE = 17 * MiB;
constexpr size_t WS_G = 280 * MiB;
constexpr size_t WS_Y = 297 * MiB;
constexpr size_t WS_FRG = 339 * MiB;
constexpr size_t WS_END = 348 * MiB;
static_assert(WS_FRG + (size_t)M * 256 * 2 <= WS_END, "ws map frg");
static_assert(WS_FP + (size_t)136 * 448 * 64 * 2 <= WS_END, "ws map fp");
static_assert(WS_DN1 - WS_GU1 >= (size_t)5632 * 1024 * 2 && WS_WIN - WS_DN1 >= (size_t)1024 * 2816 * 2 && WS_WOUT - WS_WIN >= (size_t)2816 * 1024 * 2 && WS_GU2 - WS_WOUT >= (size_t)1024 * 1024 * 2, "ws map a");
static_assert(WS_DN2 - WS_GU2 >= (size_t)5632 * 1024 * 2 && WS_SMALL - WS_DN2 >= (size_t)1024 * 2816 * 2 && WS_BON - WS_MOD >= (size_t)136 * 9216 * 4 && WS_XN - WS_BON >= (size_t)M * 8 * 4, "ws map b");
static_assert(WS_ACT - WS_XN >= (size_t)M * 1024 * 2 && WS_SC - WS_ACT >= (size_t)M * 2816 * 2 && SC_STRIDE >= (size_t)M * 512 * 2 && WS_G - WS_SC >= 6 * SC_STRIDE && WS_Y - WS_G >= (size_t)M * 512 * 2 && WS_END - WS_Y >= (size_t)M * 512 * 4, "ws map c");
constexpr int CW_TMO = 0, CW_CODE = 1, CW_BAR = 4096;
constexpr int RING_OFF = 0, RING_BYTES = 139264;
constexpr int LDSCTL_OFF = RING_BYTES, MISC_OFF = LDSCTL_OFF + 320;
constexpr int LDS_BYTES = 147456;
struct Args { const float* in[30]; float* out; unsigned char* ws; int ph_lo, ph_hi; };
constexpr int PTRS_OFF = MISC_OFF + 128;
#ifndef USE_PTR_TABLE
#define USE_PTR_TABLE 1
#endif
#if !USE_PTR_TABLE
struct InAcc { const float* in[30]; };
#else
struct InPtrs { __attribute__((address_space(3))) unsigned* t;
    __device__ __forceinline__ const float* operator[](int i) const { const unsigned lo = __builtin_amdgcn_readfirstlane(t[2 * i]), hi = __builtin_amdgcn_readfirstlane(t[2 * i + 1]); return (const float*)(const __attribute__((address_space(1))) float*)(((unsigned long long)hi << 32) | lo); } };
struct InAcc { InPtrs in; };
#endif
#define GAS __attribute__((address_space(1)))
#define LAS __attribute__((address_space(3)))
typedef unsigned short bf16;
typedef unsigned v4u __attribute__((ext_vector_type(4)));
typedef float f32x4 __attribute__((ext_vector_type(4)));
typedef short bf16x8 __attribute__((ext_vector_type(8)));
typedef GAS unsigned gu32;
typedef GAS unsigned long long gu64;
#define RLX_AGENT __ATOMIC_RELAXED, __HIP_MEMORY_SCOPE_AGENT
#define LDS_WAIT() asm volatile("s_waitcnt lgkmcnt(0)" ::: "memory")
#define VM_WAIT() asm volatile("s_waitcnt vmcnt(0)" ::: "memory")
__device__ __forceinline__ unsigned long long rt() { return __builtin_amdgcn_s_memrealtime(); }
__device__ __forceinline__ unsigned f2bf(float f) { unsigned u = __builtin_bit_cast(unsigned, f); return (u + 0x7fffu + ((u >> 16) & 1u)) >> 16; }
__device__ __forceinline__ unsigned pk2(float lo, float hi) { return f2bf(lo) | (f2bf(hi) << 16); }
#define XB_TMO      128
#define XB_XCNT(j)  (256  + 64 * (j))
#define XB_XSUB(j)  (1280 + 64 * (j))
#define XB_XGEN(j)  (2304 + 64 * (j))
#define XB_TOP      3328
#define XB_TOPGEN   3392
#define XCD_BAR_WORDS 3456
#define XB_SPIN_CAP (1u << 18)

__device__ __forceinline__ unsigned xb_ld(unsigned* p)              { return __hip_atomic_load(p, __ATOMIC_RELAXED, __HIP_MEMORY_SCOPE_AGENT); }
__device__ __forceinline__ unsigned xb_add(unsigned* p, unsigned v) { return __hip_atomic_fetch_add(p, v, __ATOMIC_RELAXED, __HIP_MEMORY_SCOPE_AGENT); }
__device__ __forceinline__ unsigned xb_xcc_id() { return (unsigned)__builtin_amdgcn_s_getreg((3 << 11) | 20) & 0xFu; }
#define XB_SPIN(cond, bar) do { unsigned _sp = 0; while (cond) { __builtin_amdgcn_s_sleep(1); \
    if ((++_sp & 255u) == 0u) { if (xb_ld(&(bar)[XB_TMO])) break; if (_sp > XB_SPIN_CAP) { atomicAdd(&(bar)[XB_TMO], 1u); break; } } } } while (0)

struct XcdBarrier {
    unsigned* bar; unsigned x;
    volatile LAS unsigned* st;
};

__device__ __forceinline__ XcdBarrier xcd_barrier_post(unsigned* bar, volatile LAS unsigned* st) {
    XcdBarrier b; b.bar = bar; b.x = xb_xcc_id(); b.st = st;
    if (threadIdx.x == 0) (void)xb_add(&bar[XB_XCNT(b.x)], 1u);
    return b;
}
__device__ __forceinline__ void xcd_barrier_complete(unsigned* bar, unsigned x, unsigned& nloc, unsigned& nx) {
    const unsigned G = gridDim.x * gridDim.y * gridDim.z;
    unsigned sum, cnt, mine, sp = 0u;
    for (;;) {
        sum = 0u; cnt = 0u; mine = 0u;
#pragma unroll
        for (unsigned j = 0; j < 16; ++j) { const unsigned c = xb_ld(&bar[XB_XCNT(j)]); sum += c; cnt += (c > 0u) ? 1u : 0u; mine = (j == x) ? c : mine; }
        if (sum == G) break;
        __builtin_amdgcn_s_sleep(1);
        if ((++sp & 255u) == 0u) { if (xb_ld(&bar[XB_TMO])) break; if (sp > XB_SPIN_CAP) { atomicAdd(&bar[XB_TMO], 1u); break; } }
    }
    nloc = mine > 0u ? mine : 1u; nx = cnt > 0u ? cnt : 1u;
}

__device__ __forceinline__ void xcd_barrier(const XcdBarrier& b) {
    asm volatile("s_waitcnt vmcnt(0)" ::: "memory");
    __syncthreads();
    if (threadIdx.x == 0) {
        unsigned* bar = b.bar;
        __builtin_amdgcn_s_waitcnt(0);
        unsigned nloc = b.st[0], nx = b.st[1];
        if (nloc == 0u) { xcd_barrier_complete(bar, b.x, nloc, nx); b.st[0] = nloc; b.st[1] = nx; }
        const unsigned old = xb_add(&bar[XB_XSUB(b.x)], 1u);
        const unsigned gen = old / nloc;
        if (old + 1u == (gen + 1u) * nloc) {
            __builtin_amdgcn_fence(__ATOMIC_RELEASE, "agent");
            asm volatile("s_waitcnt vmcnt(0)" ::: "memory");
            const unsigned og = xb_add(&bar[XB_TOP], 1u);
            const unsigned tg = og / nx;
            if (og + 1u == (tg + 1u) * nx) xb_add(&bar[XB_TOPGEN], 1u);
            else XB_SPIN(xb_ld(&bar[XB_TOPGEN]) == tg, bar);
            __builtin_amdgcn_fence(__ATOMIC_ACQUIRE, "agent");
            xb_add(&bar[XB_XGEN(b.x)], 1u);
            asm volatile("s_waitcnt vmcnt(0)" ::: "memory");
        } else {
            XB_SPIN(xb_ld(&bar[XB_XGEN(b.x)]) == gen, bar);
            __builtin_amdgcn_fence(__ATOMIC_ACQUIRE, "agent");
            asm volatile("s_waitcnt vmcnt(0)" ::: "memory");
        }
    }
    __syncthreads();
}
struct Frame {
    LAS unsigned char* lds;
    volatile LAS unsigned* MISC;
    gu32* ctl;
    int tid, lane, wave, gw, NGW, G;
    float* out; unsigned char* ws;
};
__device__ __forceinline__ float wave_sum(float v) {
#pragma unroll
    for (int o = 1; o < 64; o <<= 1) v += __shfl_xor(v, o);
    return v;
}
__device__ __forceinline__ float bf2f(unsigned short b) { return __uint_as_float((unsigned)b << 16); }
__device__ __forceinline__ void unpack8(v4u w, float* f) {
    f[0] = __uint_as_float(w.x << 16); f[1] = __uint_as_float(w.x & 0xffff0000u); f[2] = __uint_as_float(w.y << 16); f[3] = __uint_as_float(w.y & 0xffff0000u);
    f[4] = __uint_as_float(w.z << 16); f[5] = __uint_as_float(w.z & 0xffff0000u); f[6] = __uint_as_float(w.w << 16); f[7] = __uint_as_float(w.w & 0xffff0000u);
}
typedef unsigned v2u __attribute__((ext_vector_type(2)));
__device__ __forceinline__ void unpack4(v2u w, float* f) {
    f[0] = __uint_as_float(w.x << 16); f[1] = __uint_as_float(w.x & 0xffff0000u); f[2] = __uint_as_float(w.y << 16); f[3] = __uint_as_float(w.y & 0xffff0000u);
}
__device__ __forceinline__ v2u pack4(const float* f) { v2u w; w.x = pk2(f[0], f[1]); w.y = pk2(f[2], f[3]); return w; }
__device__ __forceinline__ v4u pack8(const float* f) { v4u w; w.x = pk2(f[0], f[1]); w.y = pk2(f[2], f[3]); w.z = pk2(f[4], f[5]); w.w = pk2(f[6], f[7]); return w; }
__device__ __forceinline__ bf16x8 as_bf16x8(v4u w) { return __builtin_bit_cast(bf16x8, w); }
__device__ __forceinline__ float sigmoid_f(float x) { return 1.0f / (1.0f + __expf(-x)); }
__device__ __forceinline__ float tanh_f(float x) { const float e = __expf(2.0f * x); return 1.0f - 2.0f / (e + 1.0f); }

__device__ __forceinline__ void transpose_item(const float* W, int K, int N, bf16* WT, int kb, int nb, int orow0, LAS float* scr, int lane) {
    const int k0 = 64 * kb, n0 = 32 * nb;
#pragma unroll 8
    for (int i = 0; i < 32; ++i) { const int kk = 2 * i + (lane >> 5); scr[kk * 33 + (lane & 31)] = W[(size_t)(k0 + kk) * N + n0 + (lane & 31)]; }
    LDS_WAIT(); asm volatile("" ::: "memory");
    const int c = lane & 7;
#pragma unroll
    for (int j = 0; j < 4; ++j) { const int n = (lane >> 3) + 8 * j; const LAS float* s = scr + (8 * c) * 33 + n;
        v4u o; o.x = pk2(s[0 * 33], s[1 * 33]); o.y = pk2(s[2 * 33], s[3 * 33]); o.z = pk2(s[4 * 33], s[5 * 33]); o.w = pk2(s[6 * 33], s[7 * 33]);
        *(GAS v4u*)(WT + (size_t)(orow0 + n) * K + k0 + 8 * c) = o; }
    LDS_WAIT(); asm volatile("" ::: "memory");
}
__device__ __forceinline__ int gu_row(int n0) { return n0 < FF ? 256 * (n0 >> 7) + (n0 & 127) : 256 * ((n0 - FF) >> 7) + 128 + ((n0 - FF) & 127); }
__device__ __forceinline__ void p0_prologue(Frame& F, const InAcc& A) {
    LAS float* scr = (LAS float*)(F.lds + RING_OFF + F.wave * 16384);
    constexpr int I_GU = 16 * 176, I_DN = 44 * 32, I_IN = 16 * 88, I_OUT = 16 * 32, I_L64 = 16, I_L128 = 32;
    constexpr int NITEMS = 2 * I_GU + 2 * I_DN + I_IN + I_OUT + 2 * I_L64 + I_L128;
    for (int it = F.gw; it < NITEMS; it += F.NGW) {
        int r = it;
        if (r < I_GU) { const int kb = r / 176, nb = r % 176; transpose_item(A.in[8], 1024, 5632, ((bf16*)(F.ws + WS_GU1)), kb, nb, gu_row(32 * nb), scr, F.lane); continue; } r -= I_GU;
        if (r < I_GU) { const int kb = r / 176, nb = r % 176; transpose_item(A.in[27], 1024, 5632, ((bf16*)(F.ws + WS_GU2)), kb, nb, gu_row(32 * nb), scr, F.lane); continue; } r -= I_GU;
        if (r < I_DN) { const int kb = r / 32, nb = r % 32; transpose_item(A.in[9], 2816, 1024, ((bf16*)(F.ws + WS_DN1)), kb, nb, 32 * nb, scr, F.lane); continue; } r -= I_DN;
        if (r < I_DN) { const int kb = r / 32, nb = r % 32; transpose_item(A.in[28], 2816, 1024, ((bf16*)(F.ws + WS_DN2)), kb, nb, 32 * nb, scr, F.lane); continue; } r -= I_DN;
        if (r < I_IN) { const int kb = r / 88, nb = r % 88; transpose_item(A.in[10], 1024, 2816, ((bf16*)(F.ws + WS_WIN)), kb, nb, 32 * nb, scr, F.lane); continue; } r -= I_IN;
        if (r < I_OUT) { const int kb = r / 32, nb = r % 32; transpose_item(A.in[26], 1024, 1024, ((bf16*)(F.ws + WS_WOUT)), kb, nb, 32 * nb, scr, F.lane); continue; } r -= I_OUT;
        if (r < I_L64) { transpose_item(A.in[13], 64, 512, ((bf16*)(F.ws + WS_WLT)), 0, r, 32 * r, scr, F.lane); continue; } r -= I_L64;
        if (r < I_L64) { transpose_item(A.in[15], 64, 512, ((bf16*)(F.ws + WS_ALT)), 0, r, 32 * r, scr, F.lane); continue; } r -= I_L64;
        { const int kb = r / 16, nb = r % 16; transpose_item(A.in[16], 128, 512, ((bf16*)(F.ws + WS_GLT)), kb, nb, 32 * nb, scr, F.lane); }
    }
    const int gt = F.gw * 64 + F.lane, NGT = F.NGW * 64;
    for (int i = gt; i < NSEQ * 448; i += NGT) { const int sq = i / 448, cg = i % 448;
        f32x4 v = {0.f, 0.f, 0.f, 0.f}; if (sq >= 8) v = *(const f32x4*)(A.in[2] + (size_t)(sq - 8) * RC + 4 * cg);
        v2u w; w.x = pk2(v.x, v.y); w.y = pk2(v.z, v.w); *(v2u*)((bf16*)(F.ws + WS_FP) + (size_t)i * 64) = w; }
    for (int i = gt; i < 8 * 128 * 64; i += NGT) { const int j = (i & 63) * 2, ii = (i >> 6) & 127;
        const float a = A.in[24][2 * (size_t)i], b = A.in[24][2 * (size_t)i + 1];
        ((unsigned*)((bf16*)(F.ws + WS_WSB)))[i] = pk2(j <= ii ? a : 0.f, (j + 1) <= ii ? b : 0.f); }
}
__device__ __forceinline__ void p1_mod(Frame& F, const InAcc& A) {
    const int l15 = F.lane & 15, q = F.lane >> 4;
    const float* w_ada = A.in[6]; const float* b_ada = A.in[7];
    const float* c_p = A.in[4]; const float* c_s = A.in[5];
    LAS f32x4* red = (LAS f32x4*)(F.lds + RING_OFF);
    for (int nt = blockIdx.x; nt < MODW / 16; nt += F.G) {
        const int n0 = 16 * nt, kb = 128 * F.wave + 8 * q;
        float wv[4][8];
        const float* wp = w_ada + (size_t)kb * MODW + n0 + l15;
#pragma unroll
        for (int ks = 0; ks < 4; ++ks) {
#pragma unroll
            for (int j = 0; j < 8; ++j) { wv[ks][j] = *wp; wp += MODW; asm volatile("" : "+v"(wp)); }
            wp += 24 * MODW; }
        f32x4 acc[9];
#pragma unroll
        for (int mt = 0; mt < 9; ++mt) acc[mt] = (f32x4){0.f, 0.f, 0.f, 0.f};
#pragma unroll 1
        for (int ks = 0; ks < 4; ++ks) {
            f32x4 raw[9][2];
#pragma unroll
            for (int mt = 0; mt < 9; ++mt) { const int sq = 16 * mt + l15; const int sc = sq < NSEQ ? sq : 0;
                const float* cr = (sc < 8 ? c_p + (size_t)sc * D : c_s + (size_t)(sc - 8) * D) + kb + 32 * ks; raw[mt][0] = *(const f32x4*)cr; raw[mt][1] = *(const f32x4*)(cr + 4); }
            __builtin_amdgcn_sched_barrier(0);
            const bf16x8 wf = as_bf16x8(pack8(wv[0]));
#pragma unroll
            for (int mt = 0; mt < 9; ++mt) { const bool ok = 16 * mt + l15 < NSEQ; float t[8];
#pragma unroll
                for (int e = 0; e < 4; ++e) { t[e] = ok ? pg8::silu_f(raw[mt][0][e]) : 0.f; t[4 + e] = ok ? pg8::silu_f(raw[mt][1][e]) : 0.f; }
                acc[mt] = __builtin_amdgcn_mfma_f32_16x16x32_bf16(wf, as_bf16x8(pack8(t)), acc[mt], 0, 0, 0); }
            __builtin_amdgcn_sched_barrier(0);
#pragma unroll
            for (int i = 0; i < 3; ++i)
#pragma unroll
                for (int j = 0; j < 8; ++j) wv[i][j] = wv[i + 1][j];
        }
#pragma unroll
        for (int mt = 0; mt < 9; ++mt) red[(F.wave * 9 + mt) * 64 + F.lane] = acc[mt];
        __syncthreads();
        const f32x4 bv = *(const f32x4*)(b_ada + n0 + 4 * q);
#pragma unroll
        for (int rr = 0; rr < 2; ++rr) { const int mt = F.wave + 8 * rr; if (mt < 9) { f32x4 s = bv;
#pragma unroll
                for (int w2 = 0; w2 < 8; ++w2) s += red[(w2 * 9 + mt) * 64 + F.lane];
                const int sq = 16 * mt + l15; if (sq < NSEQ) *(f32x4*)(((float*)(F.ws + WS_MOD)) + (size_t)sq * MODW + n0 + 4 * q) = s; } }
        __syncthreads();
    }
}
__device__ __forceinline__ const float* res_row(const float* pP, const float* pS, int row) { return row < MP ? pP + (size_t)row * D : pS + (size_t)(row - MP) * D; }
__device__ __forceinline__ void norm_rows_bf16(Frame& F, const InAcc& A, const float* srcP, const float* srcS, int sh_off, int sc_off, int ns, int g_off, float coef) {
    const float* MODp = (const float*)(F.ws + WS_MOD);
    for (int row = F.gw; row < M; row += F.NGW) {
        const f32x4* xr = (const f32x4*)res_row(srcP, srcS, row) + F.lane; const int s = pg8::seq_of_row(row);
        f32x4 v[4];
#pragma unroll
        for (int j = 0; j < 4; ++j) v[j] = xr[64 * j];
        if (ns > 0 && row >= MP) { const f32x4* sl = (const f32x4*)(F.ws + WS_SC) + (size_t)(row - MP) * (D / 4) + F.lane; const f32x4* gp = (const f32x4*)(MODp + (size_t)s * MODW + g_off) + F.lane;
            f32x4* hr = (f32x4*)(F.out + (size_t)row * D) + F.lane;
#pragma unroll
            for (int j = 0; j < 4; ++j) { f32x4 t = {0.f, 0.f, 0.f, 0.f}; for (int k = 0; k < ns; ++k) t += sl[(size_t)k * (1024 * D / 4) + 64 * j]; v[j] = v[j] + (gp[64 * j] * coef) * t; hr[64 * j] = v[j]; } }
        float ss = 0.f;
#pragma unroll
        for (int j = 0; j < 4; ++j) ss += (v[j].x * v[j].x + v[j].y * v[j].y) + (v[j].z * v[j].z + v[j].w * v[j].w);
        const float rstd = 1.0f / sqrtf(wave_sum(ss) * (1.0f / D) + RMS_EPS);
        const f32x4* sc = (const f32x4*)(MODp + (size_t)s * MODW + sc_off) + F.lane; const f32x4* sh = (const f32x4*)(MODp + (size_t)s * MODW + sh_off) + F.lane;
        v2u* o = (v2u*)(((bf16*)(F.ws + WS_XN)) + (size_t)row * D) + F.lane;
#pragma unroll
        for (int j = 0; j < 4; ++j) { const f32x4 a = sc[64 * j], bb = sh[64 * j]; const f32x4 r = v[j] * rstd * (a + 1.0f) + bb; float t[4] = {r.x, r.y, r.z, r.w}; o[64 * j] = pack4(t); }
    }
}
__device__ __forceinline__ void final_norm_rows(Frame& F, const InAcc& A, int ns, int g_off, float coef) {
    const float* MODp = (const float*)(F.ws + WS_MOD);
    for (int row = F.gw; row < M; row += F.NGW) {
        f32x4* xr = (f32x4*)(F.out + (size_t)row * D) + F.lane;
        f32x4 v[4];
#pragma unroll
        for (int j = 0; j < 4; ++j) v[j] = xr[64 * j];
        if (ns > 0 && row >= MP) { const int s = pg8::seq_of_row(row); const f32x4* sl = (const f32x4*)(F.ws + WS_SC) + (size_t)(row - MP) * (D / 4) + F.lane; const f32x4* gp = (const f32x4*)(MODp + (size_t)s * MODW + g_off) + F.lane;
#pragma unroll
            for (int j = 0; j < 4; ++j) { f32x4 t = {0.f, 0.f, 0.f, 0.f}; for (int k = 0; k < ns; ++k) t += sl[(size_t)k * (1024 * D / 4) + 64 * j]; v[j] = v[j] + (gp[64 * j] * coef) * t; } }
        float ss = 0.f;
#pragma unroll
        for (int j = 0; j < 4; ++j) ss += (v[j].x * v[j].x + v[j].y * v[j].y) + (v[j].z * v[j].z + v[j].w * v[j].w);
        const float rstd = 1.0f / sqrtf(wave_sum(ss) * (1.0f / D) + RMS_EPS);
        const f32x4* g = (const f32x4*)A.in[29] + F.lane;
#pragma unroll
        for (int j = 0; j < 4; ++j) xr[64 * j] = v[j] * rstd * g[64 * j];
    }
}
__device__ __forceinline__ unsigned dpp_shr1(unsigned x) { return (unsigned)__builtin_amdgcn_update_dpp(0, (int)x, 0x111, 0xf, 0xf, false); }
__device__ __forceinline__ size_t sc_off(int row, int c) { return ((size_t)((row >> 4) * 128 + (c >> 2)) * 16 + (row & 15)) * 4 + (c & 3); }
__device__ __forceinline__ void frag_item(Frame& F, const InAcc& A, int r0) {
    const int l15 = F.lane & 15, q = F.lane >> 4, row = r0 + l15, tile = r0 >> 4;
    const bf16* PB = (const bf16*)(F.ws + WS_ACT);
    const bf16* pcur = PB + ((size_t)tile * 448 * 16 + l15) * 4;
    const bool first = pg8::row_is_first(row);
    const bf16* fp = (const bf16*)(F.ws + WS_FP) + (size_t)pg8::seq_of_row(row) * 448 * 64;
    const bf16* pprv = PB + ((size_t)(tile > 0 ? tile - 1 : 0) * 448 * 16 + 15) * 4;
    const bf16* pb = first ? fp : (l15 == 0 ? pprv : pcur - 4);
    const float* mu = A.in[11];
    v2u lc[16], lp[16];
#pragma unroll
    for (int i = 0; i < 16; ++i) { const size_t o = (size_t)(384 + 8 * (i >> 1) + 2 * q + (i & 1)) * 64; lc[i] = *(const v2u*)(pcur + o); lp[i] = *(const v2u*)(pb + o); }
#pragma unroll
    for (int g = 0; g < 8; ++g) { const int col = 1536 + 32 * g + 8 * q; float cur[8], prv[8]; unpack4(lc[2 * g], cur); unpack4(lc[2 * g + 1], cur + 4); unpack4(lp[2 * g], prv); unpack4(lp[2 * g + 1], prv + 4);
        const f32x4 m0 = *(const f32x4*)(mu + col), m1 = *(const f32x4*)(mu + col + 4); const float mm[8] = {m0.x, m0.y, m0.z, m0.w, m1.x, m1.y, m1.z, m1.w};
        float t[8];
#pragma unroll
        for (int e = 0; e < 8; ++e) { const float x = cur[e] + (prv[e] - cur[e]) * mm[e]; t[e] = g < 2 ? tanh_f(x) : (g < 4 ? x : sigmoid_f(x)); }
        *(v4u*)((bf16*)(F.ws + WS_FRG) + ((size_t)((tile * 8 + g) * 4 + q) * 16 + l15) * 8) = pack8(t); }
}
__device__ __forceinline__ void prep_item(Frame& F, const InAcc& A, int r0, int h) {
    const int l15 = F.lane & 15, q = F.lane >> 4, row = r0 + l15, tile = r0 >> 4;
    const bf16* PB = (const bf16*)(F.ws + WS_ACT);
    const bf16* pcur = PB + ((size_t)tile * 448 * 16 + l15) * 4;
    const bool first = pg8::row_is_first(row);
    const bf16* fp = (const bf16*)(F.ws + WS_FP) + (size_t)pg8::seq_of_row(row) * 448 * 64;
    const bf16* pprv = PB + ((size_t)(tile > 0 ? tile - 1 : 0) * 448 * 16 + 15) * 4;
    const float* mu = A.in[11];
    v2u xc[4][3], xp[4][3];
    const bf16* pb = first ? fp : (l15 == 0 ? pprv : pcur - 4); constexpr int pmul = 64;
    bf16x8 fr[8];
#pragma unroll
    for (int g = 0; g < 8; ++g) fr[g] = *(const bf16x8*)((const bf16*)(F.ws + WS_FRG) + ((size_t)((tile * 8 + g) * 4 + q) * 16 + l15) * 8);
#pragma unroll
    for (int ntl = 0; ntl < 4; ++ntl)
#pragma unroll
        for (int sct = 0; sct < 3; ++sct) xc[ntl][sct] = *(const v2u*)(pcur + (size_t)(128 * sct + 16 * h + 4 * ntl + q) * 64);
#pragma unroll
    for (int ntl = 0; ntl < 4; ++ntl)
#pragma unroll
        for (int sct = 0; sct < 3; ++sct) xp[ntl][sct] = *(const v2u*)(pb + (size_t)(128 * sct + 16 * h + 4 * ntl + q) * pmul);
    v2u xm[4][3];
    const float* k_k = A.in[17];
    float ss = 0.f, bon = 0.f;
#pragma unroll
    for (int ntl = 0; ntl < 4; ++ntl)
#pragma unroll
        for (int sct = 0; sct < 3; ++sct) { const int col = 512 * sct + 64 * h + 16 * ntl + 4 * q; float cur[4], prv[4], x[4]; unpack4(xc[ntl][sct], cur); unpack4(xp[ntl][sct], prv);
            const f32x4 m0 = *(const f32x4*)(mu + col);
#pragma unroll
            for (int e = 0; e < 4; ++e) x[e] = cur[e] + (prv[e] - cur[e]) * m0[e];
            xm[ntl][sct] = pack4(x);
            if (sct == 1) { float xb[4]; unpack4(xm[ntl][sct], xb); const f32x4 kkv = *(const f32x4*)(k_k + 64 * h + 16 * ntl + 4 * q);
#pragma unroll
                for (int e = 0; e < 4; ++e) { const float kr = xb[e] * kkv[e]; ss += kr * kr; } } }
    __builtin_amdgcn_sched_barrier(0);
    ss += __shfl_xor(ss, 16); ss += __shfl_xor(ss, 32);
    const float inv = 1.0f / fmaxf(sqrtf(ss), 1e-12f);
    const LAS bf16x8* wl = (const LAS bf16x8*)(F.lds + RING_OFF) + F.lane;
    const LAS float* hp = (const LAS float*)(F.lds + RING_OFF + 32768);
#pragma unroll 1
    for (int ntl = 0; ntl < 4; ++ntl) {
        const int n0 = 64 * h + 16 * ntl, c0 = n0 + 4 * q;
        f32x4 aw = {0.f, 0.f, 0.f, 0.f}, aa = aw, ag = aw;
#pragma unroll
        for (int ks = 0; ks < 2; ++ks) {
            aw = __builtin_amdgcn_mfma_f32_16x16x32_bf16(wl[(2 * ntl + ks) * 64], fr[ks], aw, 0, 0, 0);
            aa = __builtin_amdgcn_mfma_f32_16x16x32_bf16(wl[(8 + 2 * ntl + ks) * 64], fr[2 + ks], aa, 0, 0, 0); }
#pragma unroll
        for (int ks = 0; ks < 4; ++ks)
            ag = __builtin_amdgcn_mfma_f32_16x16x32_bf16(wl[(16 + 4 * ntl + ks) * 64], fr[4 + ks], ag, 0, 0, 0);
        const int cl = 16 * ntl + 4 * q;
        const f32x4 w0v = *(const LAS f32x4*)(hp + cl), a0v = *(const LAS f32x4*)(hp + 64 + cl), kkv = *(const LAS f32x4*)(hp + 128 + cl), kav = *(const LAS f32x4*)(hp + 192 + cl), rkv = *(const LAS f32x4*)(hp + 256 + cl);
        float omd[4], km[4], gg[4], kk[4], bb[4], xrf[4], xkf[4]; unpack4(xm[0][0], xrf); unpack4(xm[0][1], xkf);
#pragma unroll
        for (int e = 0; e < 4; ++e) {
            const float z = -(w0v[e] + aw[e]);
            const float sp = z > 20.f ? z : __logf(1.0f + __expf(z));
            const float wlog = -sp - 0.5f;
            const float dec = __expf(-__expf(wlog));
            omd[e] = 1.0f - dec;
            const float a = sigmoid_f(a0v[e] + aa[e]);
            kk[e] = xkf[e] * kkv[e] * inv; bb[e] = kk[e] * a;
            km[e] = xkf[e] * (1.0f + (a - 1.0f) * kav[e]);
            bon += xrf[e] * km[e] * rkv[e];
            gg[e] = ag[e];
        }
        const size_t o = sc_off(row, c0);
        *(v2u*)(((bf16*)(F.ws + WS_SC)) + o) = xm[0][0]; *(v2u*)(((bf16*)(F.ws + (WS_SC + SC_STRIDE))) + o) = pack4(km); *(v2u*)(((bf16*)(F.ws + (WS_SC + 2 * SC_STRIDE))) + o) = xm[0][2];
        *(v2u*)(((bf16*)(F.ws + (WS_SC + 3 * SC_STRIDE))) + o) = pack4(kk); *(v2u*)(((bf16*)(F.ws + (WS_SC + 4 * SC_STRIDE))) + o) = pack4(bb);
        *(v2u*)(((bf16*)(F.ws + (WS_SC + 5 * SC_STRIDE))) + o) = pack4(omd); *(v2u*)(((bf16*)(F.ws + WS_G)) + o) = pack4(gg);
#pragma unroll
        for (int i = 0; i < 3; ++i)
#pragma unroll
            for (int e = 0; e < 3; ++e) xm[i][e] = xm[i + 1][e];
    }
    bon += __shfl_xor(bon, 16); bon += __shfl_xor(bon, 32);
    if (q == 0) ((float*)(F.ws + WS_BON))[(size_t)row * 8 + h] = bon;
}
__device__ __forceinline__ void prep_all(Frame& F, const InAcc& A) {
    const int w = blockIdx.x, h = w & 7; const int nslots = (F.G >> 3) * NWAVES;
    if (F.G & 7) return;
    { const bf16* WLT = (const bf16*)(F.ws + WS_WLT); const bf16* ALT = (const bf16*)(F.ws + WS_ALT); const bf16* GLT = (const bf16*)(F.ws + WS_GLT);
      LAS v4u* dst = (LAS v4u*)(F.lds + RING_OFF);
#pragma unroll
      for (int i = 0; i < 4; ++i) { const int p = F.tid + 512 * i, f = p >> 6, L = p & 63, l15 = L & 15, q = L >> 4;
          const bf16* src;
          if (f < 8) src = WLT + (size_t)(64 * h + 16 * (f >> 1) + l15) * 64 + 32 * (f & 1) + 8 * q;
          else if (f < 16) src = ALT + (size_t)(64 * h + 16 * ((f - 8) >> 1) + l15) * 64 + 32 * (f & 1) + 8 * q;
          else src = GLT + (size_t)(64 * h + 16 * ((f - 16) >> 2) + l15) * 128 + 32 * (f & 3) + 8 * q;
          dst[p] = *(const v4u*)src; }
      if (F.tid < 320) { const int a = F.tid >> 6, i = F.tid & 63; const float* src = a == 0 ? A.in[12] : a == 1 ? A.in[14] : a == 2 ? A.in[17] : a == 3 ? A.in[18] : A.in[19];
          ((LAS float*)(F.lds + RING_OFF + 32768))[F.tid] = src[64 * h + i]; }
      __syncthreads(); }
    for (int tt = (w >> 3) * NWAVES + F.wave; tt < M / 16; tt += nslots) prep_item(F, A, 16 * tt, h);
    __syncthreads();
}
__device__ __forceinline__ void lnv_rows(Frame& F, const InAcc& A) {
    for (int row = F.gw; row < M; row += F.NGW) {
        v4u* pv = (v4u*)(((bf16*)(F.ws + WS_PUV)) + (size_t)row * 1024 + 512) + F.lane;
        float x[8]; unpack8(*pv, x);
        float s = 0.f;
#pragma unroll
        for (int e = 0; e < 8; ++e) s += x[e];
        const float mean = wave_sum(s) * (1.0f / 512.0f); float qq = 0.f;
#pragma unroll
        for (int e = 0; e < 8; ++e) { x[e] -= mean; qq += x[e] * x[e]; }
        const float rstd = 1.0f / sqrtf(wave_sum(qq) * (1.0f / 512.0f) + LN_EPS);
        const f32x4 g0 = *(const f32x4*)(A.in[22] + 8 * F.lane), g1 = *(const f32x4*)(A.in[22] + 8 * F.lane + 4), b0 = *(const f32x4*)(A.in[23] + 8 * F.lane), b1 = *(const f32x4*)(A.in[23] + 8 * F.lane + 4);
        const float gg[8] = {g0.x, g0.y, g0.z, g0.w, g1.x, g1.y, g1.z, g1.w}, bb[8] = {b0.x, b0.y, b0.z, b0.w, b1.x, b1.y, b1.z, b1.w};
#pragma unroll
        for (int e = 0; e < 8; ++e) x[e] = x[e] * rstd * gg[e] + bb[e];
        *pv = pack8(x);
        if (row >= MP) { float* o = F.out + O_CVS + (size_t)(row - MP) * 512 + 8 * F.lane; *(f32x4*)o = (f32x4){x[0], x[1], x[2], x[3]}; *(f32x4*)(o + 4) = (f32x4){x[4], x[5], x[6], x[7]}; }
    }
}
template <bool SAMP> __device__ __forceinline__ void gmlp_item(Frame& F, const InAcc& A, int ci, int h) {
    const int l15 = F.lane & 15, q = F.lane >> 4;
    const int base = SAMP ? MP + 8 * ci : 128 * ci;
    const bf16* P = (const bf16*)(F.ws + WS_PUV);
    const bf16* WSB = (const bf16*)(F.ws + WS_WSB);
    const float* b_s = A.in[25];
    LAS unsigned short* tile = (LAS unsigned short*)(F.lds + RING_OFF + F.wave * 17408);
    constexpr int NIT = SAMP ? 1 : 8, NKS = SAMP ? 1 : 4;
#pragma unroll
    for (int i = 0; i < (SAMP ? 1 : 16); ++i) { const int r = 8 * i + (F.lane >> 3), c8 = (F.lane & 7) * 8;
        const v4u x = *(const v4u*)(P + (size_t)(base + r) * 1024 + 512 + h * 64 + c8);
        LAS unsigned* d = (LAS unsigned*)(tile + r * 66 + c8); d[0] = x.x; d[1] = x.y; d[2] = x.z; d[3] = x.w; }
    LDS_WAIT(); asm volatile("" ::: "memory");
#pragma unroll 1
    for (int dt = 0; dt < 4; ++dt) {
        bf16x8 vf[NKS];
#pragma unroll
        for (int ks = 0; ks < NKS; ++ks)
#pragma unroll
            for (int jj = 0; jj < 8; ++jj) { const int jr = 32 * ks + 8 * q + jj; vf[ks][jj] = (SAMP && jr >= 8) ? (short)0 : (short)tile[jr * 66 + 16 * dt + l15]; }
        const int cc = h * 64 + 16 * dt + 4 * q;
#pragma unroll
        for (int it = 0; it < NIT; ++it) {
            f32x4 acc = {0.f, 0.f, 0.f, 0.f};
#pragma unroll
            for (int ks = 0; ks < NKS; ++ks) if (ks <= (it >> 1))
                acc = __builtin_amdgcn_mfma_f32_16x16x32_bf16(vf[ks], *(const bf16x8*)(WSB + ((size_t)(h * 128 + 16 * it + l15)) * 128 + 32 * ks + 8 * q), acc, 0, 0, 0);
            const int i = 16 * it + l15;
            if (!SAMP || i < 8) { const int row = base + i; const float bs = b_s[h * 128 + i];
                float pu[4]; unpack4(*(const v2u*)(P + (size_t)row * 1024 + cc), pu);
                float o[4];
#pragma unroll
                for (int e = 0; e < 4; ++e) o[e] = pu[e] * (acc[e] + bs);
                *(v2u*)(((bf16*)(F.ws + WS_XN)) + (size_t)row * D + 512 + cc) = pack4(o); }
        }
    }
    LDS_WAIT(); asm volatile("" ::: "memory");
}
__device__ __forceinline__ float red16(float x) {
    x += __builtin_bit_cast(float, __builtin_amdgcn_update_dpp(0, __builtin_bit_cast(int, x), 0x128, 0xf, 0xf, false));
    x += __builtin_bit_cast(float, __builtin_amdgcn_update_dpp(0, __builtin_bit_cast(int, x), 0x124, 0xf, 0xf, false));
    x += __builtin_bit_cast(float, __builtin_amdgcn_update_dpp(0, __builtin_bit_cast(int, x), 0x122, 0xf, 0xf, false));
    x += __builtin_bit_cast(float, __builtin_amdgcn_update_dpp(0, __builtin_bit_cast(int, x), 0x121, 0xf, 0xf, false));
    return x;
}
typedef float f32x2 __attribute__((ext_vector_type(2)));
#define DPP_ROR(x, n) __builtin_bit_cast(float, __builtin_amdgcn_update_dpp(0, __builtin_bit_cast(int, (x)), 0x120 + (n), 0xf, 0xf, false))
__device__ __forceinline__ void red16x2(float& a, float& b) {
    a += DPP_ROR(a, 8); b += DPP_ROR(b, 8); a += DPP_ROR(a, 4); b += DPP_ROR(b, 4); a += DPP_ROR(a, 2); b += DPP_ROR(b, 2); a += DPP_ROR(a, 1); b += DPP_ROR(b, 1);
}
__device__ __forceinline__ float wkv_step(f32x4& S, const f32x4 w, const f32x4 kk, const f32x4 bb, const f32x4 k, const f32x4 r, const float vv, float& ypend) {
    f32x2 Sa = {S.x, S.y}, Sb = {S.z, S.w};
    f32x2 p = Sa * (f32x2){kk.x, kk.y}; p = Sb * (f32x2){kk.z, kk.w} + p;
    float d = p.x + p.y;
    red16x2(d, ypend);
    const f32x2 v2 = {vv, vv};
    f32x2 Ta = (f32x2){k.x, k.y} * v2, Tb = (f32x2){k.z, k.w} * v2;
    Ta = Sa * (f32x2){w.x, w.y} + Ta; Tb = Sb * (f32x2){w.z, w.w} + Tb;
    const f32x2 nd = {-d, -d};
    Sa = (f32x2){bb.x, bb.y} * nd + Ta; Sb = (f32x2){bb.z, bb.w} * nd + Tb;
    f32x2 yv = Sa * (f32x2){r.x, r.y}; yv = Sb * (f32x2){r.z, r.w} + yv;
    S = (f32x4){Sa.x, Sa.y, Sb.x, Sb.y};
    return yv.x + yv.y;
}
__device__ __forceinline__ void scan_sample_item(Frame& F, const InAcc& A, int it) {
    const int sbh = it >> 3, rp = it & 7, sb = sbh >> 3, h = sbh & 7, j = F.lane & 15, v0 = 8 * rp + (F.lane >> 4), v1 = v0 + 4;
    const size_t so0 = ((size_t)sbh * 64 + v0) * 64 + 4 * j, so1 = so0 + 4 * 64;
    f32x4 S0 = *(const f32x4*)(A.in[3] + so0), S1 = *(const f32x4*)(A.in[3] + so1);
    const size_t ro0 = (size_t)(MP + 8 * sb) * RW + h * 64;
    const bf16* scr = (const bf16*)(F.ws + WS_SC);
    v2u lw[8], lkk[8], lbb[8], lk[8], lr[8]; unsigned short lv0[8], lv1[8];
#pragma unroll
    for (int t = 0; t < 8; ++t) { const int row = MP + 8 * sb + t; const size_t ro = sc_off(row, h * 64 + 4 * j);
        lw[t] = *(const v2u*)(scr + 5 * (SC_STRIDE / 2) + ro); lkk[t] = *(const v2u*)(scr + 3 * (SC_STRIDE / 2) + ro); lbb[t] = *(const v2u*)(scr + 4 * (SC_STRIDE / 2) + ro);
        lk[t] = *(const v2u*)(scr + 1 * (SC_STRIDE / 2) + ro); lr[t] = *(const v2u*)(scr + ro); lv0[t] = scr[2 * (SC_STRIDE / 2) + sc_off(row, h * 64 + v0)]; lv1[t] = scr[2 * (SC_STRIDE / 2) + sc_off(row, h * 64 + v1)]; }
    float yk0 = 0.f, yk1 = 0.f;
#pragma unroll
    for (int t = 0; t < 8; ++t) {
        float w[4], kk[4], bb[4], k[4], r[4];
        unpack4(lw[t], w); unpack4(lkk[t], kk); unpack4(lbb[t], bb); unpack4(lk[t], k); unpack4(lr[t], r);
        const f32x4 w4 = {1.f - w[0], 1.f - w[1], 1.f - w[2], 1.f - w[3]}, kk4 = {kk[0], kk[1], kk[2], kk[3]}, bb4 = {bb[0], bb[1], bb[2], bb[3]}, k4 = {k[0], k[1], k[2], k[3]}, r4 = {r[0], r[1], r[2], r[3]};
        float dm0 = 0.f; const float y0 = red16(wkv_step(S0, w4, kk4, bb4, k4, r4, bf2f(lv0[t]), dm0));
        float dm1 = 0.f; const float y1 = red16(wkv_step(S1, w4, kk4, bb4, k4, r4, bf2f(lv1[t]), dm1));
        yk0 = (j == t) ? y0 : yk0; yk1 = (j == t) ? y1 : yk1;
    }
    if (j < 8) { float* yg = ((float*)(F.ws + WS_Y)) + ro0 + (size_t)j * RW; yg[v0] = yk0; yg[v1] = yk1; }
    *(f32x4*)(F.out + O_WKVS + so0) = S0; *(f32x4*)(F.out + O_WKVS + so1) = S1;
}
typedef short bf16x4 __attribute__((ext_vector_type(4)));
#define PADV(x) asm volatile("s_nop 15\n\ts_nop 15" : "+v"(x))
#define MFMA16(a, b, c) __builtin_amdgcn_mfma_f32_16x16x16bf16_1k((a), (b), (c), 0, 0, 0)
#define MFMA32(a, b, c) __builtin_amdgcn_mfma_f32_16x16x32_bf16((a), (b), (c), 0, 0, 0)
__device__ __forceinline__ bf16x4 cvt4(const f32x4 v) { v2u w; w.x = pk2(v.x, v.y); w.y = pk2(v.z, v.w); return __builtin_bit_cast(bf16x4, w); }
__device__ __forceinline__ bf16x8 cvt8(const f32x4 a, const f32x4 b) { v4u w; w.x = pk2(a.x, a.y); w.y = pk2(a.z, a.w); w.z = pk2(b.x, b.y); w.w = pk2(b.z, b.w); return __builtin_bit_cast(bf16x8, w); }
#define DPP_SHR(x, n, fill) __builtin_bit_cast(float, __builtin_amdgcn_update_dpp(__builtin_bit_cast(int, (float)(fill)), __builtin_bit_cast(int, (x)), 0x110 + (n), 0xf, 0xf, false))
#ifndef CK_AHEAD
#define CK_AHEAD 7
#endif
#ifndef CK_DUMMY_CUT
#define CK_DUMMY_CUT 0
#endif
constexpr int CK_SLOT_B = 11264, CK_NSLOT = 8, CK_SCR_OFF = CK_SLOT_B * CK_NSLOT, CK_SCR_B = 4096, CK_FLAG_OFF = CK_SCR_OFF + 7 * CK_SCR_B;
constexpr int CK_KH = 0, CK_RH = 2048, CK_AKK = 4096, CK_AKR = 4608, CK_ABR = 5120, CK_TM = 5632, CK_VM = 6144, CK_KB = 6656, CK_BB = 8704, CK_GC = 10752;
static_assert(CK_FLAG_OFF + 128 <= RING_BYTES, "chunked scan LDS map");
template <int CUT = 0> __device__ __forceinline__ void chunk_prepare(Frame& F, int h, int qtr, int t0, LAS unsigned char* slot, LAS unsigned short* scr) {
    const int l15 = F.lane & 15, q = F.lane >> 4, row = t0 + l15;
    const bf16* sc = (const bf16*)(F.ws + WS_SC);
    float w[16], kk[16], bb[16], kv[16], r[16];
#pragma unroll
    for (int p = 0; p < 4; ++p) { const size_t o = sc_off(row, 64 * h + 4 * (8 * (p >> 1) + 4 * (p & 1) + q));
        unpack4(*(const v2u*)(sc + 5 * (SC_STRIDE / 2) + o), w + 4 * p); unpack4(*(const v2u*)(sc + 3 * (SC_STRIDE / 2) + o), kk + 4 * p); unpack4(*(const v2u*)(sc + 4 * (SC_STRIDE / 2) + o), bb + 4 * p);
        unpack4(*(const v2u*)(sc + 1 * (SC_STRIDE / 2) + o), kv + 4 * p); unpack4(*(const v2u*)(sc + o), r + 4 * p); }
    unsigned short vraw[4];
#pragma unroll
    for (int jj = 0; jj < 4; ++jj) vraw[jj] = sc[2 * (SC_STRIDE / 2) + sc_off(t0 + 4 * q + jj, 64 * h + 16 * qtr + l15)];
    float kh[16], rh[16], kt[16], bt[16], Kb[16], Bb[16];
#pragma unroll
    for (int c = 0; c < 16; ++c) { float g = 1.0f - w[c];
        g *= DPP_SHR(g, 1, 1.0f); g *= DPP_SHR(g, 2, 1.0f); g *= DPP_SHR(g, 4, 1.0f); g *= DPP_SHR(g, 8, 1.0f);
        float gC = 1.0f - w[c]; gC *= DPP_ROR(gC, 8); gC *= DPP_ROR(gC, 4); gC *= DPP_ROR(gC, 2); gC *= DPP_ROR(gC, 1);
        const float ge = DPP_SHR(g, 1, 1.0f), inv = 1.0f / g;
        kh[c] = ge * kk[c]; rh[c] = g * r[c]; kt[c] = kv[c] * inv; bt[c] = bb[c] * inv; Kb[c] = kt[c] * gC; Bb[c] = -(bt[c] * gC);
        w[c] = gC; }
    if (CUT == 1) { float s_ = 0.f;
#pragma unroll
        for (int c = 0; c < 16; ++c) s_ += kh[c] + rh[c] + kt[c] + bt[c] + Kb[c] + Bb[c] + w[c]; if (s_ == 1.2345f) *(LAS float*)slot = s_ + (float)vraw[0] + (float)vraw[3]; return; }
    const bf16x8 khf0 = as_bf16x8(pack8(kh)), khf1 = as_bf16x8(pack8(kh + 8)), rhf0 = as_bf16x8(pack8(rh)), rhf1 = as_bf16x8(pack8(rh + 8));
    const bf16x8 ktf0 = as_bf16x8(pack8(kt)), ktf1 = as_bf16x8(pack8(kt + 8)), btf0 = as_bf16x8(pack8(bt)), btf1 = as_bf16x8(pack8(bt + 8));
    const f32x4 z4 = {0.f, 0.f, 0.f, 0.f};
    f32x4 Akk = MFMA32(ktf1, khf1, MFMA32(ktf0, khf0, z4)), Abk = MFMA32(btf1, khf1, MFMA32(btf0, khf0, z4)), AbkT = MFMA32(khf1, btf1, MFMA32(khf0, btf0, z4));
    f32x4 Akr = MFMA32(ktf1, rhf1, MFMA32(ktf0, rhf0, z4)), Abr = MFMA32(btf1, rhf1, MFMA32(btf0, rhf0, z4));
    PADV(Akk); PADV(Abk); PADV(AbkT); PADV(Akr); PADV(Abr);
    f32x4 Id;
#pragma unroll
    for (int e = 0; e < 4; ++e) { const int rr = 4 * q + e;
        Akk[e] = rr < l15 ? Akk[e] : 0.f; Abk[e] = rr < l15 ? Abk[e] : 0.f; AbkT[e] = l15 < rr ? AbkT[e] : 0.f;
        Akr[e] = rr <= l15 ? Akr[e] : 0.f; Abr[e] = rr <= l15 ? -Abr[e] : 0.f; Id[e] = rr == l15 ? 1.f : 0.f; }
#define CK_MM(Xt, Y) MFMA16(cvt4(Xt), cvt4(Y), z4)
    f32x4 A2 = CK_MM(AbkT, Abk), A2t = CK_MM(Abk, AbkT); PADV(A2); PADV(A2t);
    f32x4 A4 = CK_MM(A2t, A2), A4t = CK_MM(A2, A2t); PADV(A4); PADV(A4t);
    f32x4 A8 = CK_MM(A4t, A4); PADV(A8);
    f32x4 P = Id + A8; P = CK_MM(Id + A4t, P); PADV(P); P = CK_MM(Id + A2t, P); PADV(P); P = CK_MM(Id - AbkT, P); PADV(P);
#undef CK_MM
    if (CUT == 2) { const f32x4 s_ = P + Akk + Akr + Abr; if (s_[0] + s_[1] + s_[2] + s_[3] == 1.2345f) *(LAS float*)slot = s_[0] + Kb[0] + Bb[0] + w[0] + (float)vraw[0]; return; }
    LAS bf16x8* s8 = (LAS bf16x8*)slot; s8[F.lane] = khf0; s8[64 + F.lane] = khf1; s8[128 + F.lane] = rhf0; s8[192 + F.lane] = rhf1;
    LAS bf16x4* s4 = (LAS bf16x4*)slot;
    s4[CK_AKK / 8 + F.lane] = cvt4(Akk); s4[CK_AKR / 8 + F.lane] = cvt4(Akr); s4[CK_ABR / 8 + F.lane] = cvt4(Abr); s4[CK_TM / 8 + F.lane] = cvt4(P);
    { bf16x4 vm; vm[0] = (short)vraw[0]; vm[1] = (short)vraw[1]; vm[2] = (short)vraw[2]; vm[3] = (short)vraw[3]; s4[CK_VM / 8 + F.lane] = vm; }
    if (CUT == 3) { if (Kb[0] + Bb[0] + w[0] == 1.2345f) *(LAS float*)slot = Kb[1]; LDS_WAIT(); return; }
    LAS unsigned short* mk = scr; LAS unsigned short* mb = scr + 1024;
#pragma unroll
    for (int p = 0; p < 4; ++p) { const int col = 32 * (p >> 1) + 16 * (p & 1) + 4 * q; *(LAS v2u*)(mk + l15 * 64 + col) = pack4(Kb + 4 * p); *(LAS v2u*)(mb + l15 * 64 + col) = pack4(Bb + 4 * p); }
    LDS_WAIT(); asm volatile("" ::: "memory");
#pragma unroll
    for (int nt = 0; nt < 4; ++nt) { bf16x4 a, bq;
#pragma unroll
        for (int jj = 0; jj < 4; ++jj) { a[jj] = (short)mk[(4 * q + jj) * 64 + 16 * nt + l15]; bq[jj] = (short)mb[(4 * q + jj) * 64 + 16 * nt + l15]; }
        s4[CK_KB / 8 + nt * 64 + F.lane] = a; s4[CK_BB / 8 + nt * 64 + F.lane] = bq; }
    if (l15 == 15) {
#pragma unroll
        for (int p = 0; p < 4; ++p) *(LAS f32x4*)(slot + CK_GC + 4 * (32 * (p >> 1) + 16 * (p & 1) + 4 * q)) = (f32x4){w[4 * p], w[4 * p + 1], w[4 * p + 2], w[4 * p + 3]}; }
    LDS_WAIT(); asm volatile("" ::: "memory");
}
#ifdef CK_DUMMY_MODE
__device__ __forceinline__ void dummy_work(Frame& F, int h, int t0, LAS unsigned char* area) {
    const f32x4 z4 = {0.f, 0.f, 0.f, 0.f}; f32x4 acc = z4; float sink = 0.f;
#if CK_DUMMY_MODE == 1
    bf16x8 a; for (int j = 0; j < 8; ++j) a[j] = (short)(0x3f80 + F.lane + j);
    for (int i = 0; i < 64; ++i) { acc = MFMA32(a, a, acc); asm volatile("" : "+v"(acc)); }
    sink = acc[0];
#elif CK_DUMMY_MODE == 2
    LAS f32x4* p = (LAS f32x4*)area + F.lane;
#pragma unroll 1
    for (int i = 0; i < 40; ++i) { LAS f32x4* pw = p + 64 * (i & 7); *pw = (f32x4){(float)i, 1.f, 2.f, 3.f}; asm volatile("s_waitcnt lgkmcnt(0)" ::: "memory"); const LAS f32x4* pr = p + 64 * ((i + 3) & 7); acc += *pr; }
    sink = acc[0];
#elif CK_DUMMY_MODE == 3
    const bf16* sc = (const bf16*)(F.ws + WS_SC);
    for (int i = 0; i < 24; ++i) { float t[4]; unpack4(*(const v2u*)(sc + (size_t)(i % 6) * (SC_STRIDE / 2) + sc_off(t0 + (F.lane & 15), 64 * h + 4 * ((F.lane >> 4) + 4 * (i & 3)))), t); sink += t[0] + t[3]; }
#elif CK_DUMMY_MODE == 4
    float g = 1.0f + 0.001f * F.lane;
    for (int i = 0; i < 200; ++i) { g *= DPP_SHR(g, 1, 1.0f); g = g * 0.999f + DPP_ROR(g, 4) * 0.001f; asm volatile("" : "+v"(g)); }
    sink = g;
#endif
    if (sink == 123456.789f) ((LAS float*)area)[F.lane] = sink;
}
#endif
__device__ __forceinline__ void scan_prompt_unit(Frame& F, const InAcc& A, int unit) {
    const int bh = unit >> 2, qtr = unit & 3, b = bh >> 3, h = bh & 7;
    const int rowbase = b * 2048;
    LAS unsigned char* const base = F.lds + RING_OFF;
    volatile LAS int* flg = (volatile LAS int*)(base + CK_FLAG_OFF);
    if (F.tid < 32) flg[F.tid] = 0;
    __syncthreads();
    const int l15 = F.lane & 15, q = F.lane >> 4;
#ifdef CK_SYNC_DEBUG
    {
        f32x4 S[4] = {{0.f, 0.f, 0.f, 0.f}, {0.f, 0.f, 0.f, 0.f}, {0.f, 0.f, 0.f, 0.f}, {0.f, 0.f, 0.f, 0.f}};
        const f32x4 z4 = {0.f, 0.f, 0.f, 0.f};
        float* yg = (float*)(F.ws + WS_Y) + (size_t)rowbase * RW + h * 64 + 16 * qtr + l15;
        LAS unsigned short* scr = (LAS unsigned short*)(base + CK_SCR_OFF + (F.wave > 0 ? F.wave - 1 : 0) * CK_SCR_B);
        for (int c = 0; c < 128; ++c) {
            if (F.wave == 1 + (c % 7)) chunk_prepare(F, h, qtr, rowbase + 16 * c, base + (c & 7) * CK_SLOT_B, scr);
            __syncthreads();
#ifdef CK_DUMMY_MODE
            if (F.wave == 2 + (c % 6)) dummy_work(F, h, rowbase + 16 * c, base + CK_FLAG_OFF + 256);
#else
            if (F.wave == 2 + (c % 6)) chunk_prepare<CK_DUMMY_CUT>(F, h, qtr, rowbase + 16 * c, base + CK_FLAG_OFF + 256, scr);
#endif
            if (F.wave == 0) {
                const LAS unsigned char* slot = base + (c & 7) * CK_SLOT_B;
                const LAS bf16x8* s8 = (const LAS bf16x8*)slot; const LAS bf16x4* s4 = (const LAS bf16x4*)slot;
                const bf16x8 kh0 = s8[F.lane], kh1 = s8[64 + F.lane], rh0 = s8[128 + F.lane], rh1 = s8[192 + F.lane];
                const bf16x4 akk = s4[CK_AKK / 8 + F.lane], akr = s4[CK_AKR / 8 + F.lane], nabr = s4[CK_ABR / 8 + F.lane], tm = s4[CK_TM / 8 + F.lane], vm = s4[CK_VM / 8 + F.lane];
                const bf16x8 sb0 = cvt8(S[0], S[1]), sb1 = cvt8(S[2], S[3]);
                f32x4 GT = MFMA32(kh0, sb0, z4); GT = MFMA32(kh1, sb1, GT); GT = MFMA16(akk, vm, GT);
                const f32x4 DT = MFMA16(tm, cvt4(GT), z4);
                const bf16x4 db = cvt4(DT);
                f32x4 YT = MFMA32(rh0, sb0, z4); YT = MFMA32(rh1, sb1, YT); YT = MFMA16(akr, vm, YT); YT = MFMA16(nabr, db, YT);
#pragma unroll
                for (int nt = 0; nt < 4; ++nt) { const f32x4 g = *(const LAS f32x4*)(slot + CK_GC + 4 * (16 * nt + 4 * q));
                    const bf16x4 kb = s4[CK_KB / 8 + nt * 64 + F.lane], nbb = s4[CK_BB / 8 + nt * 64 + F.lane];
                    S[nt] = MFMA16(nbb, db, MFMA16(kb, vm, S[nt] * g)); }
#pragma unroll
                for (int e = 0; e < 4; ++e) yg[(size_t)(16 * c + 4 * q + e) * RW] = YT[e];
            }
            __syncthreads();
        }
        if (F.wave == 0) {
#pragma unroll
            for (int nt = 0; nt < 4; ++nt) *(f32x4*)(F.out + O_WKVP + ((size_t)bh * 64 + 16 * qtr + l15) * 64 + 16 * nt + 4 * q) = S[nt]; }
    }
#else
    if (F.wave == 0) {
        f32x4 S[4] = {{0.f, 0.f, 0.f, 0.f}, {0.f, 0.f, 0.f, 0.f}, {0.f, 0.f, 0.f, 0.f}, {0.f, 0.f, 0.f, 0.f}};
        const f32x4 z4 = {0.f, 0.f, 0.f, 0.f};
        float* yg = (float*)(F.ws + WS_Y) + (size_t)rowbase * RW + h * 64 + 16 * qtr + l15;
        for (int c = 0; c < 128; ++c) {
            while (__hip_atomic_load((LAS int*)&flg[c & 7], __ATOMIC_ACQUIRE, __HIP_MEMORY_SCOPE_WORKGROUP) != c + 1) __builtin_amdgcn_s_sleep(1);
            __builtin_amdgcn_fence(__ATOMIC_ACQUIRE, "workgroup");
#ifdef CK_DELAY
            __builtin_amdgcn_s_sleep(CK_DELAY);
#endif
            asm volatile("s_waitcnt lgkmcnt(0)" ::: "memory");
            const LAS unsigned char* slot = base + (c & 7) * CK_SLOT_B;
            const LAS bf16x8* s8 = (const LAS bf16x8*)slot; const LAS bf16x4* s4 = (const LAS bf16x4*)slot;
            const bf16x8 kh0 = s8[F.lane], kh1 = s8[64 + F.lane], rh0 = s8[128 + F.lane], rh1 = s8[192 + F.lane];
            const bf16x4 akk = s4[CK_AKK / 8 + F.lane], akr = s4[CK_AKR / 8 + F.lane], nabr = s4[CK_ABR / 8 + F.lane], tm = s4[CK_TM / 8 + F.lane], vm = s4[CK_VM / 8 + F.lane];
            const bf16x8 sb0 = cvt8(S[0], S[1]), sb1 = cvt8(S[2], S[3]);
            f32x4 GT = MFMA32(kh0, sb0, z4); GT = MFMA32(kh1, sb1, GT); GT = MFMA16(akk, vm, GT);
            asm volatile("s_nop 15\n\ts_nop 15" : "+v"(GT));
            f32x4 DT = MFMA16(tm, cvt4(GT), z4);
            asm volatile("s_nop 15\n\ts_nop 15" : "+v"(DT));
            const bf16x4 db = cvt4(DT);
            f32x4 YT = MFMA32(rh0, sb0, z4); YT = MFMA32(rh1, sb1, YT); YT = MFMA16(akr, vm, YT); YT = MFMA16(nabr, db, YT);
            asm volatile("s_nop 15\n\ts_nop 15" : "+v"(YT));
#pragma unroll
            for (int nt = 0; nt < 4; ++nt) { const f32x4 g = *(const LAS f32x4*)(slot + CK_GC + 4 * (16 * nt + 4 * q));
                const bf16x4 kb = s4[CK_KB / 8 + nt * 64 + F.lane], nbb = s4[CK_BB / 8 + nt * 64 + F.lane];
                S[nt] = MFMA16(nbb, db, MFMA16(kb, vm, S[nt] * g)); }
            asm volatile("s_nop 15\n\ts_nop 15\n\ts_waitcnt lgkmcnt(0)" : "+v"(S[0]), "+v"(S[1]), "+v"(S[2]), "+v"(S[3]) :: "memory");
            __builtin_amdgcn_fence(__ATOMIC_RELEASE, "workgroup");
            if (F.lane == 0) __hip_atomic_store((LAS int*)&flg[16], c + 1, __ATOMIC_RELEASE, __HIP_MEMORY_SCOPE_WORKGROUP);
#pragma unroll
            for (int e = 0; e < 4; ++e) yg[(size_t)(16 * c + 4 * q + e) * RW] = YT[e];
        }
#pragma unroll
        for (int nt = 0; nt < 4; ++nt) *(f32x4*)(F.out + O_WKVP + ((size_t)bh * 64 + 16 * qtr + l15) * 64 + 16 * nt + 4 * q) = S[nt];
    } else {
        LAS unsigned short* scr = (LAS unsigned short*)(base + CK_SCR_OFF + (F.wave - 1) * CK_SCR_B);
#ifdef CK_ONE_HELPER
        for (int c = 0; c < (F.wave == 1 ? 128 : 0); ++c) {
#else
        for (int c = F.wave - 1; c < 128; c += 7) {
#endif
            while (__hip_atomic_load((LAS int*)&flg[16], __ATOMIC_ACQUIRE, __HIP_MEMORY_SCOPE_WORKGROUP) < c - CK_AHEAD) __builtin_amdgcn_s_sleep(2);
            __builtin_amdgcn_fence(__ATOMIC_ACQUIRE, "workgroup");
            chunk_prepare(F, h, qtr, rowbase + 16 * c, base + (c & 7) * CK_SLOT_B, scr);
#ifdef CK_POST_SPIN
            { float g_ = 1.0f + 0.001f * F.lane; for (int i_ = 0; i_ < CK_POST_SPIN; ++i_) { g_ = g_ * 0.999f + 0.001f; asm volatile("" : "+v"(g_)); } if (g_ == 123.456f) scr[0] = 1; }
#endif
            __builtin_amdgcn_fence(__ATOMIC_RELEASE, "workgroup");
            if (F.lane == 0) __hip_atomic_store((LAS int*)&flg[c & 7], c + 1, __ATOMIC_RELEASE, __HIP_MEMORY_SCOPE_WORKGROUP);
        }
    }
#endif
    __syncthreads();
}
__device__ __forceinline__ void postscan_item(Frame& F, const InAcc& A, int r0, int h) {
    const int l15 = F.lane & 15, q = F.lane >> 4, row = r0 + l15;
    const float* Y = (const float*)(F.ws + WS_Y); const bf16* V = (const bf16*)(F.ws + WS_SC + 2 * SC_STRIDE); const bf16* G = (const bf16*)(F.ws + WS_G);
    const float* gn_w = A.in[20]; const float* gn_b = A.in[21];
    float y[4][4]; float s = 0.f;
#pragma unroll
    for (int ntl = 0; ntl < 4; ++ntl) { const f32x4 t = *(const f32x4*)(Y + (size_t)row * RW + 64 * h + 16 * ntl + 4 * q); y[ntl][0] = t.x; y[ntl][1] = t.y; y[ntl][2] = t.z; y[ntl][3] = t.w; s += (t.x + t.y) + (t.z + t.w); }
    s += __shfl_xor(s, 16); s += __shfl_xor(s, 32);
    const float mu = s * (1.0f / 64.0f); float qq = 0.f;
#pragma unroll
    for (int ntl = 0; ntl < 4; ++ntl)
#pragma unroll
        for (int e = 0; e < 4; ++e) { y[ntl][e] -= mu; qq += y[ntl][e] * y[ntl][e]; }
    qq += __shfl_xor(qq, 16); qq += __shfl_xor(qq, 32);
    const float rstd = 1.0f / sqrtf(qq * (1.0f / 64.0f) + GN_EPS);
    const float bon = ((const float*)(F.ws + WS_BON))[(size_t)row * 8 + h];
#pragma unroll
    for (int ntl = 0; ntl < 4; ++ntl) { const int c0 = 64 * h + 16 * ntl + 4 * q; const size_t o = sc_off(row, c0);
        const f32x4 gw = *(const f32x4*)(gn_w + c0), gb = *(const f32x4*)(gn_b + c0);
        float vv[4], gg[4], ov[4]; unpack4(*(const v2u*)(V + o), vv); unpack4(*(const v2u*)(G + o), gg);
#pragma unroll
        for (int e = 0; e < 4; ++e) ov[e] = (y[ntl][e] * rstd * gw[e] + gb[e] + bon * vv[e]) * gg[e];
        *(v2u*)(((bf16*)(F.ws + WS_XN)) + (size_t)row * D + c0) = pack4(ov); }
}
__device__ __forceinline__ void postscan_rows(Frame& F, const InAcc& A) { for (int it = F.gw; it < (M / 16) * 8; it += F.NGW) postscan_item(F, A, 16 * (it >> 3), it & 7); }
__global__ void __launch_bounds__(NWAVES * 64, 2) fwd_kernel(Args args) {
    extern __shared__ __attribute__((aligned(16))) unsigned char lds[];
    Frame F;
    F.lds = (LAS unsigned char*)lds;
    F.MISC = (volatile LAS unsigned*)(F.lds + MISC_OFF);
    F.tid = threadIdx.x; F.lane = F.tid & 63; F.wave = __builtin_amdgcn_readfirstlane(F.tid >> 6);
    F.G = gridDim.x; F.gw = blockIdx.x * NWAVES + F.wave; F.NGW = F.G * NWAVES;
    unsigned char* ws = args.ws;
    F.ctl = (gu32*)(ws + WS_CTL);
    F.out = args.out; F.ws = ws;
    for (int u = F.tid; u < (LDS_BYTES - LDSCTL_OFF) / 4; u += NWAVES * 64) ((LAS unsigned*)(F.lds + LDSCTL_OFF))[u] = 0u;
    __syncthreads();
    if (F.tid == 0) { LAS unsigned long long* pt = (LAS unsigned long long*)(F.lds + PTRS_OFF);
#pragma unroll
        for (int i = 0; i < 30; ++i) pt[i] = (unsigned long long)args.in[i]; }
    __syncthreads();
#if USE_PTR_TABLE
    InAcc A; A.in.t = (LAS unsigned*)(F.lds + PTRS_OFF);
#else
    InAcc A;
#pragma unroll
    for (int i = 0; i < 30; ++i) A.in[i] = args.in[i];
#endif
    XcdBarrier bar; bar.bar = (unsigned*)(F.ctl + CW_BAR); bar.x = 0; bar.st = nullptr;
    if (MK_N_LAUNCHES == 1) bar = xcd_barrier_post((unsigned*)(F.ctl + CW_BAR), F.MISC + 8);
    const int lo = args.ph_lo, hi = args.ph_hi;
#ifndef PH_MASK
#define PH_MASK 0x7fff
#endif
#define IN(k) (((PH_MASK >> (k)) & 1) && lo <= (k) && (k) < hi)
#ifndef DUP_ID
#define DUP_ID -1
#endif
#define DUPN(id) ((DUP_ID == (id)) ? 2 : 1)
#define DUPBAR(r) do { if (r) xcd_barrier(bar); } while (0)
#define SEAM(k) do { if (IN(k) && IN((k) + 1)) xcd_barrier(bar); } while (0)
    float* const H = F.out;

    if (IN(0)) for (int rep_ = 0; rep_ < DUPN(0); ++rep_) { DUPBAR(rep_); p1_mod(F, A); p0_prologue(F, A); }
    SEAM(1);
    if (IN(2)) for (int rep_ = 0; rep_ < DUPN(2); ++rep_) { DUPBAR(rep_); norm_rows_bf16(F, A, A.in[0], A.in[1], 0, 1024, 0, 0, 0.f); } SEAM(2);
    if (IN(3)) for (int rep_ = 0; rep_ < DUPN(3); ++rep_) { DUPBAR(rep_); pg8::Gemm g{((bf16*)(F.ws + WS_XN)), ((bf16*)(F.ws + WS_GU1)), M, 2 * FF, D, D}; pg8::StaticOrder S; S.init(M, 2 * FF, D, F.G, (int)blockIdx.x); pg8::EpiSwiglu E{((bf16*)(F.ws + WS_ACT))};
        pg8::gemm_phase<pg8::EpiSwiglu, pg8::StaticOrder, PG8_ALIGN, PG8_SP2>(F.lds + RING_OFF, g, S, E); } SEAM(3);
    if (IN(4)) for (int rep_ = 0; rep_ < DUPN(4); ++rep_) { DUPBAR(rep_); pg8::Gemm g{((bf16*)(F.ws + WS_ACT)), ((bf16*)(F.ws + WS_DN1)), M, D, FF, FF}; pg8::SplitOrder S; S.init(MP, D, FF, 11, F.G, (int)blockIdx.x); pg8::EpiResid E{A.in[0], A.in[1], H, ((float*)(F.ws + WS_MOD)) + 2048, 0.5f, (float*)(F.ws + WS_SC)};
        pg8::gemm_phase<pg8::EpiResid, pg8::SplitOrder, PG8_ALIGN, PG8_SP2>(F.lds + RING_OFF, g, S, E); } SEAM(4);
    if (IN(5)) for (int rep_ = 0; rep_ < DUPN(5); ++rep_) { DUPBAR(rep_); norm_rows_bf16(F, A, H, A.in[1], 3072, 4096, 11, 2048, 0.5f); } SEAM(5);
    if (IN(6)) for (int rep_ = 0; rep_ < DUPN(6); ++rep_) { DUPBAR(rep_); pg8::Gemm g{((bf16*)(F.ws + WS_XN)), ((bf16*)(F.ws + WS_WIN)), M, PC, D, D}; pg8::StaticOrder S; S.init(M, PC, D, F.G, (int)blockIdx.x); pg8::EpiP E{((bf16*)(F.ws + WS_ACT)), ((bf16*)(F.ws + WS_PUV)), F.out + O_SHP, F.out + O_SHS};
        pg8::gemm_phase<pg8::EpiP, pg8::StaticOrder, PG8_ALIGN, PG8_SP2>(F.lds + RING_OFF, g, S, E); } SEAM(6);
    if (IN(7)) { for (int it = F.gw; it < M / 16; it += F.NGW) frag_item(F, A, 16 * it); lnv_rows(F, A); xcd_barrier(bar);
        for (int rep_ = 0; rep_ < DUPN(70); ++rep_) { DUPBAR(rep_); prep_all(F, A); } } SEAM(7);
    if (IN(8)) {
        for (int rep_ = 0; rep_ < DUPN(80); ++rep_) for (int u = blockIdx.x; u < 256; u += F.G) scan_prompt_unit(F, A, u);
        for (int rep_ = 0; rep_ < DUPN(81); ++rep_) for (int it = F.gw; it < 2048; it += F.NGW) { if (it < 1024) gmlp_item<false>(F, A, it >> 3, it & 7); else gmlp_item<true>(F, A, (it - 1024) >> 3, it & 7); }
        for (int it = F.gw; it < 128 * 8 * 8; it += F.NGW) scan_sample_item(F, A, it);
    } SEAM(8);
    if (IN(9)) for (int rep_ = 0; rep_ < DUPN(9); ++rep_) { DUPBAR(rep_); postscan_rows(F, A); } SEAM(9);
    if (IN(10)) { pg8::Gemm g{((bf16*)(F.ws + WS_XN)), ((bf16*)(F.ws + WS_WOUT)), M, D, D, D}; pg8::SplitOrder S; S.init(MP, D, D, 4, F.G, (int)blockIdx.x); pg8::EpiResid E{H, H + (size_t)MP * D, H, ((float*)(F.ws + WS_MOD)) + 5120, 1.0f, (float*)(F.ws + WS_SC)};
        pg8::gemm_phase<pg8::EpiResid, pg8::SplitOrder, PG8_ALIGN, PG8_SP2>(F.lds + RING_OFF, g, S, E); } SEAM(10);
    if (IN(11)) for (int rep_ = 0; rep_ < DUPN(11); ++rep_) { DUPBAR(rep_); norm_rows_bf16(F, A, H, H + (size_t)MP * D, 6144, 7168, 4, 5120, 1.0f); } SEAM(11);
    if (IN(12)) { pg8::Gemm g{((bf16*)(F.ws + WS_XN)), ((bf16*)(F.ws + WS_GU2)), M, 2 * FF, D, D}; pg8::StaticOrder S; S.init(M, 2 * FF, D, F.G, (int)blockIdx.x); pg8::EpiSwiglu E{((bf16*)(F.ws + WS_ACT))};
        pg8::gemm_phase<pg8::EpiSwiglu, pg8::StaticOrder, PG8_ALIGN, PG8_SP2>(F.lds + RING_OFF, g, S, E); } SEAM(12);
    if (IN(13)) { pg8::Gemm g{((bf16*)(F.ws + WS_ACT)), ((bf16*)(F.ws + WS_DN2)), M, D, FF, FF}; pg8::SplitOrder S; S.init(MP, D, FF, 11, F.G, (int)blockIdx.x); pg8::EpiResid E{H, H + (size_t)MP * D, H, ((float*)(F.ws + WS_MOD)) + 8192, 0.5f, (float*)(F.ws + WS_SC)};
        pg8::gemm_phase<pg8::EpiResid, pg8::SplitOrder, PG8_ALIGN, PG8_SP2>(F.lds + RING_OFF, g, S, E); } SEAM(13);
    if (IN(14)) { final_norm_rows(F, A, 11, 8192, 0.5f); }
#undef IN
#undef SEAM
}

extern "C" void kernel_launch(void* const* d_in, const int* in_sizes, int n_in, void* d_out, int out_size, void* d_ws, size_t ws_size, hipStream_t stream) {
    static int grid = 0;
    if (grid == 0) {
        if (n_in != 30 || in_sizes[0] != MP * D || (size_t)out_size != O_END || ws_size < WS_END) { fprintf(stderr, "kernel_launch: unexpected problem shape / workspace (%d inputs, out %d, ws %zu); nothing launched\n", n_in, out_size, ws_size); grid = -1; return; }
        int dev = 0, cus = 0, per_cu = 0;
        if (hipGetDevice(&dev) != hipSuccess || hipDeviceGetAttribute(&cus, hipDeviceAttributeMultiprocessorCount, dev) != hipSuccess) { grid = -1; return; }
        if (hipFuncSetAttribute((const void*)fwd_kernel, hipFuncAttributeMaxDynamicSharedMemorySize, LDS_BYTES) != hipSuccess) { fprintf(stderr, "kernel_launch: hipFuncSetAttribute failed\n"); grid = -1; return; }
        if (hipOccupancyMaxActiveBlocksPerMultiprocessor(&per_cu, (const void*)fwd_kernel, NWAVES * 64, LDS_BYTES) != hipSuccess || per_cu < 1) { fprintf(stderr, "kernel_launch: occupancy query says %d blocks per CU\n", per_cu); }
        (void)hipGetLastError();
        grid = cus;
    }
    if (grid < 0) return;
    (void)hipMemsetAsync((char*)d_ws + WS_CTL, 0, CTL_ZERO_BYTES, stream);
    Args a{};
    for (int i = 0; i < 30; ++i) a.in[i] = (const float*)d_in[i];
    a.out = (float*)d_out; a.ws = (unsigned char*)d_ws;
    if (MK_N_LAUNCHES == 1) { a.ph_lo = 0; a.ph_hi = N_PHASES; hipLaunchKernelGGL(fwd_kernel, dim3(grid), dim3(NWAVES * 64), LDS_BYTES, stream, a); }
    else for (int p = 0; p < N_PHASES; ++p) { a.ph_lo = p; a.ph_hi = p + 1; hipLaunchKernelGGL(fwd_kernel, dim3(grid), dim3(NWAVES * 64), LDS_BYTES, stream, a); }
}
```

```cpp
#include <hip/hip_runtime.h>
#include <cstdio>
#include <cstdint>
namespace pg8 {
#define PG8_LAS __attribute__((address_space(3)))
typedef unsigned short bf16_t;
typedef short bf16x8 __attribute__((ext_vector_type(8)));
typedef float f32x4 __attribute__((ext_vector_type(4)));
typedef unsigned u32x4 __attribute__((ext_vector_type(4)));
constexpr int BM = 256, BK = 64, HALF = 128, HTB = HALF * BK * 2  , STAGE_BYTES = 8 * HTB, NXCD = 8, WGM = 8;

__host__ __device__ __forceinline__ int lds_byte(int r, int c) { const int st = (r >> 4) * 2 + (c >> 5), rr = r & 15, cc = c & 31, ob = rr * 64 + cc * 2; return st * 1024 + (ob ^ (((ob >> 9) & 1) << 5)); }
__host__ __device__ __forceinline__ void stage_rc(int b, int& R, int& C) { const int st = b / 1024, sb = b % 1024, swz = sb ^ (((sb >> 9) & 1) << 5); R = (st >> 1) * 16 + swz / 64; C = (st & 1) * 32 + (swz % 64) / 2; }
__host__ __device__ __forceinline__ int perm32(int rho) { const int n = rho >> 4, i = rho & 15; return 8 * (i >> 2) + 4 * n + (i & 3); }

struct Unit { int pm, pn, kb, nt, ks; };
struct Gemm { const bf16_t* A; const bf16_t* Bt; int M, N, K, ld; };

struct StaticOrder {
    int nM, nN, nwg, G, c, knt;
    __host__ __device__ void init(int M, int N, int K, int G_, int c_) { nM = M / BM; nN = N / BM; nwg = nM * nN; G = G_; c = c_; knt = K / BK; }
    __host__ __device__ __forceinline__ bool next(int i, Unit& u) const {
        const long L = (long)i * G + c; if (L >= nwg) return false;
        int wgid = (int)L; { const int q = nwg / NXCD, r = nwg % NXCD, xcd = wgid % NXCD, off = wgid / NXCD; wgid = (xcd < r ? xcd * (q + 1) : r * (q + 1) + (xcd - r) * q) + off; }
        const int nig = WGM * nN, gid = wgid / nig, fm = gid * WGM, gsz = (nM - fm) < WGM ? (nM - fm) : WGM;
        u.pm = fm + ((wgid % nig) % gsz); u.pn = (wgid % nig) / gsz; u.kb = 0; u.nt = knt; u.ks = -1; return true;
    }
    __device__ __forceinline__ void a_ready(const Unit&) const {}
    __device__ __forceinline__ void done(const Unit&) const {}
};
struct SplitOrder {
    StaticOrder so; int ns, c, G;
    __host__ __device__ void init(int Mmain, int N, int K, int ns_, int G_, int c_) { so.init(Mmain, N, K, G_, c_); ns = ns_; c = c_; G = G_; }
    __host__ __device__ __forceinline__ bool next(int i, Unit& u) const {
        const int nsub = 16 * ns, mine = c < nsub ? (nsub - 1 - c) / G + 1 : 0;
        const bool sub = i < mine; const int s = c + i * G;
        Unit m; m.pm = 0; m.pn = 0; m.kb = 0; m.nt = so.knt; m.ks = -1;
        const bool okm = so.next(sub ? 0 : i - mine, m);
        u.pm = sub ? so.nM + s / (4 * ns) : m.pm; u.pn = sub ? ((s / ns) & 3) : m.pn; u.ks = sub ? s % ns : -1; u.kb = sub ? (s % ns) * 4 * BK * 2 : 0; u.nt = sub ? 4 : so.knt;
        return sub || okm;
    }
    __device__ __forceinline__ void a_ready(const Unit&) const {}
    __device__ __forceinline__ void done(const Unit&) const {}
};
__device__ __forceinline__ unsigned cvt_pk_bf16(float lo, float hi) { unsigned r; asm volatile("v_cvt_pk_bf16_f32 %0, %1, %2" : "=v"(r) : "v"(lo), "v"(hi)); return r; }
typedef float f32x2 __attribute__((ext_vector_type(2)));
constexpr int ROWS_P = 16384, ROWS_ALL = 17408, DM = 1024, MODW = 9216, FFW = 2816, RCOLS = 1792;
__device__ __forceinline__ int seq_of_row(int r) { return r < ROWS_P ? (r >> 11) : 8 + ((r - ROWS_P) >> 3); }
__device__ __forceinline__ bool row_is_first(int r) { return r < ROWS_P ? ((r & 2047) == 0) : (((r - ROWS_P) & 7) == 0); }
__device__ __forceinline__ bool row_is_last(int r) { return r < ROWS_P ? ((r & 2047) == 2047) : (((r - ROWS_P) & 7) == 7); }
__device__ __forceinline__ float silu_f(float x) { return x * __builtin_amdgcn_rcpf(1.0f + __builtin_amdgcn_exp2f(-1.4426950408889634f * x)); }

struct EpiSwiglu {
    static constexpr bool PERM = true, AFTER_DRAIN = false;
    bf16_t* O;
    __device__ __forceinline__ void operator()(const f32x4 (&acc)[2][2][4][2], const Unit& u, int wr, int wc, int fr, int fq) const {
        const int row0 = u.pm * BM + wr * 64 + fr, col0 = u.pn * HALF + wc * 32 + 8 * fq;
#pragma unroll
        for (int ai = 0; ai < 2; ++ai)
#pragma unroll
            for (int m = 0; m < 4; ++m) {
                bf16_t* rowp = O + (size_t)(row0 + ai * HALF + m * 16) * FFW + col0;
                const f32x4 g0 = acc[ai][0][m][0], g1 = acc[ai][0][m][1], u0 = acc[ai][1][m][0], u1 = acc[ai][1][m][1];
                u32x4 w;
                w.x = cvt_pk_bf16(silu_f(g0[0]) * u0[0], silu_f(g0[1]) * u0[1]); w.y = cvt_pk_bf16(silu_f(g0[2]) * u0[2], silu_f(g0[3]) * u0[3]);
                w.z = cvt_pk_bf16(silu_f(g1[0]) * u1[0], silu_f(g1[1]) * u1[1]); w.w = cvt_pk_bf16(silu_f(g1[2]) * u1[2], silu_f(g1[3]) * u1[3]);
                *(u32x4*)rowp = w;
            }
    }
};
constexpr int HLD = 2048, HOFF = 1024;
template <bool RESF32> struct EpiResid {
    static constexpr bool PERM = false, AFTER_DRAIN = false;
    const float* resP; const float* resS; bf16_t* hb; const float* gate; float coef; float* slab;
    __device__ __forceinline__ void operator()(const f32x4 (&acc)[2][2][4][2], const Unit& u, int wr, int wc, int fr, int fq) const {
        typedef unsigned u32x2 __attribute__((ext_vector_type(2)));
        const int col0 = u.pn * BM + wc * 32 + 4 * fq;
        if (u.ks >= 0) {
#pragma unroll
            for (int ai = 0; ai < 2; ++ai)
#pragma unroll
                for (int m = 0; m < 4; ++m) { float* srow = slab + ((size_t)u.ks * 1024 + (size_t)(u.pm * BM + ai * HALF + wr * 64 + m * 16 + fr - ROWS_P)) * DM + col0;
#pragma unroll
                    for (int bj = 0; bj < 2; ++bj)
#pragma unroll
                        for (int n = 0; n < 2; ++n) *(f32x4*)(srow + bj * HALF + n * 16) = acc[ai][bj][m][n]; }
            return; }
#pragma unroll
        for (int ai = 0; ai < 2; ++ai)
#pragma unroll
            for (int m = 0; m < 4; ++m) {
                const int row = u.pm * BM + ai * HALF + wr * 64 + m * 16 + fr; const int s = seq_of_row(row);
                const float* rrow = (row < ROWS_P ? resP + (size_t)row * DM : resS + (size_t)(row - ROWS_P) * DM) + col0;
                bf16_t* hrow = hb + (size_t)row * HLD + HOFF + col0; const float* grow = gate + (size_t)s * MODW + col0;
#pragma unroll
                for (int bj = 0; bj < 2; ++bj)
#pragma unroll
                    for (int n = 0; n < 2; ++n) { const int off = bj * HALF + n * 16; const f32x4 g = *(const f32x4*)(grow + off); f32x4 r;
                        if (RESF32) r = *(const f32x4*)(rrow + off);
                        else { const u32x2 w = *(const u32x2*)(hrow + off); r = (f32x4){__uint_as_float(w.x << 16), __uint_as_float(w.x & 0xffff0000u), __uint_as_float(w.y << 16), __uint_as_float(w.y & 0xffff0000u)}; }
                        const f32x4 o = r + (g * coef) * acc[ai][bj][m][n];
                        *(u32x2*)(hrow + off) = (u32x2){cvt_pk_bf16(o[0], o[1]), cvt_pk_bf16(o[2], o[3])}; }
            }
    }
};
struct EpiP {
    static constexpr bool PERM = true, AFTER_DRAIN = false;
    bf16_t* PB; bf16_t* PUV; float* shp; float* shs;
    __device__ __forceinline__ void operator()(const f32x4 (&acc)[2][2][4][2], const Unit& u, int wr, int wc, int fr, int fq) const {
        typedef unsigned u32x2 __attribute__((ext_vector_type(2)));
        const int row0 = u.pm * BM + wr * 64 + fr, col0 = u.pn * BM + wc * 32 + 8 * fq;
#pragma unroll
        for (int ai = 0; ai < 2; ++ai)
#pragma unroll
            for (int m = 0; m < 4; ++m) {
                const int row = row0 + ai * HALF + m * 16; const bool last = row_is_last(row);
#pragma unroll
                for (int bj = 0; bj < 2; ++bj) { const f32x4 v0 = acc[ai][bj][m][0], v1 = acc[ai][bj][m][1]; const int col = col0 + bj * HALF;
                    u32x4 w; w.x = cvt_pk_bf16(v0[0], v0[1]); w.y = cvt_pk_bf16(v0[2], v0[3]); w.z = cvt_pk_bf16(v1[0], v1[1]); w.w = cvt_pk_bf16(v1[2], v1[3]);
                    if (u.pn < 7) { bf16_t* p = PB + ((size_t)((row >> 4) * 448 + (col >> 2)) * 16 + (row & 15)) * 4; *(u32x2*)p = (u32x2){w.x, w.y}; *(u32x2*)(p + 64) = (u32x2){w.z, w.w};
                        if (last) { float* o = (row < ROWS_P ? shp + (size_t)(row >> 11) * RCOLS : shs + (size_t)((row - ROWS_P) >> 3) * RCOLS) + col; *(f32x4*)o = v0; *(f32x4*)(o + 4) = v1; } }
                    else *(u32x4*)(PUV + (size_t)row * 1024 + (col - RCOLS)) = w; }
            }
    }
};
template <class Epi, class Sched, bool ALIGN_EPI = false, bool SP2 = false>
__device__ __forceinline__ void gemm_phase(PG8_LAS unsigned char* lds, const Gemm g, const Sched& S, const Epi& E) {
    const int tid = threadIdx.x, wid = __builtin_amdgcn_readfirstlane(tid >> 6), lane = tid & 63, wr = wid >> 2, wc = wid & 3, fr = lane & 15, fq = lane >> 4;
    const int K = g.ld;
    unsigned voffA[2], voffB[2];
#pragma unroll
    for (int i = 0; i < 2; ++i) { int R, C; stage_rc(tid * 16 + i * 8192, R, C); const int Rb = Epi::PERM ? ((R & ~31) + perm32(R & 31)) : R;
        voffA[i] = (unsigned)(R * K + C) * 2u; voffB[i] = (unsigned)(Rb * K + C) * 2u; }
    const size_t kstep = (size_t)(BK * 2);
    const size_t hstep = (size_t)HALF * K * 2;
    const size_t tstep = 2 * hstep;
    const unsigned ldsw = (unsigned)wid * 1024u;
    const int aoff = lds_byte(wr * 64 + fr, fq * 8), boff = lds_byte(wc * 32 + fr, fq * 8);
#define PG8_SA(b, h) (((b) * 2 + (h)) * HTB)
#define PG8_SB(b, h) ((4 + (b) * 2 + (h)) * HTB)
#define PG8_STAGE(bufoff, gbase, voff) do { _Pragma("unroll") for (int _i = 0; _i < 2; ++_i) \
        __builtin_amdgcn_global_load_lds((const unsigned*)((const char*)(gbase) + (voff)[_i]), (PG8_LAS unsigned*)(lds + (bufoff) + ldsw + _i * 8192), 16, 0, 0); } while (0)
#define PG8_LDA(dst, b, h) do { _Pragma("unroll") for (int m = 0; m < 4; ++m) _Pragma("unroll") for (int k = 0; k < 2; ++k) dst[m][k] = *(const PG8_LAS bf16x8*)(lds + PG8_SA(b, h) + aoff + m * 2048 + k * 1024); } while (0)
#define PG8_LDB(dst, b, h) do { _Pragma("unroll") for (int n = 0; n < 2; ++n) _Pragma("unroll") for (int k = 0; k < 2; ++k) dst[n][k] = *(const PG8_LAS bf16x8*)(lds + PG8_SB(b, h) + boff + n * 2048 + k * 1024); } while (0)
#define PG8_MMA(ai, bj, At, Bt) do { __builtin_amdgcn_s_setprio(1); _Pragma("unroll") for (int m = 0; m < 4; ++m) _Pragma("unroll") for (int n = 0; n < 2; ++n) _Pragma("unroll") for (int k = 0; k < 2; ++k) \
        acc[ai][bj][m][n] = __builtin_amdgcn_mfma_f32_16x16x32_bf16(Bt[n][k], At[m][k], acc[ai][bj][m][n], 0, 0, 0); __builtin_amdgcn_s_setprio(0); } while (0)
#define PG8_WAIT_V(n) asm volatile("s_waitcnt vmcnt(" #n ")" ::: "memory")
#define PG8_WAIT_L(n) asm volatile("s_waitcnt lgkmcnt(" #n ")" ::: "memory")
#define PG8_BAR __builtin_amdgcn_s_barrier()
#define PG8_SCHED __builtin_amdgcn_sched_barrier(0)
    Unit cur, nxt; int ui = 0;
    if (!S.next(0, cur)) return;
    f32x4 acc[2][2][4][2];
#pragma unroll
    for (int a = 0; a < 2; ++a)
#pragma unroll
        for (int b = 0; b < 2; ++b)
#pragma unroll
            for (int m = 0; m < 4; ++m)
#pragma unroll
                for (int n = 0; n < 2; ++n) acc[a][b][m][n] = (f32x4){0.f, 0.f, 0.f, 0.f};
    bf16x8 At[4][2], B0[2][2], B1[2][2];
    const char* cA = (const char*)g.A + (size_t)cur.pm * tstep + cur.kb; const char* cB = (const char*)g.Bt + (size_t)cur.pn * tstep + cur.kb;
    S.a_ready(cur);
    if constexpr (SP2) {
        PG8_STAGE(PG8_SB(0, 0), cB, voffB); PG8_STAGE(PG8_SB(0, 1), cB + hstep, voffB); PG8_STAGE(PG8_SA(0, 0), cA, voffA); PG8_STAGE(PG8_SA(0, 1), cA + hstep, voffA);
        if (wr == 1) PG8_BAR;
        PG8_WAIT_V(2); PG8_BAR;
        PG8_STAGE(PG8_SB(1, 0), cB + kstep, voffB); PG8_STAGE(PG8_SA(1, 0), cA + kstep, voffA); PG8_STAGE(PG8_SB(1, 1), cB + hstep + kstep, voffB);
        PG8_WAIT_V(6); PG8_BAR;
    } else {
        PG8_STAGE(PG8_SB(0, 0), cB, voffB); PG8_STAGE(PG8_SA(0, 0), cA, voffA); PG8_STAGE(PG8_SB(0, 1), cB + hstep, voffB); PG8_STAGE(PG8_SA(0, 1), cA + hstep, voffA);
        if (wr == 1) PG8_BAR;
        PG8_WAIT_V(4); PG8_BAR;
        PG8_STAGE(PG8_SB(1, 0), cB + kstep, voffB); PG8_STAGE(PG8_SA(1, 0), cA + kstep, voffA); PG8_STAGE(PG8_SB(1, 1), cB + hstep + kstep, voffB);
        PG8_WAIT_V(6); PG8_BAR;
    }
    for (;;) {
        const bool has_next = S.next(ui + 1, nxt);
        const char* nA = has_next ? (const char*)g.A + (size_t)nxt.pm * tstep + nxt.kb : cA; const char* nB = has_next ? (const char*)g.Bt + (size_t)nxt.pn * tstep + nxt.kb : cB;
        const int nt = cur.nt;
        for (int t = 0; t < nt; t += 2) {
            const bool last = (t == nt - 2);
            const char* a1 = cA + (size_t)(t + 1) * kstep;
            const char* a2 = last ? nA : cA + (size_t)(t + 2) * kstep; const char* b2 = last ? nB : cB + (size_t)(t + 2) * kstep;
            const char* a3 = a2 + kstep; const char* b3 = b2 + kstep;
            if (last && has_next) S.a_ready(nxt);
            if constexpr (SP2) {
            PG8_LDB(B0, 0, 0); PG8_LDB(B1, 0, 1); PG8_SCHED; PG8_LDA(At, 0, 0); PG8_STAGE(PG8_SA(1, 1), a1 + hstep, voffA);
            PG8_WAIT_V(8); PG8_WAIT_L(0); PG8_BAR; PG8_MMA(0, 0, At, B0); PG8_MMA(0, 1, At, B1); PG8_BAR; PG8_SCHED;
            PG8_LDA(At, 0, 1); PG8_STAGE(PG8_SB(0, 0), b2, voffB); PG8_STAGE(PG8_SB(0, 1), b2 + hstep, voffB); PG8_STAGE(PG8_SA(0, 0), a2, voffA);
            PG8_WAIT_V(8); PG8_WAIT_L(0); PG8_BAR; PG8_MMA(1, 0, At, B0); PG8_MMA(1, 1, At, B1); PG8_BAR; PG8_SCHED;
            PG8_LDB(B0, 1, 0); PG8_LDB(B1, 1, 1); PG8_SCHED; PG8_LDA(At, 1, 0); PG8_STAGE(PG8_SA(0, 1), a2 + hstep, voffA);
            PG8_WAIT_V(8); PG8_WAIT_L(0); PG8_BAR; PG8_MMA(0, 0, At, B0); PG8_MMA(0, 1, At, B1); PG8_BAR; PG8_SCHED;
            PG8_LDA(At, 1, 1); PG8_STAGE(PG8_SB(1, 0), b3, voffB); PG8_STAGE(PG8_SB(1, 1), b3 + hstep, voffB); PG8_STAGE(PG8_SA(1, 0), a3, voffA);
            PG8_WAIT_V(8); PG8_WAIT_L(0); PG8_BAR; PG8_MMA(1, 0, At, B0); PG8_MMA(1, 1, At, B1); PG8_BAR; PG8_SCHED;
            } else {
            PG8_LDB(B0, 0, 0); PG8_SCHED; PG8_LDA(At, 0, 0); PG8_STAGE(PG8_SA(1, 1), a1 + hstep, voffA);
            PG8_WAIT_L(8); PG8_BAR; PG8_WAIT_L(0); PG8_MMA(0, 0, At, B0); PG8_BAR; PG8_SCHED;
            PG8_LDB(B1, 0, 1); PG8_STAGE(PG8_SB(0, 0), b2, voffB);
            PG8_BAR; PG8_WAIT_L(0); PG8_MMA(0, 1, At, B1); PG8_BAR;
            PG8_LDA(At, 0, 1); PG8_STAGE(PG8_SA(0, 0), a2, voffA);
            PG8_BAR; PG8_WAIT_L(0); PG8_MMA(1, 0, At, B0); PG8_BAR; PG8_SCHED;
            PG8_STAGE(PG8_SB(0, 1), b2 + hstep, voffB);
            PG8_WAIT_V(6); PG8_BAR; PG8_MMA(1, 1, At, B1); PG8_BAR;
            PG8_LDB(B0, 1, 0); PG8_SCHED; PG8_LDA(At, 1, 0); PG8_STAGE(PG8_SA(0, 1), a2 + hstep, voffA);
            PG8_WAIT_L(8); PG8_BAR; PG8_WAIT_L(0); PG8_MMA(0, 0, At, B0); PG8_BAR; PG8_SCHED;
            PG8_LDB(B1, 1, 1); PG8_STAGE(PG8_SB(1, 0), b3, voffB);
            PG8_BAR; PG8_WAIT_L(0); PG8_MMA(0, 1, At, B1); PG8_BAR;
            PG8_LDA(At, 1, 1); PG8_STAGE(PG8_SA(1, 0), a3, voffA);
            PG8_BAR; PG8_WAIT_L(0); PG8_MMA(1, 0, At, B0); PG8_BAR; PG8_SCHED;
            PG8_STAGE(PG8_SB(1, 1), b3 + hstep, voffB);
            PG8_WAIT_V(6); PG8_BAR; PG8_MMA(1, 1, At, B1); PG8_BAR;
            }
        }
        if constexpr (ALIGN_EPI) { if (wr == 0) PG8_BAR; }
        if constexpr (!Epi::AFTER_DRAIN) { E(acc, cur, wr, wc, fr, fq); S.done(cur); }
        if (!has_next) break;
#pragma unroll
        for (int a = 0; a < 2; ++a)
#pragma unroll
            for (int b = 0; b < 2; ++b)
#pragma unroll
                for (int m = 0; m < 4; ++m)
#pragma unroll
                    for (int n = 0; n < 2; ++n) acc[a][b][m][n] = (f32x4){0.f, 0.f, 0.f, 0.f};
        cur = nxt; cA = nA; cB = nB; ++ui;
        if constexpr (ALIGN_EPI) { if (wr == 1) PG8_BAR; }
    }
    PG8_WAIT_V(0);
    if constexpr (!ALIGN_EPI) { if (wr == 0) PG8_BAR; }
    PG8_BAR;
    if constexpr (Epi::AFTER_DRAIN) { E.fused(acc, cur, wr, wc, fr, fq, lds, wid, lane); S.done(cur); }
#undef PG8_SA
#undef PG8_SB
#undef PG8_STAGE
#undef PG8_LDA
#undef PG8_LDB
#undef PG8_MMA
#undef PG8_WAIT_V
#undef PG8_WAIT_L
#undef PG8_BAR
#undef PG8_SCHED
}
}
#ifndef PG8_SP2
#define PG8_SP2 true
#endif
#ifndef PG8_ALIGN
#define PG8_ALIGN true
#endif
#ifndef MK_N_LAUNCHES
#define MK_N_LAUNCHES 1
#endif
constexpr int NWAVES = 8;
constexpr int N_PHASES = 15;
constexpr int D = 1024, MP = 16384, MS = 1024, M = MP + MS, NSEQ = 136, FF = 2816, RC = 1792, PC = 2816, RW = 512, MODW = 9216;
constexpr float RMS_EPS = 1e-6f, LN_EPS = 1e-5f, GN_EPS = 64e-5f;
constexpr size_t O_Y = 0, O_SHP = 17825792, O_WKVP = 17840128, O_SHS = 18102272, O_WKVS = 18331648, O_CVS = 22525952, O_END = 23050240;
constexpr size_t MiB = 1u << 20;
constexpr size_t WS_CTL = 0, CTL_ZERO_BYTES = 1 * MiB;
constexpr size_t WS_GU1 = 1 * MiB, WS_DN1 = 12 * MiB, WS_WIN = 18 * MiB, WS_WOUT = 24 * MiB, WS_GU2 = 26 * MiB, WS_DN2 = 37 * MiB;
constexpr size_t WS_SMALL = 43 * MiB;
constexpr size_t WS_WLT = WS_SMALL, WS_ALT = WS_SMALL + 65536, WS_GLT = WS_SMALL + 131072, WS_WSB = WS_SMALL + 262144, WS_SILUC = WS_SMALL + 524288;
constexpr size_t WS_MOD = 44 * MiB;
constexpr size_t WS_BON = 49 * MiB;
constexpr size_t WS_FP = 331 * MiB;
constexpr size_t WS_XN = 50 * MiB;
constexpr size_t WS_ACT = 84 * MiB;
constexpr size_t WS_PUV = WS_ACT + 60 * MiB;
static_assert((size_t)M * 1792 * 2 <= 60 * MiB && WS_PUV + (size_t)M * 1024 * 2 <= 178 * MiB, "ws map puv");
constexpr size_t WS_SC = 178 * MiB, SC_STRIDE = 17 * MiB;
constexpr size_t WS_G = 280 * MiB;
constexpr size_t WS_Y = 297 * MiB;
constexpr size_t WS_FRG = 339 * MiB;
constexpr size_t WS_END = 348 * MiB;
static_assert(WS_FRG + (size_t)M * 256 * 2 <= WS_END, "ws map frg");
static_assert(WS_FP + (size_t)136 * 448 * 64 * 2 <= WS_END, "ws map fp");
static_assert(WS_DN1 - WS_GU1 >= (size_t)5632 * 1024 * 2 && WS_WIN - WS_DN1 >= (size_t)1024 * 2816 * 2 && WS_WOUT - WS_WIN >= (size_t)2816 * 1024 * 2 && WS_GU2 - WS_WOUT >= (size_t)1024 * 1024 * 2, "ws map a");
static_assert(WS_DN2 - WS_GU2 >= (size_t)5632 * 1024 * 2 && WS_SMALL - WS_DN2 >= (size_t)1024 * 2816 * 2 && WS_BON - WS_MOD >= (size_t)136 * 9216 * 4 && WS_XN - WS_BON >= (size_t)M * 8 * 4, "ws map b");
static_assert(WS_ACT - WS_XN >= (size_t)M * 1024 * 2 && WS_SC - WS_ACT >= (size_t)M * 2816 * 2 && SC_STRIDE >= (size_t)M * 512 * 2 && WS_G - WS_SC >= 6 * SC_STRIDE && WS_Y - WS_G >= (size_t)M * 512 * 2 && WS_END - WS_Y >= (size_t)M * 512 * 4, "ws map c");
constexpr int CW_TMO = 0, CW_CODE = 1, CW_BAR = 4096;
constexpr int RING_OFF = 0, RING_BYTES = 139264;
constexpr int LDS_BYTES = 163840;
constexpr int LDSCTL_OFF = LDS_BYTES - 1024, MISC_OFF = LDSCTL_OFF + 320;
struct Args { const float* in[30]; float* out; unsigned char* ws; int ph_lo, ph_hi; };
constexpr int PTRS_OFF = MISC_OFF + 128;
#ifndef USE_PTR_TABLE
#define USE_PTR_TABLE 1
#endif
#if !USE_PTR_TABLE
struct InAcc { const float* in[30]; };
#else
struct InPtrs { __attribute__((address_space(3))) unsigned* t;
    __device__ __forceinline__ const float* operator[](int i) const { const unsigned lo = __builtin_amdgcn_readfirstlane(t[2 * i]), hi = __builtin_amdgcn_readfirstlane(t[2 * i + 1]); return (const float*)(const __attribute__((address_space(1))) float*)(((unsigned long long)hi << 32) | lo); } };
struct InAcc { InPtrs in; };
#endif
#define GAS __attribute__((address_space(1)))
#define LAS __attribute__((address_space(3)))
typedef unsigned short bf16;
typedef unsigned v4u __attribute__((ext_vector_type(4)));
typedef float f32x4 __attribute__((ext_vector_type(4)));
typedef short bf16x8 __attribute__((ext_vector_type(8)));
typedef GAS unsigned gu32;
typedef GAS unsigned long long gu64;
#define RLX_AGENT __ATOMIC_RELAXED, __HIP_MEMORY_SCOPE_AGENT
#define LDS_WAIT() asm volatile("s_waitcnt lgkmcnt(0)" ::: "memory")
#define VM_WAIT() asm volatile("s_waitcnt vmcnt(0)" ::: "memory")
__device__ __forceinline__ unsigned long long rt() { return __builtin_amdgcn_s_memrealtime(); }
__device__ __forceinline__ unsigned f2bf(float f) { unsigned u = __builtin_bit_cast(unsigned, f); return (u + 0x7fffu + ((u >> 16) & 1u)) >> 16; }
__device__ __forceinline__ unsigned pk2(float lo, float hi) { return f2bf(lo) | (f2bf(hi) << 16); }
#define XB_TMO      128
#define XB_XCNT(j)  (256  + 64 * (j))
#define XB_XSUB(j)  (1280 + 64 * (j))
#define XB_XGEN(j)  (2304 + 64 * (j))
#define XB_TOP      3328
#define XB_TOPGEN   3392
#define XCD_BAR_WORDS 3456
#define XB_SPIN_CAP (1u << 18)

__device__ __forceinline__ unsigned xb_ld(unsigned* p)              { return __hip_atomic_load(p, __ATOMIC_RELAXED, __HIP_MEMORY_SCOPE_AGENT); }
__device__ __forceinline__ unsigned xb_add(unsigned* p, unsigned v) { return __hip_atomic_fetch_add(p, v, __ATOMIC_RELAXED, __HIP_MEMORY_SCOPE_AGENT); }
__device__ __forceinline__ unsigned xb_xcc_id() { return (unsigned)__builtin_amdgcn_s_getreg((3 << 11) | 20) & 0xFu; }
#define XB_SPIN(cond, bar) do { unsigned _sp = 0; while (cond) { __builtin_amdgcn_s_sleep(1); \
    if ((++_sp & 255u) == 0u) { if (xb_ld(&(bar)[XB_TMO])) break; if (_sp > XB_SPIN_CAP) { atomicAdd(&(bar)[XB_TMO], 1u); break; } } } } while (0)

struct XcdBarrier {
    unsigned* bar; unsigned x;
    volatile LAS unsigned* st;
};

__device__ __forceinline__ XcdBarrier xcd_barrier_post(unsigned* bar, volatile LAS unsigned* st) {
    XcdBarrier b; b.bar = bar; b.x = xb_xcc_id(); b.st = st;
    if (threadIdx.x == 0) (void)xb_add(&bar[XB_XCNT(b.x)], 1u);
    return b;
}
__device__ __forceinline__ void xcd_barrier_complete(unsigned* bar, unsigned x, unsigned& nloc, unsigned& nx) {
    const unsigned G = gridDim.x * gridDim.y * gridDim.z;
    unsigned sum, cnt, mine, sp = 0u;
    for (;;) {
        sum = 0u; cnt = 0u; mine = 0u;
#pragma unroll
        for (unsigned j = 0; j < 16; ++j) { const unsigned c = xb_ld(&bar[XB_XCNT(j)]); sum += c; cnt += (c > 0u) ? 1u : 0u; mine = (j == x) ? c : mine; }
        if (sum == G) break;
        __builtin_amdgcn_s_sleep(1);
        if ((++sp & 255u) == 0u) { if (xb_ld(&bar[XB_TMO])) break; if (sp > XB_SPIN_CAP) { atomicAdd(&bar[XB_TMO], 1u); break; } }
    }
    nloc = mine > 0u ? mine : 1u; nx = cnt > 0u ? cnt : 1u;
}

__device__ __forceinline__ void xcd_barrier(const XcdBarrier& b) {
    asm volatile("s_waitcnt vmcnt(0)" ::: "memory");
    __syncthreads();
    if (threadIdx.x == 0) {
        unsigned* bar = b.bar;
        __builtin_amdgcn_s_waitcnt(0);
        unsigned nloc = b.st[0], nx = b.st[1];
        if (nloc == 0u) { xcd_barrier_complete(bar, b.x, nloc, nx); b.st[0] = nloc; b.st[1] = nx; }
        const unsigned old = xb_add(&bar[XB_XSUB(b.x)], 1u);
        const unsigned gen = old / nloc;
        if (old + 1u == (gen + 1u) * nloc) {
            __builtin_amdgcn_fence(__ATOMIC_RELEASE, "agent");
            asm volatile("s_waitcnt vmcnt(0)" ::: "memory");
            const unsigned og = xb_add(&bar[XB_TOP], 1u);
            const unsigned tg = og / nx;
            if (og + 1u == (tg + 1u) * nx) xb_add(&bar[XB_TOPGEN], 1u);
            else XB_SPIN(xb_ld(&bar[XB_TOPGEN]) == tg, bar);
            __builtin_amdgcn_fence(__ATOMIC_ACQUIRE, "agent");
            xb_add(&bar[XB_XGEN(b.x)], 1u);
            asm volatile("s_waitcnt vmcnt(0)" ::: "memory");
        } else {
            XB_SPIN(xb_ld(&bar[XB_XGEN(b.x)]) == gen, bar);
            __builtin_amdgcn_fence(__ATOMIC_ACQUIRE, "agent");
            asm volatile("s_waitcnt vmcnt(0)" ::: "memory");
        }
    }
    __syncthreads();
}
struct Frame {
    LAS unsigned char* lds;
    volatile LAS unsigned* MISC;
    gu32* ctl;
    int tid, lane, wave, gw, NGW, G;
    float* out; unsigned char* ws;
};
__device__ __forceinline__ float wave_sum(float v) {
#pragma unroll
    for (int o = 1; o < 64; o <<= 1) v += __shfl_xor(v, o);
    return v;
}
__device__ __forceinline__ float bf2f(unsigned short b) { return __uint_as_float((unsigned)b << 16); }
__device__ __forceinline__ void unpack8(v4u w, float* f) {
    f[0] = __uint_as_float(w.x << 16); f[1] = __uint_as_float(w.x & 0xffff0000u); f[2] = __uint_as_float(w.y << 16); f[3] = __uint_as_float(w.y & 0xffff0000u);
    f[4] = __uint_as_float(w.z << 16); f[5] = __uint_as_float(w.z & 0xffff0000u); f[6] = __uint_as_float(w.w << 16); f[7] = __uint_as_float(w.w & 0xffff0000u);
}
typedef unsigned v2u __attribute__((ext_vector_type(2)));
__device__ __forceinline__ void unpack4(v2u w, float* f) {
    f[0] = __uint_as_float(w.x << 16); f[1] = __uint_as_float(w.x & 0xffff0000u); f[2] = __uint_as_float(w.y << 16); f[3] = __uint_as_float(w.y & 0xffff0000u);
}
__device__ __forceinline__ v2u pack4(const float* f) { v2u w; w.x = pk2(f[0], f[1]); w.y = pk2(f[2], f[3]); return w; }
__device__ __forceinline__ v4u pack8(const float* f) { v4u w; w.x = pk2(f[0], f[1]); w.y = pk2(f[2], f[3]); w.z = pk2(f[4], f[5]); w.w = pk2(f[6], f[7]); return w; }
__device__ __forceinline__ bf16x8 as_bf16x8(v4u w) { return __builtin_bit_cast(bf16x8, w); }
__device__ __forceinline__ float sigmoid_f(float x) { return 1.0f / (1.0f + __expf(-x)); }
__device__ __forceinline__ float tanh_f(float x) { const float e = __expf(2.0f * x); return 1.0f - 2.0f / (e + 1.0f); }

__device__ __forceinline__ void transpose_item(const float* W, int K, int N, bf16* WT, int kb, int nb, int orow0, LAS float* scr, int lane) {
    const int k0 = 64 * kb, n0 = 32 * nb;
#pragma unroll 8
    for (int i = 0; i < 32; ++i) { const int kk = 2 * i + (lane >> 5); scr[kk * 33 + (lane & 31)] = W[(size_t)(k0 + kk) * N + n0 + (lane & 31)]; }
    LDS_WAIT(); asm volatile("" ::: "memory");
    const int c = lane & 7;
#pragma unroll
    for (int j = 0; j < 4; ++j) { const int n = (lane >> 3) + 8 * j; const LAS float* s = scr + (8 * c) * 33 + n;
        v4u o; o.x = pk2(s[0 * 33], s[1 * 33]); o.y = pk2(s[2 * 33], s[3 * 33]); o.z = pk2(s[4 * 33], s[5 * 33]); o.w = pk2(s[6 * 33], s[7 * 33]);
        *(GAS v4u*)(WT + (size_t)(orow0 + n) * K + k0 + 8 * c) = o; }
    LDS_WAIT(); asm volatile("" ::: "memory");
}
__device__ __forceinline__ int gu_row(int n0) { return n0 < FF ? 256 * (n0 >> 7) + (n0 & 127) : 256 * ((n0 - FF) >> 7) + 128 + ((n0 - FF) & 127); }
__device__ __forceinline__ void p0_prologue(Frame& F, const InAcc& A) {
    LAS float* scr = (LAS float*)(F.lds + RING_OFF + F.wave * 16384);
    constexpr int I_GU = 16 * 176, I_DN = 44 * 32, I_IN = 16 * 88, I_OUT = 16 * 32, I_L64 = 16, I_L128 = 32;
    constexpr int NITEMS = 2 * I_GU + 2 * I_DN + I_IN + I_OUT + 2 * I_L64 + I_L128;
    for (int it = F.gw; it < NITEMS; it += F.NGW) {
        int r = it;
        if (r < I_GU) { const int kb = r / 176, nb = r % 176; transpose_item(A.in[8], 1024, 5632, ((bf16*)(F.ws + WS_GU1)), kb, nb, gu_row(32 * nb), scr, F.lane); continue; } r -= I_GU;
        if (r < I_GU) { const int kb = r / 176, nb = r % 176; transpose_item(A.in[27], 1024, 5632, ((bf16*)(F.ws + WS_GU2)), kb, nb, gu_row(32 * nb), scr, F.lane); continue; } r -= I_GU;
        if (r < I_DN) { const int kb = r / 32, nb = r % 32; transpose_item(A.in[9], 2816, 1024, ((bf16*)(F.ws + WS_DN1)), kb, nb, 32 * nb, scr, F.lane); continue; } r -= I_DN;
        if (r < I_DN) { const int kb = r / 32, nb = r % 32; transpose_item(A.in[28], 2816, 1024, ((bf16*)(F.ws + WS_DN2)), kb, nb, 32 * nb, scr, F.lane); continue; } r -= I_DN;
        if (r < I_IN) { const int kb = r / 88, nb = r % 88; transpose_item(A.in[10], 1024, 2816, ((bf16*)(F.ws + WS_WIN)), kb, nb, 32 * nb, scr, F.lane); continue; } r -= I_IN;
        if (r < I_OUT) { const int kb = r / 32, nb = r % 32; transpose_item(A.in[26], 1024, 1024, ((bf16*)(F.ws + WS_WOUT)), kb, nb, 32 * nb, scr, F.lane); continue; } r -= I_OUT;
        if (r < I_L64) { transpose_item(A.in[13], 64, 512, ((bf16*)(F.ws + WS_WLT)), 0, r, 32 * r, scr, F.lane); continue; } r -= I_L64;
        if (r < I_L64) { transpose_item(A.in[15], 64, 512, ((bf16*)(F.ws + WS_ALT)), 0, r, 32 * r, scr, F.lane); continue; } r -= I_L64;
        { const int kb = r / 16, nb = r % 16; transpose_item(A.in[16], 128, 512, ((bf16*)(F.ws + WS_GLT)), kb, nb, 32 * nb, scr, F.lane); }
    }
    const int gt = F.gw * 64 + F.lane, NGT = F.NGW * 64;
    for (int i = gt; i < NSEQ * 448; i += NGT) { const int sq = i / 448, cg = i % 448;
        f32x4 v = {0.f, 0.f, 0.f, 0.f}; if (sq >= 8) v = *(const f32x4*)(A.in[2] + (size_t)(sq - 8) * RC + 4 * cg);
        v2u w; w.x = pk2(v.x, v.y); w.y = pk2(v.z, v.w); *(v2u*)((bf16*)(F.ws + WS_FP) + (size_t)i * 64) = w; }
    for (int i = gt; i < 8 * 128 * 64; i += NGT) { const int j = (i & 63) * 2, ii = (i >> 6) & 127;
        const float a = A.in[24][2 * (size_t)i], b = A.in[24][2 * (size_t)i + 1];
        ((unsigned*)((bf16*)(F.ws + WS_WSB)))[i] = pk2(j <= ii ? a : 0.f, (j + 1) <= ii ? b : 0.f); }
}
__device__ __forceinline__ void p1_mod(Frame& F, const InAcc& A) {
    const int l15 = F.lane & 15, q = F.lane >> 4;
    const float* w_ada = A.in[6]; const float* b_ada = A.in[7];
    const float* c_p = A.in[4]; const float* c_s = A.in[5];
    LAS f32x4* red = (LAS f32x4*)(F.lds + RING_OFF);
    for (int nt = blockIdx.x; nt < MODW / 16; nt += F.G) {
        const int n0 = 16 * nt, kb = 128 * F.wave + 8 * q;
        float wv[4][8];
        const float* wp = w_ada + (size_t)kb * MODW + n0 + l15;
#pragma unroll
        for (int ks = 0; ks < 4; ++ks) {
#pragma unroll
            for (int j = 0; j < 8; ++j) { wv[ks][j] = *wp; wp += MODW; asm volatile("" : "+v"(wp)); }
            wp += 24 * MODW; }
        f32x4 acc[9];
#pragma unroll
        for (int mt = 0; mt < 9; ++mt) acc[mt] = (f32x4){0.f, 0.f, 0.f, 0.f};
#pragma unroll 1
        for (int ks = 0; ks < 4; ++ks) {
            f32x4 raw[9][2];
#pragma unroll
            for (int mt = 0; mt < 9; ++mt) { const int sq = 16 * mt + l15; const int sc = sq < NSEQ ? sq : 0;
                const float* cr = (sc < 8 ? c_p + (size_t)sc * D : c_s + (size_t)(sc - 8) * D) + kb + 32 * ks; raw[mt][0] = *(const f32x4*)cr; raw[mt][1] = *(const f32x4*)(cr + 4); }
            __builtin_amdgcn_sched_barrier(0);
            const bf16x8 wf = as_bf16x8(pack8(wv[0]));
#pragma unroll
            for (int mt = 0; mt < 9; ++mt) { const bool ok = 16 * mt + l15 < NSEQ; float t[8];
#pragma unroll
                for (int e = 0; e < 4; ++e) { t[e] = ok ? pg8::silu_f(raw[mt][0][e]) : 0.f; t[4 + e] = ok ? pg8::silu_f(raw[mt][1][e]) : 0.f; }
                acc[mt] = __builtin_amdgcn_mfma_f32_16x16x32_bf16(wf, as_bf16x8(pack8(t)), acc[mt], 0, 0, 0); }
            __builtin_amdgcn_sched_barrier(0);
#pragma unroll
            for (int i = 0; i < 3; ++i)
#pragma unroll
                for (int j = 0; j < 8; ++j) wv[i][j] = wv[i + 1][j];
        }
#pragma unroll
        for (int mt = 0; mt < 9; ++mt) red[(F.wave * 9 + mt) * 64 + F.lane] = acc[mt];
        __syncthreads();
        const f32x4 bv = *(const f32x4*)(b_ada + n0 + 4 * q);
#pragma unroll
        for (int rr = 0; rr < 2; ++rr) { const int mt = F.wave + 8 * rr; if (mt < 9) { f32x4 s = bv;
#pragma unroll
                for (int w2 = 0; w2 < 8; ++w2) s += red[(w2 * 9 + mt) * 64 + F.lane];
                const int sq = 16 * mt + l15; if (sq < NSEQ) *(f32x4*)(((float*)(F.ws + WS_MOD)) + (size_t)sq * MODW + n0 + 4 * q) = s; } }
        __syncthreads();
    }
}
__device__ __forceinline__ const float* res_row(const float* pP, const float* pS, int row) { return row < MP ? pP + (size_t)row * D : pS + (size_t)(row - MP) * D; }
__device__ __forceinline__ void load_h_row(const bf16* hb, int row, int lane, f32x4* v) {
    const v2u* hr = (const v2u*)(hb + (size_t)row * 2048 + 1024) + lane;
#pragma unroll
    for (int j = 0; j < 4; ++j) { float t[4]; unpack4(hr[64 * j], t); v[j] = (f32x4){t[0], t[1], t[2], t[3]}; }
}
template <bool SRC_X> struct RowRaw { f32x4 x[4]; v2u h[4]; };
template <bool SRC_X> __device__ __forceinline__ void norm_load(RowRaw<SRC_X>& R, const float* srcP, const float* srcS, const bf16* hb, int row, int lane) {
    if (SRC_X) { const f32x4* xr = (const f32x4*)res_row(srcP, srcS, row) + lane;
#pragma unroll
        for (int j = 0; j < 4; ++j) R.x[j] = xr[64 * j]; }
    else { const v2u* hr = (const v2u*)(hb + (size_t)row * 2048 + 1024) + lane;
#pragma unroll
        for (int j = 0; j < 4; ++j) R.h[j] = hr[64 * j]; }
}
__device__ __forceinline__ void norm_finish(Frame& F, const f32x4* v, int row, int s, int sh_off, int sc_off) {
    const float* MODp = (const float*)(F.ws + WS_MOD);
    float ss = 0.f;
#pragma unroll
    for (int j = 0; j < 4; ++j) ss += (v[j].x * v[j].x + v[j].y * v[j].y) + (v[j].z * v[j].z + v[j].w * v[j].w);
    const float rstd = 1.0f / sqrtf(wave_sum(ss) * (1.0f / D) + RMS_EPS);
    const f32x4* sc = (const f32x4*)(MODp + (size_t)s * MODW + sc_off) + F.lane; const f32x4* sh = (const f32x4*)(MODp + (size_t)s * MODW + sh_off) + F.lane;
    v2u* o = (v2u*)(((bf16*)(F.ws + WS_XN)) + (size_t)row * D) + F.lane;
#pragma unroll
    for (int j = 0; j < 4; ++j) { const f32x4 a = sc[64 * j], bb = sh[64 * j]; const f32x4 r = v[j] * rstd * (a + 1.0f) + bb; float t[4] = {r.x, r.y, r.z, r.w}; o[64 * j] = pack4(t); }
}
template <bool SRC_X> __device__ __forceinline__ void norm_rows_bf16(Frame& F, const InAcc& A, const float* srcP, const float* srcS, bool sample_src_x, int sh_off, int sc_off, int ns, int g_off, float coef) {
    const float* MODp = (const float*)(F.ws + WS_MOD); bf16* hb = (bf16*)F.out;
    const int nmain = ns > 0 ? MP : M;
    RowRaw<SRC_X> cur, nxt;
    int row = F.gw;
    if (row < nmain) norm_load<SRC_X>(cur, srcP, srcS, hb, row, F.lane);
    while (row < nmain) {
        const int nrow = row + F.NGW;
        if (nrow < nmain) norm_load<SRC_X>(nxt, srcP, srcS, hb, nrow, F.lane);
        f32x4 v[4];
#pragma unroll
        for (int j = 0; j < 4; ++j) { if (SRC_X) v[j] = cur.x[j]; else { float t[4]; unpack4(cur.h[j], t); v[j] = (f32x4){t[0], t[1], t[2], t[3]}; } }
        norm_finish(F, v, row, pg8::seq_of_row(row), sh_off, sc_off);
        cur = nxt; row = nrow;
    }
    if (ns > 0) for (int r2 = MP + F.gw; r2 < M; r2 += F.NGW) {
        const int s = pg8::seq_of_row(r2);
        f32x4 v[4];
        if (sample_src_x) { const f32x4* xr = (const f32x4*)(srcS + (size_t)(r2 - MP) * D) + F.lane;
#pragma unroll
            for (int j = 0; j < 4; ++j) v[j] = xr[64 * j]; }
        else load_h_row(hb, r2, F.lane, v);
        const f32x4* sl = (const f32x4*)(F.ws + WS_SC) + (size_t)(r2 - MP) * (D / 4) + F.lane; const f32x4* gp = (const f32x4*)(MODp + (size_t)s * MODW + g_off) + F.lane;
        v2u* hr = (v2u*)(hb + (size_t)r2 * 2048 + 1024) + F.lane;
#pragma unroll
        for (int j = 0; j < 4; ++j) { f32x4 t = {0.f, 0.f, 0.f, 0.f}; for (int k = 0; k < ns; ++k) t += sl[(size_t)k * (1024 * D / 4) + 64 * j]; v[j] = v[j] + (gp[64 * j] * coef) * t;
            float q4[4] = {v[j].x, v[j].y, v[j].z, v[j].w}; const v2u pk = pack4(q4); hr[64 * j] = pk; float u4[4]; unpack4(pk, u4); v[j] = (f32x4){u4[0], u4[1], u4[2], u4[3]}; }
        norm_finish(F, v, r2, s, sh_off, sc_off);
    }
}
__device__ __forceinline__ void final_norm_rows(Frame& F, const InAcc& A, int ns, int g_off, float coef) {
    const float* MODp = (const float*)(F.ws + WS_MOD); const bf16* hb = (const bf16*)F.out;
    const f32x4* g = (const f32x4*)A.in[29] + F.lane;
    RowRaw<false> cur, nxt;
    int row = F.gw;
    if (row < M) norm_load<false>(cur, nullptr, nullptr, hb, row, F.lane);
    while (row < M) {
        const int nrow = row + F.NGW;
        if (nrow < M) norm_load<false>(nxt, nullptr, nullptr, hb, nrow, F.lane);
        f32x4* xr = (f32x4*)(F.out + (size_t)row * D) + F.lane;
        f32x4 v[4];
#pragma unroll
        for (int j = 0; j < 4; ++j) { float t[4]; unpack4(cur.h[j], t); v[j] = (f32x4){t[0], t[1], t[2], t[3]}; }
        if (ns > 0 && row >= MP) { const int s = pg8::seq_of_row(row); const f32x4* sl = (const f32x4*)(F.ws + WS_SC) + (size_t)(row - MP) * (D / 4) + F.lane; const f32x4* gp = (const f32x4*)(MODp + (size_t)s * MODW + g_off) + F.lane;
#pragma unroll
            for (int j = 0; j < 4; ++j) { f32x4 t = {0.f, 0.f, 0.f, 0.f}; for (int k = 0; k < ns; ++k) t += sl[(size_t)k * (1024 * D / 4) + 64 * j]; v[j] = v[j] + (gp[64 * j] * coef) * t; } }
        float ss = 0.f;
#pragma unroll
        for (int j = 0; j < 4; ++j) ss += (v[j].x * v[j].x + v[j].y * v[j].y) + (v[j].z * v[j].z + v[j].w * v[j].w);
        const float rstd = 1.0f / sqrtf(wave_sum(ss) * (1.0f / D) + RMS_EPS);
        asm volatile("" ::: "memory");
#pragma unroll
        for (int j = 0; j < 4; ++j) xr[64 * j] = v[j] * rstd * g[64 * j];
        cur = nxt; row = nrow;
    }
}
__device__ __forceinline__ unsigned dpp_shr1(unsigned x) { return (unsigned)__builtin_amdgcn_update_dpp(0, (int)x, 0x111, 0xf, 0xf, false); }
__device__ __forceinline__ size_t sc_off(int row, int c) { return ((size_t)((row >> 4) * 128 + (c >> 2)) * 16 + (row & 15)) * 4 + (c & 3); }
__device__ __forceinline__ void frag_item(Frame& F, const InAcc& A, int r0, int gh  ) {
    const int l15 = F.lane & 15, q = F.lane >> 4, row = r0 + l15, tile = r0 >> 4;
    const bf16* PB = (const bf16*)(F.ws + WS_ACT);
    const bf16* pcur = PB + ((size_t)tile * 448 * 16 + l15) * 4;
    const bool first = pg8::row_is_first(row);
    const bf16* fp = (const bf16*)(F.ws + WS_FP) + (size_t)pg8::seq_of_row(row) * 448 * 64;
    const bf16* pprv = PB + ((size_t)(tile > 0 ? tile - 1 : 0) * 448 * 16 + 15) * 4;
    const bf16* pb = first ? fp : (l15 == 0 ? pprv : pcur - 4);
    const float* mu = A.in[11];
    v2u lc[16], lp[16];
#pragma unroll
    for (int i = 0; i < 16; ++i) if ((i >> 3) == gh) { const size_t o = (size_t)(384 + 8 * (i >> 1) + 2 * q + (i & 1)) * 64; lc[i] = *(const v2u*)(pcur + o); lp[i] = *(const v2u*)(pb + o); }
#pragma unroll
    for (int g = 0; g < 8; ++g) if ((g >> 2) == gh) { const int col = 1536 + 32 * g + 8 * q; float cur[8], prv[8]; unpack4(lc[2 * g], cur); unpack4(lc[2 * g + 1], cur + 4); unpack4(lp[2 * g], prv); unpack4(lp[2 * g + 1], prv + 4);
        const f32x4 m0 = *(const f32x4*)(mu + col), m1 = *(const f32x4*)(mu + col + 4); const float mm[8] = {m0.x, m0.y, m0.z, m0.w, m1.x, m1.y, m1.z, m1.w};
        float t[8];
#pragma unroll
        for (int e = 0; e < 8; ++e) { const float x = cur[e] + (prv[e] - cur[e]) * mm[e]; t[e] = g < 2 ? tanh_f(x) : (g < 4 ? x : sigmoid_f(x)); }
        *(v4u*)((bf16*)(F.ws + WS_FRG) + ((size_t)((tile * 8 + g) * 4 + q) * 16 + l15) * 8) = pack8(t); }
}
__device__ __forceinline__ void prep_item(Frame& F, const InAcc& A, int r0, int h) {
    const int l15 = F.lane & 15, q = F.lane >> 4, row = r0 + l15, tile = r0 >> 4;
    const bf16* PB = (const bf16*)(F.ws + WS_ACT);
    const bf16* pcur = PB + ((size_t)tile * 448 * 16 + l15) * 4;
    const bool first = pg8::row_is_first(row);
    const bf16* fp = (const bf16*)(F.ws + WS_FP) + (size_t)pg8::seq_of_row(row) * 448 * 64;
    const bf16* pprv = PB + ((size_t)(tile > 0 ? tile - 1 : 0) * 448 * 16 + 15) * 4;
    const float* mu = A.in[11];
    v2u xc[4][3], xp[4][3];
    const bf16* pb = first ? fp : (l15 == 0 ? pprv : pcur - 4); constexpr int pmul = 64;
    bf16x8 fr[8];
#pragma unroll
    for (int g = 0; g < 8; ++g) fr[g] = *(const bf16x8*)((const bf16*)(F.ws + WS_FRG) + ((size_t)((tile * 8 + g) * 4 + q) * 16 + l15) * 8);
#pragma unroll
    for (int ntl = 0; ntl < 4; ++ntl)
#pragma unroll
        for (int sct = 0; sct < 3; ++sct) xc[ntl][sct] = *(const v2u*)(pcur + (size_t)(128 * sct + 16 * h + 4 * ntl + q) * 64);
#pragma unroll
    for (int ntl = 0; ntl < 4; ++ntl)
#pragma unroll
        for (int sct = 0; sct < 3; ++sct) xp[ntl][sct] = *(const v2u*)(pb + (size_t)(128 * sct + 16 * h + 4 * ntl + q) * pmul);
    v2u xm[4][3];
    const float* k_k = A.in[17];
    float ss = 0.f, bon = 0.f;
#pragma unroll
    for (int ntl = 0; ntl < 4; ++ntl)
#pragma unroll
        for (int sct = 0; sct < 3; ++sct) { const int col = 512 * sct + 64 * h + 16 * ntl + 4 * q; float cur[4], prv[4], x[4]; unpack4(xc[ntl][sct], cur); unpack4(xp[ntl][sct], prv);
            const f32x4 m0 = *(const f32x4*)(mu + col);
#pragma unroll
            for (int e = 0; e < 4; ++e) x[e] = cur[e] + (prv[e] - cur[e]) * m0[e];
            xm[ntl][sct] = pack4(x);
            if (sct == 1) { float xb[4]; unpack4(xm[ntl][sct], xb); const f32x4 kkv = *(const f32x4*)(k_k + 64 * h + 16 * ntl + 4 * q);
#pragma unroll
                for (int e = 0; e < 4; ++e) { const float kr = xb[e] * kkv[e]; ss += kr * kr; } } }
    __builtin_amdgcn_sched_barrier(0);
    ss += __shfl_xor(ss, 16); ss += __shfl_xor(ss, 32);
    const float inv = 1.0f / fmaxf(sqrtf(ss), 1e-12f);
    const LAS bf16x8* wl = (const LAS bf16x8*)(F.lds + RING_OFF) + F.lane;
    const LAS float* hp = (const LAS float*)(F.lds + RING_OFF + 32768);
#pragma unroll 1
    for (int ntl = 0; ntl < 4; ++ntl) {
        const int n0 = 64 * h + 16 * ntl, c0 = n0 + 4 * q;
        f32x4 aw = {0.f, 0.f, 0.f, 0.f}, aa = aw, ag = aw;
#pragma unroll
        for (int ks = 0; ks < 2; ++ks) {
            aw = __builtin_amdgcn_mfma_f32_16x16x32_bf16(wl[(2 * ntl + ks) * 64], fr[ks], aw, 0, 0, 0);
            aa = __builtin_amdgcn_mfma_f32_16x16x32_bf16(wl[(8 + 2 * ntl + ks) * 64], fr[2 + ks], aa, 0, 0, 0); }
#pragma unroll
        for (int ks = 0; ks < 4; ++ks)
            ag = __builtin_amdgcn_mfma_f32_16x16x32_bf16(wl[(16 + 4 * ntl + ks) * 64], fr[4 + ks], ag, 0, 0, 0);
        const int cl = 16 * ntl + 4 * q;
        const f32x4 w0v = *(const LAS f32x4*)(hp + cl), a0v = *(const LAS f32x4*)(hp + 64 + cl), kkv = *(const LAS f32x4*)(hp + 128 + cl), kav = *(const LAS f32x4*)(hp + 192 + cl), rkv = *(const LAS f32x4*)(hp + 256 + cl);
        float omd[4], km[4], gg[4], kk[4], bb[4], xrf[4], xkf[4]; unpack4(xm[0][0], xrf); unpack4(xm[0][1], xkf);
#pragma unroll
        for (int e = 0; e < 4; ++e) {
            const float z = -(w0v[e] + aw[e]);
            const float sp = z > 20.f ? z : __logf(1.0f + __expf(z));
            const float wlog = -sp - 0.5f;
            const float dec = __expf(-__expf(wlog));
            omd[e] = 1.0f - dec;
            const float a = sigmoid_f(a0v[e] + aa[e]);
            kk[e] = xkf[e] * kkv[e] * inv; bb[e] = kk[e] * a;
            km[e] = xkf[e] * (1.0f + (a - 1.0f) * kav[e]);
            bon += xrf[e] * km[e] * rkv[e];
            gg[e] = ag[e];
        }
        const size_t o = sc_off(row, c0);
        *(v2u*)(((bf16*)(F.ws + WS_SC)) + o) = xm[0][0]; *(v2u*)(((bf16*)(F.ws + (WS_SC + SC_STRIDE))) + o) = pack4(km); *(v2u*)(((bf16*)(F.ws + (WS_SC + 2 * SC_STRIDE))) + o) = xm[0][2];
        *(v2u*)(((bf16*)(F.ws + (WS_SC + 3 * SC_STRIDE))) + o) = pack4(kk); *(v2u*)(((bf16*)(F.ws + (WS_SC + 4 * SC_STRIDE))) + o) = pack4(bb);
        *(v2u*)(((bf16*)(F.ws + (WS_SC + 5 * SC_STRIDE))) + o) = pack4(omd); *(v2u*)(((bf16*)(F.ws + WS_G)) + o) = pack4(gg);
#pragma unroll
        for (int i = 0; i < 3; ++i)
#pragma unroll
            for (int e = 0; e < 3; ++e) xm[i][e] = xm[i + 1][e];
    }
    bon += __shfl_xor(bon, 16); bon += __shfl_xor(bon, 32);
    if (q == 0) ((float*)(F.ws + WS_BON))[(size_t)row * 8 + h] = bon;
}
__device__ __forceinline__ void prep_all(Frame& F, const InAcc& A) {
    const int w = blockIdx.x, h = w & 7; const int nslots = (F.G >> 3) * NWAVES;
    if (F.G & 7) return;
    { const bf16* WLT = (const bf16*)(F.ws + WS_WLT); const bf16* ALT = (const bf16*)(F.ws + WS_ALT); const bf16* GLT = (const bf16*)(F.ws + WS_GLT);
      LAS v4u* dst = (LAS v4u*)(F.lds + RING_OFF);
#pragma unroll
      for (int i = 0; i < 4; ++i) { const int p = F.tid + 512 * i, f = p >> 6, L = p & 63, l15 = L & 15, q = L >> 4;
          const bf16* src;
          if (f < 8) src = WLT + (size_t)(64 * h + 16 * (f >> 1) + l15) * 64 + 32 * (f & 1) + 8 * q;
          else if (f < 16) src = ALT + (size_t)(64 * h + 16 * ((f - 8) >> 1) + l15) * 64 + 32 * (f & 1) + 8 * q;
          else src = GLT + (size_t)(64 * h + 16 * ((f - 16) >> 2) + l15) * 128 + 32 * (f & 3) + 8 * q;
          dst[p] = *(const v4u*)src; }
      if (F.tid < 320) { const int a = F.tid >> 6, i = F.tid & 63; const float* src = a == 0 ? A.in[12] : a == 1 ? A.in[14] : a == 2 ? A.in[17] : a == 3 ? A.in[18] : A.in[19];
          ((LAS float*)(F.lds + RING_OFF + 32768))[F.tid] = src[64 * h + i]; }
      __syncthreads(); }
    for (int tt = (w >> 3) * NWAVES + F.wave; tt < M / 16; tt += nslots) prep_item(F, A, 16 * tt, h);
    __syncthreads();
}
__device__ __forceinline__ void lnv_rows(Frame& F, const InAcc& A) {
    for (int row = F.gw; row < M; row += F.NGW) {
        v4u* pv = (v4u*)(((bf16*)(F.ws + WS_PUV)) + (size_t)row * 1024 + 512) + F.lane;
        float x[8]; unpack8(*pv, x);
        float s = 0.f;
#pragma unroll
        for (int e = 0; e < 8; ++e) s += x[e];
        const float mean = wave_sum(s) * (1.0f / 512.0f); float qq = 0.f;
#pragma unroll
        for (int e = 0; e < 8; ++e) { x[e] -= mean; qq += x[e] * x[e]; }
        const float rstd = 1.0f / sqrtf(wave_sum(qq) * (1.0f / 512.0f) + LN_EPS);
        const f32x4 g0 = *(const f32x4*)(A.in[22] + 8 * F.lane), g1 = *(const f32x4*)(A.in[22] + 8 * F.lane + 4), b0 = *(const f32x4*)(A.in[23] + 8 * F.lane), b1 = *(const f32x4*)(A.in[23] + 8 * F.lane + 4);
        const float gg[8] = {g0.x, g0.y, g0.z, g0.w, g1.x, g1.y, g1.z, g1.w}, bb[8] = {b0.x, b0.y, b0.z, b0.w, b1.x, b1.y, b1.z, b1.w};
#pragma unroll
        for (int e = 0; e < 8; ++e) x[e] = x[e] * rstd * gg[e] + bb[e];
        *pv = pack8(x);
        if (row >= MP) { float* o = F.out + O_CVS + (size_t)(row - MP) * 512 + 8 * F.lane; *(f32x4*)o = (f32x4){x[0], x[1], x[2], x[3]}; *(f32x4*)(o + 4) = (f32x4){x[4], x[5], x[6], x[7]}; }
    }
}
template <bool SAMP> __device__ __forceinline__ void gmlp_item(Frame& F, const InAcc& A, int ci, int h, LAS unsigned short* tile  ) {
    const int l15 = F.lane & 15, q = F.lane >> 4;
    const int base = SAMP ? MP + 8 * ci : 128 * ci;
    const bf16* P = (const bf16*)(F.ws + WS_PUV);
    const bf16* WSB = (const bf16*)(F.ws + WS_WSB);
    const float* b_s = A.in[25];
    constexpr int NIT = SAMP ? 1 : 8, NKS = SAMP ? 1 : 4;
    v4u xs[SAMP ? 1 : 16];
#pragma unroll
    for (int i = 0; i < (SAMP ? 1 : 16); ++i) { const int r = 8 * i + (F.lane >> 3), c8 = (F.lane & 7) * 8; xs[i] = *(const v4u*)(P + (size_t)(base + r) * 1024 + 512 + h * 64 + c8); }
    float bs[NIT];
#pragma unroll
    for (int it = 0; it < NIT; ++it) bs[it] = b_s[h * 128 + 16 * it + l15];
#pragma unroll
    for (int i = 0; i < (SAMP ? 1 : 16); ++i) { const int r = 8 * i + (F.lane >> 3), c8 = (F.lane & 7) * 8; LAS unsigned* d = (LAS unsigned*)(tile + r * 66 + c8); d[0] = xs[i].x; d[1] = xs[i].y; d[2] = xs[i].z; d[3] = xs[i].w; }
    LDS_WAIT(); asm volatile("" ::: "memory");
#pragma unroll 1
    for (int dt = 0; dt < 4; ++dt) {
        const int cc = h * 64 + 16 * dt + 4 * q;
        v2u pu[NIT];
#pragma unroll
        for (int it = 0; it < NIT; ++it) pu[it] = *(const v2u*)(P + (size_t)(base + (SAMP ? (l15 & 7) : 16 * it + l15)) * 1024 + cc);
        bf16x8 vf[NKS];
#pragma unroll
        for (int ks = 0; ks < NKS; ++ks)
#pragma unroll
            for (int jj = 0; jj < 8; ++jj) { const int jr = 32 * ks + 8 * q + jj; vf[ks][jj] = (SAMP && jr >= 8) ? (short)0 : (short)tile[jr * 66 + 16 * dt + l15]; }
#pragma unroll
        for (int it = 0; it < NIT; ++it) {
            f32x4 acc = {0.f, 0.f, 0.f, 0.f};
#pragma unroll
            for (int ks = 0; ks < NKS; ++ks) if (ks <= (it >> 1))
                acc = __builtin_amdgcn_mfma_f32_16x16x32_bf16(vf[ks], *(const bf16x8*)(WSB + ((size_t)(h * 128 + 16 * it + l15)) * 128 + 32 * ks + 8 * q), acc, 0, 0, 0);
            const int i = 16 * it + l15;
            if (!SAMP || i < 8) { const int row = base + i;
                float puf[4]; unpack4(pu[it], puf);
                float o[4];
#pragma unroll
                for (int e = 0; e < 4; ++e) o[e] = puf[e] * (acc[e] + bs[it]);
                *(v2u*)(((bf16*)(F.ws + WS_XN)) + (size_t)row * D + 512 + cc) = pack4(o); }
        }
    }
    LDS_WAIT(); asm volatile("" ::: "memory");
}
__device__ __forceinline__ float red16(float x) {
    x += __builtin_bit_cast(float, __builtin_amdgcn_update_dpp(0, __builtin_bit_cast(int, x), 0x128, 0xf, 0xf, false));
    x += __builtin_bit_cast(float, __builtin_amdgcn_update_dpp(0, __builtin_bit_cast(int, x), 0x124, 0xf, 0xf, false));
    x += __builtin_bit_cast(float, __builtin_amdgcn_update_dpp(0, __builtin_bit_cast(int, x), 0x122, 0xf, 0xf, false));
    x += __builtin_bit_cast(float, __builtin_amdgcn_update_dpp(0, __builtin_bit_cast(int, x), 0x121, 0xf, 0xf, false));
    return x;
}
typedef float f32x2 __attribute__((ext_vector_type(2)));
#define DPP_ROR(x, n) __builtin_bit_cast(float, __builtin_amdgcn_update_dpp(0, __builtin_bit_cast(int, (x)), 0x120 + (n), 0xf, 0xf, false))
__device__ __forceinline__ void red16x2(float& a, float& b) {
    a += DPP_ROR(a, 8); b += DPP_ROR(b, 8); a += DPP_ROR(a, 4); b += DPP_ROR(b, 4); a += DPP_ROR(a, 2); b += DPP_ROR(b, 2); a += DPP_ROR(a, 1); b += DPP_ROR(b, 1);
}
__device__ __forceinline__ float wkv_step(f32x4& S, const f32x4 w, const f32x4 kk, const f32x4 bb, const f32x4 k, const f32x4 r, const float vv, float& ypend) {
    f32x2 Sa = {S.x, S.y}, Sb = {S.z, S.w};
    f32x2 p = Sa * (f32x2){kk.x, kk.y}; p = Sb * (f32x2){kk.z, kk.w} + p;
    float d = p.x + p.y;
    red16x2(d, ypend);
    const f32x2 v2 = {vv, vv};
    f32x2 Ta = (f32x2){k.x, k.y} * v2, Tb = (f32x2){k.z, k.w} * v2;
    Ta = Sa * (f32x2){w.x, w.y} + Ta; Tb = Sb * (f32x2){w.z, w.w} + Tb;
    const f32x2 nd = {-d, -d};
    Sa = (f32x2){bb.x, bb.y} * nd + Ta; Sb = (f32x2){bb.z, bb.w} * nd + Tb;
    f32x2 yv = Sa * (f32x2){r.x, r.y}; yv = Sb * (f32x2){r.z, r.w} + yv;
    S = (f32x4){Sa.x, Sa.y, Sb.x, Sb.y};
    return yv.x + yv.y;
}
__device__ __forceinline__ void scan_sample_item(Frame& F, const InAcc& A, int it) {
    const int sbh = it >> 3, rp = it & 7, sb = sbh >> 3, h = sbh & 7, j = F.lane & 15, v0 = 8 * rp + (F.lane >> 4), v1 = v0 + 4;
    const size_t so0 = ((size_t)sbh * 64 + v0) * 64 + 4 * j, so1 = so0 + 4 * 64;
    f32x4 S0 = *(const f32x4*)(A.in[3] + so0), S1 = *(const f32x4*)(A.in[3] + so1);
    const size_t ro0 = (size_t)(MP + 8 * sb) * RW + h * 64;
    const bf16* scr = (const bf16*)(F.ws + WS_SC);
    v2u lw[8], lkk[8], lbb[8], lk[8], lr[8]; unsigned short lv0[8], lv1[8];
#pragma unroll
    for (int t = 0; t < 8; ++t) { const int row = MP + 8 * sb + t; const size_t ro = sc_off(row, h * 64 + 4 * j);
        lw[t] = *(const v2u*)(scr + 5 * (SC_STRIDE / 2) + ro); lkk[t] = *(const v2u*)(scr + 3 * (SC_STRIDE / 2) + ro); lbb[t] = *(const v2u*)(scr + 4 * (SC_STRIDE / 2) + ro);
        lk[t] = *(const v2u*)(scr + 1 * (SC_STRIDE / 2) + ro); lr[t] = *(const v2u*)(scr + ro); lv0[t] = scr[2 * (SC_STRIDE / 2) + sc_off(row, h * 64 + v0)]; lv1[t] = scr[2 * (SC_STRIDE / 2) + sc_off(row, h * 64 + v1)]; }
    float yk0 = 0.f, yk1 = 0.f;
#pragma unroll
    for (int t = 0; t < 8; ++t) {
        float w[4], kk[4], bb[4], k[4], r[4];
        unpack4(lw[t], w); unpack4(lkk[t], kk); unpack4(lbb[t], bb); unpack4(lk[t], k); unpack4(lr[t], r);
        const f32x4 w4 = {1.f - w[0], 1.f - w[1], 1.f - w[2], 1.f - w[3]}, kk4 = {kk[0], kk[1], kk[2], kk[3]}, bb4 = {bb[0], bb[1], bb[2], bb[3]}, k4 = {k[0], k[1], k[2], k[3]}, r4 = {r[0], r[1], r[2], r[3]};
        float dm0 = 0.f; const float y0 = red16(wkv_step(S0, w4, kk4, bb4, k4, r4, bf2f(lv0[t]), dm0));
        float dm1 = 0.f; const float y1 = red16(wkv_step(S1, w4, kk4, bb4, k4, r4, bf2f(lv1[t]), dm1));
        yk0 = (j == t) ? y0 : yk0; yk1 = (j == t) ? y1 : yk1;
    }
    if (j < 8) { float* yg = ((float*)(F.ws + WS_Y)) + ro0 + (size_t)j * RW; yg[v0] = yk0; yg[v1] = yk1; }
    *(f32x4*)(F.out + O_WKVS + so0) = S0; *(f32x4*)(F.out + O_WKVS + so1) = S1;
}
typedef short bf16x4 __attribute__((ext_vector_type(4)));
#define PADV(x) asm volatile("s_nop 15\n\ts_nop 15" : "+v"(x))
#define MFMA16(a, b, c) __builtin_amdgcn_mfma_f32_16x16x16bf16_1k((a), (b), (c), 0, 0, 0)
#define MFMA32(a, b, c) __builtin_amdgcn_mfma_f32_16x16x32_bf16((a), (b), (c), 0, 0, 0)
typedef float f32x2_cv __attribute__((ext_vector_type(2))); typedef __bf16 bf16x2_cv __attribute__((ext_vector_type(2)));
__device__ __forceinline__ unsigned hpk2(float lo, float hi) { const f32x2_cv v = {lo, hi}; return __builtin_bit_cast(unsigned, __builtin_convertvector(v, bf16x2_cv)); }
__device__ __forceinline__ bf16x4 cvt4(const f32x4 v) { v2u w; w.x = hpk2(v.x, v.y); w.y = hpk2(v.z, v.w); return __builtin_bit_cast(bf16x4, w); }
__device__ __forceinline__ bf16x8 cvt8(const f32x4 a, const f32x4 b) { v4u w; w.x = hpk2(a.x, a.y); w.y = hpk2(a.z, a.w); w.z = hpk2(b.x, b.y); w.w = hpk2(b.z, b.w); return __builtin_bit_cast(bf16x8, w); }
__device__ __forceinline__ bf16x8 hpack8(const float* f) { v4u w; w.x = hpk2(f[0], f[1]); w.y = hpk2(f[2], f[3]); w.z = hpk2(f[4], f[5]); w.w = hpk2(f[6], f[7]); return __builtin_bit_cast(bf16x8, w); }
__device__ __forceinline__ v2u hpack4(const float* f) { v2u w; w.x = hpk2(f[0], f[1]); w.y = hpk2(f[2], f[3]); return w; }
#define DPP_SHR(x, n, fill) __builtin_bit_cast(float, __builtin_amdgcn_update_dpp(__builtin_bit_cast(int, (float)(fill)), __builtin_bit_cast(int, (x)), 0x110 + (n), 0xf, 0xf, false))
#ifndef CK_NH
#define CK_NH 4
#endif
#ifndef SIDE_MASK
#define SIDE_MASK 7
#endif
#ifndef CK_AHEAD
#define CK_AHEAD 7
#endif
#ifndef CK_DUMMY_CUT
#define CK_DUMMY_CUT 0
#endif
constexpr int CK_SLOT_B = 11264, CK_NSLOT = 8, CK_SCR_OFF = CK_SLOT_B * CK_NSLOT, CK_SCR_B = 4096, CK_FLAG_OFF = CK_SCR_OFF + CK_NH * CK_SCR_B, CK_SIDE_OFF = CK_FLAG_OFF + 256, CK_SIDE_B = 16896;
constexpr int CK_KH = 0, CK_RH = 2048, CK_AKK = 4096, CK_AKR = 4608, CK_ABR = 5120, CK_TM = 5632, CK_VM = 6144, CK_KB = 6656, CK_BB = 8704, CK_GC = 10752;
static_assert(CK_SIDE_OFF + (7 - CK_NH) * CK_SIDE_B <= LDSCTL_OFF, "chunked scan LDS map");
template <int CUT = 0> __device__ __forceinline__ void chunk_prepare(Frame& F, int h, int qtr, int t0, LAS unsigned char* slot, LAS unsigned short* scr) {
    const int l15 = F.lane & 15, q = F.lane >> 4, row = t0 + l15;
    const bf16* sc = (const bf16*)(F.ws + WS_SC);
    float w[16], kk[16], bb[16], kv[16], r[16];
#pragma unroll
    for (int p = 0; p < 4; ++p) { const size_t o = sc_off(row, 64 * h + 4 * (8 * (p >> 1) + 4 * (p & 1) + q));
        unpack4(*(const v2u*)(sc + 5 * (SC_STRIDE / 2) + o), w + 4 * p); unpack4(*(const v2u*)(sc + 3 * (SC_STRIDE / 2) + o), kk + 4 * p); unpack4(*(const v2u*)(sc + 4 * (SC_STRIDE / 2) + o), bb + 4 * p);
        unpack4(*(const v2u*)(sc + 1 * (SC_STRIDE / 2) + o), kv + 4 * p); unpack4(*(const v2u*)(sc + o), r + 4 * p); }
    unsigned short vraw[4];
#pragma unroll
    for (int jj = 0; jj < 4; ++jj) vraw[jj] = sc[2 * (SC_STRIDE / 2) + sc_off(t0 + 4 * q + jj, 64 * h + 16 * qtr + l15)];
    float kh[16], rh[16], kt[16], bt[16], Kb[16], Bb[16];
#pragma unroll
    for (int c = 0; c < 16; ++c) { float g = 1.0f - w[c];
        g *= DPP_SHR(g, 1, 1.0f); g *= DPP_SHR(g, 2, 1.0f); g *= DPP_SHR(g, 4, 1.0f); g *= DPP_SHR(g, 8, 1.0f);
        const float gC = __builtin_bit_cast(float, __builtin_amdgcn_update_dpp(0, __builtin_bit_cast(int, g), 0x15F, 0xf, 0xf, false));
        const float ge = DPP_SHR(g, 1, 1.0f), inv = __builtin_amdgcn_rcpf(g);
        kh[c] = ge * kk[c]; rh[c] = g * r[c]; kt[c] = kv[c] * inv; bt[c] = bb[c] * inv; Kb[c] = kt[c] * gC; Bb[c] = -(bt[c] * gC);
        w[c] = gC; }
    if (CUT == 1) { float s_ = 0.f;
#pragma unroll
        for (int c = 0; c < 16; ++c) s_ += kh[c] + rh[c] + kt[c] + bt[c] + Kb[c] + Bb[c] + w[c]; if (s_ == 1.2345f) *(LAS float*)slot = s_ + (float)vraw[0] + (float)vraw[3]; return; }
    const bf16x8 khf0 = hpack8(kh), khf1 = hpack8(kh + 8), rhf0 = hpack8(rh), rhf1 = hpack8(rh + 8);
    const bf16x8 ktf0 = hpack8(kt), ktf1 = hpack8(kt + 8), btf0 = hpack8(bt), btf1 = hpack8(bt + 8);
    const f32x4 z4 = {0.f, 0.f, 0.f, 0.f};
    f32x4 Akk = MFMA32(ktf1, khf1, MFMA32(ktf0, khf0, z4)), Abk = MFMA32(btf1, khf1, MFMA32(btf0, khf0, z4)), AbkT = MFMA32(khf1, btf1, MFMA32(khf0, btf0, z4));
    f32x4 Akr = MFMA32(ktf1, rhf1, MFMA32(ktf0, rhf0, z4)), Abr = MFMA32(btf1, rhf1, MFMA32(btf0, rhf0, z4));
    PADV(Akk); PADV(Abk); PADV(AbkT); PADV(Akr); PADV(Abr);
    f32x4 Id;
#pragma unroll
    for (int e = 0; e < 4; ++e) { const int rr = 4 * q + e;
        Akk[e] = rr < l15 ? Akk[e] : 0.f; Abk[e] = rr < l15 ? Abk[e] : 0.f; AbkT[e] = l15 < rr ? AbkT[e] : 0.f;
        Akr[e] = rr <= l15 ? Akr[e] : 0.f; Abr[e] = rr <= l15 ? -Abr[e] : 0.f; Id[e] = rr == l15 ? 1.f : 0.f; }
#define CK_MM(Xt, Y) MFMA16(cvt4(Xt), cvt4(Y), z4)
    f32x4 A2 = CK_MM(AbkT, Abk), A2t = CK_MM(Abk, AbkT); PADV(A2); PADV(A2t);
    f32x4 A4 = CK_MM(A2t, A2), A4t = CK_MM(A2, A2t); PADV(A4); PADV(A4t);
    f32x4 A8 = CK_MM(A4t, A4); PADV(A8);
    f32x4 P = Id + A8; P = CK_MM(Id + A4t, P); PADV(P); P = CK_MM(Id + A2t, P); PADV(P); P = CK_MM(Id - AbkT, P); PADV(P);
#undef CK_MM
    if (CUT == 2) { const f32x4 s_ = P + Akk + Akr + Abr; if (s_[0] + s_[1] + s_[2] + s_[3] == 1.2345f) *(LAS float*)slot = s_[0] + Kb[0] + Bb[0] + w[0] + (float)vraw[0]; return; }
    LAS bf16x8* s8 = (LAS bf16x8*)slot; s8[F.lane] = khf0; s8[64 + F.lane] = khf1; s8[128 + F.lane] = rhf0; s8[192 + F.lane] = rhf1;
    LAS bf16x4* s4 = (LAS bf16x4*)slot;
    s4[CK_AKK / 8 + F.lane] = cvt4(Akk); s4[CK_AKR / 8 + F.lane] = cvt4(Akr); s4[CK_ABR / 8 + F.lane] = cvt4(Abr); s4[CK_TM / 8 + F.lane] = cvt4(P);
    { bf16x4 vm; vm[0] = (short)vraw[0]; vm[1] = (short)vraw[1]; vm[2] = (short)vraw[2]; vm[3] = (short)vraw[3]; s4[CK_VM / 8 + F.lane] = vm; }
    if (CUT == 3) { if (Kb[0] + Bb[0] + w[0] == 1.2345f) *(LAS float*)slot = Kb[1]; LDS_WAIT(); return; }
    LAS unsigned short* mk = scr; LAS unsigned short* mb = scr + 1024;
#pragma unroll
    for (int p = 0; p < 4; ++p) { const int col = 32 * (p >> 1) + 16 * (p & 1) + 4 * q; *(LAS v2u*)(mk + l15 * 64 + col) = hpack4(Kb + 4 * p); *(LAS v2u*)(mb + l15 * 64 + col) = hpack4(Bb + 4 * p); }
    LDS_WAIT(); asm volatile("" ::: "memory");
#pragma unroll
    for (int nt = 0; nt < 4; ++nt) { bf16x4 a, bq;
#pragma unroll
        for (int jj = 0; jj < 4; ++jj) { a[jj] = (short)mk[(4 * q + jj) * 64 + 16 * nt + l15]; bq[jj] = (short)mb[(4 * q + jj) * 64 + 16 * nt + l15]; }
        s4[CK_KB / 8 + nt * 64 + F.lane] = a; s4[CK_BB / 8 + nt * 64 + F.lane] = bq; }
    if (l15 == 15) {
#pragma unroll
        for (int p = 0; p < 4; ++p) *(LAS f32x4*)(slot + CK_GC + 4 * (32 * (p >> 1) + 16 * (p & 1) + 4 * q)) = (f32x4){w[4 * p], w[4 * p + 1], w[4 * p + 2], w[4 * p + 3]}; }
    LDS_WAIT(); asm volatile("" ::: "memory");
}
#ifdef CK_DUMMY_MODE
__device__ __forceinline__ void dummy_work(Frame& F, int h, int t0, LAS unsigned char* area) {
    const f32x4 z4 = {0.f, 0.f, 0.f, 0.f}; f32x4 acc = z4; float sink = 0.f;
#if CK_DUMMY_MODE == 1
    bf16x8 a; for (int j = 0; j < 8; ++j) a[j] = (short)(0x3f80 + F.lane + j);
    for (int i = 0; i < 64; ++i) { acc = MFMA32(a, a, acc); asm volatile("" : "+v"(acc)); }
    sink = acc[0];
#elif CK_DUMMY_MODE == 2
    LAS f32x4* p = (LAS f32x4*)area + F.lane;
#pragma unroll 1
    for (int i = 0; i < 40; ++i) { LAS f32x4* pw = p + 64 * (i & 7); *pw = (f32x4){(float)i, 1.f, 2.f, 3.f}; asm volatile("s_waitcnt lgkmcnt(0)" ::: "memory"); const LAS f32x4* pr = p + 64 * ((i + 3) & 7); acc += *pr; }
    sink = acc[0];
#elif CK_DUMMY_MODE == 3
    const bf16* sc = (const bf16*)(F.ws + WS_SC);
    for (int i = 0; i < 24; ++i) { float t[4]; unpack4(*(const v2u*)(sc + (size_t)(i % 6) * (SC_STRIDE / 2) + sc_off(t0 + (F.lane & 15), 64 * h + 4 * ((F.lane >> 4) + 4 * (i & 3)))), t); sink += t[0] + t[3]; }
#elif CK_DUMMY_MODE == 4
    float g = 1.0f + 0.001f * F.lane;
    for (int i = 0; i < 200; ++i) { g *= DPP_SHR(g, 1, 1.0f); g = g * 0.999f + DPP_ROR(g, 4) * 0.001f; asm volatile("" : "+v"(g)); }
    sink = g;
#endif
    if (sink == 123456.789f) ((LAS float*)area)[F.lane] = sink;
}
#endif
__device__ __forceinline__ void scan_prompt_unit(Frame& F, const InAcc& A, int unit, bool side) {
    const int bh = unit >> 2, qtr = unit & 3, b = bh >> 3, h = bh & 7;
    const int rowbase = b * 2048;
    LAS unsigned char* const base = F.lds + RING_OFF;
    volatile LAS int* flg = (volatile LAS int*)(base + CK_FLAG_OFF);
    if (F.tid < 32) flg[F.tid] = 0;
    __syncthreads();
    const int l15 = F.lane & 15, q = F.lane >> 4;
    if (F.wave == 0) {
        f32x4 S[4] = {{0.f, 0.f, 0.f, 0.f}, {0.f, 0.f, 0.f, 0.f}, {0.f, 0.f, 0.f, 0.f}, {0.f, 0.f, 0.f, 0.f}};
        const f32x4 z4 = {0.f, 0.f, 0.f, 0.f};
        float* yg = (float*)(F.ws + WS_Y) + (size_t)rowbase * RW + h * 64 + 16 * qtr + l15;
        for (int c = 0; c < 128; ++c) {
            while (__hip_atomic_load((LAS int*)&flg[c & 7], __ATOMIC_ACQUIRE, __HIP_MEMORY_SCOPE_WORKGROUP) != c + 1) __builtin_amdgcn_s_sleep(1);
            __builtin_amdgcn_fence(__ATOMIC_ACQUIRE, "workgroup");
#ifdef CK_DELAY
            __builtin_amdgcn_s_sleep(CK_DELAY);
#endif
            asm volatile("s_waitcnt lgkmcnt(0)" ::: "memory");
            const LAS unsigned char* slot = base + (c & 7) * CK_SLOT_B;
            const LAS bf16x8* s8 = (const LAS bf16x8*)slot; const LAS bf16x4* s4 = (const LAS bf16x4*)slot;
            const bf16x8 kh0 = s8[F.lane], kh1 = s8[64 + F.lane], rh0 = s8[128 + F.lane], rh1 = s8[192 + F.lane];
            const bf16x4 akk = s4[CK_AKK / 8 + F.lane], akr = s4[CK_AKR / 8 + F.lane], nabr = s4[CK_ABR / 8 + F.lane], tm = s4[CK_TM / 8 + F.lane], vm = s4[CK_VM / 8 + F.lane];
            const bf16x8 sb0 = cvt8(S[0], S[1]), sb1 = cvt8(S[2], S[3]);
            f32x4 GT = MFMA32(kh1, sb1, MFMA32(kh0, sb0, z4)); f32x4 G16 = MFMA16(akk, vm, z4);
            asm volatile("s_nop 15\n\ts_nop 15" : "+v"(GT), "+v"(G16));
            GT += G16;
            f32x4 DT = MFMA16(tm, cvt4(GT), z4);
            asm volatile("s_nop 15\n\ts_nop 15" : "+v"(DT));
            const bf16x4 db = cvt4(DT);
            f32x4 YT = MFMA32(rh1, sb1, MFMA32(rh0, sb0, z4)); f32x4 Y16 = MFMA16(nabr, db, MFMA16(akr, vm, z4));
            asm volatile("s_nop 15\n\ts_nop 15" : "+v"(YT), "+v"(Y16));
            YT += Y16;
#pragma unroll
            for (int nt = 0; nt < 4; ++nt) { const f32x4 g = *(const LAS f32x4*)(slot + CK_GC + 4 * (16 * nt + 4 * q));
                const bf16x4 kb = s4[CK_KB / 8 + nt * 64 + F.lane], nbb = s4[CK_BB / 8 + nt * 64 + F.lane];
                S[nt] = MFMA16(nbb, db, MFMA16(kb, vm, S[nt] * g)); }
            asm volatile("s_nop 15\n\ts_nop 15\n\ts_waitcnt lgkmcnt(0)" : "+v"(S[0]), "+v"(S[1]), "+v"(S[2]), "+v"(S[3]) :: "memory");
            __builtin_amdgcn_fence(__ATOMIC_RELEASE, "workgroup");
            if (F.lane == 0) __hip_atomic_store((LAS int*)&flg[16], c + 1, __ATOMIC_RELEASE, __HIP_MEMORY_SCOPE_WORKGROUP);
#pragma unroll
            for (int e = 0; e < 4; ++e) yg[(size_t)(16 * c + 4 * q + e) * RW] = YT[e];
#ifdef DBG_YWAIT
            asm volatile("s_waitcnt vmcnt(0)" ::: "memory");
#endif
        }
#pragma unroll
        for (int nt = 0; nt < 4; ++nt) *(f32x4*)(F.out + O_WKVP + ((size_t)bh * 64 + 16 * qtr + l15) * 64 + 16 * nt + 4 * q) = S[nt];
    } else if (F.wave > CK_NH) {
        if (side) {
            constexpr int NS = 7 - CK_NH; const int sw = (int)blockIdx.x * NS + (F.wave - CK_NH - 1), NSW = F.G * NS;
            LAS unsigned short* tile = (LAS unsigned short*)(base + CK_SIDE_OFF + (F.wave - CK_NH - 1) * CK_SIDE_B);
#if SIDE_MASK & 1
            for (int it = sw; it < 1024; it += NSW) gmlp_item<false>(F, A, it >> 3, it & 7, tile);
#endif
#if SIDE_MASK & 2
            for (int it = NSW - 1 - sw; it < 1024; it += NSW) gmlp_item<true>(F, A, it >> 3, it & 7, tile);
#endif
#if SIDE_MASK & 4
            for (int it = sw; it < 128 * 8 * 8; it += NSW) scan_sample_item(F, A, it);
#endif
        }
    } else {
        LAS unsigned short* scr = (LAS unsigned short*)(base + CK_SCR_OFF + (F.wave - 1) * CK_SCR_B);
        for (int c = F.wave - 1; c < 128; c += CK_NH) {
            while (__hip_atomic_load((LAS int*)&flg[16], __ATOMIC_ACQUIRE, __HIP_MEMORY_SCOPE_WORKGROUP) < c - CK_AHEAD) __builtin_amdgcn_s_sleep(2);
            __builtin_amdgcn_fence(__ATOMIC_ACQUIRE, "workgroup");
            chunk_prepare(F, h, qtr, rowbase + 16 * c, base + (c & 7) * CK_SLOT_B, scr);
#ifdef CK_POST_SPIN
            { float g_ = 1.0f + 0.001f * F.lane; for (int i_ = 0; i_ < CK_POST_SPIN; ++i_) { g_ = g_ * 0.999f + 0.001f; asm volatile("" : "+v"(g_)); } if (g_ == 123.456f) scr[0] = 1; }
#endif
            __builtin_amdgcn_fence(__ATOMIC_RELEASE, "workgroup");
            if (F.lane == 0) __hip_atomic_store((LAS int*)&flg[c & 7], c + 1, __ATOMIC_RELEASE, __HIP_MEMORY_SCOPE_WORKGROUP);
        }
    }
    __syncthreads();
}
__device__ __forceinline__ void postscan_item(Frame& F, const InAcc& A, int r0, int h) {
    const int l15 = F.lane & 15, q = F.lane >> 4, row = r0 + l15;
    const float* Y = (const float*)(F.ws + WS_Y); const bf16* V = (const bf16*)(F.ws + WS_SC + 2 * SC_STRIDE); const bf16* G = (const bf16*)(F.ws + WS_G);
    const float* gn_w = A.in[20]; const float* gn_b = A.in[21];
    float y[4][4]; float s = 0.f;
#pragma unroll
    for (int ntl = 0; ntl < 4; ++ntl) { const f32x4 t = *(const f32x4*)(Y + (size_t)row * RW + 64 * h + 16 * ntl + 4 * q); y[ntl][0] = t.x; y[ntl][1] = t.y; y[ntl][2] = t.z; y[ntl][3] = t.w; s += (t.x + t.y) + (t.z + t.w); }
    s += __shfl_xor(s, 16); s += __shfl_xor(s, 32);
    const float mu = s * (1.0f / 64.0f); float qq = 0.f;
#pragma unroll
    for (int ntl = 0; ntl < 4; ++ntl)
#pragma unroll
        for (int e = 0; e < 4; ++e) { y[ntl][e] -= mu; qq += y[ntl][e] * y[ntl][e]; }
    qq += __shfl_xor(qq, 16); qq += __shfl_xor(qq, 32);
    const float rstd = 1.0f / sqrtf(qq * (1.0f / 64.0f) + GN_EPS);
    const float bon = ((const float*)(F.ws + WS_BON))[(size_t)row * 8 + h];
#pragma unroll
    for (int ntl = 0; ntl < 4; ++ntl) { const int c0 = 64 * h + 16 * ntl + 4 * q; const size_t o = sc_off(row, c0);
        const f32x4 gw = *(const f32x4*)(gn_w + c0), gb = *(const f32x4*)(gn_b + c0);
        float vv[4], gg[4], ov[4]; unpack4(*(const v2u*)(V + o), vv); unpack4(*(const v2u*)(G + o), gg);
#pragma unroll
        for (int e = 0; e < 4; ++e) ov[e] = (y[ntl][e] * rstd * gw[e] + gb[e] + bon * vv[e]) * gg[e];
#ifdef DBG_ZERO_YR
        if (row >= DBG_ZERO_YR) { ov[0] = ov[1] = ov[2] = ov[3] = 0.f; }
#endif
        *(v2u*)(((bf16*)(F.ws + WS_XN)) + (size_t)row * D + c0) = pack4(ov); }
}
__device__ __forceinline__ void postscan_rows(Frame& F, const InAcc& A) { for (int it = F.gw; it < (M / 16) * 8; it += F.NGW) postscan_item(F, A, 16 * (it >> 3), it & 7); }
__global__ void __launch_bounds__(NWAVES * 64, 2) fwd_kernel(Args args) {
    extern __shared__ __attribute__((aligned(16))) unsigned char lds[];
    Frame F;
    F.lds = (LAS unsigned char*)lds;
    F.MISC = (volatile LAS unsigned*)(F.lds + MISC_OFF);
    F.tid = threadIdx.x; F.lane = F.tid & 63; F.wave = __builtin_amdgcn_readfirstlane(F.tid >> 6);
    F.G = gridDim.x; F.gw = blockIdx.x * NWAVES + F.wave; F.NGW = F.G * NWAVES;
    unsigned char* ws = args.ws;
    F.ctl = (gu32*)(ws + WS_CTL);
    F.out = args.out; F.ws = ws;
    for (int u = F.tid; u < (LDS_BYTES - LDSCTL_OFF) / 4; u += NWAVES * 64) ((LAS unsigned*)(F.lds + LDSCTL_OFF))[u] = 0u;
    __syncthreads();
    if (F.tid == 0) { LAS unsigned long long* pt = (LAS unsigned long long*)(F.lds + PTRS_OFF);
#pragma unroll
        for (int i = 0; i < 30; ++i) pt[i] = (unsigned long long)args.in[i]; }
    __syncthreads();
#if USE_PTR_TABLE
    InAcc A; A.in.t = (LAS unsigned*)(F.lds + PTRS_OFF);
#else
    InAcc A;
#pragma unroll
    for (int i = 0; i < 30; ++i) A.in[i] = args.in[i];
#endif
    XcdBarrier bar; bar.bar = (unsigned*)(F.ctl + CW_BAR); bar.x = 0; bar.st = nullptr;
    if (MK_N_LAUNCHES == 1) bar = xcd_barrier_post((unsigned*)(F.ctl + CW_BAR), F.MISC + 8);
    const int lo = args.ph_lo, hi = args.ph_hi;
#ifndef PH_MASK
#define PH_MASK 0x7fff
#endif
#define IN(k) (((PH_MASK >> (k)) & 1) && lo <= (k) && (k) < hi)
#ifndef DUP_ID
#define DUP_ID -1
#endif
#define DUPN(id) ((DUP_ID == (id)) ? 2 : 1)
#define DUPBAR(r) do { if (r) xcd_barrier(bar); } while (0)
#define SEAM(k) do { if (IN(k) && IN((k) + 1)) xcd_barrier(bar); } while (0)
    float* const H = F.out;

    if (IN(0)) for (int rep_ = 0; rep_ < DUPN(0); ++rep_) { DUPBAR(rep_); p1_mod(F, A); p0_prologue(F, A); }
    SEAM(1);
    if (IN(2)) for (int rep_ = 0; rep_ < DUPN(2); ++rep_) { DUPBAR(rep_); norm_rows_bf16<true>(F, A, A.in[0], A.in[1], false, 0, 1024, 0, 0, 0.f); } SEAM(2);
    if (IN(3)) for (int rep_ = 0; rep_ < DUPN(3); ++rep_) { DUPBAR(rep_); pg8::Gemm g{((bf16*)(F.ws + WS_XN)), ((bf16*)(F.ws + WS_GU1)), M, 2 * FF, D, D}; pg8::StaticOrder S; S.init(M, 2 * FF, D, F.G, (int)blockIdx.x); pg8::EpiSwiglu E{((bf16*)(F.ws + WS_ACT))};
        pg8::gemm_phase<pg8::EpiSwiglu, pg8::StaticOrder, PG8_ALIGN, PG8_SP2>(F.lds + RING_OFF, g, S, E); } SEAM(3);
    if (IN(4)) for (int rep_ = 0; rep_ < DUPN(4); ++rep_) { DUPBAR(rep_); pg8::Gemm g{((bf16*)(F.ws + WS_ACT)), ((bf16*)(F.ws + WS_DN1)), M, D, FF, FF}; pg8::SplitOrder S; S.init(MP, D, FF, 11, F.G, (int)blockIdx.x); pg8::EpiResid<true> E{A.in[0], A.in[1], (bf16*)F.out, ((float*)(F.ws + WS_MOD)) + 2048, 0.5f, (float*)(F.ws + WS_SC)};
        pg8::gemm_phase<pg8::EpiResid<true>, pg8::SplitOrder, PG8_ALIGN, PG8_SP2>(F.lds + RING_OFF, g, S, E); } SEAM(4);
    if (IN(5)) for (int rep_ = 0; rep_ < DUPN(5); ++rep_) { DUPBAR(rep_); norm_rows_bf16<false>(F, A, nullptr, A.in[1], true, 3072, 4096, 11, 2048, 0.5f); } SEAM(5);
    if (IN(6)) for (int rep_ = 0; rep_ < DUPN(6); ++rep_) { DUPBAR(rep_); pg8::Gemm g{((bf16*)(F.ws + WS_XN)), ((bf16*)(F.ws + WS_WIN)), M, PC, D, D}; pg8::StaticOrder S; S.init(M, PC, D, F.G, (int)blockIdx.x); pg8::EpiP E{((bf16*)(F.ws + WS_ACT)), ((bf16*)(F.ws + WS_PUV)), F.out + O_SHP, F.out + O_SHS};
        pg8::gemm_phase<pg8::EpiP, pg8::StaticOrder, PG8_ALIGN, PG8_SP2>(F.lds + RING_OFF, g, S, E); } SEAM(6);
    if (IN(7)) { for (int rep_ = 0; rep_ < DUPN(71); ++rep_) { DUPBAR(rep_); for (int it = F.gw; it < 2 * (M / 16); it += F.NGW) { if (it & 1) frag_item(F, A, 16 * (it >> 1), 1); else frag_item(F, A, 16 * (it >> 1), 0); } } for (int rep_ = 0; rep_ < DUPN(72); ++rep_) lnv_rows(F, A); xcd_barrier(bar);
        for (int rep_ = 0; rep_ < DUPN(70); ++rep_) { DUPBAR(rep_); prep_all(F, A); } } SEAM(7);
    if (IN(8)) {
        for (int rep_ = 0; rep_ < DUPN(80); ++rep_) for (int u = blockIdx.x; u < 256; u += F.G) scan_prompt_unit(F, A, u, u == (int)blockIdx.x);
#if !(SIDE_MASK & 1)
        for (int it = F.gw; it < 1024; it += F.NGW) gmlp_item<false>(F, A, it >> 3, it & 7, (LAS unsigned short*)(F.lds + RING_OFF + F.wave * 17408));
#endif
#if !(SIDE_MASK & 2)
        for (int it = F.gw; it < 1024; it += F.NGW) gmlp_item<true>(F, A, it >> 3, it & 7, (LAS unsigned short*)(F.lds + RING_OFF + F.wave * 17408));
#endif
#if !(SIDE_MASK & 4)
        for (int it = F.gw; it < 128 * 8 * 8; it += F.NGW) scan_sample_item(F, A, it);
#endif
    } SEAM(8);
    if (IN(9)) for (int rep_ = 0; rep_ < DUPN(9); ++rep_) { DUPBAR(rep_); postscan_rows(F, A); } SEAM(9);
    if (IN(10)) { pg8::Gemm g{((bf16*)(F.ws + WS_XN)), ((bf16*)(F.ws + WS_WOUT)), M, D, D, D}; pg8::SplitOrder S; S.init(MP, D, D, 4, F.G, (int)blockIdx.x); pg8::EpiResid<false> E{nullptr, nullptr, (bf16*)F.out, ((float*)(F.ws + WS_MOD)) + 5120, 1.0f, (float*)(F.ws + WS_SC)};
        pg8::gemm_phase<pg8::EpiResid<false>, pg8::SplitOrder, PG8_ALIGN, PG8_SP2>(F.lds + RING_OFF, g, S, E); } SEAM(10);
    if (IN(11)) for (int rep_ = 0; rep_ < DUPN(11); ++rep_) { DUPBAR(rep_); norm_rows_bf16<false>(F, A, nullptr, nullptr, false, 6144, 7168, 4, 5120, 1.0f); } SEAM(11);
    if (IN(12)) { pg8::Gemm g{((bf16*)(F.ws + WS_XN)), ((bf16*)(F.ws + WS_GU2)), M, 2 * FF, D, D}; pg8::StaticOrder S; S.init(M, 2 * FF, D, F.G, (int)blockIdx.x); pg8::EpiSwiglu E{((bf16*)(F.ws + WS_ACT))};
        pg8::gemm_phase<pg8::EpiSwiglu, pg8::StaticOrder, PG8_ALIGN, PG8_SP2>(F.lds + RING_OFF, g, S, E); } SEAM(12);
    if (IN(13)) { pg8::Gemm g{((bf16*)(F.ws + WS_ACT)), ((bf16*)(F.ws + WS_DN2)), M, D, FF, FF}; pg8::SplitOrder S; S.init(MP, D, FF, 11, F.G, (int)blockIdx.x); pg8::EpiResid<false> E{nullptr, nullptr, (bf16*)F.out, ((float*)(F.ws + WS_MOD)) + 8192, 0.5f, (float*)(F.ws + WS_SC)};
        pg8::gemm_phase<pg8::EpiResid<false>, pg8::SplitOrder, PG8_ALIGN, PG8_SP2>(F.lds + RING_OFF, g, S, E); } SEAM(13);
    if (IN(14)) { final_norm_rows(F, A, 11, 8192, 0.5f); }
#undef IN
#undef SEAM
}

extern "C" void kernel_launch(void* const* d_in, const int* in_sizes, int n_in, void* d_out, int out_size, void* d_ws, size_t ws_size, hipStream_t stream) {
    static int grid = 0;
    if (grid == 0) {
        if (n_in != 30 || in_sizes[0] != MP * D || (size_t)out_size != O_END || ws_size < WS_END) { fprintf(stderr, "kernel_launch: unexpected problem shape / workspace (%d inputs, out %d, ws %zu); nothing launched\n", n_in, out_size, ws_size); grid = -1; return; }
        int dev = 0, cus = 0, per_cu = 0;
        if (hipGetDevice(&dev) != hipSuccess || hipDeviceGetAttribute(&cus, hipDeviceAttributeMultiprocessorCount, dev) != hipSuccess) { grid = -1; return; }
        if (hipFuncSetAttribute((const void*)fwd_kernel, hipFuncAttributeMaxDynamicSharedMemorySize, LDS_BYTES) != hipSuccess) { fprintf(stderr, "kernel_launch: hipFuncSetAttribute failed\n"); grid = -1; return; }
        if (hipOccupancyMaxActiveBlocksPerMultiprocessor(&per_cu, (const void*)fwd_kernel, NWAVES * 64, LDS_BYTES) != hipSuccess || per_cu < 1) { fprintf(stderr, "kernel_launch: occupancy query says %d blocks per CU\n", per_cu); }
        (void)hipGetLastError();
        grid = cus;
    }
    if (grid < 0) return;
    (void)hipMemsetAsync((char*)d_ws + WS_CTL, 0, CTL_ZERO_BYTES, stream);
    Args a{};
    for (int i = 0; i < 30; ++i) a.in[i] = (const float*)d_in[i];
    a.out = (float*)d_out; a.ws = (unsigned char*)d_ws;
    if (MK_N_LAUNCHES == 1) { a.ph_lo = 0; a.ph_hi = N_PHASES; hipLaunchKernelGGL(fwd_kernel, dim3(grid), dim3(NWAVES * 64), LDS_BYTES, stream, a); }
    else for (int p = 0; p < N_PHASES; ++p) { a.ph_lo = p; a.ph_hi = p + 1; hipLaunchKernelGGL(fwd_kernel, dim3(grid), dim3(NWAVES * 64), LDS_BYTES, stream, a); }
}
```

```cpp
#include <hip/hip_runtime.h>
#include <cstdio>
#include <cstdint>
namespace pg8 {
#define PG8_LAS __attribute__((address_space(3)))
typedef unsigned short bf16_t;
typedef short bf16x8 __attribute__((ext_vector_type(8)));
typedef float f32x4 __attribute__((ext_vector_type(4)));
typedef unsigned u32x4 __attribute__((ext_vector_type(4)));
constexpr int BM = 256, BK = 64, HALF = 128, HTB = HALF * BK * 2  , STAGE_BYTES = 8 * HTB, NXCD = 8, WGM = 8;

__host__ __device__ __forceinline__ int lds_byte(int r, int c) { const int st = (r >> 4) * 2 + (c >> 5), rr = r & 15, cc = c & 31, ob = rr * 64 + cc * 2; return st * 1024 + (ob ^ (((ob >> 9) & 1) << 5)); }
__host__ __device__ __forceinline__ void stage_rc(int b, int& R, int& C) { const int st = b / 1024, sb = b % 1024, swz = sb ^ (((sb >> 9) & 1) << 5); R = (st >> 1) * 16 + swz / 64; C = (st & 1) * 32 + (swz % 64) / 2; }
__host__ __device__ __forceinline__ int perm32(int rho) { const int n = rho >> 4, i = rho & 15; return 8 * (i >> 2) + 4 * n + (i & 3); }

struct Unit { int pm, pn, kb, nt, ks; };
struct Gemm { const bf16_t* A; const bf16_t* Bt; int M, N, K, ld; };

struct StaticOrder {
    int nM, nN, nwg, G, c, knt;
    __host__ __device__ void init(int M, int N, int K, int G_, int c_) { nM = M / BM; nN = N / BM; nwg = nM * nN; G = G_; c = c_; knt = K / BK; }
    __host__ __device__ __forceinline__ bool next(int i, Unit& u) const {
        const long L = (long)i * G + c; if (L >= nwg) return false;
        int wgid = (int)L; { const int q = nwg / NXCD, r = nwg % NXCD, xcd = wgid % NXCD, off = wgid / NXCD; wgid = (xcd < r ? xcd * (q + 1) : r * (q + 1) + (xcd - r) * q) + off; }
        const int nig = WGM * nN, gid = wgid / nig, fm = gid * WGM, gsz = (nM - fm) < WGM ? (nM - fm) : WGM;
        u.pm = fm + ((wgid % nig) % gsz); u.pn = (wgid % nig) / gsz; u.kb = 0; u.nt = knt; u.ks = -1; return true;
    }
    __device__ __forceinline__ void a_ready(const Unit&) const {}
    __device__ __forceinline__ void done(const Unit&) const {}
};
struct SplitOrder {
    StaticOrder so; int ns, c, G;
    __host__ __device__ void init(int Mmain, int N, int K, int ns_, int G_, int c_) { so.init(Mmain, N, K, G_, c_); ns = ns_; c = c_; G = G_; }
    __host__ __device__ __forceinline__ bool next(int i, Unit& u) const {
        const int nsub = 16 * ns, mine = c < nsub ? (nsub - 1 - c) / G + 1 : 0;
        const bool sub = i < mine; const int s = c + i * G;
        Unit m; m.pm = 0; m.pn = 0; m.kb = 0; m.nt = so.knt; m.ks = -1;
        const bool okm = so.next(sub ? 0 : i - mine, m);
        u.pm = sub ? so.nM + s / (4 * ns) : m.pm; u.pn = sub ? ((s / ns) & 3) : m.pn; u.ks = sub ? s % ns : -1; u.kb = sub ? (s % ns) * 4 * BK * 2 : 0; u.nt = sub ? 4 : so.knt;
        return sub || okm;
    }
    __device__ __forceinline__ void a_ready(const Unit&) const {}
    __device__ __forceinline__ void done(const Unit&) const {}
};
__device__ __forceinline__ unsigned cvt_pk_bf16(float lo, float hi) { unsigned r; asm volatile("v_cvt_pk_bf16_f32 %0, %1, %2" : "=v"(r) : "v"(lo), "v"(hi)); return r; }
typedef float f32x2 __attribute__((ext_vector_type(2)));
constexpr int ROWS_P = 16384, ROWS_ALL = 17408, DM = 1024, MODW = 9216, FFW = 2816, RCOLS = 1792;
__device__ __forceinline__ int seq_of_row(int r) { return r < ROWS_P ? (r >> 11) : 8 + ((r - ROWS_P) >> 3); }
__device__ __forceinline__ bool row_is_first(int r) { return r < ROWS_P ? ((r & 2047) == 0) : (((r - ROWS_P) & 7) == 0); }
__device__ __forceinline__ bool row_is_last(int r) { return r < ROWS_P ? ((r & 2047) == 2047) : (((r - ROWS_P) & 7) == 7); }
__device__ __forceinline__ float silu_f(float x) { return x * __builtin_amdgcn_rcpf(1.0f + __builtin_amdgcn_exp2f(-1.4426950408889634f * x)); }

struct EpiSwiglu {
    static constexpr bool PERM = true, AFTER_DRAIN = false;
    bf16_t* O;
    __device__ __forceinline__ void operator()(const f32x4 (&acc)[2][2][4][2], const Unit& u, int wr, int wc, int fr, int fq) const {
        const int row0 = u.pm * BM + wr * 64 + fr, col0 = u.pn * HALF + wc * 32 + 8 * fq;
#pragma unroll
        for (int ai = 0; ai < 2; ++ai)
#pragma unroll
            for (int m = 0; m < 4; ++m) {
                bf16_t* rowp = O + (size_t)(row0 + ai * HALF + m * 16) * FFW + col0;
                const f32x4 g0 = acc[ai][0][m][0], g1 = acc[ai][0][m][1], u0 = acc[ai][1][m][0], u1 = acc[ai][1][m][1];
                u32x4 w;
                w.x = cvt_pk_bf16(silu_f(g0[0]) * u0[0], silu_f(g0[1]) * u0[1]); w.y = cvt_pk_bf16(silu_f(g0[2]) * u0[2], silu_f(g0[3]) * u0[3]);
                w.z = cvt_pk_bf16(silu_f(g1[0]) * u1[0], silu_f(g1[1]) * u1[1]); w.w = cvt_pk_bf16(silu_f(g1[2]) * u1[2], silu_f(g1[3]) * u1[3]);
                *(u32x4*)rowp = w;
            }
    }
};
constexpr int HLD = 2048, HOFF = 1024;
template <bool RESF32> struct EpiResid {
    static constexpr bool PERM = false, AFTER_DRAIN = false;
    const float* resP; const float* resS; bf16_t* hb; const float* gate; float coef; float* slab;
    __device__ __forceinline__ void operator()(const f32x4 (&acc)[2][2][4][2], const Unit& u, int wr, int wc, int fr, int fq) const {
        typedef unsigned u32x2 __attribute__((ext_vector_type(2)));
        const int col0 = u.pn * BM + wc * 32 + 4 * fq;
        if (u.ks >= 0) {
#pragma unroll
            for (int ai = 0; ai < 2; ++ai)
#pragma unroll
                for (int m = 0; m < 4; ++m) { float* srow = slab + ((size_t)u.ks * 1024 + (size_t)(u.pm * BM + ai * HALF + wr * 64 + m * 16 + fr - ROWS_P)) * DM + col0;
#pragma unroll
                    for (int bj = 0; bj < 2; ++bj)
#pragma unroll
                        for (int n = 0; n < 2; ++n) *(f32x4*)(srow + bj * HALF + n * 16) = acc[ai][bj][m][n]; }
            return; }
#pragma unroll
        for (int ai = 0; ai < 2; ++ai)
#pragma unroll
            for (int m = 0; m < 4; ++m) {
                const int row = u.pm * BM + ai * HALF + wr * 64 + m * 16 + fr; const int s = seq_of_row(row);
                const float* rrow = (row < ROWS_P ? resP + (size_t)row * DM : resS + (size_t)(row - ROWS_P) * DM) + col0;
                bf16_t* hrow = hb + (size_t)row * HLD + HOFF + col0; const float* grow = gate + (size_t)s * MODW + col0;
#pragma unroll
                for (int bj = 0; bj < 2; ++bj)
#pragma unroll
                    for (int n = 0; n < 2; ++n) { const int off = bj * HALF + n * 16; const f32x4 g = *(const f32x4*)(grow + off); f32x4 r;
                        if (RESF32) r = *(const f32x4*)(rrow + off);
                        else { const u32x2 w = *(const u32x2*)(hrow + off); r = (f32x4){__uint_as_float(w.x << 16), __uint_as_float(w.x & 0xffff0000u), __uint_as_float(w.y << 16), __uint_as_float(w.y & 0xffff0000u)}; }
                        const f32x4 o = r + (g * coef) * acc[ai][bj][m][n];
                        *(u32x2*)(hrow + off) = (u32x2){cvt_pk_bf16(o[0], o[1]), cvt_pk_bf16(o[2], o[3])}; }
            }
    }
};
struct EpiP {
    static constexpr bool PERM = true, AFTER_DRAIN = false;
    bf16_t* PB; bf16_t* PUV; float* shp; float* shs;
    __device__ __forceinline__ void operator()(const f32x4 (&acc)[2][2][4][2], const Unit& u, int wr, int wc, int fr, int fq) const {
        typedef unsigned u32x2 __attribute__((ext_vector_type(2)));
        const int row0 = u.pm * BM + wr * 64 + fr, col0 = u.pn * BM + wc * 32 + 8 * fq;
#pragma unroll
        for (int ai = 0; ai < 2; ++ai)
#pragma unroll
            for (int m = 0; m < 4; ++m) {
                const int row = row0 + ai * HALF + m * 16; const bool last = row_is_last(row);
#pragma unroll
                for (int bj = 0; bj < 2; ++bj) { const f32x4 v0 = acc[ai][bj][m][0], v1 = acc[ai][bj][m][1]; const int col = col0 + bj * HALF;
                    u32x4 w; w.x = cvt_pk_bf16(v0[0], v0[1]); w.y = cvt_pk_bf16(v0[2], v0[3]); w.z = cvt_pk_bf16(v1[0], v1[1]); w.w = cvt_pk_bf16(v1[2], v1[3]);
                    if (u.pn < 7) { bf16_t* p = PB + ((size_t)((row >> 4) * 448 + (col >> 2)) * 16 + (row & 15)) * 4; *(u32x2*)p = (u32x2){w.x, w.y}; *(u32x2*)(p + 64) = (u32x2){w.z, w.w};
                        if (last) { float* o = (row < ROWS_P ? shp + (size_t)(row >> 11) * RCOLS : shs + (size_t)((row - ROWS_P) >> 3) * RCOLS) + col; *(f32x4*)o = v0; *(f32x4*)(o + 4) = v1; } }
                    else *(u32x4*)(PUV + (size_t)row * 1024 + (col - RCOLS)) = w; }
            }
    }
};
template <class Epi, class Sched, bool ALIGN_EPI = false, bool SP2 = false>
__device__ __forceinline__ void gemm_phase(PG8_LAS unsigned char* lds, const Gemm g, const Sched& S, const Epi& E) {
    const int tid = threadIdx.x, wid = __builtin_amdgcn_readfirstlane(tid >> 6), lane = tid & 63, wr = wid >> 2, wc = wid & 3, fr = lane & 15, fq = lane >> 4;
    const int K = g.ld;
    unsigned voffA[2], voffB[2];
#pragma unroll
    for (int i = 0; i < 2; ++i) { int R, C; stage_rc(tid * 16 + i * 8192, R, C); const int Rb = Epi::PERM ? ((R & ~31) + perm32(R & 31)) : R;
        voffA[i] = (unsigned)(R * K + C) * 2u; voffB[i] = (unsigned)(Rb * K + C) * 2u; }
    const size_t kstep = (size_t)(BK * 2);
    const size_t hstep = (size_t)HALF * K * 2;
    const size_t tstep = 2 * hstep;
    const unsigned ldsw = (unsigned)wid * 1024u;
    const int aoff = lds_byte(wr * 64 + fr, fq * 8), boff = lds_byte(wc * 32 + fr, fq * 8);
#define PG8_SA(b, h) (((b) * 2 + (h)) * HTB)
#define PG8_SB(b, h) ((4 + (b) * 2 + (h)) * HTB)
#define PG8_STAGE(bufoff, gbase, voff) do { _Pragma("unroll") for (int _i = 0; _i < 2; ++_i) \
        __builtin_amdgcn_global_load_lds((const unsigned*)((const char*)(gbase) + (voff)[_i]), (PG8_LAS unsigned*)(lds + (bufoff) + ldsw + _i * 8192), 16, 0, 0); } while (0)
#define PG8_LDA(dst, b, h) do { _Pragma("unroll") for (int m = 0; m < 4; ++m) _Pragma("unroll") for (int k = 0; k < 2; ++k) dst[m][k] = *(const PG8_LAS bf16x8*)(lds + PG8_SA(b, h) + aoff + m * 2048 + k * 1024); } while (0)
#define PG8_LDB(dst, b, h) do { _Pragma("unroll") for (int n = 0; n < 2; ++n) _Pragma("unroll") for (int k = 0; k < 2; ++k) dst[n][k] = *(const PG8_LAS bf16x8*)(lds + PG8_SB(b, h) + boff + n * 2048 + k * 1024); } while (0)
#define PG8_MMA(ai, bj, At, Bt) do { __builtin_amdgcn_s_setprio(1); _Pragma("unroll") for (int m = 0; m < 4; ++m) _Pragma("unroll") for (int n = 0; n < 2; ++n) _Pragma("unroll") for (int k = 0; k < 2; ++k) \
        acc[ai][bj][m][n] = __builtin_amdgcn_mfma_f32_16x16x32_bf16(Bt[n][k], At[m][k], acc[ai][bj][m][n], 0, 0, 0); __builtin_amdgcn_s_setprio(0); } while (0)
#define PG8_WAIT_V(n) asm volatile("s_waitcnt vmcnt(" #n ")" ::: "memory")
#define PG8_WAIT_L(n) asm volatile("s_waitcnt lgkmcnt(" #n ")" ::: "memory")
#define PG8_BAR __builtin_amdgcn_s_barrier()
#define PG8_SCHED __builtin_amdgcn_sched_barrier(0)
    Unit cur, nxt; int ui = 0;
    if (!S.next(0, cur)) return;
    f32x4 acc[2][2][4][2];
#pragma unroll
    for (int a = 0; a < 2; ++a)
#pragma unroll
        for (int b = 0; b < 2; ++b)
#pragma unroll
            for (int m = 0; m < 4; ++m)
#pragma unroll
                for (int n = 0; n < 2; ++n) acc[a][b][m][n] = (f32x4){0.f, 0.f, 0.f, 0.f};
    bf16x8 At[4][2], B0[2][2], B1[2][2];
    const char* cA = (const char*)g.A + (size_t)cur.pm * tstep + cur.kb; const char* cB = (const char*)g.Bt + (size_t)cur.pn * tstep + cur.kb;
    S.a_ready(cur);
    if constexpr (SP2) {
        PG8_STAGE(PG8_SB(0, 0), cB, voffB); PG8_STAGE(PG8_SB(0, 1), cB + hstep, voffB); PG8_STAGE(PG8_SA(0, 0), cA, voffA); PG8_STAGE(PG8_SA(0, 1), cA + hstep, voffA);
        if (wr == 1) PG8_BAR;
        PG8_WAIT_V(2); PG8_BAR;
        PG8_STAGE(PG8_SB(1, 0), cB + kstep, voffB); PG8_STAGE(PG8_SA(1, 0), cA + kstep, voffA); PG8_STAGE(PG8_SB(1, 1), cB + hstep + kstep, voffB);
        PG8_WAIT_V(6); PG8_BAR;
    } else {
        PG8_STAGE(PG8_SB(0, 0), cB, voffB); PG8_STAGE(PG8_SA(0, 0), cA, voffA); PG8_STAGE(PG8_SB(0, 1), cB + hstep, voffB); PG8_STAGE(PG8_SA(0, 1), cA + hstep, voffA);
        if (wr == 1) PG8_BAR;
        PG8_WAIT_V(4); PG8_BAR;
        PG8_STAGE(PG8_SB(1, 0), cB + kstep, voffB); PG8_STAGE(PG8_SA(1, 0), cA + kstep, voffA); PG8_STAGE(PG8_SB(1, 1), cB + hstep + kstep, voffB);
        PG8_WAIT_V(6); PG8_BAR;
    }
    for (;;) {
        const bool has_next = S.next(ui + 1, nxt);
        const char* nA = has_next ? (const char*)g.A + (size_t)nxt.pm * tstep + nxt.kb : cA; const char* nB = has_next ? (const char*)g.Bt + (size_t)nxt.pn * tstep + nxt.kb : cB;
        const int nt = cur.nt;
        for (int t = 0; t < nt; t += 2) {
            const bool last = (t == nt - 2);
            const char* a1 = cA + (size_t)(t + 1) * kstep;
            const char* a2 = last ? nA : cA + (size_t)(t + 2) * kstep; const char* b2 = last ? nB : cB + (size_t)(t + 2) * kstep;
            const char* a3 = a2 + kstep; const char* b3 = b2 + kstep;
            if (last && has_next) S.a_ready(nxt);
            if constexpr (SP2) {
            PG8_LDB(B0, 0, 0); PG8_LDB(B1, 0, 1); PG8_SCHED; PG8_LDA(At, 0, 0); PG8_STAGE(PG8_SA(1, 1), a1 + hstep, voffA);
            PG8_WAIT_V(8); PG8_WAIT_L(0); PG8_BAR; PG8_MMA(0, 0, At, B0); PG8_MMA(0, 1, At, B1); PG8_BAR; PG8_SCHED;
            PG8_LDA(At, 0, 1); PG8_STAGE(PG8_SB(0, 0), b2, voffB); PG8_STAGE(PG8_SB(0, 1), b2 + hstep, voffB); PG8_STAGE(PG8_SA(0, 0), a2, voffA);
            PG8_WAIT_V(8); PG8_WAIT_L(0); PG8_BAR; PG8_MMA(1, 0, At, B0); PG8_MMA(1, 1, At, B1); PG8_BAR; PG8_SCHED;
            PG8_LDB(B0, 1, 0); PG8_LDB(B1, 1, 1); PG8_SCHED; PG8_LDA(At, 1, 0); PG8_STAGE(PG8_SA(0, 1), a2 + hstep, voffA);
            PG8_WAIT_V(8); PG8_WAIT_L(0); PG8_BAR; PG8_MMA(0, 0, At, B0); PG8_MMA(0, 1, At, B1); PG8_BAR; PG8_SCHED;
            PG8_LDA(At, 1, 1); PG8_STAGE(PG8_SB(1, 0), b3, voffB); PG8_STAGE(PG8_SB(1, 1), b3 + hstep, voffB); PG8_STAGE(PG8_SA(1, 0), a3, voffA);
            PG8_WAIT_V(8); PG8_WAIT_L(0); PG8_BAR; PG8_MMA(1, 0, At, B0); PG8_MMA(1, 1, At, B1); PG8_BAR; PG8_SCHED;
            } else {
            PG8_LDB(B0, 0, 0); PG8_SCHED; PG8_LDA(At, 0, 0); PG8_STAGE(PG8_SA(1, 1), a1 + hstep, voffA);
            PG8_WAIT_L(8); PG8_BAR; PG8_WAIT_L(0); PG8_MMA(0, 0, At, B0); PG8_BAR; PG8_SCHED;
            PG8_LDB(B1, 0, 1); PG8_STAGE(PG8_SB(0, 0), b2, voffB);
            PG8_BAR; PG8_WAIT_L(0); PG8_MMA(0, 1, At, B1); PG8_BAR;
            PG8_LDA(At, 0, 1); PG8_STAGE(PG8_SA(0, 0), a2, voffA);
            PG8_BAR; PG8_WAIT_L(0); PG8_MMA(1, 0, At, B0); PG8_BAR; PG8_SCHED;
            PG8_STAGE(PG8_SB(0, 1), b2 + hstep, voffB);
            PG8_WAIT_V(6); PG8_BAR; PG8_MMA(1, 1, At, B1); PG8_BAR;
            PG8_LDB(B0, 1, 0); PG8_SCHED; PG8_LDA(At, 1, 0); PG8_STAGE(PG8_SA(0, 1), a2 + hstep, voffA);
            PG8_WAIT_L(8); PG8_BAR; PG8_WAIT_L(0); PG8_MMA(0, 0, At, B0); PG8_BAR; PG8_SCHED;
            PG8_LDB(B1, 1, 1); PG8_STAGE(PG8_SB(1, 0), b3, voffB);
            PG8_BAR; PG8_WAIT_L(0); PG8_MMA(0, 1, At, B1); PG8_BAR;
            PG8_LDA(At, 1, 1); PG8_STAGE(PG8_SA(1, 0), a3, voffA);
            PG8_BAR; PG8_WAIT_L(0); PG8_MMA(1, 0, At, B0); PG8_BAR; PG8_SCHED;
            PG8_STAGE(PG8_SB(1, 1), b3 + hstep, voffB);
            PG8_WAIT_V(6); PG8_BAR; PG8_MMA(1, 1, At, B1); PG8_BAR;
            }
        }
        if constexpr (ALIGN_EPI) { if (wr == 0) PG8_BAR; }
        if constexpr (!Epi::AFTER_DRAIN) { E(acc, cur, wr, wc, fr, fq); S.done(cur); }
        if (!has_next) break;
#pragma unroll
        for (int a = 0; a < 2; ++a)
#pragma unroll
            for (int b = 0; b < 2; ++b)
#pragma unroll
                for (int m = 0; m < 4; ++m)
#pragma unroll
                    for (int n = 0; n < 2; ++n) acc[a][b][m][n] = (f32x4){0.f, 0.f, 0.f, 0.f};
        cur = nxt; cA = nA; cB = nB; ++ui;
        if constexpr (ALIGN_EPI) { if (wr == 1) PG8_BAR; }
    }
    PG8_WAIT_V(0);
    if constexpr (!ALIGN_EPI) { if (wr == 0) PG8_BAR; }
    PG8_BAR;
    if constexpr (Epi::AFTER_DRAIN) { E.fused(acc, cur, wr, wc, fr, fq, lds, wid, lane); S.done(cur); }
#undef PG8_SA
#undef PG8_SB
#undef PG8_STAGE
#undef PG8_LDA
#undef PG8_LDB
#undef PG8_MMA
#undef PG8_WAIT_V
#undef PG8_WAIT_L
#undef PG8_BAR
#undef PG8_SCHED
}
}
#ifndef PG8_SP2
#define PG8_SP2 true
#endif
#ifndef PG8_ALIGN
#define PG8_ALIGN true
#endif
#ifndef MK_N_LAUNCHES
#define MK_N_LAUNCHES 1
#endif
constexpr int NWAVES = 8;
constexpr int N_PHASES = 15;
constexpr int D = 1024, MP = 16384, MS = 1024, M = MP + MS, NSEQ = 136, FF = 2816, RC = 1792, PC = 2816, RW = 512, MODW = 9216;
constexpr float RMS_EPS = 1e-6f, LN_EPS = 1e-5f, GN_EPS = 64e-5f;
constexpr size_t O_Y = 0, O_SHP = 17825792, O_WKVP = 17840128, O_SHS = 18102272, O_WKVS = 18331648, O_CVS = 22525952, O_END = 23050240;
constexpr size_t MiB = 1u << 20;
constexpr size_t WS_CTL = 0, CTL_ZERO_BYTES = 1 * MiB;
constexpr size_t WS_GU1 = 1 * MiB, WS_DN1 = 12 * MiB, WS_WIN = 18 * MiB, WS_WOUT = 24 * MiB, WS_GU2 = 26 * MiB, WS_DN2 = 37 * MiB;
constexpr size_t WS_SMALL = 43 * MiB;
constexpr size_t WS_WLT = WS_SMALL, WS_ALT = WS_SMALL + 65536, WS_GLT = WS_SMALL + 131072, WS_WSB = WS_SMALL + 262144, WS_SILUC = WS_SMALL + 524288;
constexpr size_t WS_MOD = 44 * MiB;
constexpr size_t WS_BON = 49 * MiB;
constexpr size_t WS_FP = 331 * MiB;
constexpr size_t WS_XN = 50 * MiB;
constexpr size_t WS_ACT = 84 * MiB;
constexpr size_t WS_PUV = WS_ACT + 60 * MiB;
static_assert((size_t)M * 1792 * 2 <= 60 * MiB && WS_PUV + (size_t)M * 1024 * 2 <= 178 * MiB, "ws map puv");
constexpr size_t WS_SC = 178 * MiB, SC_STRIDE = 17 * MiB;
constexpr size_t WS_G = 280 * MiB;
constexpr size_t WS_Y = 297 * MiB;
constexpr size_t WS_FRG = 339 * MiB;
constexpr size_t WS_END = 348 * MiB;
static_assert(WS_FRG + (size_t)M * 256 * 2 <= WS_END, "ws map frg");
static_assert(WS_FP + (size_t)136 * 448 * 64 * 2 <= WS_END, "ws map fp");
static_assert(WS_DN1 - WS_GU1 >= (size_t)5632 * 1024 * 2 && WS_WIN - WS_DN1 >= (size_t)1024 * 2816 * 2 && WS_WOUT - WS_WIN >= (size_t)2816 * 1024 * 2 && WS_GU2 - WS_WOUT >= (size_t)1024 * 1024 * 2, "ws map a");
static_assert(WS_DN2 - WS_GU2 >= (size_t)5632 * 1024 * 2 && WS_SMALL - WS_DN2 >= (size_t)1024 * 2816 * 2 && WS_BON - WS_MOD >= (size_t)136 * 9216 * 4 && WS_XN - WS_BON >= (size_t)M * 8 * 4, "ws map b");
static_assert(WS_ACT - WS_XN >= (size_t)M * 1024 * 2 && WS_SC - WS_ACT >= (size_t)M * 2816 * 2 && SC_STRIDE >= (size_t)M * 512 * 2 && WS_G - WS_SC >= 6 * SC_STRIDE && WS_Y - WS_G >= (size_t)M * 512 * 2 && WS_END - WS_Y >= (size_t)M * 512 * 4, "ws map c");
constexpr int CW_TMO = 0, CW_CODE = 1, CW_BAR = 4096;
constexpr int RING_OFF = 0, RING_BYTES = 139264;
constexpr int LDS_BYTES = 163840;
constexpr int LDSCTL_OFF = LDS_BYTES - 1024, MISC_OFF = LDSCTL_OFF + 320;
struct Args { const float* in[30]; float* out; unsigned char* ws; int ph_lo, ph_hi; };
constexpr int PTRS_OFF = MISC_OFF + 128;
#ifndef USE_PTR_TABLE
#define USE_PTR_TABLE 1
#endif
#if !USE_PTR_TABLE
struct InAcc { const float* in[30]; };
#else
struct InPtrs { __attribute__((address_space(3))) unsigned* t;
    __device__ __forceinline__ const float* operator[](int i) const { const unsigned lo = __builtin_amdgcn_readfirstlane(t[2 * i]), hi = __builtin_amdgcn_readfirstlane(t[2 * i + 1]); return (const float*)(const __attribute__((address_space(1))) float*)(((unsigned long long)hi << 32) | lo); } };
struct InAcc { InPtrs in; };
#endif
#define GAS __attribute__((address_space(1)))
#define LAS __attribute__((address_space(3)))
typedef unsigned short bf16;
typedef unsigned v4u __attribute__((ext_vector_type(4)));
typedef float f32x4 __attribute__((ext_vector_type(4)));
typedef short bf16x8 __attribute__((ext_vector_type(8)));
typedef GAS unsigned gu32;
typedef GAS unsigned long long gu64;
#define RLX_AGENT __ATOMIC_RELAXED, __HIP_MEMORY_SCOPE_AGENT
#define LDS_WAIT() asm volatile("s_waitcnt lgkmcnt(0)" ::: "memory")
#define VM_WAIT() asm volatile("s_waitcnt vmcnt(0)" ::: "memory")
__device__ __forceinline__ unsigned long long rt() { return __builtin_amdgcn_s_memrealtime(); }
__device__ __forceinline__ unsigned f2bf(float f) { unsigned u = __builtin_bit_cast(unsigned, f); return (u + 0x7fffu + ((u >> 16) & 1u)) >> 16; }
__device__ __forceinline__ unsigned pk2(float lo, float hi) { return f2bf(lo) | (f2bf(hi) << 16); }
#define XB_TMO      128
#define XB_XCNT(j)  (256  + 64 * (j))
#define XB_XSUB(j)  (1280 + 64 * (j))
#define XB_XGEN(j)  (2304 + 64 * (j))
#define XB_TOP      3328
#define XB_TOPGEN   3392
#define XCD_BAR_WORDS 3456
#define XB_SPIN_CAP (1u << 18)

__device__ __forceinline__ unsigned xb_ld(unsigned* p)              { return __hip_atomic_load(p, __ATOMIC_RELAXED, __HIP_MEMORY_SCOPE_AGENT); }
__device__ __forceinline__ unsigned xb_add(unsigned* p, unsigned v) { return __hip_atomic_fetch_add(p, v, __ATOMIC_RELAXED, __HIP_MEMORY_SCOPE_AGENT); }
__device__ __forceinline__ unsigned xb_xcc_id() { return (unsigned)__builtin_amdgcn_s_getreg((3 << 11) | 20) & 0xFu; }
#define XB_SPIN(cond, bar) do { unsigned _sp = 0; while (cond) { __builtin_amdgcn_s_sleep(1); \
    if ((++_sp & 255u) == 0u) { if (xb_ld(&(bar)[XB_TMO])) break; if (_sp > XB_SPIN_CAP) { atomicAdd(&(bar)[XB_TMO], 1u); break; } } } } while (0)

struct XcdBarrier {
    unsigned* bar; unsigned x;
    volatile LAS unsigned* st;
};

__device__ __forceinline__ XcdBarrier xcd_barrier_post(unsigned* bar, volatile LAS unsigned* st) {
    XcdBarrier b; b.bar = bar; b.x = xb_xcc_id(); b.st = st;
    if (threadIdx.x == 0) (void)xb_add(&bar[XB_XCNT(b.x)], 1u);
    return b;
}
__device__ __forceinline__ void xcd_barrier_complete(unsigned* bar, unsigned x, unsigned& nloc, unsigned& nx) {
    const unsigned G = gridDim.x * gridDim.y * gridDim.z;
    unsigned sum, cnt, mine, sp = 0u;
    for (;;) {
        sum = 0u; cnt = 0u; mine = 0u;
#pragma unroll
        for (unsigned j = 0; j < 16; ++j) { const unsigned c = xb_ld(&bar[XB_XCNT(j)]); sum += c; cnt += (c > 0u) ? 1u : 0u; mine = (j == x) ? c : mine; }
        if (sum == G) break;
        __builtin_amdgcn_s_sleep(1);
        if ((++sp & 255u) == 0u) { if (xb_ld(&bar[XB_TMO])) break; if (sp > XB_SPIN_CAP) { atomicAdd(&bar[XB_TMO], 1u); break; } }
    }
    nloc = mine > 0u ? mine : 1u; nx = cnt > 0u ? cnt : 1u;
}

__device__ __forceinline__ void xcd_barrier(const XcdBarrier& b) {
    asm volatile("s_waitcnt vmcnt(0)" ::: "memory");
    __syncthreads();
    if (threadIdx.x == 0) {
        unsigned* bar = b.bar;
        __builtin_amdgcn_s_waitcnt(0);
        unsigned nloc = b.st[0], nx = b.st[1];
        if (nloc == 0u) { xcd_barrier_complete(bar, b.x, nloc, nx); b.st[0] = nloc; b.st[1] = nx; }
        const unsigned old = xb_add(&bar[XB_XSUB(b.x)], 1u);
        const unsigned gen = old / nloc;
        if (old + 1u == (gen + 1u) * nloc) {
            __builtin_amdgcn_fence(__ATOMIC_RELEASE, "agent");
            asm volatile("s_waitcnt vmcnt(0)" ::: "memory");
            const unsigned og = xb_add(&bar[XB_TOP], 1u);
            const unsigned tg = og / nx;
            if (og + 1u == (tg + 1u) * nx) xb_add(&bar[XB_TOPGEN], 1u);
            else XB_SPIN(xb_ld(&bar[XB_TOPGEN]) == tg, bar);
            __builtin_amdgcn_fence(__ATOMIC_ACQUIRE, "agent");
            xb_add(&bar[XB_XGEN(b.x)], 1u);
            asm volatile("s_waitcnt vmcnt(0)" ::: "memory");
        } else {
            XB_SPIN(xb_ld(&bar[XB_XGEN(b.x)]) == gen, bar);
            __builtin_amdgcn_fence(__ATOMIC_ACQUIRE, "agent");
            asm volatile("s_waitcnt vmcnt(0)" ::: "memory");
        }
    }
    __syncthreads();
}
struct Frame {
    LAS unsigned char* lds;
    volatile LAS unsigned* MISC;
    gu32* ctl;
    int tid, lane, wave, gw, NGW, G;
    float* out; unsigned char* ws;
};
__device__ __forceinline__ float wave_sum(float v) {
#pragma unroll
    for (int o = 1; o < 64; o <<= 1) v += __shfl_xor(v, o);
    return v;
}
__device__ __forceinline__ float bf2f(unsigned short b) { return __uint_as_float((unsigned)b << 16); }
__device__ __forceinline__ void unpack8(v4u w, float* f) {
    f[0] = __uint_as_float(w.x << 16); f[1] = __uint_as_float(w.x & 0xffff0000u); f[2] = __uint_as_float(w.y << 16); f[3] = __uint_as_float(w.y & 0xffff0000u);
    f[4] = __uint_as_float(w.z << 16); f[5] = __uint_as_float(w.z & 0xffff0000u); f[6] = __uint_as_float(w.w << 16); f[7] = __uint_as_float(w.w & 0xffff0000u);
}
typedef unsigned v2u __attribute__((ext_vector_type(2)));
__device__ __forceinline__ void unpack4(v2u w, float* f) {
    f[0] = __uint_as_float(w.x << 16); f[1] = __uint_as_float(w.x & 0xffff0000u); f[2] = __uint_as_float(w.y << 16); f[3] = __uint_as_float(w.y & 0xffff0000u);
}
__device__ __forceinline__ v2u pack4(const float* f) { v2u w; w.x = pk2(f[0], f[1]); w.y = pk2(f[2], f[3]); return w; }
__device__ __forceinline__ v4u pack8(const float* f) { v4u w; w.x = pk2(f[0], f[1]); w.y = pk2(f[2], f[3]); w.z = pk2(f[4], f[5]); w.w = pk2(f[6], f[7]); return w; }
__device__ __forceinline__ bf16x8 as_bf16x8(v4u w) { return __builtin_bit_cast(bf16x8, w); }
__device__ __forceinline__ float sigmoid_f(float x) { return 1.0f / (1.0f + __expf(-x)); }
__device__ __forceinline__ float tanh_f(float x) { const float e = __expf(2.0f * x); return 1.0f - 2.0f / (e + 1.0f); }

__device__ __forceinline__ void transpose_item(const float* W, int K, int N, bf16* WT, int kb, int nb, int orow0, LAS float* scr, int lane) {
    const int k0 = 64 * kb, n0 = 32 * nb;
#pragma unroll 8
    for (int i = 0; i < 32; ++i) { const int kk = 2 * i + (lane >> 5); scr[kk * 33 + (lane & 31)] = W[(size_t)(k0 + kk) * N + n0 + (lane & 31)]; }
    LDS_WAIT(); asm volatile("" ::: "memory");
    const int c = lane & 7;
#pragma unroll
    for (int j = 0; j < 4; ++j) { const int n = (lane >> 3) + 8 * j; const LAS float* s = scr + (8 * c) * 33 + n;
        v4u o; o.x = pk2(s[0 * 33], s[1 * 33]); o.y = pk2(s[2 * 33], s[3 * 33]); o.z = pk2(s[4 * 33], s[5 * 33]); o.w = pk2(s[6 * 33], s[7 * 33]);
        *(GAS v4u*)(WT + (size_t)(orow0 + n) * K + k0 + 8 * c) = o; }
    LDS_WAIT(); asm volatile("" ::: "memory");
}
__device__ __forceinline__ int gu_row(int n0) { return n0 < FF ? 256 * (n0 >> 7) + (n0 & 127) : 256 * ((n0 - FF) >> 7) + 128 + ((n0 - FF) & 127); }
__device__ __forceinline__ void p0_prologue(Frame& F, const InAcc& A) {
    LAS float* scr = (LAS float*)(F.lds + RING_OFF + F.wave * 16384);
    constexpr int I_GU = 16 * 176, I_DN = 44 * 32, I_IN = 16 * 88, I_OUT = 16 * 32, I_L64 = 16, I_L128 = 32;
    constexpr int NITEMS = 2 * I_GU + 2 * I_DN + I_IN + I_OUT + 2 * I_L64 + I_L128;
    for (int it = F.gw; it < NITEMS; it += F.NGW) {
        int r = it;
        if (r < I_GU) { const int kb = r / 176, nb = r % 176; transpose_item(A.in[8], 1024, 5632, ((bf16*)(F.ws + WS_GU1)), kb, nb, gu_row(32 * nb), scr, F.lane); continue; } r -= I_GU;
        if (r < I_GU) { const int kb = r / 176, nb = r % 176; transpose_item(A.in[27], 1024, 5632, ((bf16*)(F.ws + WS_GU2)), kb, nb, gu_row(32 * nb), scr, F.lane); continue; } r -= I_GU;
        if (r < I_DN) { const int kb = r / 32, nb = r % 32; transpose_item(A.in[9], 2816, 1024, ((bf16*)(F.ws + WS_DN1)), kb, nb, 32 * nb, scr, F.lane); continue; } r -= I_DN;
        if (r < I_DN) { const int kb = r / 32, nb = r % 32; transpose_item(A.in[28], 2816, 1024, ((bf16*)(F.ws + WS_DN2)), kb, nb, 32 * nb, scr, F.lane); continue; } r -= I_DN;
        if (r < I_IN) { const int kb = r / 88, nb = r % 88; transpose_item(A.in[10], 1024, 2816, ((bf16*)(F.ws + WS_WIN)), kb, nb, 32 * nb, scr, F.lane); continue; } r -= I_IN;
        if (r < I_OUT) { const int kb = r / 32, nb = r % 32; transpose_item(A.in[26], 1024, 1024, ((bf16*)(F.ws + WS_WOUT)), kb, nb, 32 * nb, scr, F.lane); continue; } r -= I_OUT;
        if (r < I_L64) { transpose_item(A.in[13], 64, 512, ((bf16*)(F.ws + WS_WLT)), 0, r, 32 * r, scr, F.lane); continue; } r -= I_L64;
        if (r < I_L64) { transpose_item(A.in[15], 64, 512, ((bf16*)(F.ws + WS_ALT)), 0, r, 32 * r, scr, F.lane); continue; } r -= I_L64;
        { const int kb = r / 16, nb = r % 16; transpose_item(A.in[16], 128, 512, ((bf16*)(F.ws + WS_GLT)), kb, nb, 32 * nb, scr, F.lane); }
    }
    const int gt = F.gw * 64 + F.lane, NGT = F.NGW * 64;
    for (int i = gt; i < NSEQ * 448; i += NGT) { const int sq = i / 448, cg = i % 448;
        f32x4 v = {0.f, 0.f, 0.f, 0.f}; if (sq >= 8) v = *(const f32x4*)(A.in[2] + (size_t)(sq - 8) * RC + 4 * cg);
        v2u w; w.x = pk2(v.x, v.y); w.y = pk2(v.z, v.w); *(v2u*)((bf16*)(F.ws + WS_FP) + (size_t)i * 64) = w; }
    for (int i = gt; i < 8 * 128 * 64; i += NGT) { const int j = (i & 63) * 2, ii = (i >> 6) & 127;
        const float a = A.in[24][2 * (size_t)i], b = A.in[24][2 * (size_t)i + 1];
        ((unsigned*)((bf16*)(F.ws + WS_WSB)))[i] = pk2(j <= ii ? a : 0.f, (j + 1) <= ii ? b : 0.f); }
}
__device__ __forceinline__ void p1_mod(Frame& F, const InAcc& A) {
    const int l15 = F.lane & 15, q = F.lane >> 4;
    const float* w_ada = A.in[6]; const float* b_ada = A.in[7];
    const float* c_p = A.in[4]; const float* c_s = A.in[5];
    LAS f32x4* red = (LAS f32x4*)(F.lds + RING_OFF);
    for (int nt = blockIdx.x; nt < MODW / 16; nt += F.G) {
        const int n0 = 16 * nt, kb = 128 * F.wave + 8 * q;
        float wv[4][8];
        const float* wp = w_ada + (size_t)kb * MODW + n0 + l15;
#pragma unroll
        for (int ks = 0; ks < 4; ++ks) {
#pragma unroll
            for (int j = 0; j < 8; ++j) { wv[ks][j] = *wp; wp += MODW; asm volatile("" : "+v"(wp)); }
            wp += 24 * MODW; }
        f32x4 acc[9];
#pragma unroll
        for (int mt = 0; mt < 9; ++mt) acc[mt] = (f32x4){0.f, 0.f, 0.f, 0.f};
#pragma unroll 1
        for (int ks = 0; ks < 4; ++ks) {
            f32x4 raw[9][2];
#pragma unroll
            for (int mt = 0; mt < 9; ++mt) { const int sq = 16 * mt + l15; const int sc = sq < NSEQ ? sq : 0;
                const float* cr = (sc < 8 ? c_p + (size_t)sc * D : c_s + (size_t)(sc - 8) * D) + kb + 32 * ks; raw[mt][0] = *(const f32x4*)cr; raw[mt][1] = *(const f32x4*)(cr + 4); }
            __builtin_amdgcn_sched_barrier(0);
            const bf16x8 wf = as_bf16x8(pack8(wv[0]));
#pragma unroll
            for (int mt = 0; mt < 9; ++mt) { const bool ok = 16 * mt + l15 < NSEQ; float t[8];
#pragma unroll
                for (int e = 0; e < 4; ++e) { t[e] = ok ? pg8::silu_f(raw[mt][0][e]) : 0.f; t[4 + e] = ok ? pg8::silu_f(raw[mt][1][e]) : 0.f; }
                acc[mt] = __builtin_amdgcn_mfma_f32_16x16x32_bf16(wf, as_bf16x8(pack8(t)), acc[mt], 0, 0, 0); }
            __builtin_amdgcn_sched_barrier(0);
#pragma unroll
            for (int i = 0; i < 3; ++i)
#pragma unroll
                for (int j = 0; j < 8; ++j) wv[i][j] = wv[i + 1][j];
        }
#pragma unroll
        for (int mt = 0; mt < 9; ++mt) red[(F.wave * 9 + mt) * 64 + F.lane] = acc[mt];
        __syncthreads();
        const f32x4 bv = *(const f32x4*)(b_ada + n0 + 4 * q);
#pragma unroll
        for (int rr = 0; rr < 2; ++rr) { const int mt = F.wave + 8 * rr; if (mt < 9) { f32x4 s = bv;
#pragma unroll
                for (int w2 = 0; w2 < 8; ++w2) s += red[(w2 * 9 + mt) * 64 + F.lane];
                const int sq = 16 * mt + l15; if (sq < NSEQ) *(f32x4*)(((float*)(F.ws + WS_MOD)) + (size_t)sq * MODW + n0 + 4 * q) = s; } }
        __syncthreads();
    }
}
__device__ __forceinline__ const float* res_row(const float* pP, const float* pS, int row) { return row < MP ? pP + (size_t)row * D : pS + (size_t)(row - MP) * D; }
__device__ __forceinline__ void load_h_row(const bf16* hb, int row, int lane, f32x4* v) {
    const v2u* hr = (const v2u*)(hb + (size_t)row * 2048 + 1024) + lane;
#pragma unroll
    for (int j = 0; j < 4; ++j) { float t[4]; unpack4(hr[64 * j], t); v[j] = (f32x4){t[0], t[1], t[2], t[3]}; }
}
template <bool SRC_X> struct RowRaw { f32x4 x[4]; v2u h[4]; };
template <bool SRC_X> __device__ __forceinline__ void norm_load(RowRaw<SRC_X>& R, const float* srcP, const float* srcS, const bf16* hb, int row, int lane) {
    if (SRC_X) { const f32x4* xr = (const f32x4*)res_row(srcP, srcS, row) + lane;
#pragma unroll
        for (int j = 0; j < 4; ++j) R.x[j] = xr[64 * j]; }
    else { const v2u* hr = (const v2u*)(hb + (size_t)row * 2048 + 1024) + lane;
#pragma unroll
        for (int j = 0; j < 4; ++j) R.h[j] = hr[64 * j]; }
}
__device__ __forceinline__ void norm_finish(Frame& F, const f32x4* v, int row, int s, int sh_off, int sc_off) {
    const float* MODp = (const float*)(F.ws + WS_MOD);
    float ss = 0.f;
#pragma unroll
    for (int j = 0; j < 4; ++j) ss += (v[j].x * v[j].x + v[j].y * v[j].y) + (v[j].z * v[j].z + v[j].w * v[j].w);
    const float rstd = 1.0f / sqrtf(wave_sum(ss) * (1.0f / D) + RMS_EPS);
    const f32x4* sc = (const f32x4*)(MODp + (size_t)s * MODW + sc_off) + F.lane; const f32x4* sh = (const f32x4*)(MODp + (size_t)s * MODW + sh_off) + F.lane;
    v2u* o = (v2u*)(((bf16*)(F.ws + WS_XN)) + (size_t)row * D) + F.lane;
#pragma unroll
    for (int j = 0; j < 4; ++j) { const f32x4 a = sc[64 * j], bb = sh[64 * j]; const f32x4 r = v[j] * rstd * (a + 1.0f) + bb; float t[4] = {r.x, r.y, r.z, r.w}; o[64 * j] = pack4(t); }
}
template <bool SRC_X> __device__ __forceinline__ void norm_rows_bf16(Frame& F, const InAcc& A, const float* srcP, const float* srcS, bool sample_src_x, int sh_off, int sc_off, int ns, int g_off, float coef) {
    const float* MODp = (const float*)(F.ws + WS_MOD); bf16* hb = (bf16*)F.out;
    const int nmain = ns > 0 ? MP : M;
    RowRaw<SRC_X> cur, nxt;
    int row = F.gw;
    if (row < nmain) norm_load<SRC_X>(cur, srcP, srcS, hb, row, F.lane);
    while (row < nmain) {
        const int nrow = row + F.NGW;
        if (nrow < nmain) norm_load<SRC_X>(nxt, srcP, srcS, hb, nrow, F.lane);
        f32x4 v[4];
#pragma unroll
        for (int j = 0; j < 4; ++j) { if (SRC_X) v[j] = cur.x[j]; else { float t[4]; unpack4(cur.h[j], t); v[j] = (f32x4){t[0], t[1], t[2], t[3]}; } }
        norm_finish(F, v, row, pg8::seq_of_row(row), sh_off, sc_off);
        cur = nxt; row = nrow;
    }
    if (ns > 0) for (int r2 = MP + F.gw; r2 < M; r2 += F.NGW) {
        const int s = pg8::seq_of_row(r2);
        f32x4 v[4];
        if (sample_src_x) { const f32x4* xr = (const f32x4*)(srcS + (size_t)(r2 - MP) * D) + F.lane;
#pragma unroll
            for (int j = 0; j < 4; ++j) v[j] = xr[64 * j]; }
        else load_h_row(hb, r2, F.lane, v);
        const f32x4* sl = (const f32x4*)(F.ws + WS_SC) + (size_t)(r2 - MP) * (D / 4) + F.lane; const f32x4* gp = (const f32x4*)(MODp + (size_t)s * MODW + g_off) + F.lane;
        v2u* hr = (v2u*)(hb + (size_t)r2 * 2048 + 1024) + F.lane;
#pragma unroll
        for (int j = 0; j < 4; ++j) { f32x4 t = {0.f, 0.f, 0.f, 0.f}; for (int k = 0; k < ns; ++k) t += sl[(size_t)k * (1024 * D / 4) + 64 * j]; v[j] = v[j] + (gp[64 * j] * coef) * t;
            float q4[4] = {v[j].x, v[j].y, v[j].z, v[j].w}; const v2u pk = pack4(q4); hr[64 * j] = pk; float u4[4]; unpack4(pk, u4); v[j] = (f32x4){u4[0], u4[1], u4[2], u4[3]}; }
        norm_finish(F, v, r2, s, sh_off, sc_off);
    }
}
__device__ __forceinline__ void final_norm_rows(Frame& F, const InAcc& A, int ns, int g_off, float coef) {
    const float* MODp = (const float*)(F.ws + WS_MOD); const bf16* hb = (const bf16*)F.out;
    const f32x4* g = (const f32x4*)A.in[29] + F.lane;
    RowRaw<false> cur, nxt;
    int row = F.gw;
    if (row < M) norm_load<false>(cur, nullptr, nullptr, hb, row, F.lane);
    while (row < M) {
        const int nrow = row + F.NGW;
        if (nrow < M) norm_load<false>(nxt, nullptr, nullptr, hb, nrow, F.lane);
        f32x4* xr = (f32x4*)(F.out + (size_t)row * D) + F.lane;
        f32x4 v[4];
#pragma unroll
        for (int j = 0; j < 4; ++j) { float t[4]; unpack4(cur.h[j], t); v[j] = (f32x4){t[0], t[1], t[2], t[3]}; }
        if (ns > 0 && row >= MP) { const int s = pg8::seq_of_row(row); const f32x4* sl = (const f32x4*)(F.ws + WS_SC) + (size_t)(row - MP) * (D / 4) + F.lane; const f32x4* gp = (const f32x4*)(MODp + (size_t)s * MODW + g_off) + F.lane;
#pragma unroll
            for (int j = 0; j < 4; ++j) { f32x4 t = {0.f, 0.f, 0.f, 0.f}; for (int k = 0; k < ns; ++k) t += sl[(size_t)k * (1024 * D / 4) + 64 * j]; v[j] = v[j] + (gp[64 * j] * coef) * t; } }
        float ss = 0.f;
#pragma unroll
        for (int j = 0; j < 4; ++j) ss += (v[j].x * v[j].x + v[j].y * v[j].y) + (v[j].z * v[j].z + v[j].w * v[j].w);
        const float rstd = 1.0f / sqrtf(wave_sum(ss) * (1.0f / D) + RMS_EPS);
        asm volatile("" ::: "memory");
#pragma unroll
        for (int j = 0; j < 4; ++j) xr[64 * j] = v[j] * rstd * g[64 * j];
        cur = nxt; row = nrow;
    }
}
__device__ __forceinline__ unsigned dpp_shr1(unsigned x) { return (unsigned)__builtin_amdgcn_update_dpp(0, (int)x, 0x111, 0xf, 0xf, false); }
__device__ __forceinline__ size_t sc_off(int row, int c) { return ((size_t)((row >> 4) * 128 + (c >> 2)) * 16 + (row & 15)) * 4 + (c & 3); }
__device__ __forceinline__ void frag_item(Frame& F, const InAcc& A, int r0, int gh  ) {
    const int l15 = F.lane & 15, q = F.lane >> 4, row = r0 + l15, tile = r0 >> 4;
    const bf16* PB = (const bf16*)(F.ws + WS_ACT);
    const bf16* pcur = PB + ((size_t)tile * 448 * 16 + l15) * 4;
    const bool first = pg8::row_is_first(row);
    const bf16* fp = (const bf16*)(F.ws + WS_FP) + (size_t)pg8::seq_of_row(row) * 448 * 64;
    const bf16* pprv = PB + ((size_t)(tile > 0 ? tile - 1 : 0) * 448 * 16 + 15) * 4;
    const bf16* pb = first ? fp : (l15 == 0 ? pprv : pcur - 4);
    const float* mu = A.in[11];
    v2u lc[16], lp[16];
#pragma unroll
    for (int i = 0; i < 16; ++i) if ((i >> 3) == gh) { const size_t o = (size_t)(384 + 8 * (i >> 1) + 2 * q + (i & 1)) * 64; lc[i] = *(const v2u*)(pcur + o); lp[i] = *(const v2u*)(pb + o); }
#pragma unroll
    for (int g = 0; g < 8; ++g) if ((g >> 2) == gh) { const int col = 1536 + 32 * g + 8 * q; float cur[8], prv[8]; unpack4(lc[2 * g], cur); unpack4(lc[2 * g + 1], cur + 4); unpack4(lp[2 * g], prv); unpack4(lp[2 * g + 1], prv + 4);
        const f32x4 m0 = *(const f32x4*)(mu + col), m1 = *(const f32x4*)(mu + col + 4); const float mm[8] = {m0.x, m0.y, m0.z, m0.w, m1.x, m1.y, m1.z, m1.w};
        float t[8];
#pragma unroll
        for (int e = 0; e < 8; ++e) { const float x = cur[e] + (prv[e] - cur[e]) * mm[e]; t[e] = g < 2 ? tanh_f(x) : (g < 4 ? x : sigmoid_f(x)); }
        *(v4u*)((bf16*)(F.ws + WS_FRG) + ((size_t)((tile * 8 + g) * 4 + q) * 16 + l15) * 8) = pack8(t); }
}
template <bool GL> __device__ __forceinline__ void prep_item(Frame& F, const InAcc& A, int r0, int h) {
    const int l15 = F.lane & 15, q = F.lane >> 4, row = r0 + l15, tile = r0 >> 4;
    const bf16* PB = (const bf16*)(F.ws + WS_ACT);
    const bf16* pcur = PB + ((size_t)tile * 448 * 16 + l15) * 4;
    const bool first = pg8::row_is_first(row);
    const bf16* fp = (const bf16*)(F.ws + WS_FP) + (size_t)pg8::seq_of_row(row) * 448 * 64;
    const bf16* pprv = PB + ((size_t)(tile > 0 ? tile - 1 : 0) * 448 * 16 + 15) * 4;
    const float* mu = A.in[11];
    v2u xc[4][3], xp[4][3];
    const bf16* pb = first ? fp : (l15 == 0 ? pprv : pcur - 4); constexpr int pmul = 64;
    bf16x8 fr[8];
#pragma unroll
    for (int g = 0; g < 8; ++g) fr[g] = *(const bf16x8*)((const bf16*)(F.ws + WS_FRG) + ((size_t)((tile * 8 + g) * 4 + q) * 16 + l15) * 8);
#pragma unroll
    for (int ntl = 0; ntl < 4; ++ntl)
#pragma unroll
        for (int sct = 0; sct < 3; ++sct) xc[ntl][sct] = *(const v2u*)(pcur + (size_t)(128 * sct + 16 * h + 4 * ntl + q) * 64);
#pragma unroll
    for (int ntl = 0; ntl < 4; ++ntl)
#pragma unroll
        for (int sct = 0; sct < 3; ++sct) xp[ntl][sct] = *(const v2u*)(pb + (size_t)(128 * sct + 16 * h + 4 * ntl + q) * pmul);
    v2u xm[4][3];
    const float* k_k = A.in[17];
    float ss = 0.f, bon = 0.f;
#pragma unroll
    for (int ntl = 0; ntl < 4; ++ntl)
#pragma unroll
        for (int sct = 0; sct < 3; ++sct) { const int col = 512 * sct + 64 * h + 16 * ntl + 4 * q; float cur[4], prv[4], x[4]; unpack4(xc[ntl][sct], cur); unpack4(xp[ntl][sct], prv);
            const f32x4 m0 = *(const f32x4*)(mu + col);
#pragma unroll
            for (int e = 0; e < 4; ++e) x[e] = cur[e] + (prv[e] - cur[e]) * m0[e];
            xm[ntl][sct] = pack4(x);
            if (sct == 1) { float xb[4]; unpack4(xm[ntl][sct], xb); const f32x4 kkv = *(const f32x4*)(k_k + 64 * h + 16 * ntl + 4 * q);
#pragma unroll
                for (int e = 0; e < 4; ++e) { const float kr = xb[e] * kkv[e]; ss += kr * kr; } } }
    __builtin_amdgcn_sched_barrier(0);
    ss += __shfl_xor(ss, 16); ss += __shfl_xor(ss, 32);
    const float inv = 1.0f / fmaxf(sqrtf(ss), 1e-12f);
    const LAS bf16x8* wl = (const LAS bf16x8*)(F.lds + RING_OFF) + F.lane;
    const LAS float* hp = (const LAS float*)(F.lds + RING_OFF + 32768);
    const bf16* gW = (const bf16*)(F.ws + WS_WLT) + (size_t)(64 * h + l15) * 64 + 8 * q; const bf16* gA = (const bf16*)(F.ws + WS_ALT) + (size_t)(64 * h + l15) * 64 + 8 * q; const bf16* gG = (const bf16*)(F.ws + WS_GLT) + (size_t)(64 * h + l15) * 128 + 8 * q;
    const float* g_w0 = A.in[12]; const float* g_a0 = A.in[14]; const float* g_ka = A.in[18]; const float* g_rk = A.in[19];
#define PREP_WL(f) (GL ? ((f) < 8 ? *(const bf16x8*)(gW + (size_t)(16 * ((f) >> 1)) * 64 + 32 * ((f) & 1)) : (f) < 16 ? *(const bf16x8*)(gA + (size_t)(16 * (((f) - 8) >> 1)) * 64 + 32 * ((f) & 1)) : *(const bf16x8*)(gG + (size_t)(16 * (((f) - 16) >> 2)) * 128 + 32 * ((f) & 3))) : wl[(f) * 64])
#pragma unroll 1
    for (int ntl = 0; ntl < 4; ++ntl) {
        const int n0 = 64 * h + 16 * ntl, c0 = n0 + 4 * q;
        f32x4 aw = {0.f, 0.f, 0.f, 0.f}, aa = aw, ag = aw;
#pragma unroll
        for (int ks = 0; ks < 2; ++ks) {
            aw = __builtin_amdgcn_mfma_f32_16x16x32_bf16(PREP_WL(2 * ntl + ks), fr[ks], aw, 0, 0, 0);
            aa = __builtin_amdgcn_mfma_f32_16x16x32_bf16(PREP_WL(8 + 2 * ntl + ks), fr[2 + ks], aa, 0, 0, 0); }
#pragma unroll
        for (int ks = 0; ks < 4; ++ks)
            ag = __builtin_amdgcn_mfma_f32_16x16x32_bf16(PREP_WL(16 + 4 * ntl + ks), fr[4 + ks], ag, 0, 0, 0);
        const int cl = 16 * ntl + 4 * q;
        f32x4 w0v, a0v, kkv, kav, rkv;
        if (GL) { w0v = *(const f32x4*)(g_w0 + 64 * h + cl); a0v = *(const f32x4*)(g_a0 + 64 * h + cl); kkv = *(const f32x4*)(k_k + 64 * h + cl); kav = *(const f32x4*)(g_ka + 64 * h + cl); rkv = *(const f32x4*)(g_rk + 64 * h + cl); }
        else { w0v = *(const LAS f32x4*)(hp + cl); a0v = *(const LAS f32x4*)(hp + 64 + cl); kkv = *(const LAS f32x4*)(hp + 128 + cl); kav = *(const LAS f32x4*)(hp + 192 + cl); rkv = *(const LAS f32x4*)(hp + 256 + cl); }
        float omd[4], km[4], gg[4], kk[4], bb[4], xrf[4], xkf[4]; unpack4(xm[0][0], xrf); unpack4(xm[0][1], xkf);
#pragma unroll
        for (int e = 0; e < 4; ++e) {
            const float z = -(w0v[e] + aw[e]);
            const float sp = z > 20.f ? z : __logf(1.0f + __expf(z));
            const float wlog = -sp - 0.5f;
            const float dec = __expf(-__expf(wlog));
            omd[e] = 1.0f - dec;
            const float a = sigmoid_f(a0v[e] + aa[e]);
            kk[e] = xkf[e] * kkv[e] * inv; bb[e] = kk[e] * a;
            km[e] = xkf[e] * (1.0f + (a - 1.0f) * kav[e]);
            bon += xrf[e] * km[e] * rkv[e];
            gg[e] = ag[e];
        }
        const size_t o = sc_off(row, c0);
        *(v2u*)(((bf16*)(F.ws + WS_SC)) + o) = xm[0][0]; *(v2u*)(((bf16*)(F.ws + (WS_SC + SC_STRIDE))) + o) = pack4(km); *(v2u*)(((bf16*)(F.ws + (WS_SC + 2 * SC_STRIDE))) + o) = xm[0][2];
        *(v2u*)(((bf16*)(F.ws + (WS_SC + 3 * SC_STRIDE))) + o) = pack4(kk); *(v2u*)(((bf16*)(F.ws + (WS_SC + 4 * SC_STRIDE))) + o) = pack4(bb);
        *(v2u*)(((bf16*)(F.ws + (WS_SC + 5 * SC_STRIDE))) + o) = pack4(omd); *(v2u*)(((bf16*)(F.ws + WS_G)) + o) = pack4(gg);
#pragma unroll
        for (int i = 0; i < 3; ++i)
#pragma unroll
            for (int e = 0; e < 3; ++e) xm[i][e] = xm[i + 1][e];
    }
    bon += __shfl_xor(bon, 16); bon += __shfl_xor(bon, 32);
    if (q == 0) ((float*)(F.ws + WS_BON))[(size_t)row * 8 + h] = bon;
#undef PREP_WL
}
__device__ __forceinline__ void prep_all(Frame& F, const InAcc& A) {
    const int w = blockIdx.x, h = w & 7; const int nslots = (F.G >> 3) * NWAVES;
    if (F.G & 7) return;
    { const bf16* WLT = (const bf16*)(F.ws + WS_WLT); const bf16* ALT = (const bf16*)(F.ws + WS_ALT); const bf16* GLT = (const bf16*)(F.ws + WS_GLT);
      LAS v4u* dst = (LAS v4u*)(F.lds + RING_OFF);
#pragma unroll
      for (int i = 0; i < 4; ++i) { const int p = F.tid + 512 * i, f = p >> 6, L = p & 63, l15 = L & 15, q = L >> 4;
          const bf16* src;
          if (f < 8) src = WLT + (size_t)(64 * h + 16 * (f >> 1) + l15) * 64 + 32 * (f & 1) + 8 * q;
          else if (f < 16) src = ALT + (size_t)(64 * h + 16 * ((f - 8) >> 1) + l15) * 64 + 32 * (f & 1) + 8 * q;
          else src = GLT + (size_t)(64 * h + 16 * ((f - 16) >> 2) + l15) * 128 + 32 * (f & 3) + 8 * q;
          dst[p] = *(const v4u*)src; }
      if (F.tid < 320) { const int a = F.tid >> 6, i = F.tid & 63; const float* src = a == 0 ? A.in[12] : a == 1 ? A.in[14] : a == 2 ? A.in[17] : a == 3 ? A.in[18] : A.in[19];
          ((LAS float*)(F.lds + RING_OFF + 32768))[F.tid] = src[64 * h + i]; }
      __syncthreads(); }
    for (int tt = (w >> 3) * NWAVES + F.wave; tt < MP / 16; tt += nslots) prep_item<false>(F, A, 16 * tt, h);
    __syncthreads();
}
__device__ __forceinline__ void lnv_rows(Frame& F, const InAcc& A) {
    for (int row = F.gw; row < M; row += F.NGW) {
        v4u* pv = (v4u*)(((bf16*)(F.ws + WS_PUV)) + (size_t)row * 1024 + 512) + F.lane;
        float x[8]; unpack8(*pv, x);
        float s = 0.f;
#pragma unroll
        for (int e = 0; e < 8; ++e) s += x[e];
        const float mean = wave_sum(s) * (1.0f / 512.0f); float qq = 0.f;
#pragma unroll
        for (int e = 0; e < 8; ++e) { x[e] -= mean; qq += x[e] * x[e]; }
        const float rstd = 1.0f / sqrtf(wave_sum(qq) * (1.0f / 512.0f) + LN_EPS);
        const f32x4 g0 = *(const f32x4*)(A.in[22] + 8 * F.lane), g1 = *(const f32x4*)(A.in[22] + 8 * F.lane + 4), b0 = *(const f32x4*)(A.in[23] + 8 * F.lane), b1 = *(const f32x4*)(A.in[23] + 8 * F.lane + 4);
        const float gg[8] = {g0.x, g0.y, g0.z, g0.w, g1.x, g1.y, g1.z, g1.w}, bb[8] = {b0.x, b0.y, b0.z, b0.w, b1.x, b1.y, b1.z, b1.w};
#pragma unroll
        for (int e = 0; e < 8; ++e) x[e] = x[e] * rstd * gg[e] + bb[e];
        *pv = pack8(x);
        if (row >= MP) { float* o = F.out + O_CVS + (size_t)(row - MP) * 512 + 8 * F.lane; *(f32x4*)o = (f32x4){x[0], x[1], x[2], x[3]}; *(f32x4*)(o + 4) = (f32x4){x[4], x[5], x[6], x[7]}; }
    }
}
template <bool SAMP> __device__ __forceinline__ void gmlp_item(Frame& F, const InAcc& A, int ci, int h, LAS unsigned short* tile  ) {
    const int l15 = F.lane & 15, q = F.lane >> 4;
    const int base = SAMP ? MP + 8 * ci : 128 * ci;
    const bf16* P = (const bf16*)(F.ws + WS_PUV);
    const bf16* WSB = (const bf16*)(F.ws + WS_WSB);
    const float* b_s = A.in[25];
    constexpr int NIT = SAMP ? 1 : 8, NKS = SAMP ? 1 : 4;
    v4u xs[SAMP ? 1 : 16];
#pragma unroll
    for (int i = 0; i < (SAMP ? 1 : 16); ++i) { const int r = 8 * i + (F.lane >> 3), c8 = (F.lane & 7) * 8; xs[i] = *(const v4u*)(P + (size_t)(base + r) * 1024 + 512 + h * 64 + c8); }
    float bs[NIT];
#pragma unroll
    for (int it = 0; it < NIT; ++it) bs[it] = b_s[h * 128 + 16 * it + l15];
#pragma unroll
    for (int i = 0; i < (SAMP ? 1 : 16); ++i) { const int r = 8 * i + (F.lane >> 3), c8 = (F.lane & 7) * 8; LAS unsigned* d = (LAS unsigned*)(tile + r * 66 + c8); d[0] = xs[i].x; d[1] = xs[i].y; d[2] = xs[i].z; d[3] = xs[i].w; }
    LDS_WAIT(); asm volatile("" ::: "memory");
#pragma unroll 1
    for (int dt = 0; dt < 4; ++dt) {
        const int cc = h * 64 + 16 * dt + 4 * q;
        v2u pu[NIT];
#pragma unroll
        for (int it = 0; it < NIT; ++it) pu[it] = *(const v2u*)(P + (size_t)(base + (SAMP ? (l15 & 7) : 16 * it + l15)) * 1024 + cc);
        bf16x8 vf[NKS];
#pragma unroll
        for (int ks = 0; ks < NKS; ++ks)
#pragma unroll
            for (int jj = 0; jj < 8; ++jj) { const int jr = 32 * ks + 8 * q + jj; vf[ks][jj] = (SAMP && jr >= 8) ? (short)0 : (short)tile[jr * 66 + 16 * dt + l15]; }
#pragma unroll
        for (int it = 0; it < NIT; ++it) {
            f32x4 acc = {0.f, 0.f, 0.f, 0.f};
#pragma unroll
            for (int ks = 0; ks < NKS; ++ks) if (ks <= (it >> 1))
                acc = __builtin_amdgcn_mfma_f32_16x16x32_bf16(vf[ks], *(const bf16x8*)(WSB + ((size_t)(h * 128 + 16 * it + l15)) * 128 + 32 * ks + 8 * q), acc, 0, 0, 0);
            const int i = 16 * it + l15;
            if (!SAMP || i < 8) { const int row = base + i;
                float puf[4]; unpack4(pu[it], puf);
                float o[4];
#pragma unroll
                for (int e = 0; e < 4; ++e) o[e] = puf[e] * (acc[e] + bs[it]);
                *(v2u*)(((bf16*)(F.ws + WS_XN)) + (size_t)row * D + 512 + cc) = pack4(o); }
        }
    }
    LDS_WAIT(); asm volatile("" ::: "memory");
}
__device__ __forceinline__ float red16(float x) {
    x += __builtin_bit_cast(float, __builtin_amdgcn_update_dpp(0, __builtin_bit_cast(int, x), 0x128, 0xf, 0xf, false));
    x += __builtin_bit_cast(float, __builtin_amdgcn_update_dpp(0, __builtin_bit_cast(int, x), 0x124, 0xf, 0xf, false));
    x += __builtin_bit_cast(float, __builtin_amdgcn_update_dpp(0, __builtin_bit_cast(int, x), 0x122, 0xf, 0xf, false));
    x += __builtin_bit_cast(float, __builtin_amdgcn_update_dpp(0, __builtin_bit_cast(int, x), 0x121, 0xf, 0xf, false));
    return x;
}
typedef float f32x2 __attribute__((ext_vector_type(2)));
#define DPP_ROR(x, n) __builtin_bit_cast(float, __builtin_amdgcn_update_dpp(0, __builtin_bit_cast(int, (x)), 0x120 + (n), 0xf, 0xf, false))
__device__ __forceinline__ void red16x2(float& a, float& b) {
    a += DPP_ROR(a, 8); b += DPP_ROR(b, 8); a += DPP_ROR(a, 4); b += DPP_ROR(b, 4); a += DPP_ROR(a, 2); b += DPP_ROR(b, 2); a += DPP_ROR(a, 1); b += DPP_ROR(b, 1);
}
__device__ __forceinline__ float wkv_step(f32x4& S, const f32x4 w, const f32x4 kk, const f32x4 bb, const f32x4 k, const f32x4 r, const float vv, float& ypend) {
    f32x2 Sa = {S.x, S.y}, Sb = {S.z, S.w};
    f32x2 p = Sa * (f32x2){kk.x, kk.y}; p = Sb * (f32x2){kk.z, kk.w} + p;
    float d = p.x + p.y;
    red16x2(d, ypend);
    const f32x2 v2 = {vv, vv};
    f32x2 Ta = (f32x2){k.x, k.y} * v2, Tb = (f32x2){k.z, k.w} * v2;
    Ta = Sa * (f32x2){w.x, w.y} + Ta; Tb = Sb * (f32x2){w.z, w.w} + Tb;
    const f32x2 nd = {-d, -d};
    Sa = (f32x2){bb.x, bb.y} * nd + Ta; Sb = (f32x2){bb.z, bb.w} * nd + Tb;
    f32x2 yv = Sa * (f32x2){r.x, r.y}; yv = Sb * (f32x2){r.z, r.w} + yv;
    S = (f32x4){Sa.x, Sa.y, Sb.x, Sb.y};
    return yv.x + yv.y;
}
__device__ __forceinline__ void scan_sample_item(Frame& F, const InAcc& A, int it) {
    const int sbh = it >> 3, rp = it & 7, sb = sbh >> 3, h = sbh & 7, j = F.lane & 15, v0 = 8 * rp + (F.lane >> 4), v1 = v0 + 4;
    const size_t so0 = ((size_t)sbh * 64 + v0) * 64 + 4 * j, so1 = so0 + 4 * 64;
    f32x4 S0 = *(const f32x4*)(A.in[3] + so0), S1 = *(const f32x4*)(A.in[3] + so1);
    const size_t ro0 = (size_t)(MP + 8 * sb) * RW + h * 64;
    const bf16* scr = (const bf16*)(F.ws + WS_SC);
    v2u lw[8], lkk[8], lbb[8], lk[8], lr[8]; unsigned short lv0[8], lv1[8];
#pragma unroll
    for (int t = 0; t < 8; ++t) { const int row = MP + 8 * sb + t; const size_t ro = sc_off(row, h * 64 + 4 * j);
        lw[t] = *(const v2u*)(scr + 5 * (SC_STRIDE / 2) + ro); lkk[t] = *(const v2u*)(scr + 3 * (SC_STRIDE / 2) + ro); lbb[t] = *(const v2u*)(scr + 4 * (SC_STRIDE / 2) + ro);
        lk[t] = *(const v2u*)(scr + 1 * (SC_STRIDE / 2) + ro); lr[t] = *(const v2u*)(scr + ro); lv0[t] = scr[2 * (SC_STRIDE / 2) + sc_off(row, h * 64 + v0)]; lv1[t] = scr[2 * (SC_STRIDE / 2) + sc_off(row, h * 64 + v1)]; }
    float yk0 = 0.f, yk1 = 0.f;
#pragma unroll
    for (int t = 0; t < 8; ++t) {
        float w[4], kk[4], bb[4], k[4], r[4];
        unpack4(lw[t], w); unpack4(lkk[t], kk); unpack4(lbb[t], bb); unpack4(lk[t], k); unpack4(lr[t], r);
        const f32x4 w4 = {1.f - w[0], 1.f - w[1], 1.f - w[2], 1.f - w[3]}, kk4 = {kk[0], kk[1], kk[2], kk[3]}, bb4 = {bb[0], bb[1], bb[2], bb[3]}, k4 = {k[0], k[1], k[2], k[3]}, r4 = {r[0], r[1], r[2], r[3]};
        float dm0 = 0.f; const float y0 = red16(wkv_step(S0, w4, kk4, bb4, k4, r4, bf2f(lv0[t]), dm0));
        float dm1 = 0.f; const float y1 = red16(wkv_step(S1, w4, kk4, bb4, k4, r4, bf2f(lv1[t]), dm1));
        yk0 = (j == t) ? y0 : yk0; yk1 = (j == t) ? y1 : yk1;
    }
    if (j < 8) { float* yg = ((float*)(F.ws + WS_Y)) + ro0 + (size_t)j * RW; yg[v0] = yk0; yg[v1] = yk1; }
    *(f32x4*)(F.out + O_WKVS + so0) = S0; *(f32x4*)(F.out + O_WKVS + so1) = S1;
}
__device__ __forceinline__ void scan_sample_seq(Frame& F, const InAcc& A, int sbh) {
    const int sb = sbh >> 3, h = sbh & 7, j = F.lane & 15, vq = F.lane >> 4;
    const float* Sin = A.in[3];
    const size_t ro0 = (size_t)(MP + 8 * sb) * RW + h * 64;
    const bf16* scr = (const bf16*)(F.ws + WS_SC);
    v2u lw[8], lkk[8], lbb[8], lk[8], lr[8];
#pragma unroll
    for (int t = 0; t < 8; ++t) { const int row = MP + 8 * sb + t; const size_t ro = sc_off(row, h * 64 + 4 * j);
        lw[t] = *(const v2u*)(scr + 5 * (SC_STRIDE / 2) + ro); lkk[t] = *(const v2u*)(scr + 3 * (SC_STRIDE / 2) + ro); lbb[t] = *(const v2u*)(scr + 4 * (SC_STRIDE / 2) + ro);
        lk[t] = *(const v2u*)(scr + 1 * (SC_STRIDE / 2) + ro); lr[t] = *(const v2u*)(scr + ro); }
    f32x4 nS0, nS1; unsigned nv0[8], nv1[8];
#define SS_FETCH(rp_) do { const int v0_ = 8 * (rp_) + vq; const size_t so_ = ((size_t)sbh * 64 + v0_) * 64 + 4 * j; nS0 = *(const f32x4*)(Sin + so_); nS1 = *(const f32x4*)(Sin + so_ + 4 * 64); \
        _Pragma("unroll") for (int t = 0; t < 8; ++t) { const int row = MP + 8 * sb + t; nv0[t] = scr[2 * (SC_STRIDE / 2) + sc_off(row, h * 64 + v0_)]; nv1[t] = scr[2 * (SC_STRIDE / 2) + sc_off(row, h * 64 + v0_ + 4)]; } } while (0)
    SS_FETCH(0);
#pragma unroll 1
    for (int rp = 0; rp < 8; ++rp) {
        f32x4 S0 = nS0, S1 = nS1; unsigned lv0[8], lv1[8];
#pragma unroll
        for (int t = 0; t < 8; ++t) { lv0[t] = nv0[t]; lv1[t] = nv1[t]; }
        asm volatile("" ::: "memory");
        if (rp + 1 < 8) SS_FETCH(rp + 1);
#pragma unroll
        for (int t = 0; t < 8; ++t) asm volatile("" : "+v"(lw[t]), "+v"(lkk[t]), "+v"(lbb[t]), "+v"(lk[t]), "+v"(lr[t]));
        const int v0 = 8 * rp + vq, v1 = v0 + 4;
        float yk0 = 0.f, yk1 = 0.f;
#pragma unroll
        for (int t = 0; t < 8; ++t) {
            float w[4], kk[4], bb[4], k[4], r[4];
            unpack4(lw[t], w); unpack4(lkk[t], kk); unpack4(lbb[t], bb); unpack4(lk[t], k); unpack4(lr[t], r);
            const f32x4 w4 = {1.f - w[0], 1.f - w[1], 1.f - w[2], 1.f - w[3]}, kk4 = {kk[0], kk[1], kk[2], kk[3]}, bb4 = {bb[0], bb[1], bb[2], bb[3]}, k4 = {k[0], k[1], k[2], k[3]}, r4 = {r[0], r[1], r[2], r[3]};
            float dm0 = 0.f; const float y0 = red16(wkv_step(S0, w4, kk4, bb4, k4, r4, bf2f((unsigned short)lv0[t]), dm0));
            float dm1 = 0.f; const float y1 = red16(wkv_step(S1, w4, kk4, bb4, k4, r4, bf2f((unsigned short)lv1[t]), dm1));
            yk0 = (j == t) ? y0 : yk0; yk1 = (j == t) ? y1 : yk1;
        }
        if (j < 8) { float* yg = ((float*)(F.ws + WS_Y)) + ro0 + (size_t)j * RW; yg[v0] = yk0; yg[v1] = yk1; }
        const size_t so0 = ((size_t)sbh * 64 + v0) * 64 + 4 * j;
        *(f32x4*)(F.out + O_WKVS + so0) = S0; *(f32x4*)(F.out + O_WKVS + so0 + 4 * 64) = S1;
    }
#undef SS_FETCH
}
typedef short bf16x4 __attribute__((ext_vector_type(4)));
#define PADV(x) asm volatile("s_nop 15\n\ts_nop 15" : "+v"(x))
#define MFMA16(a, b, c) __builtin_amdgcn_mfma_f32_16x16x16bf16_1k((a), (b), (c), 0, 0, 0)
#define MFMA32(a, b, c) __builtin_amdgcn_mfma_f32_16x16x32_bf16((a), (b), (c), 0, 0, 0)
typedef float f32x2_cv __attribute__((ext_vector_type(2))); typedef __bf16 bf16x2_cv __attribute__((ext_vector_type(2)));
__device__ __forceinline__ unsigned hpk2(float lo, float hi) { const f32x2_cv v = {lo, hi}; return __builtin_bit_cast(unsigned, __builtin_convertvector(v, bf16x2_cv)); }
__device__ __forceinline__ bf16x4 cvt4(const f32x4 v) { v2u w; w.x = hpk2(v.x, v.y); w.y = hpk2(v.z, v.w); return __builtin_bit_cast(bf16x4, w); }
__device__ __forceinline__ bf16x8 cvt8(const f32x4 a, const f32x4 b) { v4u w; w.x = hpk2(a.x, a.y); w.y = hpk2(a.z, a.w); w.z = hpk2(b.x, b.y); w.w = hpk2(b.z, b.w); return __builtin_bit_cast(bf16x8, w); }
__device__ __forceinline__ bf16x8 hpack8(const float* f) { v4u w; w.x = hpk2(f[0], f[1]); w.y = hpk2(f[2], f[3]); w.z = hpk2(f[4], f[5]); w.w = hpk2(f[6], f[7]); return __builtin_bit_cast(bf16x8, w); }
__device__ __forceinline__ v2u hpack4(const float* f) { v2u w; w.x = hpk2(f[0], f[1]); w.y = hpk2(f[2], f[3]); return w; }
#define DPP_SHR(x, n, fill) __builtin_bit_cast(float, __builtin_amdgcn_update_dpp(__builtin_bit_cast(int, (float)(fill)), __builtin_bit_cast(int, (x)), 0x110 + (n), 0xf, 0xf, false))
#ifndef CK_NH
#define CK_NH 4
#endif
#ifndef SIDE_MASK
#define SIDE_MASK 7
#endif
#ifndef CK_AHEAD
#define CK_AHEAD 7
#endif
#ifndef CK_DUMMY_CUT
#define CK_DUMMY_CUT 0
#endif
constexpr int CK_SLOT_B = 11264, CK_NSLOT = 8, CK_SCR_OFF = CK_SLOT_B * CK_NSLOT, CK_SCR_B = 4096, CK_FLAG_OFF = CK_SCR_OFF + CK_NH * CK_SCR_B, CK_SIDE_OFF = CK_FLAG_OFF + 256, CK_SIDE_B = 16896;
constexpr int CK_KH = 0, CK_RH = 2048, CK_AKK = 4096, CK_AKR = 4608, CK_ABR = 5120, CK_TM = 5632, CK_VM = 6144, CK_KB = 6656, CK_BB = 8704, CK_GC = 10752;
static_assert(CK_SIDE_OFF + (7 - CK_NH) * CK_SIDE_B <= LDSCTL_OFF, "chunked scan LDS map");
struct CkRaw { v2u w[4], kk[4], bb[4], kv[4], r[4]; unsigned vraw[4]; };
__device__ __forceinline__ void chunk_load(CkRaw& R, Frame& F, int h, int qtr, int t0) {
    const int l15 = F.lane & 15, q = F.lane >> 4, row = t0 + l15;
    const bf16* sc = (const bf16*)(F.ws + WS_SC);
#pragma unroll
    for (int p = 0; p < 4; ++p) { const size_t o = sc_off(row, 64 * h + 4 * (8 * (p >> 1) + 4 * (p & 1) + q));
        R.w[p] = *(const v2u*)(sc + 5 * (SC_STRIDE / 2) + o); R.kk[p] = *(const v2u*)(sc + 3 * (SC_STRIDE / 2) + o); R.bb[p] = *(const v2u*)(sc + 4 * (SC_STRIDE / 2) + o);
        R.kv[p] = *(const v2u*)(sc + 1 * (SC_STRIDE / 2) + o); R.r[p] = *(const v2u*)(sc + o); }
#pragma unroll
    for (int jj = 0; jj < 4; ++jj) R.vraw[jj] = sc[2 * (SC_STRIDE / 2) + sc_off(t0 + 4 * q + jj, 64 * h + 16 * qtr + l15)];
}
template <int CUT = 0> __device__ __forceinline__ void chunk_prepare(Frame& F, CkRaw& R, int h, int qtr, int tnext, LAS unsigned char* slot, LAS unsigned short* scr) {
    const int l15 = F.lane & 15, q = F.lane >> 4;
    float w[16], kk[16], bb[16], kv[16], r[16];
#pragma unroll
    for (int p = 0; p < 4; ++p) { unpack4(R.w[p], w + 4 * p); unpack4(R.kk[p], kk + 4 * p); unpack4(R.bb[p], bb + 4 * p); unpack4(R.kv[p], kv + 4 * p); unpack4(R.r[p], r + 4 * p); }
    unsigned short vraw[4];
#pragma unroll
    for (int jj = 0; jj < 4; ++jj) vraw[jj] = (unsigned short)R.vraw[jj];
    asm volatile("" ::: "memory");
    if (tnext >= 0) chunk_load(R, F, h, qtr, tnext);
    float kh[16], rh[16], kt[16], bt[16], Kb[16], Bb[16];
    {
        float g[16];
#pragma unroll
        for (int c = 0; c < 16; ++c) g[c] = 1.0f - w[c];
#pragma unroll
        for (int c = 0; c < 16; ++c) asm volatile("s_nop 1\n\tv_mul_f32_dpp %0, %0, %0 row_shr:1 row_mask:0xf bank_mask:0xf" : "+v"(g[c]));
#pragma unroll
        for (int c = 0; c < 16; ++c) asm volatile("v_mul_f32_dpp %0, %0, %0 row_shr:2 row_mask:0xf bank_mask:0xf" : "+v"(g[c]));
#pragma unroll
        for (int c = 0; c < 16; ++c) asm volatile("v_mul_f32_dpp %0, %0, %0 row_shr:4 row_mask:0xf bank_mask:0xf" : "+v"(g[c]));
#pragma unroll
        for (int c = 0; c < 16; ++c) asm volatile("v_mul_f32_dpp %0, %0, %0 row_shr:8 row_mask:0xf bank_mask:0xf" : "+v"(g[c]));
#pragma unroll
        for (int c = 0; c < 16; ++c) { float gC;
            asm volatile("v_mov_b32_dpp %0, %1 row_newbcast:15 row_mask:0xf bank_mask:0xf" : "=v"(gC) : "v"(g[c]));
            w[c] = gC; }
#pragma unroll
        for (int c = 0; c < 16; ++c) { float khc = kk[c];
            asm volatile("v_mul_f32_dpp %0, %1, %0 row_shr:1 row_mask:0xf bank_mask:0xf" : "+v"(khc) : "v"(g[c]));
            kh[c] = khc; }
#pragma unroll
        for (int c = 0; c < 16; ++c) { const float inv = __builtin_amdgcn_rcpf(g[c]);
            rh[c] = g[c] * r[c]; kt[c] = kv[c] * inv; bt[c] = bb[c] * inv; Kb[c] = kt[c] * w[c]; Bb[c] = -(bt[c] * w[c]); }
    }
    if (CUT == 1) { float s_ = 0.f;
#pragma unroll
        for (int c = 0; c < 16; ++c) s_ += kh[c] + rh[c] + kt[c] + bt[c] + Kb[c] + Bb[c] + w[c]; if (s_ == 1.2345f) *(LAS float*)slot = s_ + (float)vraw[0] + (float)vraw[3]; return; }
    const bf16x8 khf0 = hpack8(kh), khf1 = hpack8(kh + 8), rhf0 = hpack8(rh), rhf1 = hpack8(rh + 8);
    const bf16x8 ktf0 = hpack8(kt), ktf1 = hpack8(kt + 8), btf0 = hpack8(bt), btf1 = hpack8(bt + 8);
    const f32x4 z4 = {0.f, 0.f, 0.f, 0.f};
    f32x4 Akk = MFMA32(ktf1, khf1, MFMA32(ktf0, khf0, z4)), Abk = MFMA32(btf1, khf1, MFMA32(btf0, khf0, z4)), AbkT = MFMA32(khf1, btf1, MFMA32(khf0, btf0, z4));
    f32x4 Akr = MFMA32(ktf1, rhf1, MFMA32(ktf0, rhf0, z4)), Abr = MFMA32(btf1, rhf1, MFMA32(btf0, rhf0, z4));
    PADV(Akk); PADV(Abk); PADV(AbkT); PADV(Akr); PADV(Abr);
    f32x4 Id;
#pragma unroll
    for (int e = 0; e < 4; ++e) { const int rr = 4 * q + e;
        Akk[e] = rr < l15 ? Akk[e] : 0.f; Abk[e] = rr < l15 ? Abk[e] : 0.f; AbkT[e] = l15 < rr ? AbkT[e] : 0.f;
        Akr[e] = rr <= l15 ? Akr[e] : 0.f; Abr[e] = rr <= l15 ? -Abr[e] : 0.f; Id[e] = rr == l15 ? 1.f : 0.f; }
#define CK_MM(Xt, Y) MFMA16(cvt4(Xt), cvt4(Y), z4)
    f32x4 A2 = CK_MM(AbkT, Abk), A2t = CK_MM(Abk, AbkT); PADV(A2); PADV(A2t);
    f32x4 A4 = CK_MM(A2t, A2), A4t = CK_MM(A2, A2t); PADV(A4); PADV(A4t);
    f32x4 A8 = CK_MM(A4t, A4); PADV(A8);
    f32x4 P = Id + A8; P = CK_MM(Id + A4t, P); PADV(P); P = CK_MM(Id + A2t, P); PADV(P); P = CK_MM(Id - AbkT, P); PADV(P);
#undef CK_MM
    if (CUT == 2) { const f32x4 s_ = P + Akk + Akr + Abr; if (s_[0] + s_[1] + s_[2] + s_[3] == 1.2345f) *(LAS float*)slot = s_[0] + Kb[0] + Bb[0] + w[0] + (float)vraw[0]; return; }
    LAS bf16x8* s8 = (LAS bf16x8*)slot; s8[F.lane] = khf0; s8[64 + F.lane] = khf1; s8[128 + F.lane] = rhf0; s8[192 + F.lane] = rhf1;
    LAS bf16x4* s4 = (LAS bf16x4*)slot;
    s4[CK_AKK / 8 + F.lane] = cvt4(Akk); s4[CK_AKR / 8 + F.lane] = cvt4(Akr); s4[CK_ABR / 8 + F.lane] = cvt4(Abr); s4[CK_TM / 8 + F.lane] = cvt4(P);
    { bf16x4 vm; vm[0] = (short)vraw[0]; vm[1] = (short)vraw[1]; vm[2] = (short)vraw[2]; vm[3] = (short)vraw[3]; s4[CK_VM / 8 + F.lane] = vm; }
    if (CUT == 3) { if (Kb[0] + Bb[0] + w[0] == 1.2345f) *(LAS float*)slot = Kb[1]; LDS_WAIT(); return; }
    { bf16x4 idb;
#pragma unroll
      for (int e = 0; e < 4; ++e) idb[e] = (4 * q + e == l15) ? (short)0x3F80 : (short)0;
      f32x4 tk[4], tb[4];
#pragma unroll
      for (int nt = 0; nt < 4; ++nt) { tk[nt] = MFMA16(__builtin_bit_cast(bf16x4, hpack4(Kb + 4 * nt)), idb, z4); tb[nt] = MFMA16(__builtin_bit_cast(bf16x4, hpack4(Bb + 4 * nt)), idb, z4); }
      asm volatile("s_nop 15\n\ts_nop 15" : "+v"(tk[0]), "+v"(tk[1]), "+v"(tk[2]), "+v"(tk[3]), "+v"(tb[0]), "+v"(tb[1]), "+v"(tb[2]), "+v"(tb[3]));
#pragma unroll
      for (int nt = 0; nt < 4; ++nt) { s4[CK_KB / 8 + nt * 64 + F.lane] = cvt4(tk[nt]); s4[CK_BB / 8 + nt * 64 + F.lane] = cvt4(tb[nt]); } }
    if (l15 == 15) {
#pragma unroll
        for (int p = 0; p < 4; ++p) *(LAS f32x4*)(slot + CK_GC + 4 * (32 * (p >> 1) + 16 * (p & 1) + 4 * q)) = (f32x4){w[4 * p], w[4 * p + 1], w[4 * p + 2], w[4 * p + 3]}; }
    LDS_WAIT(); asm volatile("" ::: "memory");
}
#ifdef CK_DUMMY_MODE
__device__ __forceinline__ void dummy_work(Frame& F, int h, int t0, LAS unsigned char* area) {
    const f32x4 z4 = {0.f, 0.f, 0.f, 0.f}; f32x4 acc = z4; float sink = 0.f;
#if CK_DUMMY_MODE == 1
    bf16x8 a; for (int j = 0; j < 8; ++j) a[j] = (short)(0x3f80 + F.lane + j);
    for (int i = 0; i < 64; ++i) { acc = MFMA32(a, a, acc); asm volatile("" : "+v"(acc)); }
    sink = acc[0];
#elif CK_DUMMY_MODE == 2
    LAS f32x4* p = (LAS f32x4*)area + F.lane;
#pragma unroll 1
    for (int i = 0; i < 40; ++i) { LAS f32x4* pw = p + 64 * (i & 7); *pw = (f32x4){(float)i, 1.f, 2.f, 3.f}; asm volatile("s_waitcnt lgkmcnt(0)" ::: "memory"); const LAS f32x4* pr = p + 64 * ((i + 3) & 7); acc += *pr; }
    sink = acc[0];
#elif CK_DUMMY_MODE == 3
    const bf16* sc = (const bf16*)(F.ws + WS_SC);
    for (int i = 0; i < 24; ++i) { float t[4]; unpack4(*(const v2u*)(sc + (size_t)(i % 6) * (SC_STRIDE / 2) + sc_off(t0 + (F.lane & 15), 64 * h + 4 * ((F.lane >> 4) + 4 * (i & 3)))), t); sink += t[0] + t[3]; }
#elif CK_DUMMY_MODE == 4
    float g = 1.0f + 0.001f * F.lane;
    for (int i = 0; i < 200; ++i) { g *= DPP_SHR(g, 1, 1.0f); g = g * 0.999f + DPP_ROR(g, 4) * 0.001f; asm volatile("" : "+v"(g)); }
    sink = g;
#endif
    if (sink == 123456.789f) ((LAS float*)area)[F.lane] = sink;
}
#endif
struct CkOps { bf16x8 kh0, kh1, rh0, rh1; bf16x4 akk, akr, nabr, tm, vm; f32x4 g[4]; bf16x4 kb[4], nbb[4]; };
template <class T> __device__ __forceinline__ void ck_load_slot(CkOps& X, const LAS unsigned char* slot, int lane, int q) {
    const LAS bf16x8* s8 = (const LAS bf16x8*)slot; const LAS bf16x4* s4 = (const LAS bf16x4*)slot;
    X.kh0 = s8[lane]; X.kh1 = s8[64 + lane]; X.akk = s4[CK_AKK / 8 + lane]; X.vm = s4[CK_VM / 8 + lane]; X.tm = s4[CK_TM / 8 + lane];
#pragma unroll
    for (int nt = 0; nt < 4; ++nt) { X.g[nt] = *(const LAS f32x4*)(slot + CK_GC + 4 * (16 * nt + 4 * q)); X.kb[nt] = s4[CK_KB / 8 + nt * 64 + lane]; X.nbb[nt] = s4[CK_BB / 8 + nt * 64 + lane]; }
    X.rh0 = s8[128 + lane]; X.rh1 = s8[192 + lane]; X.akr = s4[CK_AKR / 8 + lane]; X.nabr = s4[CK_ABR / 8 + lane];
}
__device__ __forceinline__ void chain_step(Frame& F, f32x4 (&S)[4], const CkOps& X, CkOps& N, int c, LAS unsigned char* base, volatile LAS int* flg, float* yg, int q) {
    const f32x4 z4 = {0.f, 0.f, 0.f, 0.f};
    int fnext = 0;
    if (c + 1 < 128) fnext = __hip_atomic_load((LAS int*)&flg[(c + 1) & 7], __ATOMIC_RELAXED, __HIP_MEMORY_SCOPE_WORKGROUP);
#ifdef CK_DELAY
    __builtin_amdgcn_s_sleep(CK_DELAY);
#endif
    const bf16x8 sb0 = cvt8(S[0], S[1]), sb1 = cvt8(S[2], S[3]);
    f32x4 GT = MFMA32(X.kh1, sb1, MFMA32(X.kh0, sb0, z4)); f32x4 G16 = MFMA16(X.akk, X.vm, z4);
    asm volatile("s_nop 15\n\ts_nop 15" : "+v"(GT), "+v"(G16));
    GT += G16;
    f32x4 DT = MFMA16(X.tm, cvt4(GT), z4);
    asm volatile("s_nop 15\n\ts_nop 15" : "+v"(DT));
    const bf16x4 db = cvt4(DT);
#pragma unroll
    for (int nt = 0; nt < 4; ++nt) S[nt] = MFMA16(X.nbb[nt], db, MFMA16(X.kb[nt], X.vm, S[nt] * X.g[nt]));
    f32x4 YT = MFMA32(X.rh1, sb1, MFMA32(X.rh0, sb0, z4)); f32x4 Y16 = MFMA16(X.nabr, db, MFMA16(X.akr, X.vm, z4));
    asm volatile("s_waitcnt lgkmcnt(0)" ::: "memory");
    __builtin_amdgcn_fence(__ATOMIC_RELEASE, "workgroup");
    if (F.lane == 0) __hip_atomic_store((LAS int*)&flg[16], c + 1, __ATOMIC_RELEASE, __HIP_MEMORY_SCOPE_WORKGROUP);
    if (c + 1 < 128) {
        if (fnext != c + 2) while (__hip_atomic_load((LAS int*)&flg[(c + 1) & 7], __ATOMIC_ACQUIRE, __HIP_MEMORY_SCOPE_WORKGROUP) != c + 2) __builtin_amdgcn_s_sleep(1);
        __builtin_amdgcn_fence(__ATOMIC_ACQUIRE, "workgroup");
        ck_load_slot<int>(N, base + ((c + 1) & 7) * CK_SLOT_B, F.lane, q);
    }
    asm volatile("s_nop 15\n\ts_nop 15" : "+v"(S[0]), "+v"(S[1]), "+v"(S[2]), "+v"(S[3]), "+v"(YT), "+v"(Y16));
    YT += Y16;
#pragma unroll
    for (int e = 0; e < 4; ++e) yg[(size_t)(16 * c + 4 * q + e) * RW] = YT[e];
}
__device__ __forceinline__ void scan_prompt_unit(Frame& F, const InAcc& A, int unit, int side, bool scan = true) {
    const int xcd = unit & 7, jj_ = unit >> 3, bh = xcd + 8 * (jj_ >> 2), qtr = jj_ & 3, b = bh >> 3, h = bh & 7;
    const int rowbase = b * 2048;
    LAS unsigned char* const base = F.lds + RING_OFF;
    volatile LAS int* flg = (volatile LAS int*)(base + CK_FLAG_OFF);
    if (F.tid < 32) flg[F.tid] = 0;
    __syncthreads();
    const int l15 = F.lane & 15, q = F.lane >> 4;
    if (F.wave == 0) { if (scan) {
        f32x4 S[4] = {{0.f, 0.f, 0.f, 0.f}, {0.f, 0.f, 0.f, 0.f}, {0.f, 0.f, 0.f, 0.f}, {0.f, 0.f, 0.f, 0.f}};
        float* yg = (float*)(F.ws + WS_Y) + (size_t)rowbase * RW + h * 64 + 16 * qtr + l15;
        CkOps X, Y;
#ifndef CK_NOPRIO
        __builtin_amdgcn_s_setprio(3);
#endif
        while (__hip_atomic_load((LAS int*)&flg[0], __ATOMIC_ACQUIRE, __HIP_MEMORY_SCOPE_WORKGROUP) != 1) __builtin_amdgcn_s_sleep(1);
        __builtin_amdgcn_fence(__ATOMIC_ACQUIRE, "workgroup");
        ck_load_slot<int>(X, base, F.lane, q);
        for (int c = 0; c < 128; c += 2) {
            chain_step(F, S, X, Y, c, base, flg, yg, q);
            chain_step(F, S, Y, X, c + 1, base, flg, yg, q);
        }
#ifndef CK_NOPRIO
        __builtin_amdgcn_s_setprio(0);
#endif
#pragma unroll
        for (int nt = 0; nt < 4; ++nt) *(f32x4*)(F.out + O_WKVP + ((size_t)bh * 64 + 16 * qtr + l15) * 64 + 16 * nt + 4 * q) = S[nt];
    } } else {
        if (F.wave > CK_NH && side) {
            constexpr int NS = 7 - CK_NH; const int sw = (int)blockIdx.x * NS + (F.wave - CK_NH - 1), NSW = F.G * NS;
            LAS unsigned short* tile = (LAS unsigned short*)(base + CK_SIDE_OFF + (F.wave - CK_NH - 1) * CK_SIDE_B);
            if (side & 1) for (int it = sw; it < 1024; it += NSW) gmlp_item<false>(F, A, it >> 3, it & 7, tile);
            if (side & 2) for (int it = NSW - 1 - sw; it < 1024; it += NSW) gmlp_item<true>(F, A, it >> 3, it & 7, tile);
            if (side & 4) for (int it = NSW - 1 - sw; it < (MS / 16) * 8; it += NSW) { const int tl = it >> 3, hh = it & 7;
                prep_item<true>(F, A, MP + 16 * tl, hh);
                __builtin_amdgcn_fence(__ATOMIC_RELEASE, "agent"); __builtin_amdgcn_fence(__ATOMIC_ACQUIRE, "agent");
                scan_sample_seq(F, A, (2 * tl) * 8 + hh); scan_sample_seq(F, A, (2 * tl + 1) * 8 + hh); }
        }
        if (scan) {
            LAS unsigned short* scr = nullptr;
            CkRaw R;
#define CK_CLAIM() __builtin_amdgcn_readfirstlane(F.lane == 0 ? __hip_atomic_fetch_add((LAS int*)&flg[17], 1, __ATOMIC_RELAXED, __HIP_MEMORY_SCOPE_WORKGROUP) : 0)
            int c = CK_CLAIM();
            if (c < 128) chunk_load(R, F, h, qtr, rowbase + 16 * c);
            while (c < 128) {
                const int cn = CK_CLAIM();
                while (__hip_atomic_load((LAS int*)&flg[16], __ATOMIC_ACQUIRE, __HIP_MEMORY_SCOPE_WORKGROUP) < c - CK_AHEAD) __builtin_amdgcn_s_sleep(2);
                __builtin_amdgcn_fence(__ATOMIC_ACQUIRE, "workgroup");
                chunk_prepare(F, R, h, qtr, cn < 128 ? rowbase + 16 * cn : -1, base + (c & 7) * CK_SLOT_B, scr);
#ifdef CK_HDELAY
                __builtin_amdgcn_s_sleep(CK_HDELAY);
#endif
                __builtin_amdgcn_fence(__ATOMIC_RELEASE, "workgroup");
                if (F.lane == 0) __hip_atomic_store((LAS int*)&flg[c & 7], c + 1, __ATOMIC_RELEASE, __HIP_MEMORY_SCOPE_WORKGROUP);
                c = cn;
            }
#undef CK_CLAIM
        }
    }
    __syncthreads();
}
__device__ __forceinline__ void postscan_item(Frame& F, const InAcc& A, int r0, int h) {
    const int l15 = F.lane & 15, q = F.lane >> 4, row = r0 + l15;
    const float* Y = (const float*)(F.ws + WS_Y); const bf16* V = (const bf16*)(F.ws + WS_SC + 2 * SC_STRIDE); const bf16* G = (const bf16*)(F.ws + WS_G);
    const float* gn_w = A.in[20]; const float* gn_b = A.in[21];
    float y[4][4]; float s = 0.f;
#pragma unroll
    for (int ntl = 0; ntl < 4; ++ntl) { const f32x4 t = *(const f32x4*)(Y + (size_t)row * RW + 64 * h + 16 * ntl + 4 * q); y[ntl][0] = t.x; y[ntl][1] = t.y; y[ntl][2] = t.z; y[ntl][3] = t.w; s += (t.x + t.y) + (t.z + t.w); }
    s += __shfl_xor(s, 16); s += __shfl_xor(s, 32);
    const float mu = s * (1.0f / 64.0f); float qq = 0.f;
#pragma unroll
    for (int ntl = 0; ntl < 4; ++ntl)
#pragma unroll
        for (int e = 0; e < 4; ++e) { y[ntl][e] -= mu; qq += y[ntl][e] * y[ntl][e]; }
    qq += __shfl_xor(qq, 16); qq += __shfl_xor(qq, 32);
    const float rstd = 1.0f / sqrtf(qq * (1.0f / 64.0f) + GN_EPS);
    const float bon = ((const float*)(F.ws + WS_BON))[(size_t)row * 8 + h];
#pragma unroll
    for (int ntl = 0; ntl < 4; ++ntl) { const int c0 = 64 * h + 16 * ntl + 4 * q; const size_t o = sc_off(row, c0);
        const f32x4 gw = *(const f32x4*)(gn_w + c0), gb = *(const f32x4*)(gn_b + c0);
        float vv[4], gg[4], ov[4]; unpack4(*(const v2u*)(V + o), vv); unpack4(*(const v2u*)(G + o), gg);
#pragma unroll
        for (int e = 0; e < 4; ++e) ov[e] = (y[ntl][e] * rstd * gw[e] + gb[e] + bon * vv[e]) * gg[e];
#ifdef DBG_ZERO_YR
        if (row >= DBG_ZERO_YR) { ov[0] = ov[1] = ov[2] = ov[3] = 0.f; }
#endif
        *(v2u*)(((bf16*)(F.ws + WS_XN)) + (size_t)row * D + c0) = pack4(ov); }
}
__device__ __forceinline__ void postscan_rows(Frame& F, const InAcc& A) { for (int it = F.gw; it < (M / 16) * 8; it += F.NGW) postscan_item(F, A, 16 * (it >> 3), it & 7); }
__global__ void __launch_bounds__(NWAVES * 64, 2) fwd_kernel(Args args) {
    extern __shared__ __attribute__((aligned(16))) unsigned char lds[];
    Frame F;
    F.lds = (LAS unsigned char*)lds;
    F.MISC = (volatile LAS unsigned*)(F.lds + MISC_OFF);
    F.tid = threadIdx.x; F.lane = F.tid & 63; F.wave = __builtin_amdgcn_readfirstlane(F.tid >> 6);
    F.G = gridDim.x; F.gw = blockIdx.x * NWAVES + F.wave; F.NGW = F.G * NWAVES;
    unsigned char* ws = args.ws;
    F.ctl = (gu32*)(ws + WS_CTL);
    F.out = args.out; F.ws = ws;
    for (int u = F.tid; u < (LDS_BYTES - LDSCTL_OFF) / 4; u += NWAVES * 64) ((LAS unsigned*)(F.lds + LDSCTL_OFF))[u] = 0u;
    __syncthreads();
    if (F.tid == 0) { LAS unsigned long long* pt = (LAS unsigned long long*)(F.lds + PTRS_OFF);
#pragma unroll
        for (int i = 0; i < 30; ++i) pt[i] = (unsigned long long)args.in[i]; }
    __syncthreads();
#if USE_PTR_TABLE
    InAcc A; A.in.t = (LAS unsigned*)(F.lds + PTRS_OFF);
#else
    InAcc A;
#pragma unroll
    for (int i = 0; i < 30; ++i) A.in[i] = args.in[i];
#endif
    XcdBarrier bar; bar.bar = (unsigned*)(F.ctl + CW_BAR); bar.x = 0; bar.st = nullptr;
    if (MK_N_LAUNCHES == 1) bar = xcd_barrier_post((unsigned*)(F.ctl + CW_BAR), F.MISC + 8);
    const int lo = args.ph_lo, hi = args.ph_hi;
#ifndef PH_MASK
#define PH_MASK 0x7fff
#endif
#define IN(k) (((PH_MASK >> (k)) & 1) && lo <= (k) && (k) < hi)
#ifndef DUP_ID
#define DUP_ID -1
#endif
#ifndef SIDE2_MASK
#define SIDE2_MASK 7
#endif
#define DUPN(id) ((DUP_ID == (id)) ? 2 : 1)
#define DUPBAR(r) do { if (r) xcd_barrier(bar); } while (0)
#define SEAM(k) do { if (IN(k) && IN((k) + 1)) xcd_barrier(bar); } while (0)
    float* const H = F.out;

    if (IN(0)) for (int rep_ = 0; rep_ < DUPN(0); ++rep_) { DUPBAR(rep_); p1_mod(F, A); p0_prologue(F, A); }
    SEAM(1);
    if (IN(2)) for (int rep_ = 0; rep_ < DUPN(2); ++rep_) { DUPBAR(rep_); norm_rows_bf16<true>(F, A, A.in[0], A.in[1], false, 0, 1024, 0, 0, 0.f); } SEAM(2);
    if (IN(3)) for (int rep_ = 0; rep_ < DUPN(3); ++rep_) { DUPBAR(rep_); pg8::Gemm g{((bf16*)(F.ws + WS_XN)), ((bf16*)(F.ws + WS_GU1)), M, 2 * FF, D, D}; pg8::StaticOrder S; S.init(M, 2 * FF, D, F.G, (int)blockIdx.x); pg8::EpiSwiglu E{((bf16*)(F.ws + WS_ACT))};
        pg8::gemm_phase<pg8::EpiSwiglu, pg8::StaticOrder, PG8_ALIGN, PG8_SP2>(F.lds + RING_OFF, g, S, E); } SEAM(3);
    if (IN(4)) for (int rep_ = 0; rep_ < DUPN(4); ++rep_) { DUPBAR(rep_); pg8::Gemm g{((bf16*)(F.ws + WS_ACT)), ((bf16*)(F.ws + WS_DN1)), M, D, FF, FF}; pg8::SplitOrder S; S.init(MP, D, FF, 11, F.G, (int)blockIdx.x); pg8::EpiResid<true> E{A.in[0], A.in[1], (bf16*)F.out, ((float*)(F.ws + WS_MOD)) + 2048, 0.5f, (float*)(F.ws + WS_SC)};
        pg8::gemm_phase<pg8::EpiResid<true>, pg8::SplitOrder, PG8_ALIGN, PG8_SP2>(F.lds + RING_OFF, g, S, E); } SEAM(4);
    if (IN(5)) for (int rep_ = 0; rep_ < DUPN(5); ++rep_) { DUPBAR(rep_); norm_rows_bf16<false>(F, A, nullptr, A.in[1], true, 3072, 4096, 11, 2048, 0.5f); } SEAM(5);
    if (IN(6)) for (int rep_ = 0; rep_ < DUPN(6); ++rep_) { DUPBAR(rep_); pg8::Gemm g{((bf16*)(F.ws + WS_XN)), ((bf16*)(F.ws + WS_WIN)), M, PC, D, D}; pg8::StaticOrder S; S.init(M, PC, D, F.G, (int)blockIdx.x); pg8::EpiP E{((bf16*)(F.ws + WS_ACT)), ((bf16*)(F.ws + WS_PUV)), F.out + O_SHP, F.out + O_SHS};
        pg8::gemm_phase<pg8::EpiP, pg8::StaticOrder, PG8_ALIGN, PG8_SP2>(F.lds + RING_OFF, g, S, E); } SEAM(6);
    if (IN(7)) { for (int rep_ = 0; rep_ < DUPN(71); ++rep_) { DUPBAR(rep_); for (int it = F.gw; it < 2 * (M / 16); it += F.NGW) { if (it & 1) frag_item(F, A, 16 * (it >> 1), 1); else frag_item(F, A, 16 * (it >> 1), 0); } } for (int rep_ = 0; rep_ < DUPN(72); ++rep_) lnv_rows(F, A); xcd_barrier(bar);
        for (int rep_ = 0; rep_ < DUPN(70); ++rep_) { DUPBAR(rep_); prep_all(F, A); } } SEAM(7);
    if (IN(8)) {
        for (int rep_ = 0; rep_ < ((DUP_ID == 83 || DUP_ID == 84) ? 2 : DUPN(80)); ++rep_) for (int u = blockIdx.x; u < 256; u += F.G) scan_prompt_unit(F, A, u, u != (int)blockIdx.x ? 0 : rep_ == 0 ? 7 : (DUP_ID == 83 || DUP_ID == 84) ? SIDE2_MASK : 0, DUP_ID != 83 || rep_ == 0);
    } SEAM(8);
    if (IN(9)) for (int rep_ = 0; rep_ < DUPN(9); ++rep_) { DUPBAR(rep_); postscan_rows(F, A); } SEAM(9);
    if (IN(10)) { pg8::Gemm g{((bf16*)(F.ws + WS_XN)), ((bf16*)(F.ws + WS_WOUT)), M, D, D, D}; pg8::SplitOrder S; S.init(MP, D, D, 4, F.G, (int)blockIdx.x); pg8::EpiResid<false> E{nullptr, nullptr, (bf16*)F.out, ((float*)(F.ws + WS_MOD)) + 5120, 1.0f, (float*)(F.ws + WS_SC)};
        pg8::gemm_phase<pg8::EpiResid<false>, pg8::SplitOrder, PG8_ALIGN, PG8_SP2>(F.lds + RING_OFF, g, S, E); } SEAM(10);
    if (IN(11)) for (int rep_ = 0; rep_ < DUPN(11); ++rep_) { DUPBAR(rep_); norm_rows_bf16<false>(F, A, nullptr, nullptr, false, 6144, 7168, 4, 5120, 1.0f); } SEAM(11);
    if (IN(12)) { pg8::Gemm g{((bf16*)(F.ws + WS_XN)), ((bf16*)(F.ws + WS_GU2)), M, 2 * FF, D, D}; pg8::StaticOrder S; S.init(M, 2 * FF, D, F.G, (int)blockIdx.x); pg8::EpiSwiglu E{((bf16*)(F.ws + WS_ACT))};
        pg8::gemm_phase<pg8::EpiSwiglu, pg8::StaticOrder, PG8_ALIGN, PG8_SP2>(F.lds + RING_OFF, g, S, E); } SEAM(12);
    if (IN(13)) { pg8::Gemm g{((bf16*)(F.ws + WS_ACT)), ((bf16*)(F.ws + WS_DN2)), M, D, FF, FF}; pg8::SplitOrder S; S.init(MP, D, FF, 11, F.G, (int)blockIdx.x); pg8::EpiResid<false> E{nullptr, nullptr, (bf16*)F.out, ((float*)(F.ws + WS_MOD)) + 8192, 0.5f, (float*)(F.ws + WS_SC)};
        pg8::gemm_phase<pg8::EpiResid<false>, pg8::SplitOrder, PG8_ALIGN, PG8_SP2>(F.lds + RING_OFF, g, S, E); } SEAM(13);
    if (IN(14)) { final_norm_rows(F, A, 11, 8192, 0.5f); }
#undef IN
#undef SEAM
}

extern "C" void kernel_launch(void* const* d_in, const int* in_sizes, int n_in, void* d_out, int out_size, void* d_ws, size_t ws_size, hipStream_t stream) {
    static int grid = 0;
    if (grid == 0) {
        if (n_in != 30 || in_sizes[0] != MP * D || (size_t)out_size != O_END || ws_size < WS_END) { fprintf(stderr, "kernel_launch: unexpected problem shape / workspace (%d inputs, out %d, ws %zu); nothing launched\n", n_in, out_size, ws_size); grid = -1; return; }
        int dev = 0, cus = 0, per_cu = 0;
        if (hipGetDevice(&dev) != hipSuccess || hipDeviceGetAttribute(&cus, hipDeviceAttributeMultiprocessorCount, dev) != hipSuccess) { grid = -1; return; }
        if (hipFuncSetAttribute((const void*)fwd_kernel, hipFuncAttributeMaxDynamicSharedMemorySize, LDS_BYTES) != hipSuccess) { fprintf(stderr, "kernel_launch: hipFuncSetAttribute failed\n"); grid = -1; return; }
        if (hipOccupancyMaxActiveBlocksPerMultiprocessor(&per_cu, (const void*)fwd_kernel, NWAVES * 64, LDS_BYTES) != hipSuccess || per_cu < 1) { fprintf(stderr, "kernel_launch: occupancy query says %d blocks per CU\n", per_cu); }
        (void)hipGetLastError();
        grid = cus;
    }
    if (grid < 0) return;
    (void)hipMemsetAsync((char*)d_ws + WS_CTL, 0, CTL_ZERO_BYTES, stream);
    Args a{};
    for (int i = 0; i < 30; ++i) a.in[i] = (const float*)d_in[i];
    a.out = (float*)d_out; a.ws = (unsigned char*)d_ws;
    if (MK_N_LAUNCHES == 1) { a.ph_lo = 0; a.ph_hi = N_PHASES; hipLaunchKernelGGL(fwd_kernel, dim3(grid), dim3(NWAVES * 64), LDS_BYTES, stream, a); }
    else for (int p = 0; p < N_PHASES; ++p) { a.ph_lo = p; a.ph_hi = p + 1; hipLaunchKernelGGL(fwd_kernel, dim3(grid), dim3(NWAVES * 64), LDS_BYTES, stream, a); }
}
```

```cpp
#include <hip/hip_runtime.h>
#include <cstdio>
#include <cstdint>
namespace pg8 {
#define PG8_LAS __attribute__((address_space(3)))
typedef unsigned short bf16_t;
typedef short bf16x8 __attribute__((ext_vector_type(8)));
typedef float f32x4 __attribute__((ext_vector_type(4)));
typedef unsigned u32x4 __attribute__((ext_vector_type(4)));
constexpr int BM = 256, BK = 64, HALF = 128, HTB = HALF * BK * 2  , STAGE_BYTES = 8 * HTB, NXCD = 8, WGM = 8;

__host__ __device__ __forceinline__ int lds_byte(int r, int c) { const int st = (r >> 4) * 2 + (c >> 5), rr = r & 15, cc = c & 31, ob = rr * 64 + cc * 2; return st * 1024 + (ob ^ (((ob >> 9) & 1) << 5)); }
__host__ __device__ __forceinline__ void stage_rc(int b, int& R, int& C) { const int st = b / 1024, sb = b % 1024, swz = sb ^ (((sb >> 9) & 1) << 5); R = (st >> 1) * 16 + swz / 64; C = (st & 1) * 32 + (swz % 64) / 2; }
__host__ __device__ __forceinline__ int perm32(int rho) { const int n = rho >> 4, i = rho & 15; return 8 * (i >> 2) + 4 * n + (i & 3); }

struct Unit { int pm, pn, kb, nt, ks; };
struct Gemm { const bf16_t* A; const bf16_t* Bt; int M, N, K, ld; };

struct StaticOrder {
    int nM, nN, nwg, G, c, knt;
    __host__ __device__ void init(int M, int N, int K, int G_, int c_) { nM = M / BM; nN = N / BM; nwg = nM * nN; G = G_; c = c_; knt = K / BK; }
    __host__ __device__ __forceinline__ bool next(int i, Unit& u) const {
        const long L = (long)i * G + c; if (L >= nwg) return false;
        int wgid = (int)L; { const int q = nwg / NXCD, r = nwg % NXCD, xcd = wgid % NXCD, off = wgid / NXCD; wgid = (xcd < r ? xcd * (q + 1) : r * (q + 1) + (xcd - r) * q) + off; }
        const int nig = WGM * nN, gid = wgid / nig, fm = gid * WGM, gsz = (nM - fm) < WGM ? (nM - fm) : WGM;
        u.pm = fm + ((wgid % nig) % gsz); u.pn = (wgid % nig) / gsz; u.kb = 0; u.nt = knt; u.ks = -1; return true;
    }
    __device__ __forceinline__ void a_ready(const Unit&) const {}
    __device__ __forceinline__ void done(const Unit&) const {}
};
struct SplitOrder {
    StaticOrder so; int ns, c, G;
    __host__ __device__ void init(int Mmain, int N, int K, int ns_, int G_, int c_) { so.init(Mmain, N, K, G_, c_); ns = ns_; c = c_; G = G_; }
    __host__ __device__ __forceinline__ bool next(int i, Unit& u) const {
        const int nsub = 16 * ns, P = nsub >> 2; const bool grp = (G == 256);
        const int mine = grp ? (((c & 63) < P) ? 1 : 0) : (c < nsub ? (nsub - 1 - c) / G + 1 : 0);
        const bool sub = i < mine; const int s = grp ? (c >> 6) * P + (c & 63) : c + i * G;
        Unit m; m.pm = 0; m.pn = 0; m.kb = 0; m.nt = so.knt; m.ks = -1;
        const bool okm = so.next(sub ? 0 : i - mine, m);
        u.pm = sub ? so.nM + s / (4 * ns) : m.pm; u.pn = sub ? ((s / ns) & 3) : m.pn; u.ks = sub ? s % ns : -1; u.kb = sub ? (s % ns) * 4 * BK * 2 : 0; u.nt = sub ? 4 : so.knt;
        return sub || okm;
    }
    __device__ __forceinline__ void a_ready(const Unit&) const {}
    __device__ __forceinline__ void done(const Unit&) const {}
};
__device__ __forceinline__ unsigned cvt_pk_bf16(float lo, float hi) { unsigned r; asm volatile("v_cvt_pk_bf16_f32 %0, %1, %2" : "=v"(r) : "v"(lo), "v"(hi)); return r; }
typedef float f32x2 __attribute__((ext_vector_type(2)));
constexpr int ROWS_P = 16384, ROWS_ALL = 17408, DM = 1024, MODW = 9216, FFW = 2816, RCOLS = 1792;
__device__ __forceinline__ int seq_of_row(int r) { return r < ROWS_P ? (r >> 11) : 8 + ((r - ROWS_P) >> 3); }
__device__ __forceinline__ bool row_is_first(int r) { return r < ROWS_P ? ((r & 2047) == 0) : (((r - ROWS_P) & 7) == 0); }
__device__ __forceinline__ bool row_is_last(int r) { return r < ROWS_P ? ((r & 2047) == 2047) : (((r - ROWS_P) & 7) == 7); }
__device__ __forceinline__ float silu_f(float x) { return x * __builtin_amdgcn_rcpf(1.0f + __builtin_amdgcn_exp2f(-1.4426950408889634f * x)); }

struct EpiSwiglu {
    static constexpr bool PERM = true, AFTER_DRAIN = false;
    bf16_t* O;
    __device__ __forceinline__ void operator()(const f32x4 (&acc)[2][2][4][2], const Unit& u, int wr, int wc, int fr, int fq) const {
        const int row0 = u.pm * BM + wr * 64 + fr, col0 = u.pn * HALF + wc * 32 + 8 * fq;
#pragma unroll
        for (int ai = 0; ai < 2; ++ai)
#pragma unroll
            for (int m = 0; m < 4; ++m) {
                bf16_t* rowp = O + (size_t)(row0 + ai * HALF + m * 16) * FFW + col0;
                const f32x4 g0 = acc[ai][0][m][0], g1 = acc[ai][0][m][1], u0 = acc[ai][1][m][0], u1 = acc[ai][1][m][1];
                u32x4 w;
                w.x = cvt_pk_bf16(silu_f(g0[0]) * u0[0], silu_f(g0[1]) * u0[1]); w.y = cvt_pk_bf16(silu_f(g0[2]) * u0[2], silu_f(g0[3]) * u0[3]);
                w.z = cvt_pk_bf16(silu_f(g1[0]) * u1[0], silu_f(g1[1]) * u1[1]); w.w = cvt_pk_bf16(silu_f(g1[2]) * u1[2], silu_f(g1[3]) * u1[3]);
                *(u32x4*)rowp = w;
            }
    }
};
constexpr int HLD = 2048, HOFF = 1024;
template <bool RESF32> struct EpiResid {
    static constexpr bool PERM = true, AFTER_DRAIN = false;
    static constexpr int CS = PERM ? 8 : 4, NO = PERM ? 4 : 16;
    const float* resP; const float* resS; bf16_t* hb; const float* gate; float coef; float* slab;
    __device__ __forceinline__ void operator()(const f32x4 (&acc)[2][2][4][2], const Unit& u, int wr, int wc, int fr, int fq) const {
        typedef unsigned u32x2 __attribute__((ext_vector_type(2)));
        const int col0 = u.pn * BM + wc * 32 + CS * fq;
        if (u.ks >= 0) {
#pragma unroll
            for (int ai = 0; ai < 2; ++ai)
#pragma unroll
                for (int m = 0; m < 4; ++m) { bf16_t* srow = (bf16_t*)slab + ((size_t)u.ks * 1024 + (size_t)(u.pm * BM + ai * HALF + wr * 64 + m * 16 + fr - ROWS_P)) * DM + col0;
#pragma unroll
                    for (int bj = 0; bj < 2; ++bj) { const f32x4 a = acc[ai][bj][m][0], a2 = acc[ai][bj][m][1];
                        *(u32x4*)(srow + bj * HALF) = (u32x4){cvt_pk_bf16(a[0], a[1]), cvt_pk_bf16(a[2], a[3]), cvt_pk_bf16(a2[0], a2[1]), cvt_pk_bf16(a2[2], a2[3])}; } }
            return; }
        const bool uni = u.pm * BM + BM <= ROWS_P;
        f32x4 gu_[2][2];
        if (uni) { const float* grow = gate + (size_t)seq_of_row(u.pm * BM) * MODW + col0;
#pragma unroll
            for (int bj = 0; bj < 2; ++bj)
#pragma unroll
                for (int n = 0; n < 2; ++n) gu_[bj][n] = *(const f32x4*)(grow + bj * HALF + n * NO) * coef; }
        f32x4 rf[2][2][2]; u32x2 rh[2][2][2];
#define EPR_LOAD(buf, step) do { const int row_ = u.pm * BM + ((step) >> 2) * HALF + wr * 64 + ((step) & 3) * 16 + fr; \
            const float* rrow_ = (row_ < ROWS_P ? resP + (size_t)row_ * DM : resS + (size_t)(row_ - ROWS_P) * DM) + col0; const bf16_t* hrow_ = hb + (size_t)row_ * HLD + HOFF + col0; \
            _Pragma("unroll") for (int bj = 0; bj < 2; ++bj) _Pragma("unroll") for (int n = 0; n < 2; ++n) { const int off_ = bj * HALF + n * NO; \
                if (RESF32) rf[buf][bj][n] = *(const f32x4*)(rrow_ + off_); else if (n == 0) { const u32x4 w4_ = *(const u32x4*)(hrow_ + off_); rh[buf][bj][0] = (u32x2){w4_.x, w4_.y}; rh[buf][bj][1] = (u32x2){w4_.z, w4_.w}; } } } while (0)
        EPR_LOAD(0, 0);
#pragma unroll
        for (int st = 0; st < 8; ++st) {
            const int ai = st >> 2, m = st & 3, cb = st & 1;
            if (st + 1 < 8) { if (cb) EPR_LOAD(0, st + 1); else EPR_LOAD(1, st + 1); }
            const int row = u.pm * BM + ai * HALF + wr * 64 + m * 16 + fr;
            bf16_t* hrow = hb + (size_t)row * HLD + HOFF + col0; const float* grow = gate + (size_t)seq_of_row(row) * MODW + col0;
            unsigned pk0_ = 0u, pk1_ = 0u;
#pragma unroll
            for (int bj = 0; bj < 2; ++bj)
#pragma unroll
                for (int n = 0; n < 2; ++n) { const int off = bj * HALF + n * NO;
                    const f32x4 g = uni ? gu_[bj][n] : *(const f32x4*)(grow + off) * coef; f32x4 r;
                    if (RESF32) r = rf[cb][bj][n];
                    else { const u32x2 w = rh[cb][bj][n]; r = (f32x4){__uint_as_float(w.x << 16), __uint_as_float(w.x & 0xffff0000u), __uint_as_float(w.y << 16), __uint_as_float(w.y & 0xffff0000u)}; }
                    const f32x4 o = r + g * acc[ai][bj][m][n];
                    { if (n == 0) { pk0_ = cvt_pk_bf16(o[0], o[1]); pk1_ = cvt_pk_bf16(o[2], o[3]); } else *(u32x4*)(hrow + bj * HALF) = (u32x4){pk0_, pk1_, cvt_pk_bf16(o[0], o[1]), cvt_pk_bf16(o[2], o[3])}; } }
        }
#undef EPR_LOAD
    }
};
struct EpiP {
    static constexpr bool PERM = true, AFTER_DRAIN = false;
    bf16_t* PB; bf16_t* PUV; float* shp; float* shs;
    __device__ __forceinline__ void operator()(const f32x4 (&acc)[2][2][4][2], const Unit& u, int wr, int wc, int fr, int fq) const {
        typedef unsigned u32x2 __attribute__((ext_vector_type(2)));
        const int row0 = u.pm * BM + wr * 64 + fr, col0 = u.pn * BM + wc * 32 + 8 * fq;
#pragma unroll
        for (int ai = 0; ai < 2; ++ai)
#pragma unroll
            for (int m = 0; m < 4; ++m) {
                const int row = row0 + ai * HALF + m * 16; const bool last = row_is_last(row);
#pragma unroll
                for (int bj = 0; bj < 2; ++bj) { const f32x4 v0 = acc[ai][bj][m][0], v1 = acc[ai][bj][m][1]; const int col = col0 + bj * HALF;
                    u32x4 w; w.x = cvt_pk_bf16(v0[0], v0[1]); w.y = cvt_pk_bf16(v0[2], v0[3]); w.z = cvt_pk_bf16(v1[0], v1[1]); w.w = cvt_pk_bf16(v1[2], v1[3]);
                    if (u.pn < 7) { bf16_t* p = PB + ((size_t)((row >> 4) * 448 + (col >> 2)) * 16 + (row & 15)) * 4; *(u32x2*)p = (u32x2){w.x, w.y}; *(u32x2*)(p + 64) = (u32x2){w.z, w.w};
                        if (last) { float* o = (row < ROWS_P ? shp + (size_t)(row >> 11) * RCOLS : shs + (size_t)((row - ROWS_P) >> 3) * RCOLS) + col; *(f32x4*)o = v0; *(f32x4*)(o + 4) = v1; } }
                    else *(u32x4*)(PUV + (size_t)row * 1024 + (col - RCOLS)) = w; }
            }
    }
};
template <class Epi, class Sched, bool ALIGN_EPI = false, bool SP2 = false>
__device__ __forceinline__ void gemm_phase(PG8_LAS unsigned char* lds, const Gemm g, const Sched& S, const Epi& E) {
    const int tid = threadIdx.x, wid = __builtin_amdgcn_readfirstlane(tid >> 6), lane = tid & 63, wr = wid >> 2, wc = wid & 3, fr = lane & 15, fq = lane >> 4;
    const int K = g.ld;
    unsigned voffA[2], voffB[2];
#pragma unroll
    for (int i = 0; i < 2; ++i) { int R, C; stage_rc(tid * 16 + i * 8192, R, C); const int Rb = Epi::PERM ? ((R & ~31) + perm32(R & 31)) : R;
        voffA[i] = (unsigned)(R * K + C) * 2u; voffB[i] = (unsigned)(Rb * K + C) * 2u; }
    const size_t kstep = (size_t)(BK * 2);
    const size_t hstep = (size_t)HALF * K * 2;
    const size_t tstep = 2 * hstep;
    const unsigned ldsw = (unsigned)wid * 1024u;
    const int aoff = lds_byte(wr * 64 + fr, fq * 8), boff = lds_byte(wc * 32 + fr, fq * 8);
#define PG8_SA(b, h) (((b) * 2 + (h)) * HTB)
#define PG8_SB(b, h) ((4 + (b) * 2 + (h)) * HTB)
#define PG8_STAGE(bufoff, gbase, voff) do { _Pragma("unroll") for (int _i = 0; _i < 2; ++_i) \
        __builtin_amdgcn_global_load_lds((const unsigned*)((const char*)(gbase) + (voff)[_i]), (PG8_LAS unsigned*)(lds + (bufoff) + ldsw + _i * 8192), 16, 0, 0); } while (0)
#define PG8_LDA(dst, b, h) do { _Pragma("unroll") for (int m = 0; m < 4; ++m) _Pragma("unroll") for (int k = 0; k < 2; ++k) dst[m][k] = *(const PG8_LAS bf16x8*)(lds + PG8_SA(b, h) + aoff + m * 2048 + k * 1024); } while (0)
#define PG8_LDB(dst, b, h) do { _Pragma("unroll") for (int n = 0; n < 2; ++n) _Pragma("unroll") for (int k = 0; k < 2; ++k) dst[n][k] = *(const PG8_LAS bf16x8*)(lds + PG8_SB(b, h) + boff + n * 2048 + k * 1024); } while (0)
#define PG8_MMA(ai, bj, At, Bt) do { __builtin_amdgcn_s_setprio(1); _Pragma("unroll") for (int m = 0; m < 4; ++m) _Pragma("unroll") for (int n = 0; n < 2; ++n) _Pragma("unroll") for (int k = 0; k < 2; ++k) \
        acc[ai][bj][m][n] = __builtin_amdgcn_mfma_f32_16x16x32_bf16(Bt[n][k], At[m][k], acc[ai][bj][m][n], 0, 0, 0); __builtin_amdgcn_s_setprio(0); } while (0)
#define PG8_WAIT_V(n) asm volatile("s_waitcnt vmcnt(" #n ")" ::: "memory")
#define PG8_WAIT_L(n) asm volatile("s_waitcnt lgkmcnt(" #n ")" ::: "memory")
#define PG8_BAR __builtin_amdgcn_s_barrier()
#define PG8_SCHED __builtin_amdgcn_sched_barrier(0)
    Unit cur, nxt; int ui = 0;
    if (!S.next(0, cur)) return;
    f32x4 acc[2][2][4][2];
#pragma unroll
    for (int a = 0; a < 2; ++a)
#pragma unroll
        for (int b = 0; b < 2; ++b)
#pragma unroll
            for (int m = 0; m < 4; ++m)
#pragma unroll
                for (int n = 0; n < 2; ++n) acc[a][b][m][n] = (f32x4){0.f, 0.f, 0.f, 0.f};
    bf16x8 At[4][2], B0[2][2], B1[2][2];
    const char* cA = (const char*)g.A + (size_t)cur.pm * tstep + cur.kb; const char* cB = (const char*)g.Bt + (size_t)cur.pn * tstep + cur.kb;
    S.a_ready(cur);
    if constexpr (SP2) {
        PG8_STAGE(PG8_SB(0, 0), cB, voffB); PG8_STAGE(PG8_SB(0, 1), cB + hstep, voffB); PG8_STAGE(PG8_SA(0, 0), cA, voffA); PG8_STAGE(PG8_SA(0, 1), cA + hstep, voffA);
        if (wr == 1) PG8_BAR;
        PG8_WAIT_V(2); PG8_BAR;
        PG8_STAGE(PG8_SB(1, 0), cB + kstep, voffB); PG8_STAGE(PG8_SA(1, 0), cA + kstep, voffA); PG8_STAGE(PG8_SB(1, 1), cB + hstep + kstep, voffB);
        PG8_WAIT_V(6); PG8_BAR;
    } else {
        PG8_STAGE(PG8_SB(0, 0), cB, voffB); PG8_STAGE(PG8_SA(0, 0), cA, voffA); PG8_STAGE(PG8_SB(0, 1), cB + hstep, voffB); PG8_STAGE(PG8_SA(0, 1), cA + hstep, voffA);
        if (wr == 1) PG8_BAR;
        PG8_WAIT_V(4); PG8_BAR;
        PG8_STAGE(PG8_SB(1, 0), cB + kstep, voffB); PG8_STAGE(PG8_SA(1, 0), cA + kstep, voffA); PG8_STAGE(PG8_SB(1, 1), cB + hstep + kstep, voffB);
        PG8_WAIT_V(6); PG8_BAR;
    }
    for (;;) {
        const bool has_next = S.next(ui + 1, nxt);
        const char* nA = has_next ? (const char*)g.A + (size_t)nxt.pm * tstep + nxt.kb : cA; const char* nB = has_next ? (const char*)g.Bt + (size_t)nxt.pn * tstep + nxt.kb : cB;
        const int nt = cur.nt;
        for (int t = 0; t < nt; t += 2) {
            const bool last = (t == nt - 2);
            const char* a1 = cA + (size_t)(t + 1) * kstep;
            const char* a2 = last ? nA : cA + (size_t)(t + 2) * kstep; const char* b2 = last ? nB : cB + (size_t)(t + 2) * kstep;
            const char* a3 = a2 + kstep; const char* b3 = b2 + kstep;
            if (last && has_next) S.a_ready(nxt);
            if constexpr (SP2) {
            PG8_LDB(B0, 0, 0); PG8_LDB(B1, 0, 1); PG8_SCHED; PG8_LDA(At, 0, 0); PG8_STAGE(PG8_SA(1, 1), a1 + hstep, voffA);
            PG8_WAIT_V(8); PG8_WAIT_L(0); PG8_BAR; PG8_MMA(0, 0, At, B0); PG8_MMA(0, 1, At, B1); PG8_BAR; PG8_SCHED;
            PG8_LDA(At, 0, 1); PG8_STAGE(PG8_SB(0, 0), b2, voffB); PG8_STAGE(PG8_SB(0, 1), b2 + hstep, voffB); PG8_STAGE(PG8_SA(0, 0), a2, voffA);
            PG8_WAIT_V(8); PG8_WAIT_L(0); PG8_BAR; PG8_MMA(1, 0, At, B0); PG8_MMA(1, 1, At, B1); PG8_BAR; PG8_SCHED;
            PG8_LDB(B0, 1, 0); PG8_LDB(B1, 1, 1); PG8_SCHED; PG8_LDA(At, 1, 0); PG8_STAGE(PG8_SA(0, 1), a2 + hstep, voffA);
            PG8_WAIT_V(8); PG8_WAIT_L(0); PG8_BAR; PG8_MMA(0, 0, At, B0); PG8_MMA(0, 1, At, B1); PG8_BAR; PG8_SCHED;
            PG8_LDA(At, 1, 1); PG8_STAGE(PG8_SB(1, 0), b3, voffB); PG8_STAGE(PG8_SB(1, 1), b3 + hstep, voffB); PG8_STAGE(PG8_SA(1, 0), a3, voffA);
            PG8_WAIT_V(8); PG8_WAIT_L(0); PG8_BAR; PG8_MMA(1, 0, At, B0); PG8_MMA(1, 1, At, B1); PG8_BAR; PG8_SCHED;
            } else {
            PG8_LDB(B0, 0, 0); PG8_SCHED; PG8_LDA(At, 0, 0); PG8_STAGE(PG8_SA(1, 1), a1 + hstep, voffA);
            PG8_WAIT_L(8); PG8_BAR; PG8_WAIT_L(0); PG8_MMA(0, 0, At, B0); PG8_BAR; PG8_SCHED;
            PG8_LDB(B1, 0, 1); PG8_STAGE(PG8_SB(0, 0), b2, voffB);
            PG8_BAR; PG8_WAIT_L(0); PG8_MMA(0, 1, At, B1); PG8_BAR;
            PG8_LDA(At, 0, 1); PG8_STAGE(PG8_SA(0, 0), a2, voffA);
            PG8_BAR; PG8_WAIT_L(0); PG8_MMA(1, 0, At, B0); PG8_BAR; PG8_SCHED;
            PG8_STAGE(PG8_SB(0, 1), b2 + hstep, voffB);
            PG8_WAIT_V(6); PG8_BAR; PG8_MMA(1, 1, At, B1); PG8_BAR;
            PG8_LDB(B0, 1, 0); PG8_SCHED; PG8_LDA(At, 1, 0); PG8_STAGE(PG8_SA(0, 1), a2 + hstep, voffA);
            PG8_WAIT_L(8); PG8_BAR; PG8_WAIT_L(0); PG8_MMA(0, 0, At, B0); PG8_BAR; PG8_SCHED;
            PG8_LDB(B1, 1, 1); PG8_STAGE(PG8_SB(1, 0), b3, voffB);
            PG8_BAR; PG8_WAIT_L(0); PG8_MMA(0, 1, At, B1); PG8_BAR;
            PG8_LDA(At, 1, 1); PG8_STAGE(PG8_SA(1, 0), a3, voffA);
            PG8_BAR; PG8_WAIT_L(0); PG8_MMA(1, 0, At, B0); PG8_BAR; PG8_SCHED;
            PG8_STAGE(PG8_SB(1, 1), b3 + hstep, voffB);
            PG8_WAIT_V(6); PG8_BAR; PG8_MMA(1, 1, At, B1); PG8_BAR;
            }
        }
        if constexpr (ALIGN_EPI) { if (wr == 0) PG8_BAR; }
        if constexpr (!Epi::AFTER_DRAIN) { E(acc, cur, wr, wc, fr, fq); S.done(cur); }
        if (!has_next) break;
#pragma unroll
        for (int a = 0; a < 2; ++a)
#pragma unroll
            for (int b = 0; b < 2; ++b)
#pragma unroll
                for (int m = 0; m < 4; ++m)
#pragma unroll
                    for (int n = 0; n < 2; ++n) acc[a][b][m][n] = (f32x4){0.f, 0.f, 0.f, 0.f};
        cur = nxt; cA = nA; cB = nB; ++ui;
        if constexpr (ALIGN_EPI) { if (wr == 1) PG8_BAR; }
    }
    PG8_WAIT_V(0);
    if constexpr (!ALIGN_EPI) { if (wr == 0) PG8_BAR; }
    PG8_BAR;
    if constexpr (Epi::AFTER_DRAIN) { E.fused(acc, cur, wr, wc, fr, fq, lds, wid, lane); S.done(cur); }
#undef PG8_SA
#undef PG8_SB
#undef PG8_STAGE
#undef PG8_LDA
#undef PG8_LDB
#undef PG8_MMA
#undef PG8_WAIT_V
#undef PG8_WAIT_L
#undef PG8_BAR
#undef PG8_SCHED
}
}
#ifndef PG8_SP2
#define PG8_SP2 true
#endif
#ifndef PG8_ALIGN
#define PG8_ALIGN true
#endif
#ifndef MK_N_LAUNCHES
#define MK_N_LAUNCHES 1
#endif
constexpr int NWAVES = 8;
constexpr int N_PHASES = 15;
constexpr int D = 1024, MP = 16384, MS = 1024, M = MP + MS, NSEQ = 136, FF = 2816, RC = 1792, PC = 2816, RW = 512, MODW = 9216;
constexpr float RMS_EPS = 1e-6f, LN_EPS = 1e-5f, GN_EPS = 64e-5f;
constexpr size_t O_Y = 0, O_SHP = 17825792, O_WKVP = 17840128, O_SHS = 18102272, O_WKVS = 18331648, O_CVS = 22525952, O_END = 23050240;
constexpr size_t MiB = 1u << 20;
constexpr size_t WS_CTL = 0, CTL_ZERO_BYTES = 32768;
constexpr size_t WS_GU1 = 1 * MiB, WS_DN1 = 12 * MiB, WS_WIN = 18 * MiB, WS_WOUT = 24 * MiB, WS_GU2 = 26 * MiB, WS_DN2 = 37 * MiB;
constexpr size_t WS_SMALL = 43 * MiB;
constexpr size_t WS_WLT = WS_SMALL, WS_ALT = WS_SMALL + 65536, WS_GLT = WS_SMALL + 131072, WS_WSB = WS_SMALL + 262144, WS_SILUC = WS_SMALL + 524288;
constexpr size_t WS_MOD = 44 * MiB;
constexpr size_t WS_BON = 49 * MiB;
constexpr size_t WS_FP = 331 * MiB;
constexpr size_t WS_XN = 50 * MiB;
constexpr size_t WS_ACT = 84 * MiB;
constexpr size_t WS_PUV = WS_ACT + 60 * MiB;
static_assert((size_t)M * 1792 * 2 <= 60 * MiB && WS_PUV + (size_t)M * 1024 * 2 <= 178 * MiB, "ws map puv");
constexpr size_t WS_SC = 178 * MiB, SC_STRIDE = 17 * MiB;
constexpr size_t WS_G = 280 * MiB;
constexpr size_t WS_Y = 297 * MiB;
constexpr size_t WS_FRG = 339 * MiB;
constexpr size_t WS_END = 348 * MiB;
static_assert(WS_FRG + (size_t)M * 256 * 2 <= WS_END, "ws map frg");
static_assert(WS_FP + (size_t)136 * 448 * 64 * 2 <= WS_END, "ws map fp");
static_assert(WS_DN1 - WS_GU1 >= (size_t)5632 * 1024 * 2 && WS_WIN - WS_DN1 >= (size_t)1024 * 2816 * 2 && WS_WOUT - WS_WIN >= (size_t)2816 * 1024 * 2 && WS_GU2 - WS_WOUT >= (size_t)1024 * 1024 * 2, "ws map a");
static_assert(WS_DN2 - WS_GU2 >= (size_t)5632 * 1024 * 2 && WS_SMALL - WS_DN2 >= (size_t)1024 * 2816 * 2 && WS_BON - WS_MOD >= (size_t)136 * 9216 * 4 && WS_XN - WS_BON >= (size_t)M * 8 * 4, "ws map b");
static_assert(WS_ACT - WS_XN >= (size_t)M * 1024 * 2 && WS_SC - WS_ACT >= (size_t)M * 2816 * 2 && SC_STRIDE >= (size_t)M * 512 * 2 && WS_G - WS_SC >= 6 * SC_STRIDE && WS_Y - WS_G >= (size_t)M * 512 * 2 && WS_END - WS_Y >= (size_t)M * 512 * 4, "ws map c");
constexpr int CW_TMO = 0, CW_CODE = 1, CW_BAR = 4096;
constexpr int RING_OFF = 0, RING_BYTES = 139264;
constexpr int LDS_BYTES = 163840;
constexpr int LDSCTL_OFF = LDS_BYTES - 1024, MISC_OFF = LDSCTL_OFF + 320;
struct Args { const float* in[30]; float* out; unsigned char* ws; int ph_lo, ph_hi; };
constexpr int PTRS_OFF = MISC_OFF + 128;
#ifndef USE_PTR_TABLE
#define USE_PTR_TABLE 1
#endif
#if !USE_PTR_TABLE
struct InAcc { const float* in[30]; };
#else
struct InPtrs { __attribute__((address_space(3))) unsigned* t;
    __device__ __forceinline__ const float* operator[](int i) const { const unsigned lo = __builtin_amdgcn_readfirstlane(t[2 * i]), hi = __builtin_amdgcn_readfirstlane(t[2 * i + 1]); return (const float*)(const __attribute__((address_space(1))) float*)(((unsigned long long)hi << 32) | lo); } };
struct InAcc { InPtrs in; };
#endif
#define GAS __attribute__((address_space(1)))
#define LAS __attribute__((address_space(3)))
typedef unsigned short bf16;
typedef unsigned v4u __attribute__((ext_vector_type(4)));
typedef float f32x4 __attribute__((ext_vector_type(4)));
typedef short bf16x8 __attribute__((ext_vector_type(8)));
typedef GAS unsigned gu32;
typedef GAS unsigned long long gu64;
#define RLX_AGENT __ATOMIC_RELAXED, __HIP_MEMORY_SCOPE_AGENT
#define LDS_WAIT() asm volatile("s_waitcnt lgkmcnt(0)" ::: "memory")
#define VM_WAIT() asm volatile("s_waitcnt vmcnt(0)" ::: "memory")
__device__ __forceinline__ unsigned long long rt() { return __builtin_amdgcn_s_memrealtime(); }
__device__ __forceinline__ unsigned f2bf(float f) { unsigned u = __builtin_bit_cast(unsigned, f); return (u + 0x7fffu + ((u >> 16) & 1u)) >> 16; }
__device__ __forceinline__ unsigned pk2(float lo, float hi) { return f2bf(lo) | (f2bf(hi) << 16); }
#define XB_TMO      128
#define XB_XCNT(j)  (256  + 64 * (j))
#define XB_XSUB(j)  (1280 + 64 * (j))
#define XB_XGEN(j)  (2304 + 64 * (j))
#define XB_TOP      3328
#define XB_TOPGEN   3392
#define XCD_BAR_WORDS 3456
#define XB_SPIN_CAP (1u << 18)

__device__ __forceinline__ unsigned xb_ld(unsigned* p)              { return __hip_atomic_load(p, __ATOMIC_RELAXED, __HIP_MEMORY_SCOPE_AGENT); }
__device__ __forceinline__ unsigned xb_add(unsigned* p, unsigned v) { return __hip_atomic_fetch_add(p, v, __ATOMIC_RELAXED, __HIP_MEMORY_SCOPE_AGENT); }
__device__ __forceinline__ unsigned xb_xcc_id() { return (unsigned)__builtin_amdgcn_s_getreg((3 << 11) | 20) & 0xFu; }
#define XB_SPIN(cond, bar) do { unsigned _sp = 0; while (cond) { __builtin_amdgcn_s_sleep(1); \
    if ((++_sp & 255u) == 0u) { if (xb_ld(&(bar)[XB_TMO])) break; if (_sp > XB_SPIN_CAP) { atomicAdd(&(bar)[XB_TMO], 1u); break; } } } } while (0)

struct XcdBarrier {
    unsigned* bar; unsigned x;
    volatile LAS unsigned* st;
};

__device__ __forceinline__ XcdBarrier xcd_barrier_post(unsigned* bar, volatile LAS unsigned* st) {
    XcdBarrier b; b.bar = bar; b.x = xb_xcc_id(); b.st = st;
    if (threadIdx.x == 0) (void)xb_add(&bar[XB_XCNT(b.x)], 1u);
    return b;
}
__device__ __forceinline__ void xcd_barrier_complete(unsigned* bar, unsigned x, unsigned& nloc, unsigned& nx) {
    const unsigned G = gridDim.x * gridDim.y * gridDim.z;
    unsigned sum, cnt, mine, sp = 0u;
    for (;;) {
        sum = 0u; cnt = 0u; mine = 0u;
#pragma unroll
        for (unsigned j = 0; j < 16; ++j) { const unsigned c = xb_ld(&bar[XB_XCNT(j)]); sum += c; cnt += (c > 0u) ? 1u : 0u; mine = (j == x) ? c : mine; }
        if (sum == G) break;
        __builtin_amdgcn_s_sleep(1);
        if ((++sp & 255u) == 0u) { if (xb_ld(&bar[XB_TMO])) break; if (sp > XB_SPIN_CAP) { atomicAdd(&bar[XB_TMO], 1u); break; } }
    }
    nloc = mine > 0u ? mine : 1u; nx = cnt > 0u ? cnt : 1u;
}

__device__ __forceinline__ void xcd_barrier(const XcdBarrier& b) {
    asm volatile("s_waitcnt vmcnt(0)" ::: "memory");
    __syncthreads();
    if (threadIdx.x == 0) {
        unsigned* bar = b.bar;
        __builtin_amdgcn_s_waitcnt(0);
        unsigned nloc = b.st[0], nx = b.st[1];
        if (nloc == 0u) { xcd_barrier_complete(bar, b.x, nloc, nx); b.st[0] = nloc; b.st[1] = nx; }
        const unsigned old = xb_add(&bar[XB_XSUB(b.x)], 1u);
        const unsigned gen = old / nloc;
        if (old + 1u == (gen + 1u) * nloc) {
            __builtin_amdgcn_fence(__ATOMIC_RELEASE, "agent");
            asm volatile("s_waitcnt vmcnt(0)" ::: "memory");
            const unsigned og = xb_add(&bar[XB_TOP], 1u);
            const unsigned tg = og / nx;
            if (og + 1u == (tg + 1u) * nx) xb_add(&bar[XB_TOPGEN], 1u);
            else XB_SPIN(xb_ld(&bar[XB_TOPGEN]) == tg, bar);
            __builtin_amdgcn_fence(__ATOMIC_ACQUIRE, "agent");
#ifndef XB_DIRECT
#endif
            asm volatile("s_waitcnt vmcnt(0)" ::: "memory");
        } else {
#ifdef XB_DIRECT
            XB_SPIN(xb_ld(&bar[XB_TOPGEN]) == gen, bar);
#else
            XB_SPIN(xb_ld(&bar[XB_TOPGEN]) == gen, bar);
#endif
            __builtin_amdgcn_fence(__ATOMIC_ACQUIRE, "agent");
            asm volatile("s_waitcnt vmcnt(0)" ::: "memory");
        }
    }
    __syncthreads();
}
struct Frame {
    LAS unsigned char* lds;
    volatile LAS unsigned* MISC;
    gu32* ctl;
    int tid, lane, wave, gw, NGW, G;
    float* out; unsigned char* ws;
};
__device__ __forceinline__ float wave_sum(float v) {
#pragma unroll
    for (int o = 1; o < 64; o <<= 1) v += __shfl_xor(v, o);
    return v;
}
__device__ __forceinline__ float bf2f(unsigned short b) { return __uint_as_float((unsigned)b << 16); }
__device__ __forceinline__ void unpack8(v4u w, float* f) {
    f[0] = __uint_as_float(w.x << 16); f[1] = __uint_as_float(w.x & 0xffff0000u); f[2] = __uint_as_float(w.y << 16); f[3] = __uint_as_float(w.y & 0xffff0000u);
    f[4] = __uint_as_float(w.z << 16); f[5] = __uint_as_float(w.z & 0xffff0000u); f[6] = __uint_as_float(w.w << 16); f[7] = __uint_as_float(w.w & 0xffff0000u);
}
typedef unsigned v2u __attribute__((ext_vector_type(2)));
__device__ __forceinline__ void unpack4(v2u w, float* f) {
    f[0] = __uint_as_float(w.x << 16); f[1] = __uint_as_float(w.x & 0xffff0000u); f[2] = __uint_as_float(w.y << 16); f[3] = __uint_as_float(w.y & 0xffff0000u);
}
__device__ __forceinline__ v2u pack4(const float* f) { v2u w; w.x = pk2(f[0], f[1]); w.y = pk2(f[2], f[3]); return w; }
__device__ __forceinline__ v4u pack8(const float* f) { v4u w; w.x = pk2(f[0], f[1]); w.y = pk2(f[2], f[3]); w.z = pk2(f[4], f[5]); w.w = pk2(f[6], f[7]); return w; }
__device__ __forceinline__ bf16x8 as_bf16x8(v4u w) { return __builtin_bit_cast(bf16x8, w); }
__device__ __forceinline__ float sigmoid_f(float x) { return 1.0f / (1.0f + __expf(-x)); }
__device__ __forceinline__ float tanh_f(float x) { const float e = __expf(2.0f * x); return 1.0f - 2.0f / (e + 1.0f); }

__device__ __forceinline__ int gu_row(int n0) { return n0 < FF ? 256 * (n0 >> 7) + (n0 & 127) : 256 * ((n0 - FF) >> 7) + 128 + ((n0 - FF) & 127); }
#ifndef P0_HV
#define P0_HV 2
#endif
struct TrD { const float* W; bf16* WT; int K, N, kb, nb, orow0; };
__device__ __forceinline__ void tr_load(const TrD& d, int lane, f32x4 (&v)[8]) {
    const float* p = d.W + (size_t)(64 * d.kb + (lane >> 3)) * d.N + 32 * d.nb + 4 * (lane & 7);
#pragma unroll
    for (int i = 0; i < 8; ++i) v[i] = *(const f32x4*)(p + (size_t)(8 * i) * d.N);
}
__device__ __forceinline__ void tr_finish(const TrD& d, const f32x4 (&v)[8], LAS float* scr, int lane) {
    const int k0 = 64 * d.kb;
#pragma unroll
    for (int i = 0; i < 8; ++i) { LAS float* s = scr + (8 * i + (lane >> 3)) * 33 + 4 * (lane & 7); s[0] = v[i].x; s[1] = v[i].y; s[2] = v[i].z; s[3] = v[i].w; }
    LDS_WAIT(); asm volatile("" ::: "memory");
    const int c = lane & 7;
#pragma unroll
    for (int j = 0; j < 4; ++j) { const int n = (lane >> 3) + 8 * j; const LAS float* s = scr + (8 * c) * 33 + n;
        v4u o; o.x = pk2(s[0 * 33], s[1 * 33]); o.y = pk2(s[2 * 33], s[3 * 33]); o.z = pk2(s[4 * 33], s[5 * 33]); o.w = pk2(s[6 * 33], s[7 * 33]);
        *(GAS v4u*)(d.WT + (size_t)(d.orow0 + n) * d.K + k0 + 8 * c) = o; }
    LDS_WAIT(); asm volatile("" ::: "memory");
}
__device__ __forceinline__ void p0_prologue(Frame& F, const InAcc& A) {
    LAS float* scr = (LAS float*)(F.lds + RING_OFF + F.wave * 16384);
    constexpr int I_GU = 16 * 176, I_DN = 44 * 32, I_IN = 16 * 88, I_OUT = 16 * 32, I_L64 = 16, I_L128 = 32;
    constexpr int NITEMS = 2 * I_GU + 2 * I_DN + I_IN + I_OUT + 2 * I_L64 + I_L128;
#define TR_DESC(d, it_) do { int r = (it_); \
        if (r < I_GU) { d = TrD{A.in[8], ((bf16*)(F.ws + WS_GU1)), 1024, 5632, r / 176, r % 176, gu_row(32 * (r % 176))}; break; } r -= I_GU; \
        if (r < I_GU) { d = TrD{A.in[27], ((bf16*)(F.ws + WS_GU2)), 1024, 5632, r / 176, r % 176, gu_row(32 * (r % 176))}; break; } r -= I_GU; \
        if (r < I_DN) { d = TrD{A.in[9], ((bf16*)(F.ws + WS_DN1)), 2816, 1024, r / 32, r % 32, 32 * (r % 32)}; break; } r -= I_DN; \
        if (r < I_DN) { d = TrD{A.in[28], ((bf16*)(F.ws + WS_DN2)), 2816, 1024, r / 32, r % 32, 32 * (r % 32)}; break; } r -= I_DN; \
        if (r < I_IN) { d = TrD{A.in[10], ((bf16*)(F.ws + WS_WIN)), 1024, 2816, r / 88, r % 88, 32 * (r % 88)}; break; } r -= I_IN; \
        if (r < I_OUT) { d = TrD{A.in[26], ((bf16*)(F.ws + WS_WOUT)), 1024, 1024, r / 32, r % 32, 32 * (r % 32)}; break; } r -= I_OUT; \
        if (r < I_L64) { d = TrD{A.in[13], ((bf16*)(F.ws + WS_WLT)), 64, 512, 0, r, 32 * r}; break; } r -= I_L64; \
        if (r < I_L64) { d = TrD{A.in[15], ((bf16*)(F.ws + WS_ALT)), 64, 512, 0, r, 32 * r}; break; } r -= I_L64; \
        d = TrD{A.in[16], ((bf16*)(F.ws + WS_GLT)), 128, 512, r / 16, r % 16, 32 * (r % 16)}; } while (0)
    { TrD dc, dn; f32x4 vc[8], vn[8];
      const int nheavy = (MODW / 32 > F.G && MODW / 32 < 2 * F.G) ? MODW / 32 - F.G : 0, wh = nheavy * NWAVES;
      const bool hv = F.gw < wh; const int end = hv ? P0_HV * wh : NITEMS, stride = hv ? wh : F.NGW - wh;
      int it = hv ? F.gw : P0_HV * wh + (F.gw - wh);
      if (it < end) { TR_DESC(dc, it); tr_load(dc, F.lane, vc); }
      while (it < end) {
          const int itn = it + stride; const bool more = itn < end;
          if (more) { TR_DESC(dn, itn); tr_load(dn, F.lane, vn); }
          tr_finish(dc, vc, scr, F.lane);
          if (!more) break;
          dc = dn;
#pragma unroll
          for (int i = 0; i < 8; ++i) vc[i] = vn[i];
          it = itn; } }
#undef TR_DESC
    const int gt = F.gw * 64 + F.lane, NGT = F.NGW * 64;
    for (int i = gt; i < NSEQ * 448; i += NGT) { const int sq = i / 448, cg = i % 448;
        f32x4 v = {0.f, 0.f, 0.f, 0.f}; if (sq >= 8) v = *(const f32x4*)(A.in[2] + (size_t)(sq - 8) * RC + 4 * cg);
        v2u w; w.x = pk2(v.x, v.y); w.y = pk2(v.z, v.w); *(v2u*)((bf16*)(F.ws + WS_FP) + (size_t)i * 64) = w; }
    for (int i = gt; i < 8 * 128 * 64; i += NGT) { const int j = (i & 63) * 2, ii = (i >> 6) & 127;
        const float a = A.in[24][2 * (size_t)i], b = A.in[24][2 * (size_t)i + 1];
        ((unsigned*)((bf16*)(F.ws + WS_WSB)))[i] = pk2(j <= ii ? a : 0.f, (j + 1) <= ii ? b : 0.f); }
}
typedef float f32x2m __attribute__((ext_vector_type(2)));
__device__ __forceinline__ void p1_mod(Frame& F, const InAcc& A) {
    const int l15 = F.lane & 15, q = F.lane >> 4;
    const float* w_ada = A.in[6]; const float* b_ada = A.in[7];
    const float* c_p = A.in[4]; const float* c_s = A.in[5];
    LAS f32x4* red = (LAS f32x4*)(F.lds + RING_OFF);
    static_assert(8 * 18 * 64 * 16 <= LDSCTL_OFF, "mod reduction LDS");
    for (int nt = blockIdx.x; nt < MODW / 32; nt += F.G) {
        const int n0 = 32 * nt, kb = 128 * F.wave + 8 * q;
        f32x2m wv[4][8];
        const float* wp = w_ada + (size_t)kb * MODW + n0 + 2 * l15;
#pragma unroll
        for (int ks = 0; ks < 4; ++ks) {
#pragma unroll
            for (int j = 0; j < 8; ++j) { wv[ks][j] = *(const f32x2m*)wp; wp += MODW; asm volatile("" : "+v"(wp)); }
            wp += 24 * MODW; }
        f32x4 acc0[9], acc1[9];
#pragma unroll
        for (int mt = 0; mt < 9; ++mt) { acc0[mt] = (f32x4){0.f, 0.f, 0.f, 0.f}; acc1[mt] = acc0[mt]; }
#pragma unroll 1
        for (int ks = 0; ks < 4; ++ks) {
            f32x4 raw[9][2];
#pragma unroll
            for (int mt = 0; mt < 9; ++mt) { const int sq = 16 * mt + l15; const int sc = sq < NSEQ ? sq : 0;
                const float* cr = (sc < 8 ? c_p + (size_t)sc * D : c_s + (size_t)(sc - 8) * D) + kb + 32 * ks; raw[mt][0] = *(const f32x4*)cr; raw[mt][1] = *(const f32x4*)(cr + 4); }
            __builtin_amdgcn_sched_barrier(0);
            float t0[8], t1[8];
#pragma unroll
            for (int j = 0; j < 8; ++j) { t0[j] = wv[0][j].x; t1[j] = wv[0][j].y; }
            const bf16x8 wf0 = as_bf16x8(pack8(t0)), wf1 = as_bf16x8(pack8(t1));
#pragma unroll
            for (int mt = 0; mt < 9; ++mt) { const bool ok = 16 * mt + l15 < NSEQ; float t[8];
#pragma unroll
                for (int e = 0; e < 4; ++e) { t[e] = ok ? pg8::silu_f(raw[mt][0][e]) : 0.f; t[4 + e] = ok ? pg8::silu_f(raw[mt][1][e]) : 0.f; }
                const bf16x8 fr = as_bf16x8(pack8(t));
                acc0[mt] = __builtin_amdgcn_mfma_f32_16x16x32_bf16(wf0, fr, acc0[mt], 0, 0, 0); acc1[mt] = __builtin_amdgcn_mfma_f32_16x16x32_bf16(wf1, fr, acc1[mt], 0, 0, 0); }
            __builtin_amdgcn_sched_barrier(0);
#pragma unroll
            for (int i = 0; i < 3; ++i)
#pragma unroll
                for (int j = 0; j < 8; ++j) wv[i][j] = wv[i + 1][j];
        }
#pragma unroll
        for (int mt = 0; mt < 9; ++mt) { red[((F.wave * 2 + 0) * 9 + mt) * 64 + F.lane] = acc0[mt]; red[((F.wave * 2 + 1) * 9 + mt) * 64 + F.lane] = acc1[mt]; }
        __syncthreads();
        const f32x4 bv0 = *(const f32x4*)(b_ada + n0 + 8 * q), bv1 = *(const f32x4*)(b_ada + n0 + 8 * q + 4);
#pragma unroll
        for (int rr = 0; rr < 2; ++rr) { const int mt = F.wave + 8 * rr; if (mt < 9) { f32x4 s0 = {0.f, 0.f, 0.f, 0.f}, s1 = s0;
#pragma unroll
                for (int w2 = 0; w2 < 8; ++w2) { s0 += red[((w2 * 2 + 0) * 9 + mt) * 64 + F.lane]; s1 += red[((w2 * 2 + 1) * 9 + mt) * 64 + F.lane]; }
                const int sq = 16 * mt + l15; if (sq < NSEQ) { float* o = ((float*)(F.ws + WS_MOD)) + (size_t)sq * MODW + n0 + 8 * q;
                    *(f32x4*)o = (f32x4){s0[0] + bv0.x, s1[0] + bv0.y, s0[1] + bv0.z, s1[1] + bv0.w}; *(f32x4*)(o + 4) = (f32x4){s0[2] + bv1.x, s1[2] + bv1.y, s0[3] + bv1.z, s1[3] + bv1.w}; } } }
        __syncthreads();
    }
}
__device__ __forceinline__ const float* res_row(const float* pP, const float* pS, int row) { return row < MP ? pP + (size_t)row * D : pS + (size_t)(row - MP) * D; }
__device__ __forceinline__ void load_h_row(const bf16* hb, int row, int lane, f32x4* v) {
    const v2u* hr = (const v2u*)(hb + (size_t)row * 2048 + 1024) + lane;
#pragma unroll
    for (int j = 0; j < 4; ++j) { float t[4]; unpack4(hr[64 * j], t); v[j] = (f32x4){t[0], t[1], t[2], t[3]}; }
}
template <bool SRC_X> struct RowRaw { f32x4 x[4]; v2u h[4]; };
template <bool SRC_X> __device__ __forceinline__ void norm_load(RowRaw<SRC_X>& R, const float* srcP, const float* srcS, const bf16* hb, int row, int lane) {
    if (SRC_X) { const f32x4* xr = (const f32x4*)res_row(srcP, srcS, row) + lane;
#pragma unroll
        for (int j = 0; j < 4; ++j) R.x[j] = xr[64 * j]; }
    else { const v2u* hr = (const v2u*)(hb + (size_t)row * 2048 + 1024) + lane;
#pragma unroll
        for (int j = 0; j < 4; ++j) R.h[j] = hr[64 * j]; }
}
__device__ __forceinline__ void norm_finish(Frame& F, const f32x4* v, int row, int s, int sh_off, int sc_off) {
    const float* MODp = (const float*)(F.ws + WS_MOD);
    float ss = 0.f;
#pragma unroll
    for (int j = 0; j < 4; ++j) ss += (v[j].x * v[j].x + v[j].y * v[j].y) + (v[j].z * v[j].z + v[j].w * v[j].w);
    const float rstd = 1.0f / sqrtf(wave_sum(ss) * (1.0f / D) + RMS_EPS);
    const f32x4* sc = (const f32x4*)(MODp + (size_t)s * MODW + sc_off) + F.lane; const f32x4* sh = (const f32x4*)(MODp + (size_t)s * MODW + sh_off) + F.lane;
    v2u* o = (v2u*)(((bf16*)(F.ws + WS_XN)) + (size_t)row * D) + F.lane;
#pragma unroll
    for (int j = 0; j < 4; ++j) { const f32x4 a = sc[64 * j], bb = sh[64 * j]; const f32x4 r = v[j] * rstd * (a + 1.0f) + bb; float t[4] = {r.x, r.y, r.z, r.w}; o[64 * j] = pack4(t); }
}
__device__ __forceinline__ void norm_modload(Frame& F, int s, int sh_off, int sc_off, f32x4 (&a)[4], f32x4 (&bb)[4]) {
    const float* MODp = (const float*)(F.ws + WS_MOD);
    const f32x4* sc = (const f32x4*)(MODp + (size_t)s * MODW + sc_off) + F.lane; const f32x4* sh = (const f32x4*)(MODp + (size_t)s * MODW + sh_off) + F.lane;
#pragma unroll
    for (int j = 0; j < 4; ++j) { a[j] = sc[64 * j]; bb[j] = sh[64 * j]; }
}
__device__ __forceinline__ void norm_finish2(Frame& F, const f32x4* v, int row, const f32x4 (&a)[4], const f32x4 (&bb)[4]) {
    float ss = 0.f;
#pragma unroll
    for (int j = 0; j < 4; ++j) ss += (v[j].x * v[j].x + v[j].y * v[j].y) + (v[j].z * v[j].z + v[j].w * v[j].w);
    const float rstd = 1.0f / sqrtf(wave_sum(ss) * (1.0f / D) + RMS_EPS);
    v2u* o = (v2u*)(((bf16*)(F.ws + WS_XN)) + (size_t)row * D) + F.lane;
#pragma unroll
    for (int j = 0; j < 4; ++j) { const f32x4 r = v[j] * rstd * (a[j] + 1.0f) + bb[j]; float t[4] = {r.x, r.y, r.z, r.w}; o[64 * j] = pack4(t); }
}
template <bool SRC_X> __device__ __forceinline__ void norm_rows_bf16(Frame& F, const InAcc& A, const float* srcP, const float* srcS, bool sample_src_x, int sh_off, int sc_off, int ns, int g_off, float coef) {
    const float* MODp = (const float*)(F.ws + WS_MOD); bf16* hb = (bf16*)F.out;
    const bool bal = ns > 0 && F.NGW == 2 * MS; const int n1 = ns >= 8 ? 4 : 6, P1 = MS * n1;
    const int rstart = !bal ? F.gw : (F.gw < MS ? F.gw : P1 + (F.gw - MS)), rstride = bal ? MS : F.NGW, nmain = ns == 0 ? M : (!bal ? MP : (F.gw < MS ? P1 : MP));
    if (ns > 0) for (int r2 = MP + F.gw; r2 < M; r2 += F.NGW) {
        const int s = pg8::seq_of_row(r2);
        f32x4 v[4];
        if (sample_src_x) { const f32x4* xr = (const f32x4*)(srcS + (size_t)(r2 - MP) * D) + F.lane;
#pragma unroll
            for (int j = 0; j < 4; ++j) v[j] = xr[64 * j]; }
        else load_h_row(hb, r2, F.lane, v);
        const v2u* sl = (const v2u*)(F.ws + WS_SC) + (size_t)(r2 - MP) * (D / 4) + F.lane; const f32x4* gp = (const f32x4*)(MODp + (size_t)s * MODW + g_off) + F.lane;
        v2u* hr = (v2u*)(hb + (size_t)r2 * 2048 + 1024) + F.lane;
#pragma unroll
        for (int j = 0; j < 4; ++j) { f32x4 t = {0.f, 0.f, 0.f, 0.f}; for (int k = 0; k < ns; ++k) { float u_[4]; unpack4(sl[(size_t)k * (1024 * D / 4) + 64 * j], u_); t += (f32x4){u_[0], u_[1], u_[2], u_[3]}; } v[j] = v[j] + (gp[64 * j] * coef) * t;
            float q4[4] = {v[j].x, v[j].y, v[j].z, v[j].w}; const v2u pk = pack4(q4); hr[64 * j] = pk; float u4[4]; unpack4(pk, u4); v[j] = (f32x4){u4[0], u4[1], u4[2], u4[3]}; }
        norm_finish(F, v, r2, s, sh_off, sc_off);
    }
    RowRaw<SRC_X> cur, nxt, nx2;
    int row = rstart;
    if (row < nmain) norm_load<SRC_X>(cur, srcP, srcS, hb, row, F.lane);
    if (row + rstride < nmain) norm_load<SRC_X>(nxt, srcP, srcS, hb, row + rstride, F.lane);
    while (row < nmain) {
        const int nrow = row + rstride, n2row = row + 2 * rstride;
        f32x4 ma[4], mb[4]; norm_modload(F, pg8::seq_of_row(row), sh_off, sc_off, ma, mb);
        asm volatile("" ::: "memory");
        if (n2row < nmain) norm_load<SRC_X>(nx2, srcP, srcS, hb, n2row, F.lane);
        f32x4 v[4];
#pragma unroll
        for (int j = 0; j < 4; ++j) { if (SRC_X) v[j] = cur.x[j]; else { float t[4]; unpack4(cur.h[j], t); v[j] = (f32x4){t[0], t[1], t[2], t[3]}; } }
        norm_finish2(F, v, row, ma, mb);
        cur = nxt; nxt = nx2; row = nrow;
    }
}
__device__ __forceinline__ void final_norm_rows(Frame& F, const InAcc& A, int ns, int g_off, float coef) {
    const float* MODp = (const float*)(F.ws + WS_MOD); const bf16* hb = (const bf16*)F.out;
    f32x4 g[4]; { const f32x4* gp_ = (const f32x4*)A.in[29] + F.lane;
#pragma unroll
      for (int j = 0; j < 4; ++j) g[j] = gp_[64 * j]; }
    RowRaw<false> cur, nxt;
    const bool bal = ns > 0 && F.NGW == 2 * MS; const int P1 = MS * 6;
    const bool w1 = bal && F.gw < MS; const int lim = !bal ? M : (w1 ? P1 : MP), rstride = bal ? MS : F.NGW;
    int row = !bal ? F.gw : (w1 ? MP + F.gw : P1 + (F.gw - MS));
    bool live = bal ? true : row < M;
    if (live) norm_load<false>(cur, nullptr, nullptr, hb, row, F.lane);
    while (live) {
        const int nrow = (bal && row >= MP) ? F.gw : row + rstride; const bool nlive = nrow < lim;
        if (nlive) norm_load<false>(nxt, nullptr, nullptr, hb, nrow, F.lane);
        f32x4* xr = (f32x4*)(F.out + (size_t)row * D) + F.lane;
        f32x4 v[4];
#pragma unroll
        for (int j = 0; j < 4; ++j) { float t[4]; unpack4(cur.h[j], t); v[j] = (f32x4){t[0], t[1], t[2], t[3]}; }
        if (ns > 0 && row >= MP) { const int s = pg8::seq_of_row(row); const v2u* sl = (const v2u*)(F.ws + WS_SC) + (size_t)(row - MP) * (D / 4) + F.lane; const f32x4* gp = (const f32x4*)(MODp + (size_t)s * MODW + g_off) + F.lane;
#pragma unroll
            for (int j = 0; j < 4; ++j) { f32x4 t = {0.f, 0.f, 0.f, 0.f}; for (int k = 0; k < ns; ++k) { float u_[4]; unpack4(sl[(size_t)k * (1024 * D / 4) + 64 * j], u_); t += (f32x4){u_[0], u_[1], u_[2], u_[3]}; } v[j] = v[j] + (gp[64 * j] * coef) * t; } }
        float ss = 0.f;
#pragma unroll
        for (int j = 0; j < 4; ++j) ss += (v[j].x * v[j].x + v[j].y * v[j].y) + (v[j].z * v[j].z + v[j].w * v[j].w);
        const float rstd = 1.0f / sqrtf(wave_sum(ss) * (1.0f / D) + RMS_EPS);
        asm volatile("" ::: "memory");
#pragma unroll
        for (int j = 0; j < 4; ++j) xr[64 * j] = v[j] * rstd * g[j];
        cur = nxt; row = nrow; live = nlive;
    }
}
__device__ __forceinline__ unsigned dpp_shr1(unsigned x) { return (unsigned)__builtin_amdgcn_update_dpp(0, (int)x, 0x111, 0xf, 0xf, false); }
__device__ __forceinline__ size_t sc_off(int row, int c) { return ((size_t)((row >> 4) * 128 + (c >> 2)) * 16 + (row & 15)) * 4 + (c & 3); }
__device__ __forceinline__ void frag_item(Frame& F, const InAcc& A, int r0, int gh  ) {
    const int l15 = F.lane & 15, q = F.lane >> 4, row = r0 + l15, tile = r0 >> 4;
    const bf16* PB = (const bf16*)(F.ws + WS_ACT);
    const bf16* pcur = PB + ((size_t)tile * 448 * 16 + l15) * 4;
    const bool first = pg8::row_is_first(row);
    const bf16* fp = (const bf16*)(F.ws + WS_FP) + (size_t)pg8::seq_of_row(row) * 448 * 64;
    const bf16* pprv = PB + ((size_t)(tile > 0 ? tile - 1 : 0) * 448 * 16 + 15) * 4;
    const bf16* pb = first ? fp : (l15 == 0 ? pprv : pcur - 4);
    const float* mu = A.in[11];
    v2u lc[16], lp[16];
#pragma unroll
    for (int i = 0; i < 16; ++i) if ((i >> 3) == gh) { const size_t o = (size_t)(384 + 8 * (i >> 1) + 2 * q + (i & 1)) * 64; lc[i] = *(const v2u*)(pcur + o); lp[i] = *(const v2u*)(pb + o); }
#pragma unroll
    for (int g = 0; g < 8; ++g) if ((g >> 2) == gh) { const int col = 1536 + 32 * g + 8 * q; float cur[8], prv[8]; unpack4(lc[2 * g], cur); unpack4(lc[2 * g + 1], cur + 4); unpack4(lp[2 * g], prv); unpack4(lp[2 * g + 1], prv + 4);
        const f32x4 m0 = *(const f32x4*)(mu + col), m1 = *(const f32x4*)(mu + col + 4); const float mm[8] = {m0.x, m0.y, m0.z, m0.w, m1.x, m1.y, m1.z, m1.w};
        float t[8];
#pragma unroll
        for (int e = 0; e < 8; ++e) { const float x = cur[e] + (prv[e] - cur[e]) * mm[e]; t[e] = g < 2 ? tanh_f(x) : (g < 4 ? x : sigmoid_f(x)); }
        *(v4u*)((bf16*)(F.ws + WS_FRG) + ((size_t)((tile * 8 + g) * 4 + q) * 16 + l15) * 8) = pack8(t); }
}
__device__ __forceinline__ void frag_item_g(Frame& F, const InAcc& A, int r0, int g) {
    const int l15 = F.lane & 15, q = F.lane >> 4, row = r0 + l15, tile = r0 >> 4;
    const bf16* PB = (const bf16*)(F.ws + WS_ACT);
    const bf16* pcur = PB + ((size_t)tile * 448 * 16 + l15) * 4;
    const bool first = pg8::row_is_first(row);
    const bf16* fp = (const bf16*)(F.ws + WS_FP) + (size_t)pg8::seq_of_row(row) * 448 * 64;
    const bf16* pprv = PB + ((size_t)(tile > 0 ? tile - 1 : 0) * 448 * 16 + 15) * 4;
    const bf16* pb = first ? fp : (l15 == 0 ? pprv : pcur - 4);
    const float* mu = A.in[11];
    const size_t o0 = (size_t)(384 + 8 * g + 2 * q) * 64;
    const v2u c0 = *(const v2u*)(pcur + o0), c1 = *(const v2u*)(pcur + o0 + 64), p0 = *(const v2u*)(pb + o0), p1 = *(const v2u*)(pb + o0 + 64);
    const int col = 1536 + 32 * g + 8 * q; float cur[8], prv[8]; unpack4(c0, cur); unpack4(c1, cur + 4); unpack4(p0, prv); unpack4(p1, prv + 4);
    const f32x4 m0 = *(const f32x4*)(mu + col), m1 = *(const f32x4*)(mu + col + 4); const float mm[8] = {m0.x, m0.y, m0.z, m0.w, m1.x, m1.y, m1.z, m1.w};
    float t[8];
#pragma unroll
    for (int e = 0; e < 8; ++e) { const float x = cur[e] + (prv[e] - cur[e]) * mm[e]; t[e] = g < 2 ? tanh_f(x) : (g < 4 ? x : sigmoid_f(x)); }
    *(v4u*)((bf16*)(F.ws + WS_FRG) + ((size_t)((tile * 8 + g) * 4 + q) * 16 + l15) * 8) = pack8(t);
}
struct PrepRaw { bf16x8 fr[8]; v2u xc[4][3], xp[4][3]; };
__device__ __forceinline__ void prep_load_x(PrepRaw& R, Frame& F, int r0, int h) {
    const int l15 = F.lane & 15, q = F.lane >> 4, row = r0 + l15, tile = r0 >> 4;
    const bf16* PB = (const bf16*)(F.ws + WS_ACT);
    const bf16* pcur = PB + ((size_t)tile * 448 * 16 + l15) * 4;
    const bool first = pg8::row_is_first(row);
    const bf16* fp = (const bf16*)(F.ws + WS_FP) + (size_t)pg8::seq_of_row(row) * 448 * 64;
    const bf16* pprv = PB + ((size_t)(tile > 0 ? tile - 1 : 0) * 448 * 16 + 15) * 4;
    const bf16* pb = first ? fp : (l15 == 0 ? pprv : pcur - 4);
#pragma unroll
    for (int ntl = 0; ntl < 4; ++ntl)
#pragma unroll
        for (int sct = 0; sct < 3; ++sct) { R.xc[ntl][sct] = *(const v2u*)(pcur + (size_t)(128 * sct + 16 * h + 4 * ntl + q) * 64); R.xp[ntl][sct] = *(const v2u*)(pb + (size_t)(128 * sct + 16 * h + 4 * ntl + q) * 64); }
}
__device__ __forceinline__ void prep_load_fr(bf16x8 (&fr)[8], Frame& F, int r0) {
    const int l15 = F.lane & 15, q = F.lane >> 4, tile = r0 >> 4;
#pragma unroll
    for (int g = 0; g < 8; ++g) fr[g] = *(const bf16x8*)((const bf16*)(F.ws + WS_FRG) + ((size_t)((tile * 8 + g) * 4 + q) * 16 + l15) * 8);
}
template <bool GL, bool PIPE = false> __device__ __forceinline__ void prep_item(Frame& F, const InAcc& A, int r0, int h, PrepRaw* RP = nullptr, int r0next = -1) {
    const int l15 = F.lane & 15, q = F.lane >> 4, row = r0 + l15, tile = r0 >> 4;
    const bf16* PB = (const bf16*)(F.ws + WS_ACT);
    const bf16* pcur = PB + ((size_t)tile * 448 * 16 + l15) * 4;
    const bool first = pg8::row_is_first(row);
    const bf16* fp = (const bf16*)(F.ws + WS_FP) + (size_t)pg8::seq_of_row(row) * 448 * 64;
    const bf16* pprv = PB + ((size_t)(tile > 0 ? tile - 1 : 0) * 448 * 16 + 15) * 4;
    const float* mu = A.in[11];
    v2u xc[4][3], xp[4][3];
    const bf16* pb = first ? fp : (l15 == 0 ? pprv : pcur - 4); constexpr int pmul = 64;
    bf16x8 fr[8];
    if (PIPE) {
        prep_load_fr(fr, F, r0);
#pragma unroll
        for (int ntl = 0; ntl < 4; ++ntl)
#pragma unroll
            for (int sct = 0; sct < 3; ++sct) { xc[ntl][sct] = RP->xc[ntl][sct]; xp[ntl][sct] = RP->xp[ntl][sct]; }
    } else {
#pragma unroll
    for (int g = 0; g < 8; ++g) fr[g] = *(const bf16x8*)((const bf16*)(F.ws + WS_FRG) + ((size_t)((tile * 8 + g) * 4 + q) * 16 + l15) * 8);
#pragma unroll
    for (int ntl = 0; ntl < 4; ++ntl)
#pragma unroll
        for (int sct = 0; sct < 3; ++sct) xc[ntl][sct] = *(const v2u*)(pcur + (size_t)(128 * sct + 16 * h + 4 * ntl + q) * 64);
#pragma unroll
    for (int ntl = 0; ntl < 4; ++ntl)
#pragma unroll
        for (int sct = 0; sct < 3; ++sct) xp[ntl][sct] = *(const v2u*)(pb + (size_t)(128 * sct + 16 * h + 4 * ntl + q) * pmul);
    }
    v2u xm[4][3];
    const float* k_k = A.in[17];
    float ss = 0.f, bon = 0.f;
#pragma unroll
    for (int ntl = 0; ntl < 4; ++ntl)
#pragma unroll
        for (int sct = 0; sct < 3; ++sct) { const int col = 512 * sct + 64 * h + 16 * ntl + 4 * q; float cur[4], prv[4], x[4]; unpack4(xc[ntl][sct], cur); unpack4(xp[ntl][sct], prv);
            const f32x4 m0 = *(const f32x4*)(mu + col);
#pragma unroll
            for (int e = 0; e < 4; ++e) x[e] = cur[e] + (prv[e] - cur[e]) * m0[e];
            xm[ntl][sct] = pack4(x);
            if (sct == 1) { float xb[4]; unpack4(xm[ntl][sct], xb); const f32x4 kkv = *(const f32x4*)(k_k + 64 * h + 16 * ntl + 4 * q);
#pragma unroll
                for (int e = 0; e < 4; ++e) { const float kr = xb[e] * kkv[e]; ss += kr * kr; } } }
    __builtin_amdgcn_sched_barrier(0);
    if (PIPE && r0next >= 0) prep_load_x(*RP, F, r0next, h);
    ss += __shfl_xor(ss, 16); ss += __shfl_xor(ss, 32);
    const float inv = 1.0f / fmaxf(sqrtf(ss), 1e-12f);
    const LAS bf16x8* wl = (const LAS bf16x8*)(F.lds + RING_OFF) + F.lane;
    const LAS float* hp = (const LAS float*)(F.lds + RING_OFF + 32768);
    const bf16* gW = (const bf16*)(F.ws + WS_WLT) + (size_t)(64 * h + l15) * 64 + 8 * q; const bf16* gA = (const bf16*)(F.ws + WS_ALT) + (size_t)(64 * h + l15) * 64 + 8 * q; const bf16* gG = (const bf16*)(F.ws + WS_GLT) + (size_t)(64 * h + l15) * 128 + 8 * q;
    const float* g_w0 = A.in[12]; const float* g_a0 = A.in[14]; const float* g_ka = A.in[18]; const float* g_rk = A.in[19];
#define PREP_WL(f) (GL ? ((f) < 8 ? *(const bf16x8*)(gW + (size_t)(16 * ((f) >> 1)) * 64 + 32 * ((f) & 1)) : (f) < 16 ? *(const bf16x8*)(gA + (size_t)(16 * (((f) - 8) >> 1)) * 64 + 32 * ((f) & 1)) : *(const bf16x8*)(gG + (size_t)(16 * (((f) - 16) >> 2)) * 128 + 32 * ((f) & 3))) : wl[(f) * 64])
#pragma unroll 1
    for (int ntl = 0; ntl < 4; ++ntl) {
        const int n0 = 64 * h + 16 * ntl, c0 = n0 + 4 * q;
        f32x4 aw = {0.f, 0.f, 0.f, 0.f}, aa = aw, ag = aw;
#pragma unroll
        for (int ks = 0; ks < 2; ++ks) {
            aw = __builtin_amdgcn_mfma_f32_16x16x32_bf16(PREP_WL(2 * ntl + ks), fr[ks], aw, 0, 0, 0);
            aa = __builtin_amdgcn_mfma_f32_16x16x32_bf16(PREP_WL(8 + 2 * ntl + ks), fr[2 + ks], aa, 0, 0, 0); }
#pragma unroll
        for (int ks = 0; ks < 4; ++ks)
            ag = __builtin_amdgcn_mfma_f32_16x16x32_bf16(PREP_WL(16 + 4 * ntl + ks), fr[4 + ks], ag, 0, 0, 0);
        const int cl = 16 * ntl + 4 * q;
        f32x4 w0v, a0v, kkv, kav, rkv;
        if (GL) { w0v = *(const f32x4*)(g_w0 + 64 * h + cl); a0v = *(const f32x4*)(g_a0 + 64 * h + cl); kkv = *(const f32x4*)(k_k + 64 * h + cl); kav = *(const f32x4*)(g_ka + 64 * h + cl); rkv = *(const f32x4*)(g_rk + 64 * h + cl); }
        else { w0v = *(const LAS f32x4*)(hp + cl); a0v = *(const LAS f32x4*)(hp + 64 + cl); kkv = *(const LAS f32x4*)(hp + 128 + cl); kav = *(const LAS f32x4*)(hp + 192 + cl); rkv = *(const LAS f32x4*)(hp + 256 + cl); }
        float omd[4], km[4], gg[4], kk[4], bb[4], xrf[4], xkf[4]; unpack4(xm[0][0], xrf); unpack4(xm[0][1], xkf);
#pragma unroll
        for (int e = 0; e < 4; ++e) {
            const float z = -(w0v[e] + aw[e]);
            const float sp = z > 20.f ? z : __logf(1.0f + __expf(z));
            const float wlog = -sp - 0.5f;
            const float dec = __expf(-__expf(wlog));
            omd[e] = 1.0f - dec;
            const float a = sigmoid_f(a0v[e] + aa[e]);
            kk[e] = xkf[e] * kkv[e] * inv; bb[e] = kk[e] * a;
            km[e] = xkf[e] * (1.0f + (a - 1.0f) * kav[e]);
            bon += xrf[e] * km[e] * rkv[e];
            gg[e] = ag[e];
        }
        const size_t o = sc_off(row, c0);
        *(v2u*)(((bf16*)(F.ws + WS_SC)) + o) = xm[0][0]; *(v2u*)(((bf16*)(F.ws + (WS_SC + SC_STRIDE))) + o) = pack4(km); *(v2u*)(((bf16*)(F.ws + (WS_SC + 2 * SC_STRIDE))) + o) = xm[0][2];
        *(v2u*)(((bf16*)(F.ws + (WS_SC + 3 * SC_STRIDE))) + o) = pack4(kk); *(v2u*)(((bf16*)(F.ws + (WS_SC + 4 * SC_STRIDE))) + o) = pack4(bb);
        *(v2u*)(((bf16*)(F.ws + (WS_SC + 5 * SC_STRIDE))) + o) = pack4(omd); *(v2u*)(((bf16*)(F.ws + WS_G)) + o) = pack4(gg);
#pragma unroll
        for (int i = 0; i < 3; ++i)
#pragma unroll
            for (int e = 0; e < 3; ++e) xm[i][e] = xm[i + 1][e];
    }
    bon += __shfl_xor(bon, 16); bon += __shfl_xor(bon, 32);
    if (q == 0) ((float*)(F.ws + WS_BON))[(size_t)row * 8 + h] = bon;
#undef PREP_WL
}
__device__ __forceinline__ void prep_all(Frame& F, const InAcc& A) {
    const int w = blockIdx.x, h = w & 7; const int nslots = (F.G >> 3) * NWAVES;
    if (F.G & 7) return;
    { const bf16* WLT = (const bf16*)(F.ws + WS_WLT); const bf16* ALT = (const bf16*)(F.ws + WS_ALT); const bf16* GLT = (const bf16*)(F.ws + WS_GLT);
      LAS v4u* dst = (LAS v4u*)(F.lds + RING_OFF);
#pragma unroll
      for (int i = 0; i < 4; ++i) { const int p = F.tid + 512 * i, f = p >> 6, L = p & 63, l15 = L & 15, q = L >> 4;
          const bf16* src;
          if (f < 8) src = WLT + (size_t)(64 * h + 16 * (f >> 1) + l15) * 64 + 32 * (f & 1) + 8 * q;
          else if (f < 16) src = ALT + (size_t)(64 * h + 16 * ((f - 8) >> 1) + l15) * 64 + 32 * (f & 1) + 8 * q;
          else src = GLT + (size_t)(64 * h + 16 * ((f - 16) >> 2) + l15) * 128 + 32 * (f & 3) + 8 * q;
          dst[p] = *(const v4u*)src; }
      if (F.tid < 320) { const int a = F.tid >> 6, i = F.tid & 63; const float* src = a == 0 ? A.in[12] : a == 1 ? A.in[14] : a == 2 ? A.in[17] : a == 3 ? A.in[18] : A.in[19];
          ((LAS float*)(F.lds + RING_OFF + 32768))[F.tid] = src[64 * h + i]; }
      __syncthreads(); }
    { PrepRaw R; int tt = (w >> 3) * NWAVES + F.wave;
      if (tt < MP / 16) prep_load_x(R, F, 16 * tt, h);
      for (; tt < MP / 16; tt += nslots) prep_item<false, true>(F, A, 16 * tt, h, &R, tt + nslots < MP / 16 ? 16 * (tt + nslots) : -1); }
    __syncthreads();
}
__device__ __forceinline__ void lnv_rows(Frame& F, const InAcc& A) {
    const f32x4 g0 = *(const f32x4*)(A.in[22] + 8 * F.lane), g1 = *(const f32x4*)(A.in[22] + 8 * F.lane + 4), b0 = *(const f32x4*)(A.in[23] + 8 * F.lane), b1 = *(const f32x4*)(A.in[23] + 8 * F.lane + 4);
    const float gg[8] = {g0.x, g0.y, g0.z, g0.w, g1.x, g1.y, g1.z, g1.w}, bb[8] = {b0.x, b0.y, b0.z, b0.w, b1.x, b1.y, b1.z, b1.w};
    v4u* const pbase = (v4u*)(((bf16*)(F.ws + WS_PUV)) + 512) + F.lane;
    int row = F.gw;
    v4u cur = {0u, 0u, 0u, 0u}, n1 = cur, n2 = cur;
    if (row < M) cur = pbase[(size_t)row * 128];
    if (row + F.NGW < M) n1 = pbase[(size_t)(row + F.NGW) * 128];
    for (; row < M; row += F.NGW) {
        if (row + 2 * F.NGW < M) n2 = pbase[(size_t)(row + 2 * F.NGW) * 128];
        float x[8]; unpack8(cur, x);
        float s = 0.f;
#pragma unroll
        for (int e = 0; e < 8; ++e) s += x[e];
        const float mean = wave_sum(s) * (1.0f / 512.0f); float qq = 0.f;
#pragma unroll
        for (int e = 0; e < 8; ++e) { x[e] -= mean; qq += x[e] * x[e]; }
        const float rstd = 1.0f / sqrtf(wave_sum(qq) * (1.0f / 512.0f) + LN_EPS);
#pragma unroll
        for (int e = 0; e < 8; ++e) x[e] = x[e] * rstd * gg[e] + bb[e];
        pbase[(size_t)row * 128] = pack8(x);
        if (row >= MP) { float* o = F.out + O_CVS + (size_t)(row - MP) * 512 + 8 * F.lane; *(f32x4*)o = (f32x4){x[0], x[1], x[2], x[3]}; *(f32x4*)(o + 4) = (f32x4){x[4], x[5], x[6], x[7]}; }
        cur = n1; n1 = n2;
    }
}
template <bool SAMP> __device__ __forceinline__ void gmlp_item(Frame& F, const InAcc& A, int ci, int h, LAS unsigned short* tile  ) {
    const int l15 = F.lane & 15, q = F.lane >> 4;
    const int base = SAMP ? MP + 8 * ci : 128 * ci;
    const bf16* P = (const bf16*)(F.ws + WS_PUV);
    const bf16* WSB = (const bf16*)(F.ws + WS_WSB);
    const float* b_s = A.in[25];
    constexpr int NIT = SAMP ? 1 : 8, NKS = SAMP ? 1 : 4;
    v4u xs[SAMP ? 1 : 16];
#pragma unroll
    for (int i = 0; i < (SAMP ? 1 : 16); ++i) { const int r = 8 * i + (F.lane >> 3), c8 = (F.lane & 7) * 8; xs[i] = *(const v4u*)(P + (size_t)(base + r) * 1024 + 512 + h * 64 + c8); }
    float bs[NIT];
#pragma unroll
    for (int it = 0; it < NIT; ++it) bs[it] = b_s[h * 128 + 16 * it + l15];
#pragma unroll
    for (int i = 0; i < (SAMP ? 1 : 16); ++i) { const int r = 8 * i + (F.lane >> 3), c8 = (F.lane & 7) * 8; LAS unsigned* d = (LAS unsigned*)(tile + r * 66 + c8); d[0] = xs[i].x; d[1] = xs[i].y; d[2] = xs[i].z; d[3] = xs[i].w; }
    LDS_WAIT(); asm volatile("" ::: "memory");
#pragma unroll 1
    for (int dt = 0; dt < 4; ++dt) {
        const int cc = h * 64 + 16 * dt + 4 * q;
        v2u pu[NIT];
#pragma unroll
        for (int it = 0; it < NIT; ++it) pu[it] = *(const v2u*)(P + (size_t)(base + (SAMP ? (l15 & 7) : 16 * it + l15)) * 1024 + cc);
        bf16x8 vf[NKS];
#pragma unroll
        for (int ks = 0; ks < NKS; ++ks)
#pragma unroll
            for (int jj = 0; jj < 8; ++jj) { const int jr = 32 * ks + 8 * q + jj; vf[ks][jj] = (SAMP && jr >= 8) ? (short)0 : (short)tile[jr * 66 + 16 * dt + l15]; }
#pragma unroll
        for (int it = 0; it < NIT; ++it) {
            f32x4 acc = {0.f, 0.f, 0.f, 0.f};
#pragma unroll
            for (int ks = 0; ks < NKS; ++ks) if (ks <= (it >> 1))
                acc = __builtin_amdgcn_mfma_f32_16x16x32_bf16(vf[ks], *(const bf16x8*)(WSB + ((size_t)(h * 128 + 16 * it + l15)) * 128 + 32 * ks + 8 * q), acc, 0, 0, 0);
            const int i = 16 * it + l15;
            if (!SAMP || i < 8) { const int row = base + i;
                float puf[4]; unpack4(pu[it], puf);
                float o[4];
#pragma unroll
                for (int e = 0; e < 4; ++e) o[e] = puf[e] * (acc[e] + bs[it]);
                *(v2u*)(((bf16*)(F.ws + WS_XN)) + (size_t)row * D + 512 + cc) = pack4(o); }
        }
    }
    LDS_WAIT(); asm volatile("" ::: "memory");
}
__device__ __forceinline__ float red16(float x) {
    x += __builtin_bit_cast(float, __builtin_amdgcn_update_dpp(0, __builtin_bit_cast(int, x), 0x128, 0xf, 0xf, false));
    x += __builtin_bit_cast(float, __builtin_amdgcn_update_dpp(0, __builtin_bit_cast(int, x), 0x124, 0xf, 0xf, false));
    x += __builtin_bit_cast(float, __builtin_amdgcn_update_dpp(0, __builtin_bit_cast(int, x), 0x122, 0xf, 0xf, false));
    x += __builtin_bit_cast(float, __builtin_amdgcn_update_dpp(0, __builtin_bit_cast(int, x), 0x121, 0xf, 0xf, false));
    return x;
}
typedef float f32x2 __attribute__((ext_vector_type(2)));
#define DPP_ROR(x, n) __builtin_bit_cast(float, __builtin_amdgcn_update_dpp(0, __builtin_bit_cast(int, (x)), 0x120 + (n), 0xf, 0xf, false))
__device__ __forceinline__ void red16x2(float& a, float& b) {
    a += DPP_ROR(a, 8); b += DPP_ROR(b, 8); a += DPP_ROR(a, 4); b += DPP_ROR(b, 4); a += DPP_ROR(a, 2); b += DPP_ROR(b, 2); a += DPP_ROR(a, 1); b += DPP_ROR(b, 1);
}
__device__ __forceinline__ float wkv_step(f32x4& S, const f32x4 w, const f32x4 kk, const f32x4 bb, const f32x4 k, const f32x4 r, const float vv, float& ypend) {
    f32x2 Sa = {S.x, S.y}, Sb = {S.z, S.w};
    f32x2 p = Sa * (f32x2){kk.x, kk.y}; p = Sb * (f32x2){kk.z, kk.w} + p;
    float d = p.x + p.y;
    red16x2(d, ypend);
    const f32x2 v2 = {vv, vv};
    f32x2 Ta = (f32x2){k.x, k.y} * v2, Tb = (f32x2){k.z, k.w} * v2;
    Ta = Sa * (f32x2){w.x, w.y} + Ta; Tb = Sb * (f32x2){w.z, w.w} + Tb;
    const f32x2 nd = {-d, -d};
    Sa = (f32x2){bb.x, bb.y} * nd + Ta; Sb = (f32x2){bb.z, bb.w} * nd + Tb;
    f32x2 yv = Sa * (f32x2){r.x, r.y}; yv = Sb * (f32x2){r.z, r.w} + yv;
    S = (f32x4){Sa.x, Sa.y, Sb.x, Sb.y};
    return yv.x + yv.y;
}
__device__ __forceinline__ void scan_sample_seq(Frame& F, const InAcc& A, int sbh) {
    const int sb = sbh >> 3, h = sbh & 7, j = F.lane & 15, vq = F.lane >> 4;
    const float* Sin = A.in[3];
    const size_t ro0 = (size_t)(MP + 8 * sb) * RW + h * 64;
    const bf16* scr = (const bf16*)(F.ws + WS_SC);
    v2u lw[8], lkk[8], lbb[8], lk[8], lr[8];
#pragma unroll
    for (int t = 0; t < 8; ++t) { const int row = MP + 8 * sb + t; const size_t ro = sc_off(row, h * 64 + 4 * j);
        lw[t] = *(const v2u*)(scr + 5 * (SC_STRIDE / 2) + ro); lkk[t] = *(const v2u*)(scr + 3 * (SC_STRIDE / 2) + ro); lbb[t] = *(const v2u*)(scr + 4 * (SC_STRIDE / 2) + ro);
        lk[t] = *(const v2u*)(scr + 1 * (SC_STRIDE / 2) + ro); lr[t] = *(const v2u*)(scr + ro); }
    f32x4 nS0, nS1; unsigned nv0[8], nv1[8];
#define SS_FETCH(rp_) do { const int v0_ = 8 * (rp_) + vq; const size_t so_ = ((size_t)sbh * 64 + v0_) * 64 + 4 * j; nS0 = *(const f32x4*)(Sin + so_); nS1 = *(const f32x4*)(Sin + so_ + 4 * 64); \
        _Pragma("unroll") for (int t = 0; t < 8; ++t) { const int row = MP + 8 * sb + t; nv0[t] = scr[2 * (SC_STRIDE / 2) + sc_off(row, h * 64 + v0_)]; nv1[t] = scr[2 * (SC_STRIDE / 2) + sc_off(row, h * 64 + v0_ + 4)]; } } while (0)
    SS_FETCH(0);
#pragma unroll 1
    for (int rp = 0; rp < 8; ++rp) {
        f32x4 S0 = nS0, S1 = nS1; unsigned lv0[8], lv1[8];
#pragma unroll
        for (int t = 0; t < 8; ++t) { lv0[t] = nv0[t]; lv1[t] = nv1[t]; }
        asm volatile("" ::: "memory");
        if (rp + 1 < 8) SS_FETCH(rp + 1);
#pragma unroll
        for (int t = 0; t < 8; ++t) asm volatile("" : "+v"(lw[t]), "+v"(lkk[t]), "+v"(lbb[t]), "+v"(lk[t]), "+v"(lr[t]));
        const int v0 = 8 * rp + vq, v1 = v0 + 4;
        float yk0 = 0.f, yk1 = 0.f;
#pragma unroll
        for (int t = 0; t < 8; ++t) {
            float w[4], kk[4], bb[4], k[4], r[4];
            unpack4(lw[t], w); unpack4(lkk[t], kk); unpack4(lbb[t], bb); unpack4(lk[t], k); unpack4(lr[t], r);
            const f32x4 w4 = {1.f - w[0], 1.f - w[1], 1.f - w[2], 1.f - w[3]}, kk4 = {kk[0], kk[1], kk[2], kk[3]}, bb4 = {bb[0], bb[1], bb[2], bb[3]}, k4 = {k[0], k[1], k[2], k[3]}, r4 = {r[0], r[1], r[2], r[3]};
            float dm0 = 0.f; const float y0 = red16(wkv_step(S0, w4, kk4, bb4, k4, r4, bf2f((unsigned short)lv0[t]), dm0));
            float dm1 = 0.f; const float y1 = red16(wkv_step(S1, w4, kk4, bb4, k4, r4, bf2f((unsigned short)lv1[t]), dm1));
            yk0 = (j == t) ? y0 : yk0; yk1 = (j == t) ? y1 : yk1;
        }
        if (j < 8) { unsigned short* yg = ((unsigned short*)(F.ws + WS_Y)) + ro0 + (size_t)j * RW; const unsigned pk_ = pk2(yk0, yk1); yg[v0] = (unsigned short)(pk_ & 0xffffu); yg[v1] = (unsigned short)(pk_ >> 16); }
        const size_t so0 = ((size_t)sbh * 64 + v0) * 64 + 4 * j;
        *(f32x4*)(F.out + O_WKVS + so0) = S0; *(f32x4*)(F.out + O_WKVS + so0 + 4 * 64) = S1;
    }
#undef SS_FETCH
}
typedef short bf16x4 __attribute__((ext_vector_type(4)));
#define PADV(x) asm volatile("s_nop 15\n\ts_nop 15" : "+v"(x))
#define MFMA16(a, b, c) __builtin_amdgcn_mfma_f32_16x16x16bf16_1k((a), (b), (c), 0, 0, 0)
#define MFMA32(a, b, c) __builtin_amdgcn_mfma_f32_16x16x32_bf16((a), (b), (c), 0, 0, 0)
typedef float f32x2_cv __attribute__((ext_vector_type(2))); typedef __bf16 bf16x2_cv __attribute__((ext_vector_type(2)));
__device__ __forceinline__ unsigned hpk2(float lo, float hi) { const f32x2_cv v = {lo, hi}; return __builtin_bit_cast(unsigned, __builtin_convertvector(v, bf16x2_cv)); }
__device__ __forceinline__ bf16x4 cvt4(const f32x4 v) { v2u w; w.x = hpk2(v.x, v.y); w.y = hpk2(v.z, v.w); return __builtin_bit_cast(bf16x4, w); }
__device__ __forceinline__ bf16x8 cvt8(const f32x4 a, const f32x4 b) { v4u w; w.x = hpk2(a.x, a.y); w.y = hpk2(a.z, a.w); w.z = hpk2(b.x, b.y); w.w = hpk2(b.z, b.w); return __builtin_bit_cast(bf16x8, w); }
__device__ __forceinline__ bf16x8 hpack8(const float* f) { v4u w; w.x = hpk2(f[0], f[1]); w.y = hpk2(f[2], f[3]); w.z = hpk2(f[4], f[5]); w.w = hpk2(f[6], f[7]); return __builtin_bit_cast(bf16x8, w); }
__device__ __forceinline__ v2u hpack4(const float* f) { v2u w; w.x = hpk2(f[0], f[1]); w.y = hpk2(f[2], f[3]); return w; }
#define DPP_SHR(x, n, fill) __builtin_bit_cast(float, __builtin_amdgcn_update_dpp(__builtin_bit_cast(int, (float)(fill)), __builtin_bit_cast(int, (x)), 0x110 + (n), 0xf, 0xf, false))
#ifndef CK_NH
#define CK_NH 4
#endif
#ifndef SIDE_MASK
#define SIDE_MASK 7
#endif
#ifndef CK_AHEAD
#define CK_AHEAD 7
#endif
#ifndef CK_DUMMY_CUT
#define CK_DUMMY_CUT 0
#endif
constexpr int CK_SLOT_B = 11776, CK_NSLOT = 8, CK_FLAG_OFF = CK_SLOT_B * CK_NSLOT, CK_SIDE_B = 17408;
constexpr int CK_KH = 0, CK_RH = 2048, CK_AKK = 4096, CK_AKR = 4608, CK_ABR = 5120, CK_TM = 5632, CK_VM = 6144, CK_KB = 6656, CK_BB = 8704, CK_GC = 10752, CK_VM2 = 11264;
static_assert(CK_FLAG_OFF + 256 <= LDSCTL_OFF && 8 * CK_SIDE_B <= LDSCTL_OFF, "chunked scan LDS map");
struct CkRaw { v2u w[4], kk[4], bb[4], kv[4], r[4]; unsigned vraw[8]; };
struct CkOff { unsigned o[4], ov[8]; };
__device__ __forceinline__ void ck_offsets(CkOff& O, Frame& F, int h, int qtr) {
    const int l15 = F.lane & 15, q = F.lane >> 4;
#pragma unroll
    for (int p = 0; p < 4; ++p) O.o[p] = (unsigned)(((16 * h + 8 * (p >> 1) + 4 * (p & 1) + q) * 16 + l15) * 8);
#pragma unroll
    for (int jj = 0; jj < 8; ++jj) { const int cv = 64 * h + 16 * (qtr + (jj >> 2)) + l15; O.ov[jj] = (unsigned)((((cv >> 2) * 16 + 4 * q + (jj & 3)) * 4 + (cv & 3)) * 2); }
}
__device__ __forceinline__ void chunk_load(CkRaw& R, Frame& F, const CkOff& O, int tile) {
    const char* b0 = (const char*)(F.ws + WS_SC) + (size_t)tile * 16384;
#pragma unroll
    for (int p = 0; p < 4; ++p) {
        R.w[p] = *(const v2u*)(b0 + 5 * SC_STRIDE + O.o[p]); R.kk[p] = *(const v2u*)(b0 + 3 * SC_STRIDE + O.o[p]); R.bb[p] = *(const v2u*)(b0 + 4 * SC_STRIDE + O.o[p]);
        R.kv[p] = *(const v2u*)(b0 + 1 * SC_STRIDE + O.o[p]); R.r[p] = *(const v2u*)(b0 + O.o[p]); }
#pragma unroll
    for (int jj = 0; jj < 8; ++jj) R.vraw[jj] = *(const unsigned short*)(b0 + 2 * SC_STRIDE + O.ov[jj]);
}
template <int CUT = 0> __device__ __forceinline__ void chunk_prepare(Frame& F, CkRaw& R, const CkOff& O, int tnext, LAS unsigned char* slot, LAS unsigned short* scr) {
    const int l15 = F.lane & 15, q = F.lane >> 4;
    float w[16], kk[16], bb[16], kv[16], r[16];
#pragma unroll
    for (int p = 0; p < 4; ++p) { unpack4(R.w[p], w + 4 * p); unpack4(R.kk[p], kk + 4 * p); unpack4(R.bb[p], bb + 4 * p); unpack4(R.kv[p], kv + 4 * p); unpack4(R.r[p], r + 4 * p); }
    unsigned short vraw[8];
#pragma unroll
    for (int jj = 0; jj < 8; ++jj) vraw[jj] = (unsigned short)R.vraw[jj];
    asm volatile("" ::: "memory");
    if (tnext >= 0) chunk_load(R, F, O, tnext);
    float kh[16], rh[16], kt[16], bt[16], Kb[16], Bb[16];
    {
        float g[16];
#pragma unroll
        for (int c = 0; c < 16; ++c) g[c] = 1.0f - w[c];
#pragma unroll
        for (int c = 0; c < 16; ++c) asm volatile("s_nop 1\n\tv_mul_f32_dpp %0, %0, %0 row_shr:1 row_mask:0xf bank_mask:0xf" : "+v"(g[c]));
#pragma unroll
        for (int c = 0; c < 16; ++c) asm volatile("v_mul_f32_dpp %0, %0, %0 row_shr:2 row_mask:0xf bank_mask:0xf" : "+v"(g[c]));
#pragma unroll
        for (int c = 0; c < 16; ++c) asm volatile("v_mul_f32_dpp %0, %0, %0 row_shr:4 row_mask:0xf bank_mask:0xf" : "+v"(g[c]));
#pragma unroll
        for (int c = 0; c < 16; ++c) asm volatile("v_mul_f32_dpp %0, %0, %0 row_shr:8 row_mask:0xf bank_mask:0xf" : "+v"(g[c]));
#pragma unroll
        for (int c = 0; c < 16; ++c) { float gC;
            asm volatile("v_mov_b32_dpp %0, %1 row_newbcast:15 row_mask:0xf bank_mask:0xf" : "=v"(gC) : "v"(g[c]));
            w[c] = gC; }
#pragma unroll
        for (int c = 0; c < 16; ++c) { float khc = kk[c];
            asm volatile("v_mul_f32_dpp %0, %1, %0 row_shr:1 row_mask:0xf bank_mask:0xf" : "+v"(khc) : "v"(g[c]));
            kh[c] = khc; }
#pragma unroll
        for (int c = 0; c < 16; ++c) { const float inv = __builtin_amdgcn_rcpf(g[c]);
            rh[c] = g[c] * r[c]; kt[c] = kv[c] * inv; bt[c] = bb[c] * inv; Kb[c] = kt[c] * w[c]; Bb[c] = -(bt[c] * w[c]); }
    }
    if (CUT == 1) { float s_ = 0.f;
#pragma unroll
        for (int c = 0; c < 16; ++c) s_ += kh[c] + rh[c] + kt[c] + bt[c] + Kb[c] + Bb[c] + w[c]; if (s_ == 1.2345f) *(LAS float*)slot = s_ + (float)vraw[0] + (float)vraw[3]; return; }
    const bf16x8 khf0 = hpack8(kh), khf1 = hpack8(kh + 8), rhf0 = hpack8(rh), rhf1 = hpack8(rh + 8);
    const bf16x8 ktf0 = hpack8(kt), ktf1 = hpack8(kt + 8), btf0 = hpack8(bt), btf1 = hpack8(bt + 8);
    const f32x4 z4 = {0.f, 0.f, 0.f, 0.f};
    f32x4 Akk = MFMA32(ktf1, khf1, MFMA32(ktf0, khf0, z4)), Abk = MFMA32(btf1, khf1, MFMA32(btf0, khf0, z4)), AbkT = MFMA32(khf1, btf1, MFMA32(khf0, btf0, z4));
    f32x4 Akr = MFMA32(ktf1, rhf1, MFMA32(ktf0, rhf0, z4)), Abr = MFMA32(btf1, rhf1, MFMA32(btf0, rhf0, z4));
    PADV(Akk); PADV(Abk); PADV(AbkT); PADV(Akr); PADV(Abr);
    f32x4 Id;
#pragma unroll
    for (int e = 0; e < 4; ++e) { const int rr = 4 * q + e;
        Akk[e] = rr < l15 ? Akk[e] : 0.f; Abk[e] = rr < l15 ? Abk[e] : 0.f; AbkT[e] = l15 < rr ? AbkT[e] : 0.f;
        Akr[e] = rr <= l15 ? Akr[e] : 0.f; Abr[e] = rr <= l15 ? -Abr[e] : 0.f; Id[e] = rr == l15 ? 1.f : 0.f; }
#define CK_MM(Xt, Y) MFMA16(cvt4(Xt), cvt4(Y), z4)
    f32x4 A2 = CK_MM(AbkT, Abk), A2t = CK_MM(Abk, AbkT); PADV(A2); PADV(A2t);
    f32x4 A4 = CK_MM(A2t, A2), A4t = CK_MM(A2, A2t); PADV(A4); PADV(A4t);
    f32x4 A8 = CK_MM(A4t, A4); PADV(A8);
    f32x4 P = Id + A8; P = CK_MM(Id + A4t, P); PADV(P); P = CK_MM(Id + A2t, P); PADV(P); P = CK_MM(Id - AbkT, P); PADV(P);
#undef CK_MM
    if (CUT == 2) { const f32x4 s_ = P + Akk + Akr + Abr; if (s_[0] + s_[1] + s_[2] + s_[3] == 1.2345f) *(LAS float*)slot = s_[0] + Kb[0] + Bb[0] + w[0] + (float)vraw[0]; return; }
    LAS bf16x8* s8 = (LAS bf16x8*)slot; s8[F.lane] = khf0; s8[64 + F.lane] = khf1; s8[128 + F.lane] = rhf0; s8[192 + F.lane] = rhf1;
    LAS bf16x4* s4 = (LAS bf16x4*)slot;
    s4[CK_AKK / 8 + F.lane] = cvt4(Akk); s4[CK_AKR / 8 + F.lane] = cvt4(Akr); s4[CK_ABR / 8 + F.lane] = cvt4(Abr); s4[CK_TM / 8 + F.lane] = cvt4(P);
    { bf16x4 vm; vm[0] = (short)vraw[0]; vm[1] = (short)vraw[1]; vm[2] = (short)vraw[2]; vm[3] = (short)vraw[3]; s4[CK_VM / 8 + F.lane] = vm; }
    { bf16x4 vm; vm[0] = (short)vraw[4]; vm[1] = (short)vraw[5]; vm[2] = (short)vraw[6]; vm[3] = (short)vraw[7]; s4[CK_VM2 / 8 + F.lane] = vm; }
    if (CUT == 3) { if (Kb[0] + Bb[0] + w[0] == 1.2345f) *(LAS float*)slot = Kb[1]; LDS_WAIT(); return; }
    { bf16x4 idb;
#pragma unroll
      for (int e = 0; e < 4; ++e) idb[e] = (4 * q + e == l15) ? (short)0x3F80 : (short)0;
      f32x4 tk[4], tb[4];
#pragma unroll
      for (int nt = 0; nt < 4; ++nt) { tk[nt] = MFMA16(__builtin_bit_cast(bf16x4, hpack4(Kb + 4 * nt)), idb, z4); tb[nt] = MFMA16(__builtin_bit_cast(bf16x4, hpack4(Bb + 4 * nt)), idb, z4); }
      asm volatile("s_nop 15\n\ts_nop 15" : "+v"(tk[0]), "+v"(tk[1]), "+v"(tk[2]), "+v"(tk[3]), "+v"(tb[0]), "+v"(tb[1]), "+v"(tb[2]), "+v"(tb[3]));
#pragma unroll
      for (int nt = 0; nt < 4; ++nt) { s4[CK_KB / 8 + nt * 64 + F.lane] = cvt4(tk[nt]); s4[CK_BB / 8 + nt * 64 + F.lane] = cvt4(tb[nt]); } }
    if (l15 == 15) {
#pragma unroll
        for (int p = 0; p < 4; ++p) *(LAS f32x4*)(slot + CK_GC + 4 * (32 * (p >> 1) + 16 * (p & 1) + 4 * q)) = (f32x4){w[4 * p], w[4 * p + 1], w[4 * p + 2], w[4 * p + 3]}; }
    LDS_WAIT(); asm volatile("" ::: "memory");
}
#ifdef CK_DUMMY_MODE
__device__ __forceinline__ void dummy_work(Frame& F, int h, int t0, LAS unsigned char* area) {
    const f32x4 z4 = {0.f, 0.f, 0.f, 0.f}; f32x4 acc = z4; float sink = 0.f;
#if CK_DUMMY_MODE == 1
    bf16x8 a; for (int j = 0; j < 8; ++j) a[j] = (short)(0x3f80 + F.lane + j);
    for (int i = 0; i < 64; ++i) { acc = MFMA32(a, a, acc); asm volatile("" : "+v"(acc)); }
    sink = acc[0];
#elif CK_DUMMY_MODE == 2
    LAS f32x4* p = (LAS f32x4*)area + F.lane;
#pragma unroll 1
    for (int i = 0; i < 40; ++i) { LAS f32x4* pw = p + 64 * (i & 7); *pw = (f32x4){(float)i, 1.f, 2.f, 3.f}; asm volatile("s_waitcnt lgkmcnt(0)" ::: "memory"); const LAS f32x4* pr = p + 64 * ((i + 3) & 7); acc += *pr; }
    sink = acc[0];
#elif CK_DUMMY_MODE == 3
    const bf16* sc = (const bf16*)(F.ws + WS_SC);
    for (int i = 0; i < 24; ++i) { float t[4]; unpack4(*(const v2u*)(sc + (size_t)(i % 6) * (SC_STRIDE / 2) + sc_off(t0 + (F.lane & 15), 64 * h + 4 * ((F.lane >> 4) + 4 * (i & 3)))), t); sink += t[0] + t[3]; }
#elif CK_DUMMY_MODE == 4
    float g = 1.0f + 0.001f * F.lane;
    for (int i = 0; i < 200; ++i) { g *= DPP_SHR(g, 1, 1.0f); g = g * 0.999f + DPP_ROR(g, 4) * 0.001f; asm volatile("" : "+v"(g)); }
    sink = g;
#endif
    if (sink == 123456.789f) ((LAS float*)area)[F.lane] = sink;
}
#endif
struct CkOps { bf16x8 kh0, kh1, rh0, rh1; bf16x4 akk, akr, nabr, tm, vm; f32x4 g[4]; bf16x4 kb[4], nbb[4]; };
template <class T> __device__ __forceinline__ void ck_load_slot(CkOps& X, const LAS unsigned char* slot, int lane, int q, int vmoff) {
    const LAS bf16x8* s8 = (const LAS bf16x8*)slot; const LAS bf16x4* s4 = (const LAS bf16x4*)slot;
    X.kh0 = s8[lane]; X.kh1 = s8[64 + lane]; X.akk = s4[CK_AKK / 8 + lane]; X.vm = s4[vmoff / 8 + lane]; X.tm = s4[CK_TM / 8 + lane];
#pragma unroll
    for (int nt = 0; nt < 4; ++nt) { X.g[nt] = *(const LAS f32x4*)(slot + CK_GC + 4 * (16 * nt + 4 * q)); X.kb[nt] = s4[CK_KB / 8 + nt * 64 + lane]; X.nbb[nt] = s4[CK_BB / 8 + nt * 64 + lane]; }
    X.rh0 = s8[128 + lane]; X.rh1 = s8[192 + lane]; X.akr = s4[CK_AKR / 8 + lane]; X.nabr = s4[CK_ABR / 8 + lane];
}
__device__ __forceinline__ void chain_step(Frame& F, f32x4 (&S)[4], const CkOps& X, CkOps& N, int c, LAS unsigned char* base, volatile LAS int* flg, unsigned short*& yg, int q, int cons  , int vmoff) {
    const f32x4 z4 = {0.f, 0.f, 0.f, 0.f};
    int fnext = 0;
    if (c + 1 < 128) fnext = __hip_atomic_load((LAS int*)&flg[(c + 1) & 7], __ATOMIC_RELAXED, __HIP_MEMORY_SCOPE_WORKGROUP);
#ifdef CK_DELAY
    __builtin_amdgcn_s_sleep(CK_DELAY);
#endif
    const bf16x8 sb0 = cvt8(S[0], S[1]), sb1 = cvt8(S[2], S[3]);
    f32x4 GT = MFMA32(X.kh1, sb1, MFMA32(X.kh0, sb0, z4)); f32x4 G16 = MFMA16(X.akk, X.vm, z4);
    asm volatile("s_nop 15\n\ts_nop 15" : "+v"(GT), "+v"(G16));
    GT += G16;
    f32x4 DT = MFMA16(X.tm, cvt4(GT), z4);
    asm volatile("s_nop 15\n\ts_nop 15" : "+v"(DT));
    const bf16x4 db = cvt4(DT);
#pragma unroll
    for (int nt = 0; nt < 4; ++nt) { f32x4 sg;
#pragma unroll
        for (int e = 0; e < 4; ++e) { float t_; asm("v_mul_f32 %0, %1, %2" : "=v"(t_) : "v"(S[nt][e]), "v"(X.g[nt][e])); sg[e] = t_; }
        S[nt] = MFMA16(X.nbb[nt], db, MFMA16(X.kb[nt], X.vm, sg)); }
    f32x4 YT = MFMA32(X.rh1, sb1, MFMA32(X.rh0, sb0, z4)); f32x4 Y16 = MFMA16(X.nabr, db, MFMA16(X.akr, X.vm, z4));
    asm volatile("s_waitcnt lgkmcnt(0)" ::: "memory");
    __builtin_amdgcn_fence(__ATOMIC_RELEASE, "workgroup");
    if (F.lane == 0) __hip_atomic_store((LAS int*)&flg[cons], c + 1, __ATOMIC_RELEASE, __HIP_MEMORY_SCOPE_WORKGROUP);
    if (c + 1 < 128) {
        if (fnext != c + 2) while (__hip_atomic_load((LAS int*)&flg[(c + 1) & 7], __ATOMIC_ACQUIRE, __HIP_MEMORY_SCOPE_WORKGROUP) != c + 2) __builtin_amdgcn_s_sleep(1);
        __builtin_amdgcn_fence(__ATOMIC_ACQUIRE, "workgroup");
        ck_load_slot<int>(N, base + ((c + 1) & 7) * CK_SLOT_B, F.lane, q, vmoff);
    }
    asm volatile("s_nop 15\n\ts_nop 15" : "+v"(S[0]), "+v"(S[1]), "+v"(S[2]), "+v"(S[3]), "+v"(YT), "+v"(Y16));
    YT += Y16;
    { const unsigned p0_ = hpk2(YT[0], YT[1]), p1_ = hpk2(YT[2], YT[3]);
      yg[0] = (unsigned short)(p0_ & 0xffffu); yg[RW] = (unsigned short)(p0_ >> 16); yg[2 * RW] = (unsigned short)(p1_ & 0xffffu); yg[3 * RW] = (unsigned short)(p1_ >> 16); }
    yg += 16 * RW;
}
__device__ __forceinline__ void scan_prompt_unit(Frame& F, const InAcc& A, int unit) {
    const int xcd = unit & 7, jj_ = unit >> 3, bh = xcd + 8 * (jj_ >> 1), qtr0 = 2 * (jj_ & 1), b = bh >> 3, h = bh & 7;
    const int rowbase = b * 2048;
    LAS unsigned char* const base = F.lds + RING_OFF;
    volatile LAS int* flg = (volatile LAS int*)(base + CK_FLAG_OFF);
    if (F.tid < 32) flg[F.tid] = 0;
    __syncthreads();
    const int l15 = F.lane & 15, q = F.lane >> 4;
    if (F.wave < 2) {
        const int qtr = qtr0 + F.wave, cons = 16 + 2 * F.wave, vmoff = F.wave ? CK_VM2 : CK_VM;
        f32x4 S[4] = {{0.f, 0.f, 0.f, 0.f}, {0.f, 0.f, 0.f, 0.f}, {0.f, 0.f, 0.f, 0.f}, {0.f, 0.f, 0.f, 0.f}};
        unsigned short* yg = (unsigned short*)(F.ws + WS_Y) + (size_t)(rowbase + 4 * q) * RW + h * 64 + 16 * qtr + l15;
        CkOps X, Y;
        __builtin_amdgcn_s_setprio(3);
        while (__hip_atomic_load((LAS int*)&flg[0], __ATOMIC_ACQUIRE, __HIP_MEMORY_SCOPE_WORKGROUP) != 1) __builtin_amdgcn_s_sleep(1);
        __builtin_amdgcn_fence(__ATOMIC_ACQUIRE, "workgroup");
        ck_load_slot<int>(X, base, F.lane, q, vmoff);
        for (int c = 0; c < 128; c += 2) {
            chain_step(F, S, X, Y, c, base, flg, yg, q, cons, vmoff);
            chain_step(F, S, Y, X, c + 1, base, flg, yg, q, cons, vmoff);
        }
        __builtin_amdgcn_s_setprio(0);
#pragma unroll
        for (int nt = 0; nt < 4; ++nt) *(f32x4*)(F.out + O_WKVP + ((size_t)bh * 64 + 16 * qtr + l15) * 64 + 16 * nt + 4 * q) = S[nt];
    } else {
        CkRaw R;
#define CK_CLAIM() __builtin_amdgcn_readfirstlane(F.lane == 0 ? __hip_atomic_fetch_add((LAS int*)&flg[17], 1, __ATOMIC_RELAXED, __HIP_MEMORY_SCOPE_WORKGROUP) : 0)
        int c = CK_CLAIM();
        CkOff O; ck_offsets(O, F, h, qtr0);
        if (c < 128) chunk_load(R, F, O, (rowbase >> 4) + c);
        while (c < 128) {
            const int cn = CK_CLAIM();
            while (min(__hip_atomic_load((LAS int*)&flg[16], __ATOMIC_ACQUIRE, __HIP_MEMORY_SCOPE_WORKGROUP), __hip_atomic_load((LAS int*)&flg[18], __ATOMIC_ACQUIRE, __HIP_MEMORY_SCOPE_WORKGROUP)) < c - CK_AHEAD) __builtin_amdgcn_s_sleep(2);
            __builtin_amdgcn_fence(__ATOMIC_ACQUIRE, "workgroup");
            chunk_prepare(F, R, O, (rowbase >> 4) + (cn < 128 ? cn : 127), base + (c & 7) * CK_SLOT_B, nullptr);
            __builtin_amdgcn_fence(__ATOMIC_RELEASE, "workgroup");
            if (F.lane == 0) __hip_atomic_store((LAS int*)&flg[c & 7], c + 1, __ATOMIC_RELEASE, __HIP_MEMORY_SCOPE_WORKGROUP);
            c = cn;
        }
#undef CK_CLAIM
    }
    __syncthreads();
}
__device__ __forceinline__ void scan_sample_chunked(Frame& F, const InAcc& A, int tl, int hh, LAS unsigned char* slot) {
    const int l15 = F.lane & 15, q = F.lane >> 4;
    const float* Sin = A.in[3];
    const f32x4 z4 = {0.f, 0.f, 0.f, 0.f};
    CkOff O01, O23; ck_offsets(O01, F, hh, 0); ck_offsets(O23, F, hh, 2);
    CkRaw R0; chunk_load(R0, F, O01, (MP >> 4) + tl);
    unsigned v23[8];
    { const char* b0 = (const char*)(F.ws + WS_SC) + (size_t)((MP >> 4) + tl) * 16384;
#pragma unroll
      for (int jj = 0; jj < 8; ++jj) v23[jj] = *(const unsigned short*)(b0 + 2 * SC_STRIDE + O23.ov[jj]); }
#pragma unroll 1
    for (int s = 0; s < 2; ++s) {
        CkRaw R = R0;
        if ((l15 >> 3) != s) { const v2u z = {0u, 0u};
#pragma unroll
            for (int p = 0; p < 4; ++p) { R.w[p] = z; R.kk[p] = z; R.bb[p] = z; R.kv[p] = z; R.r[p] = z; } }
        chunk_prepare(F, R, O01, -1, slot, nullptr);
        const int sbh = (2 * tl + s) * 8 + hh;
#pragma unroll 1
        for (int qt = 0; qt < 4; ++qt) {
            if (qt == 2) { bf16x4 vm; LAS bf16x4* s4 = (LAS bf16x4*)slot;
                vm[0] = (short)v23[0]; vm[1] = (short)v23[1]; vm[2] = (short)v23[2]; vm[3] = (short)v23[3]; s4[CK_VM / 8 + F.lane] = vm;
                vm[0] = (short)v23[4]; vm[1] = (short)v23[5]; vm[2] = (short)v23[6]; vm[3] = (short)v23[7]; s4[CK_VM2 / 8 + F.lane] = vm;
                LDS_WAIT(); asm volatile("" ::: "memory"); }
            f32x4 S[4];
            const size_t so = ((size_t)sbh * 64 + 16 * qt + l15) * 64 + 4 * q;
#pragma unroll
            for (int nt = 0; nt < 4; ++nt) S[nt] = *(const f32x4*)(Sin + so + 16 * nt);
            CkOps X; ck_load_slot<int>(X, slot, F.lane, q, (qt & 1) ? CK_VM2 : CK_VM);
            const bf16x8 sb0 = cvt8(S[0], S[1]), sb1 = cvt8(S[2], S[3]);
            f32x4 GT = MFMA32(X.kh1, sb1, MFMA32(X.kh0, sb0, z4)); f32x4 G16 = MFMA16(X.akk, X.vm, z4);
            asm volatile("s_nop 15\n\ts_nop 15" : "+v"(GT), "+v"(G16));
            GT += G16;
            f32x4 DT = MFMA16(X.tm, cvt4(GT), z4);
            asm volatile("s_nop 15\n\ts_nop 15" : "+v"(DT));
            const bf16x4 db = cvt4(DT);
#pragma unroll
            for (int nt = 0; nt < 4; ++nt) S[nt] = MFMA16(X.nbb[nt], db, MFMA16(X.kb[nt], X.vm, S[nt] * X.g[nt]));
            f32x4 YT = MFMA32(X.rh1, sb1, MFMA32(X.rh0, sb0, z4)); f32x4 Y16 = MFMA16(X.nabr, db, MFMA16(X.akr, X.vm, z4));
            asm volatile("s_nop 15\n\ts_nop 15" : "+v"(S[0]), "+v"(S[1]), "+v"(S[2]), "+v"(S[3]), "+v"(YT), "+v"(Y16));
            YT += Y16;
            if ((q >> 1) == s) {
                unsigned short* yg = (unsigned short*)(F.ws + WS_Y) + (size_t)(MP + 16 * tl + 4 * q) * RW + hh * 64 + 16 * qt + l15;
                const unsigned p0_ = hpk2(YT[0], YT[1]), p1_ = hpk2(YT[2], YT[3]);
                yg[0] = (unsigned short)(p0_ & 0xffffu); yg[RW] = (unsigned short)(p0_ >> 16); yg[2 * RW] = (unsigned short)(p1_ & 0xffffu); yg[3 * RW] = (unsigned short)(p1_ >> 16); }
#pragma unroll
            for (int nt = 0; nt < 4; ++nt) *(f32x4*)(F.out + O_WKVS + so + 16 * nt) = S[nt];
            LDS_WAIT(); asm volatile("" ::: "memory");
        }
    }
}
__device__ __forceinline__ void scan_side_work(Frame& F, const InAcc& A, int sw, int NSW, bool light_elsewhere) {
    LAS unsigned short* tile = (LAS unsigned short*)(F.lds + RING_OFF + F.wave * CK_SIDE_B);
    constexpr int NJOB = (MS / 16) * 8;
    const int njw = NJOB < NSW ? NJOB : NSW;
    if (sw < njw) for (int it = sw; it < NJOB; it += njw) { const int tl = it >> 3, hh = it & 7;
        prep_item<true>(F, A, MP + 16 * tl, hh);
        __builtin_amdgcn_fence(__ATOMIC_RELEASE, "agent"); __builtin_amdgcn_fence(__ATOMIC_ACQUIRE, "agent");
        scan_sample_chunked(F, A, tl, hh, (LAS unsigned char*)tile); }
    const int ng = NSW > njw ? NSW - njw : NSW, gi = NSW > njw ? sw - njw : sw;
    if (gi >= 0) {
        for (int it = gi; it < 1024; it += ng) gmlp_item<false>(F, A, it >> 3, it & 7, tile);
        if (!light_elsewhere) for (int it = ng - 1 - gi; it < 1024; it += ng) gmlp_item<true>(F, A, it >> 3, it & 7, tile);
    }
}
__device__ __forceinline__ void gmlp_light(Frame& F, const InAcc& A, int w, int NW) {
    LAS unsigned short* tile = (LAS unsigned short*)(F.lds + RING_OFF + F.wave * CK_SIDE_B);
    for (int it = w; it < 1024; it += NW) gmlp_item<true>(F, A, it >> 3, it & 7, tile);
}
struct PsRaw { f32x4 y[4]; v2u v[4], g[4]; float bon; };
__device__ __forceinline__ void postscan_load(PsRaw& R, Frame& F, int r0, int h) {
    const int l15 = F.lane & 15, q = F.lane >> 4, row = r0 + l15;
    const bf16* Y = (const bf16*)(F.ws + WS_Y); const bf16* V = (const bf16*)(F.ws + WS_SC + 2 * SC_STRIDE); const bf16* G = (const bf16*)(F.ws + WS_G);
    { const v4u ya = *(const v4u*)(Y + (size_t)row * RW + 64 * h + 16 * q), yb = *(const v4u*)(Y + (size_t)row * RW + 64 * h + 16 * q + 8);
      float t_[4]; unpack4((v2u){ya.x, ya.y}, t_); R.y[0] = (f32x4){t_[0], t_[1], t_[2], t_[3]}; unpack4((v2u){ya.z, ya.w}, t_); R.y[1] = (f32x4){t_[0], t_[1], t_[2], t_[3]};
      unpack4((v2u){yb.x, yb.y}, t_); R.y[2] = (f32x4){t_[0], t_[1], t_[2], t_[3]}; unpack4((v2u){yb.z, yb.w}, t_); R.y[3] = (f32x4){t_[0], t_[1], t_[2], t_[3]}; }
#pragma unroll
    for (int ntl = 0; ntl < 4; ++ntl) { const size_t o = sc_off(row, 64 * h + 16 * q + 4 * ntl); R.v[ntl] = *(const v2u*)(V + o); R.g[ntl] = *(const v2u*)(G + o); }
    R.bon = ((const float*)(F.ws + WS_BON))[(size_t)row * 8 + h];
}
__device__ __forceinline__ void postscan_gnload(Frame& F, const float* gn_w, const float* gn_b, int h, f32x4 (&gw)[4], f32x4 (&gb)[4]) {
    const int q = F.lane >> 4;
#pragma unroll
    for (int ntl = 0; ntl < 4; ++ntl) { const int c0 = 64 * h + 16 * q + 4 * ntl; gw[ntl] = *(const f32x4*)(gn_w + c0); gb[ntl] = *(const f32x4*)(gn_b + c0); }
}
__device__ __forceinline__ void postscan_finish(const PsRaw& R, Frame& F, const f32x4 (&gwv)[4], const f32x4 (&gbv)[4], int r0, int h) {
    const int l15 = F.lane & 15, q = F.lane >> 4, row = r0 + l15;
    float y[4][4]; float s = 0.f;
#pragma unroll
    for (int ntl = 0; ntl < 4; ++ntl) { const f32x4 t = R.y[ntl]; y[ntl][0] = t.x; y[ntl][1] = t.y; y[ntl][2] = t.z; y[ntl][3] = t.w; s += (t.x + t.y) + (t.z + t.w); }
    s += __shfl_xor(s, 16); s += __shfl_xor(s, 32);
    const float mu = s * (1.0f / 64.0f); float qq = 0.f;
#pragma unroll
    for (int ntl = 0; ntl < 4; ++ntl)
#pragma unroll
        for (int e = 0; e < 4; ++e) { y[ntl][e] -= mu; qq += y[ntl][e] * y[ntl][e]; }
    qq += __shfl_xor(qq, 16); qq += __shfl_xor(qq, 32);
    const float rstd = 1.0f / sqrtf(qq * (1.0f / 64.0f) + GN_EPS);
    v2u ow[4];
#pragma unroll
    for (int ntl = 0; ntl < 4; ++ntl) { const int c0 = 64 * h + 16 * q + 4 * ntl;
        const f32x4 gw = gwv[ntl], gb = gbv[ntl];
        float vv[4], gg[4], ov[4]; unpack4(R.v[ntl], vv); unpack4(R.g[ntl], gg);
#pragma unroll
        for (int e = 0; e < 4; ++e) ov[e] = (y[ntl][e] * rstd * gw[e] + gb[e] + R.bon * vv[e]) * gg[e];
        ow[ntl] = pack4(ov); }
    { bf16* o = ((bf16*)(F.ws + WS_XN)) + (size_t)row * D + 64 * h + 16 * q;
      *(v4u*)o = (v4u){ow[0].x, ow[0].y, ow[1].x, ow[1].y}; *(v4u*)(o + 8) = (v4u){ow[2].x, ow[2].y, ow[3].x, ow[3].y}; }
}
__device__ __forceinline__ void postscan_rows(Frame& F, const InAcc& A) {
    const float* gn_w = A.in[20]; const float* gn_b = A.in[21];
    constexpr int NIT = (M / 16) * 8;
    PsRaw cur, nxt;
    int it = F.gw;
    if (it < NIT) postscan_load(cur, F, 16 * (it >> 3), it & 7);
    while (it < NIT) {
        const int itn = it + F.NGW;
        f32x4 gwv[4], gbv[4]; postscan_gnload(F, gn_w, gn_b, it & 7, gwv, gbv);
        asm volatile("" ::: "memory");
        if (itn < NIT) postscan_load(nxt, F, 16 * (itn >> 3), itn & 7);
        postscan_finish(cur, F, gwv, gbv, 16 * (it >> 3), it & 7);
        cur = nxt; it = itn;
    }
}
__global__ void __launch_bounds__(NWAVES * 64, 2) fwd_kernel(Args args) {
    extern __shared__ __attribute__((aligned(16))) unsigned char lds[];
    Frame F;
    F.lds = (LAS unsigned char*)lds;
    F.MISC = (volatile LAS unsigned*)(F.lds + MISC_OFF);
    F.tid = threadIdx.x; F.lane = F.tid & 63; F.wave = __builtin_amdgcn_readfirstlane(F.tid >> 6);
    F.G = gridDim.x; F.gw = blockIdx.x * NWAVES + F.wave; F.NGW = F.G * NWAVES;
    unsigned char* ws = args.ws;
    F.ctl = (gu32*)(ws + WS_CTL);
    F.out = args.out; F.ws = ws;
    for (int u = F.tid; u < (LDS_BYTES - LDSCTL_OFF) / 4; u += NWAVES * 64) ((LAS unsigned*)(F.lds + LDSCTL_OFF))[u] = 0u;
    __syncthreads();
    if (F.tid == 0) { LAS unsigned long long* pt = (LAS unsigned long long*)(F.lds + PTRS_OFF);
#pragma unroll
        for (int i = 0; i < 30; ++i) pt[i] = (unsigned long long)args.in[i]; }
    __syncthreads();
#if USE_PTR_TABLE
    InAcc A; A.in.t = (LAS unsigned*)(F.lds + PTRS_OFF);
#else
    InAcc A;
#pragma unroll
    for (int i = 0; i < 30; ++i) A.in[i] = args.in[i];
#endif
    XcdBarrier bar; bar.bar = (unsigned*)(F.ctl + CW_BAR); bar.x = 0; bar.st = nullptr;
    if (MK_N_LAUNCHES == 1) bar = xcd_barrier_post((unsigned*)(F.ctl + CW_BAR), F.MISC + 8);
    const int lo = args.ph_lo, hi = args.ph_hi;
#ifndef PH_MASK
#define PH_MASK 0x7fff
#endif
#define IN(k) (((PH_MASK >> (k)) & 1) && lo <= (k) && (k) < hi)
#ifndef DUP_ID
#define DUP_ID -1
#endif
#ifndef SIDE2_MASK
#define SIDE2_MASK 7
#endif
#define DUPN(id) ((DUP_ID == (id)) ? 2 : 1)
#define DUPBAR(r) do { if (r) xcd_barrier(bar); } while (0)
#define SEAM(k) do { if (IN(k) && IN((k) + 1)) xcd_barrier(bar); } while (0)
    float* const H = F.out;

    if (IN(0)) for (int rep_ = 0; rep_ < DUPN(0); ++rep_) { DUPBAR(rep_); p1_mod(F, A); p0_prologue(F, A); }
    SEAM(1);
    if (IN(2)) for (int rep_ = 0; rep_ < DUPN(2); ++rep_) { DUPBAR(rep_); norm_rows_bf16<true>(F, A, A.in[0], A.in[1], false, 0, 1024, 0, 0, 0.f); } SEAM(2);
    if (IN(3)) for (int rep_ = 0; rep_ < DUPN(3); ++rep_) { DUPBAR(rep_); pg8::Gemm g{((bf16*)(F.ws + WS_XN)), ((bf16*)(F.ws + WS_GU1)), M, 2 * FF, D, D}; pg8::StaticOrder S; S.init(M, 2 * FF, D, F.G, (int)blockIdx.x); pg8::EpiSwiglu E{((bf16*)(F.ws + WS_ACT))};
        pg8::gemm_phase<pg8::EpiSwiglu, pg8::StaticOrder, PG8_ALIGN, PG8_SP2>(F.lds + RING_OFF, g, S, E); } SEAM(3);
    if (IN(4)) for (int rep_ = 0; rep_ < DUPN(4); ++rep_) { DUPBAR(rep_); pg8::Gemm g{((bf16*)(F.ws + WS_ACT)), ((bf16*)(F.ws + WS_DN1)), M, D, FF, FF}; pg8::SplitOrder S; S.init(MP, D, FF, 11, F.G, (int)blockIdx.x); pg8::EpiResid<true> E{A.in[0], A.in[1], (bf16*)F.out, ((float*)(F.ws + WS_MOD)) + 2048, 0.5f, (float*)(F.ws + WS_SC)};
        pg8::gemm_phase<pg8::EpiResid<true>, pg8::SplitOrder, PG8_ALIGN, PG8_SP2>(F.lds + RING_OFF, g, S, E); } SEAM(4);
    if (IN(5)) for (int rep_ = 0; rep_ < DUPN(5); ++rep_) { DUPBAR(rep_); norm_rows_bf16<false>(F, A, nullptr, A.in[1], true, 3072, 4096, 11, 2048, 0.5f); } SEAM(5);
    if (IN(6)) for (int rep_ = 0; rep_ < DUPN(6); ++rep_) { DUPBAR(rep_); pg8::Gemm g{((bf16*)(F.ws + WS_XN)), ((bf16*)(F.ws + WS_WIN)), M, PC, D, D}; pg8::StaticOrder S; S.init(M, PC, D, F.G, (int)blockIdx.x); pg8::EpiP E{((bf16*)(F.ws + WS_ACT)), ((bf16*)(F.ws + WS_PUV)), F.out + O_SHP, F.out + O_SHS};
        pg8::gemm_phase<pg8::EpiP, pg8::StaticOrder, PG8_ALIGN, PG8_SP2>(F.lds + RING_OFF, g, S, E); } SEAM(6);
    if (IN(7)) { for (int rep_ = 0; rep_ < DUPN(71); ++rep_) { DUPBAR(rep_); for (int it = F.gw; it < 2 * (MP / 16); it += F.NGW) { if (it & 1) frag_item(F, A, 16 * (it >> 1), 1); else frag_item(F, A, 16 * (it >> 1), 0); } for (int it = F.gw; it < 8 * (MS / 16); it += F.NGW) frag_item_g(F, A, MP + 16 * (it >> 3), it & 7); } for (int rep_ = 0; rep_ < DUPN(72); ++rep_) lnv_rows(F, A); xcd_barrier(bar);
        for (int rep_ = 0; rep_ < DUPN(70); ++rep_) { DUPBAR(rep_); prep_all(F, A); } } SEAM(7);
    if (IN(8)) {
        const int nscan = F.G >= 2 ? F.G / 2 : 1;
        if ((int)blockIdx.x < nscan || F.G < 2) for (int u = blockIdx.x; u < 128; u += nscan) scan_prompt_unit(F, A, u);
        if (F.G < 2) scan_side_work(F, A, F.wave, NWAVES, false);
        else if ((int)blockIdx.x >= nscan) scan_side_work(F, A, ((int)blockIdx.x - nscan) * NWAVES + F.wave, (F.G - nscan) * NWAVES, true);
        else gmlp_light(F, A, (int)blockIdx.x * NWAVES + F.wave, nscan * NWAVES);
    } SEAM(8);
    if (IN(9)) for (int rep_ = 0; rep_ < DUPN(9); ++rep_) { DUPBAR(rep_); postscan_rows(F, A); } SEAM(9);
    if (IN(10)) { pg8::Gemm g{((bf16*)(F.ws + WS_XN)), ((bf16*)(F.ws + WS_WOUT)), M, D, D, D}; pg8::SplitOrder S; S.init(MP, D, D, 4, F.G, (int)blockIdx.x); pg8::EpiResid<false> E{nullptr, nullptr, (bf16*)F.out, ((float*)(F.ws + WS_MOD)) + 5120, 1.0f, (float*)(F.ws + WS_SC)};
        pg8::gemm_phase<pg8::EpiResid<false>, pg8::SplitOrder, PG8_ALIGN, PG8_SP2>(F.lds + RING_OFF, g, S, E); } SEAM(10);
    if (IN(11)) for (int rep_ = 0; rep_ < DUPN(11); ++rep_) { DUPBAR(rep_); norm_rows_bf16<false>(F, A, nullptr, nullptr, false, 6144, 7168, 4, 5120, 1.0f); } SEAM(11);
    if (IN(12)) { pg8::Gemm g{((bf16*)(F.ws + WS_XN)), ((bf16*)(F.ws + WS_GU2)), M, 2 * FF, D, D}; pg8::StaticOrder S; S.init(M, 2 * FF, D, F.G, (int)blockIdx.x); pg8::EpiSwiglu E{((bf16*)(F.ws + WS_ACT))};
        pg8::gemm_phase<pg8::EpiSwiglu, pg8::StaticOrder, PG8_ALIGN, PG8_SP2>(F.lds + RING_OFF, g, S, E); } SEAM(12);
    if (IN(13)) { pg8::Gemm g{((bf16*)(F.ws + WS_ACT)), ((bf16*)(F.ws + WS_DN2)), M, D, FF, FF}; pg8::SplitOrder S; S.init(MP, D, FF, 11, F.G, (int)blockIdx.x); pg8::EpiResid<false> E{nullptr, nullptr, (bf16*)F.out, ((float*)(F.ws + WS_MOD)) + 8192, 0.5f, (float*)(F.ws + WS_SC)};
        pg8::gemm_phase<pg8::EpiResid<false>, pg8::SplitOrder, PG8_ALIGN, PG8_SP2>(F.lds + RING_OFF, g, S, E); } SEAM(13);
    if (IN(14)) { final_norm_rows(F, A, 11, 8192, 0.5f); }
#undef IN
#undef SEAM
}

extern "C" void kernel_launch(void* const* d_in, const int* in_sizes, int n_in, void* d_out, int out_size, void* d_ws, size_t ws_size, hipStream_t stream) {
    static int grid = 0;
    if (grid == 0) {
        if (n_in != 30 || in_sizes[0] != MP * D || (size_t)out_size != O_END || ws_size < WS_END) { fprintf(stderr, "kernel_launch: unexpected problem shape / workspace (%d inputs, out %d, ws %zu); nothing launched\n", n_in, out_size, ws_size); grid = -1; return; }
        int dev = 0, cus = 0, per_cu = 0;
        if (hipGetDevice(&dev) != hipSuccess || hipDeviceGetAttribute(&cus, hipDeviceAttributeMultiprocessorCount, dev) != hipSuccess) { grid = -1; return; }
        if (hipFuncSetAttribute((const void*)fwd_kernel, hipFuncAttributeMaxDynamicSharedMemorySize, LDS_BYTES) != hipSuccess) { fprintf(stderr, "kernel_launch: hipFuncSetAttribute failed\n"); grid = -1; return; }
        if (hipOccupancyMaxActiveBlocksPerMultiprocessor(&per_cu, (const void*)fwd_kernel, NWAVES * 64, LDS_BYTES) != hipSuccess || per_cu < 1) { fprintf(stderr, "kernel_launch: occupancy query says %d blocks per CU\n", per_cu); }
        (void)hipGetLastError();
        grid = cus;
    }
    if (grid < 0) return;
    (void)hipMemsetAsync((char*)d_ws + WS_CTL, 0, CTL_ZERO_BYTES, stream);
    Args a{};
    for (int i = 0; i < 30; ++i) a.in[i] = (const float*)d_in[i];
    a.out = (float*)d_out; a.ws = (unsigned char*)d_ws;
    if (MK_N_LAUNCHES == 1) { a.ph_lo = 0; a.ph_hi = N_PHASES; hipLaunchKernelGGL(fwd_kernel, dim3(grid), dim3(NWAVES * 64), LDS_BYTES, stream, a); }
    else for (int p = 0; p < N_PHASES; ++p) { a.ph_lo = p; a.ph_hi = p + 1; hipLaunchKernelGGL(fwd_kernel, dim3(grid), dim3(NWAVES * 64), LDS_BYTES, stream, a); }
}
```
